# Optimizing an MI355X kernel written in HIP

```python
import math
import jax, jax.numpy as jnp
from jax import lax
import numpy as np

D_MODEL = 2048
BATCH = 2
SEQ = 4096
DEPTH = 1

MEM_LEN = 256

MIX_WIDTH = D_MODEL
POOL_WIDTH = D_MODEL // 4
POOL_WINDOWS = (2, 4, 8, 16)
POOL_GROUP = POOL_WIDTH // len(POOL_WINDOWS)
SWA_HEAD_DIM = 64
SWA_WIDTH = D_MODEL // 2
SWA_HEADS = SWA_WIDTH // SWA_HEAD_DIM
SWA_KV_HEADS = 4
SWA_KV_WIDTH = SWA_KV_HEADS * SWA_HEAD_DIM
WINDOW = 128
BLOCK = 128
ROPE_THETA = 500000.0
ROPE_DIM = SWA_HEAD_DIM // 4
MEM_HEADS = 4
MEM_WIDTH = D_MODEL // 4
MEM_HEAD_DIM = MEM_WIDTH // MEM_HEADS
IN_WIDTH = POOL_WIDTH + SWA_WIDTH + 2 * SWA_KV_WIDTH + MEM_WIDTH

PEER_HEADS = 8
N_KEYS = 128
N_EXPERTS = N_KEYS * N_KEYS
PEER_TOPK = 16
QUERY_DIM = 256
HALF_DIM = QUERY_DIM // 2
PEER_CHUNK = 128

ALPHA = (2.0 * DEPTH) ** 0.25
BETA = (8.0 * DEPTH) ** -0.25
LN_EPS = 1e-5
NEG = -1e30

kernel_name = "hymba_pool_swa_mem_peer_deepnorm"


def layer_norm(x, g, b):
    xf = x.astype(jnp.float32)
    mu = xf.mean(-1, keepdims=True)
    var = jnp.square(xf - mu).mean(-1, keepdims=True)
    y = (xf - mu) * lax.rsqrt(var + LN_EPS) * g.astype(jnp.float32) + b.astype(jnp.float32)
    return y.astype(x.dtype)


def partial_rope(t, positions):
    half = ROPE_DIM // 2
    inv_freq = ROPE_THETA ** (-jnp.arange(0, ROPE_DIM, 2, dtype=jnp.float32) / ROPE_DIM)
    ang = positions.astype(jnp.float32)[:, :, None] * inv_freq
    cos = jnp.cos(ang)[:, :, None, :]
    sin = jnp.sin(ang)[:, :, None, :]
    tf = t.astype(jnp.float32)
    t1, t2, rest = tf[..., :half], tf[..., half:ROPE_DIM], tf[..., ROPE_DIM:]
    out = jnp.concatenate([t1 * cos - t2 * sin, t2 * cos + t1 * sin, rest], axis=-1)
    return out.astype(t.dtype)


def multiscale_pool(v, w_pool, pool_scale):
    B, S, C = v.shape
    vf = v.astype(jnp.float32)
    csum = jnp.cumsum(vf, axis=1)
    outs = []
    for g, w in enumerate(POOL_WINDOWS):
        sl = slice(g * POOL_GROUP, (g + 1) * POOL_GROUP)
        cg = csum[..., sl]
        shifted = jnp.pad(cg, ((0, 0), (w, 0), (0, 0)))[:, :S]
        count = jnp.minimum(jnp.arange(1, S + 1), w).astype(jnp.float32)[None, :, None]
        outs.append((cg - shifted) / count - vf[..., sl])
    pooled = jnp.stack(outs, axis=2).astype(v.dtype)
    y = jnp.einsum('bsgc,gcd->bsgd', pooled, w_pool).reshape(B, S, C)
    return y * pool_scale


def sliding_window_attention(q, k, v, sinks):
    B, S, H, Dh = q.shape
    KV = SWA_KV_HEADS
    G = H // KV
    nb = S // BLOCK
    qb = q.reshape(B, nb, BLOCK, KV, G, Dh)
    pad = jnp.zeros((B, BLOCK, KV, Dh), k.dtype)
    kp = jnp.concatenate([pad, k], axis=1).reshape(B, nb + 1, BLOCK, KV, Dh)
    vp = jnp.concatenate([pad, v], axis=1).reshape(B, nb + 1, BLOCK, KV, Dh)
    kb = jnp.concatenate([kp[:, :-1], kp[:, 1:]], axis=2)
    vb = jnp.concatenate([vp[:, :-1], vp[:, 1:]], axis=2)
    s = jnp.einsum('bnqkgd,bnskd->bnkgqs', qb, kb).astype(jnp.float32) * (Dh ** -0.5)
    blk = jnp.arange(nb)[:, None] * BLOCK
    q_pos = blk + jnp.arange(BLOCK)[None, :]
    k_pos = blk - BLOCK + jnp.arange(2 * BLOCK)[None, :]
    rel = q_pos[:, :, None] - k_pos[:, None, :]
    valid = (rel >= 0) & (rel < WINDOW) & (k_pos[:, None, :] >= 0)
    s = jnp.where(valid[None, :, None, None], s, NEG)
    sink = sinks.astype(jnp.float32).reshape(KV, G)[None, None, :, :, None, None]
    m = jnp.maximum(s.max(-1, keepdims=True), sink)
    p = jnp.exp(s - m)
    p = p / (p.sum(-1, keepdims=True) + jnp.exp(sink - m))
    o = jnp.einsum('bnkgqs,bnskd->bnqkgd', p.astype(v.dtype), vb)
    return o.reshape(B, S, H * Dh)


def memory_attention(qm, km, vm):
    B, S = qm.shape[:2]
    s = jnp.einsum('bshd,bmhd->bhsm', qm, km).astype(jnp.float32) * (MEM_HEAD_DIM ** -0.5)
    p = jax.nn.softmax(s, axis=-1).astype(vm.dtype)
    o = jnp.einsum('bhsm,bmhd->bshd', p, vm)
    return o.reshape(B, S, MEM_WIDTH)


def peer(x, w_peer_q, sub_keys_1, sub_keys_2, expert_u, expert_v):
    B, S, D = x.shape
    q = (x @ w_peer_q).reshape(B, S, PEER_HEADS, 2, HALF_DIM)
    s1 = jnp.einsum('bshc,kc->bshk', q[..., 0, :], sub_keys_1).astype(jnp.float32)
    s2 = jnp.einsum('bshc,kc->bshk', q[..., 1, :], sub_keys_2).astype(jnp.float32)
    v1, i1 = lax.top_k(s1, PEER_TOPK)
    v2, i2 = lax.top_k(s2, PEER_TOPK)
    cand_s = (v1[..., :, None] + v2[..., None, :]).reshape(B, S, PEER_HEADS, PEER_TOPK * PEER_TOPK)
    cand_i = (i1[..., :, None] * N_KEYS + i2[..., None, :]).reshape(B, S, PEER_HEADS, PEER_TOPK * PEER_TOPK)
    top_s, pos = lax.top_k(cand_s, PEER_TOPK)
    idx = jnp.take_along_axis(cand_i, pos, axis=-1)
    gate = jax.nn.softmax(top_s, axis=-1).astype(x.dtype)
    T = B * S
    nc = T // PEER_CHUNK
    E = PEER_HEADS * PEER_TOPK
    xc = x.reshape(nc, PEER_CHUNK, D)
    ic = idx.reshape(nc, PEER_CHUNK, E)
    gc = gate.reshape(nc, PEER_CHUNK, E)

    def block(args):
        xb, ib, gb = args
        u = expert_u[ib]
        h = jnp.einsum('cd,ced->ce', xb, u)
        a = gb * jax.nn.gelu(h, approximate=False)
        return jnp.einsum('ce,ced->cd', a, expert_v[ib])

    out = lax.map(block, (xc, ic, gc))
    return out.reshape(B, S, D)


def setup_inputs(seed: int = 0) -> dict:
    key = jax.random.key(seed)
    ks = jax.random.split(key, 20)
    f32 = jnp.float32
    L, D = DEPTH, D_MODEL
    nrm = lambda k, shape, scale: jax.random.normal(k, shape, f32) * scale
    return {
        "x": nrm(ks[0], (BATCH, SEQ, D), 1.0),
        "mem": nrm(ks[1], (BATCH, MEM_LEN, D), 1.0),
        "positions": jnp.broadcast_to(jnp.arange(SEQ, dtype=jnp.int32)[None, :], (BATCH, SEQ)),
        "w_in": nrm(ks[2], (L, D, IN_WIDTH), D ** -0.5),
        "w_mem_kv": nrm(ks[3], (L, D, 2 * MEM_WIDTH), D ** -0.5),
        "w_pool": nrm(ks[4], (L, len(POOL_WINDOWS), POOL_GROUP, POOL_GROUP), POOL_GROUP ** -0.5),
        "pool_scale": 1.0 + nrm(ks[5], (L, POOL_WIDTH), 0.02),
        "attn_sinks": nrm(ks[6], (L, SWA_HEADS), 0.5),
        "w_out": nrm(ks[7], (L, MIX_WIDTH, D), BETA * MIX_WIDTH ** -0.5),
        "ln1_g": 1.0 + nrm(ks[8], (L, D), 0.02),
        "ln1_b": nrm(ks[9], (L, D), 0.02),
        "w_peer_q": nrm(ks[10], (L, D, PEER_HEADS * QUERY_DIM), D ** -0.5),
        "sub_keys_1": nrm(ks[11], (L, N_KEYS, HALF_DIM), HALF_DIM ** -0.5),
        "sub_keys_2": nrm(ks[12], (L, N_KEYS, HALF_DIM), HALF_DIM ** -0.5),
        "expert_u": nrm(ks[13], (L, N_EXPERTS, D), D ** -0.5),
        "expert_v": nrm(ks[14], (L, N_EXPERTS, D), BETA),
        "ln2_g": 1.0 + nrm(ks[15], (L, D), 0.02),
        "ln2_b": nrm(ks[16], (L, D), 0.02),
    }


def reference(x, mem, positions, w_in, w_mem_kv, w_pool, pool_scale, attn_sinks, w_out,
              ln1_g, ln1_b, w_peer_q, sub_keys_1, sub_keys_2, expert_u, expert_v, ln2_g, ln2_b):
    B, S, D = x.shape
    offs = np.cumsum([POOL_WIDTH, SWA_WIDTH, SWA_KV_WIDTH, SWA_KV_WIDTH]).tolist()
    for l in range(DEPTH):
        h = x @ w_in[l]
        pool_v, q, k, v, qm = jnp.split(h, offs, axis=-1)
        pool_out = multiscale_pool(pool_v, w_pool[l], pool_scale[l])
        q = partial_rope(q.reshape(B, S, SWA_HEADS, SWA_HEAD_DIM), positions)
        k = partial_rope(k.reshape(B, S, SWA_KV_HEADS, SWA_HEAD_DIM), positions)
        v = v.reshape(B, S, SWA_KV_HEADS, SWA_HEAD_DIM)
        swa_out = sliding_window_attention(q, k, v, attn_sinks[l])
        kvm = mem @ w_mem_kv[l]
        km, vm = jnp.split(kvm, 2, axis=-1)
        Mn = mem.shape[1]
        mem_out = memory_attention(qm.reshape(B, S, MEM_HEADS, MEM_HEAD_DIM),
                                   km.reshape(B, Mn, MEM_HEADS, MEM_HEAD_DIM),
                                   vm.reshape(B, Mn, MEM_HEADS, MEM_HEAD_DIM))
        mix = jnp.concatenate([pool_out, swa_out, mem_out], axis=-1) @ w_out[l]
        x = layer_norm(ALPHA * x + mix, ln1_g[l], ln1_b[l])
        ff = peer(x, w_peer_q[l], sub_keys_1[l], sub_keys_2[l], expert_u[l], expert_v[l])
        x = layer_norm(ALPHA * x + ff, ln2_g[l], ln2_b[l])
    return x
```

```cpp
#include <hip/hip_runtime.h>
#include <cstdint>
#include <cstdio>

constexpr int D_MODEL = 2048, BATCH = 2, SEQ = 4096, MTOK = BATCH * SEQ, MEM_LEN = 256, MMEM = BATCH * MEM_LEN;
constexpr int POOL_W = 512, SWA_W = 1024, KV_W = 256, MEM_W = 512, IN_W = 2560;
constexpr int NHEAD = 16, NKV = 4, HD = 64, WINDOW = 128, MHEADS = 4, MHD = 128;
constexpr int PHEADS = 8, NKEYS = 128, TOPK = 16, NEXP = NKEYS * NKEYS, EPT = PHEADS * TOPK;
constexpr float ALPHA = 1.18920711500272106672f;
constexpr float LN_EPS = 1e-5f;

typedef unsigned short bf16_t;
__device__ __forceinline__ float bf2f(bf16_t v) { return __uint_as_float((unsigned)v << 16); }
__device__ __forceinline__ bf16_t f2bf(float f) { unsigned u = __float_as_uint(f); return (bf16_t)((u + 0x7fffu + ((u >> 16) & 1u)) >> 16); }

constexpr size_t MiB = 1u << 20;
constexpr size_t WS_CTL = 0, WS_WINT = 1 * MiB, WS_WKVT = 11 * MiB, WS_WOT = 15 * MiB, WS_WQT = 23 * MiB, WS_SMALL = 31 * MiB;
constexpr size_t WS_XB = 32 * MiB, WS_X1B = 32 * MiB  , WS_MEMB = 64 * MiB, WS_KVM = 66 * MiB;
constexpr size_t WS_POOLV = 68 * MiB, WS_Q = 84 * MiB, WS_K = 100 * MiB, WS_V = 104 * MiB, WS_QM = 108 * MiB, WS_CONCAT = 116 * MiB;
constexpr size_t WS_Y1 = 148 * MiB, WS_X1 = 212 * MiB, WS_QP = 276 * MiB, WS_EIDX = 308 * MiB, WS_GATE = 312 * MiB, WS_UB = 316 * MiB, WS_VB = 380 * MiB, WS_END = 444 * MiB;
constexpr size_t WS_NV_H = 148 * MiB  , WS_NV_PS = 232 * MiB, WS_NV_KVM = 248 * MiB;

__device__ __forceinline__ void rope_cs(int pos, int j, float& c, float& s) {
    const double invf[8] = {1.0, 0.19392274474868576, 0.03760603093086393, 0.007292664737217109, 0.001414213562373095, 0.0002742481756762073, 5.318295896944988e-05, 1.031338537721246e-05};
    double f = j == 0 ? invf[0] : j == 1 ? invf[1] : j == 2 ? invf[2] : j == 3 ? invf[3] : j == 4 ? invf[4] : j == 5 ? invf[5] : j == 6 ? invf[6] : invf[7];
    double rev = (double)pos * f * 0.15915494309189533577;
    rev -= floor(rev);
    float fr = (float)rev;
    s = __builtin_amdgcn_sinf(fr); c = __builtin_amdgcn_cosf(fr);
}
__device__ __forceinline__ float gelu_erf(float h) { return 0.5f * h * (1.0f + erff(h * 0.70710678118654752440f)); }
__device__ __forceinline__ float wave_sum(float v) {
#pragma unroll
    for (int o = 1; o < 64; o <<= 1) v += __shfl_xor(v, o);
    return v;
}

__device__ __forceinline__ float toF(float v) { return v; }
__device__ __forceinline__ float toF(bf16_t v) { return bf2f(v); }

struct EpiF32 { float* C; int ldc, pad; __device__ void operator()(int r, int c, float v) const { C[(size_t)r * ldc + c] = v; } };
struct EpiBf { bf16_t* C; int ldc, pad; __device__ void operator()(int r, int c, float v) const { C[(size_t)r * ldc + c] = f2bf(v); } };
struct EpiY1 { const float* x; float* y; __device__ void operator()(int r, int c, float v) const { y[(size_t)r * D_MODEL + c] = ALPHA * x[(size_t)r * D_MODEL + c] + v; } };

template <class TA, class Epi>
__global__ void __launch_bounds__(256) nv_gemm(const TA* __restrict__ A, const float* __restrict__ B, int M, int N, int K, Epi epi) {
    __shared__ float As[16][65];
    __shared__ float Bs[16][64];
    const int tx = threadIdx.x & 15, ty = threadIdx.x >> 4;
    const int m0 = blockIdx.y * 64, n0 = blockIdx.x * 64;
    float acc[4][4];
#pragma unroll
    for (int i = 0; i < 4; ++i)
#pragma unroll
        for (int j = 0; j < 4; ++j) acc[i][j] = 0.f;
    for (int k0 = 0; k0 < K; k0 += 16) {
        for (int i = threadIdx.x; i < 1024; i += 256) { const int r = i >> 4, c = i & 15; As[c][r] = toF(A[(size_t)(m0 + r) * K + k0 + c]); }
        for (int i = threadIdx.x; i < 1024; i += 256) { const int r = i >> 6, c = i & 63; Bs[r][c] = B[(size_t)(k0 + r) * N + n0 + c]; }
        __syncthreads();
#pragma unroll
        for (int kk = 0; kk < 16; ++kk) {
            float a[4], b[4];
#pragma unroll
            for (int i = 0; i < 4; ++i) { a[i] = As[kk][ty * 4 + i]; b[i] = Bs[kk][tx * 4 + i]; }
#pragma unroll
            for (int i = 0; i < 4; ++i)
#pragma unroll
                for (int j = 0; j < 4; ++j) acc[i][j] += a[i] * b[j];
        }
        __syncthreads();
    }
#pragma unroll
    for (int i = 0; i < 4; ++i)
#pragma unroll
        for (int j = 0; j < 4; ++j) epi(m0 + ty * 4 + i, n0 + tx * 4 + j, acc[i][j]);
}

__global__ void nv_post1(const float* __restrict__ H, const int* __restrict__ positions, float* POOLV, bf16_t* Q, bf16_t* Kb, bf16_t* Vb, bf16_t* QM) {
    const size_t gid = (size_t)blockIdx.x * blockDim.x + threadIdx.x;
    if (gid >= (size_t)MTOK * IN_W) return;
    const int t = (int)(gid / IN_W), col = (int)(gid % IN_W);
    const float* hr = H + (size_t)t * IN_W;
    const float v = hr[col];
    if (col < POOL_W) { POOLV[(size_t)t * POOL_W + col] = v; return; }
    if (col < POOL_W + SWA_W + KV_W) {
        const bool isq = col < POOL_W + SWA_W;
        const int c = isq ? col - POOL_W : col - POOL_W - SWA_W;
        const int d = c & 63;
        float o = v;
        if (d < 16) {
            const int j = d & 7; float cs, sn; rope_cs(positions[t], j, cs, sn);
            if (d < 8) o = v * cs - hr[col + 8] * sn; else o = v * cs + hr[col - 8] * sn;
        }
        if (isq) Q[(size_t)t * SWA_W + c] = f2bf(o); else Kb[(size_t)t * KV_W + c] = f2bf(o);
        return;
    }
    if (col < POOL_W + SWA_W + 2 * KV_W) { Vb[(size_t)t * KV_W + (col - POOL_W - SWA_W - KV_W)] = f2bf(v); return; }
    QM[(size_t)t * MEM_W + (col - POOL_W - SWA_W - 2 * KV_W)] = f2bf(v);
}
__global__ void nv_cvt_bf16(const float* __restrict__ in, bf16_t* out, size_t n) {
    const size_t gid = (size_t)blockIdx.x * blockDim.x + threadIdx.x;
    if (gid < n) out[gid] = f2bf(in[gid]);
}
__global__ void nv_pool1(const float* __restrict__ POOLV, float* PS) {
    const size_t gid = (size_t)blockIdx.x * blockDim.x + threadIdx.x;
    if (gid >= (size_t)MTOK * POOL_W) return;
    const int t = (int)(gid / POOL_W), ch = (int)(gid % POOL_W);
    const int g = ch >> 7, w = 2 << g, s = t & (SEQ - 1);
    const int cnt = (s + 1) < w ? (s + 1) : w;
    float sum = 0.f;
    for (int i = 0; i < cnt; ++i) sum += POOLV[(size_t)(t - i) * POOL_W + ch];
    PS[gid] = sum / (float)cnt - POOLV[gid];
}
__global__ void nv_pool2(const float* __restrict__ PS, const float* __restrict__ w_pool, const float* __restrict__ pool_scale, bf16_t* CONCAT) {
    const size_t gid = (size_t)blockIdx.x * blockDim.x + threadIdx.x;
    if (gid >= (size_t)MTOK * POOL_W) return;
    const int t = (int)(gid / POOL_W), ch = (int)(gid % POOL_W);
    const int g = ch >> 7, d = ch & 127;
    const float* p = PS + (size_t)t * POOL_W + g * 128;
    const float* w = w_pool + (size_t)g * 128 * 128 + d;
    float y = 0.f;
    for (int c = 0; c < 128; ++c) y += p[c] * w[(size_t)c * 128];
    CONCAT[(size_t)t * D_MODEL + ch] = f2bf(y * pool_scale[ch]);
}
__global__ void __launch_bounds__(256) nv_swa(const bf16_t* __restrict__ Q, const bf16_t* __restrict__ Kb, const bf16_t* __restrict__ Vb, const float* __restrict__ sinks, bf16_t* CONCAT) {
    const int wv = (int)((blockIdx.x * 256 + threadIdx.x) >> 6), lane = threadIdx.x & 63;
    if (wv >= MTOK * NHEAD) return;
    const int t = wv / NHEAD, h = wv % NHEAD, kvh = h >> 2, s = t & (SEQ - 1), tb = t - s;
    const float q = bf2f(Q[(size_t)t * SWA_W + h * HD + lane]);
    float m = sinks[h], l = 1.0f, o = 0.f;
    const int k0 = s - (WINDOW - 1) < 0 ? 0 : s - (WINDOW - 1);
    for (int kk = k0; kk <= s; ++kk) {
        const size_t kt = (size_t)(tb + kk);
        const float sc = wave_sum(q * bf2f(Kb[kt * KV_W + kvh * HD + lane])) * 0.125f;
        const float mn = fmaxf(m, sc), r = expf(m - mn), p = expf(sc - mn);
        l = l * r + p; o = o * r + p * bf2f(Vb[kt * KV_W + kvh * HD + lane]); m = mn;
    }
    CONCAT[(size_t)t * D_MODEL + POOL_W + h * HD + lane] = f2bf(o / l);
}
__global__ void __launch_bounds__(256) nv_mem(const bf16_t* __restrict__ QM, const bf16_t* __restrict__ KVM, bf16_t* CONCAT) {
    const int wv = (int)((blockIdx.x * 256 + threadIdx.x) >> 6), lane = threadIdx.x & 63;
    if (wv >= MTOK * MHEADS) return;
    const int t = wv / MHEADS, hm = wv % MHEADS, b = t / SEQ;
    const float q0 = bf2f(QM[(size_t)t * MEM_W + hm * MHD + lane]), q1 = bf2f(QM[(size_t)t * MEM_W + hm * MHD + 64 + lane]);
    float m = -1e30f, l = 0.f, o0 = 0.f, o1 = 0.f;
    const float scale = 0.08838834764831845f;
    for (int j = 0; j < MEM_LEN; ++j) {
        const bf16_t* kr = KVM + (size_t)(b * MEM_LEN + j) * (2 * MEM_W) + hm * MHD;
        const bf16_t* vr = kr + MEM_W;
        const float sc = wave_sum(q0 * bf2f(kr[lane]) + q1 * bf2f(kr[64 + lane])) * scale;
        const float mn = fmaxf(m, sc), r = expf(m - mn), p = expf(sc - mn);
        l = l * r + p; o0 = o0 * r + p * bf2f(vr[lane]); o1 = o1 * r + p * bf2f(vr[64 + lane]); m = mn;
    }
    bf16_t* orow = CONCAT + (size_t)t * D_MODEL + POOL_W + SWA_W + hm * MHD;
    orow[lane] = f2bf(o0 / l); orow[64 + lane] = f2bf(o1 / l);
}
__global__ void __launch_bounds__(256) nv_ln(const float* __restrict__ in, const float* __restrict__ g, const float* __restrict__ bta, float* outf, bf16_t* outb) {
    const int row = (int)((blockIdx.x * 256 + threadIdx.x) >> 6), lane = threadIdx.x & 63;
    if (row >= MTOK) return;
    const float* r = in + (size_t)row * D_MODEL;
    float v[32]; float s = 0.f;
#pragma unroll
    for (int i = 0; i < 32; ++i) { v[i] = r[lane + 64 * i]; s += v[i]; }
    const float mean = wave_sum(s) * (1.f / D_MODEL); float q = 0.f;
#pragma unroll
    for (int i = 0; i < 32; ++i) { v[i] -= mean; q += v[i] * v[i]; }
    const float rstd = 1.0f / sqrtf(wave_sum(q) * (1.f / D_MODEL) + LN_EPS);
#pragma unroll
    for (int i = 0; i < 32; ++i) {
        const int c = lane + 64 * i; const float y = v[i] * rstd * g[c] + bta[c];
        if (outf) outf[(size_t)row * D_MODEL + c] = y;
        if (outb) outb[(size_t)row * D_MODEL + c] = f2bf(y);
    }
}
__global__ void __launch_bounds__(32) nv_topk(const bf16_t* __restrict__ QP, const float* __restrict__ K1, const float* __restrict__ K2, int* EIDX, float* GATE) {
    __shared__ float sc[256][32];
    __shared__ float lv[32][32];
    __shared__ int li[32][32];
    const int tid = threadIdx.x, gid = blockIdx.x * 32 + tid;
    const int t = gid / PHEADS, h = gid % PHEADS;
    const bf16_t* q = QP + (size_t)t * D_MODEL + h * 256;
    for (int half = 0; half < 2; ++half) {
        const float* Kk = half ? K2 : K1;
        for (int k = 0; k < NKEYS; ++k) {
            float a = 0.f;
            for (int c = 0; c < 128; ++c) a += bf2f(q[half * 128 + c]) * Kk[k * 128 + c];
            sc[half * 128 + k][tid] = a;
        }
        for (int r = 0; r < TOPK; ++r) {
            float best = -INFINITY; int bi = 0;
            for (int k = 0; k < NKEYS; ++k) { const float v = sc[half * 128 + k][tid]; if (v > best) { best = v; bi = k; } }
            lv[half * 16 + r][tid] = best; li[half * 16 + r][tid] = bi; sc[half * 128 + bi][tid] = -INFINITY;
        }
    }
    for (int a = 0; a < 16; ++a) for (int b = 0; b < 16; ++b) sc[a * 16 + b][tid] = lv[a][tid] + lv[16 + b][tid];
    float mx = 0.f, den = 0.f;
    float tv[16]; int ti[16];
#pragma unroll
    for (int r = 0; r < TOPK; ++r) {
        float best = -INFINITY; int bi = 0;
        for (int k = 0; k < 256; ++k) { const float v = sc[k][tid]; if (v > best) { best = v; bi = k; } }
        sc[bi][tid] = -INFINITY;
        if (r == 0) mx = best;
        tv[r] = expf(best - mx); den += tv[r]; ti[r] = li[bi >> 4][tid] * NKEYS + li[16 + (bi & 15)][tid];
    }
#pragma unroll
    for (int r = 0; r < TOPK; ++r) { EIDX[(size_t)t * EPT + h * TOPK + r] = ti[r]; GATE[(size_t)t * EPT + h * TOPK + r] = tv[r] / den; }
}
__global__ void __launch_bounds__(256) nv_gather(const float* __restrict__ X1, const int* __restrict__ EIDX, const float* __restrict__ GATE, const float* __restrict__ EU, const float* __restrict__ EV,
                                                  const float* __restrict__ g, const float* __restrict__ bta, float* out) {
    const int t = (int)((blockIdx.x * 256 + threadIdx.x) >> 6), lane = threadIdx.x & 63;
    if (t >= MTOK) return;
    float x[32], acc[32];
#pragma unroll
    for (int i = 0; i < 32; ++i) { x[i] = X1[(size_t)t * D_MODEL + lane + 64 * i]; acc[i] = 0.f; }
    for (int e = 0; e < EPT; ++e) {
        const int id = EIDX[(size_t)t * EPT + e]; const float gt = GATE[(size_t)t * EPT + e];
        const float* u = EU + (size_t)id * D_MODEL; const float* vv = EV + (size_t)id * D_MODEL;
        float p = 0.f;
#pragma unroll
        for (int i = 0; i < 32; ++i) p += x[i] * u[lane + 64 * i];
        const float a = gt * gelu_erf(wave_sum(p));
#pragma unroll
        for (int i = 0; i < 32; ++i) acc[i] += a * vv[lane + 64 * i];
    }
    float s = 0.f;
#pragma unroll
    for (int i = 0; i < 32; ++i) { acc[i] = ALPHA * x[i] + acc[i]; s += acc[i]; }
    const float mean = wave_sum(s) * (1.f / D_MODEL); float q = 0.f;
#pragma unroll
    for (int i = 0; i < 32; ++i) { acc[i] -= mean; q += acc[i] * acc[i]; }
    const float rstd = 1.0f / sqrtf(wave_sum(q) * (1.f / D_MODEL) + LN_EPS);
#pragma unroll
    for (int i = 0; i < 32; ++i) { const int c = lane + 64 * i; out[(size_t)t * D_MODEL + c] = acc[i] * rstd * g[c] + bta[c]; }
}

extern "C" void kernel_launch(void* const* d_in, const int* in_sizes, int n_in, void* d_out, int out_size, void* d_ws, size_t ws_size, hipStream_t stream) {
    if (n_in != 18 || in_sizes[0] != MTOK * D_MODEL || out_size != MTOK * D_MODEL || ws_size < WS_END) {
        fprintf(stderr, "kernel_launch: unexpected shapes (n_in %d, in0 %d, out %d, ws %zu)\n", n_in, n_in > 0 ? in_sizes[0] : -1, out_size, ws_size); return; }
    const float* x = (const float*)d_in[0]; const float* mem = (const float*)d_in[1]; const int* positions = (const int*)d_in[2];
    const float* w_in = (const float*)d_in[3]; const float* w_mem_kv = (const float*)d_in[4]; const float* w_pool = (const float*)d_in[5];
    const float* pool_scale = (const float*)d_in[6]; const float* sinks = (const float*)d_in[7]; const float* w_out = (const float*)d_in[8];
    const float* ln1_g = (const float*)d_in[9]; const float* ln1_b = (const float*)d_in[10]; const float* w_peer_q = (const float*)d_in[11];
    const float* sk1 = (const float*)d_in[12]; const float* sk2 = (const float*)d_in[13]; const float* eu = (const float*)d_in[14]; const float* ev = (const float*)d_in[15];
    const float* ln2_g = (const float*)d_in[16]; const float* ln2_b = (const float*)d_in[17];
    unsigned char* ws = (unsigned char*)d_ws; float* out = (float*)d_out;
    float* POOLV = (float*)(ws + WS_POOLV); bf16_t* Q = (bf16_t*)(ws + WS_Q); bf16_t* Kb = (bf16_t*)(ws + WS_K); bf16_t* Vb = (bf16_t*)(ws + WS_V); bf16_t* QM = (bf16_t*)(ws + WS_QM);
    bf16_t* KVM = (bf16_t*)(ws + WS_KVM); bf16_t* CONCAT = (bf16_t*)(ws + WS_CONCAT); float* Y1 = (float*)(ws + WS_Y1); float* X1 = (float*)(ws + WS_X1); bf16_t* X1B = (bf16_t*)(ws + WS_X1B);
    bf16_t* QP = (bf16_t*)(ws + WS_QP); int* EIDX = (int*)(ws + WS_EIDX); float* GATE = (float*)(ws + WS_GATE);
    float* NVH = (float*)(ws + WS_NV_H); float* NVPS = (float*)(ws + WS_NV_PS); float* NVKVM = (float*)(ws + WS_NV_KVM);

    nv_gemm<float, EpiF32><<<dim3(IN_W / 64, MTOK / 64), 256, 0, stream>>>(x, w_in, MTOK, IN_W, D_MODEL, EpiF32{NVH, IN_W, 0});
    nv_gemm<float, EpiF32><<<dim3(2 * MEM_W / 64, MMEM / 64), 256, 0, stream>>>(mem, w_mem_kv, MMEM, 2 * MEM_W, D_MODEL, EpiF32{NVKVM, 2 * MEM_W, 0});
    nv_post1<<<(unsigned)(((size_t)MTOK * IN_W + 255) / 256), 256, 0, stream>>>(NVH, positions, POOLV, Q, Kb, Vb, QM);
    nv_cvt_bf16<<<(MMEM * 2 * MEM_W + 255) / 256, 256, 0, stream>>>(NVKVM, KVM, (size_t)MMEM * 2 * MEM_W);
    nv_pool1<<<MTOK * POOL_W / 256, 256, 0, stream>>>(POOLV, NVPS);
    nv_pool2<<<MTOK * POOL_W / 256, 256, 0, stream>>>(NVPS, w_pool, pool_scale, CONCAT);
    nv_swa<<<MTOK * NHEAD / 4, 256, 0, stream>>>(Q, Kb, Vb, sinks, CONCAT);
    nv_mem<<<MTOK * MHEADS / 4, 256, 0, stream>>>(QM, KVM, CONCAT);
    nv_gemm<bf16_t, EpiY1><<<dim3(D_MODEL / 64, MTOK / 64), 256, 0, stream>>>(CONCAT, w_out, MTOK, D_MODEL, D_MODEL, EpiY1{x, Y1});
    nv_ln<<<MTOK / 4, 256, 0, stream>>>(Y1, ln1_g, ln1_b, X1, X1B);
    nv_gemm<float, EpiBf><<<dim3(D_MODEL / 64, MTOK / 64), 256, 0, stream>>>(X1, w_peer_q, MTOK, D_MODEL, D_MODEL, EpiBf{QP, D_MODEL, 0});
    nv_topk<<<MTOK * PHEADS / 32, 32, 0, stream>>>(QP, sk1, sk2, EIDX, GATE);
    nv_gather<<<MTOK / 4, 256, 0, stream>>>(X1, EIDX, GATE, eu, ev, ln2_g, ln2_b, out);
}
```

```cpp
#include <hip/hip_runtime.h>
#include <cstdint>
#include <cstdio>
#ifndef NAIVE_MASK
#define NAIVE_MASK 0
#endif

constexpr int D_MODEL = 2048, BATCH = 2, SEQ = 4096, MTOK = BATCH * SEQ, MEM_LEN = 256, MMEM = BATCH * MEM_LEN;
constexpr int POOL_W = 512, SWA_W = 1024, KV_W = 256, MEM_W = 512, IN_W = 2560;
constexpr int NHEAD = 16, NKV = 4, HD = 64, WINDOW = 128, MHEADS = 4, MHD = 128;
constexpr int PHEADS = 8, NKEYS = 128, TOPK = 16, NEXP = NKEYS * NKEYS, EPT = PHEADS * TOPK;
constexpr float ALPHA = 1.18920711500272106672f;
constexpr float LN_EPS = 1e-5f;

typedef unsigned short bf16_t;
__device__ __forceinline__ float bf2f(bf16_t v) { return __uint_as_float((unsigned)v << 16); }
__device__ __forceinline__ bf16_t f2bf(float f) { unsigned u = __float_as_uint(f); return (bf16_t)((u + 0x7fffu + ((u >> 16) & 1u)) >> 16); }

constexpr size_t MiB = 1u << 20;
constexpr size_t WS_CTL = 0, WS_WINT = 1 * MiB, WS_WKVT = 11 * MiB, WS_WOT = 15 * MiB, WS_WQT = 23 * MiB, WS_SMALL = 31 * MiB;
constexpr size_t WS_XB = 32 * MiB, WS_X1B = 32 * MiB  , WS_MEMB = 64 * MiB, WS_KVM = 66 * MiB;
constexpr size_t WS_POOLV = 68 * MiB, WS_Q = 84 * MiB, WS_K = 100 * MiB, WS_V = 104 * MiB, WS_QM = 108 * MiB, WS_CONCAT = 116 * MiB;
constexpr size_t WS_Y1 = 148 * MiB, WS_X1 = 212 * MiB, WS_QP = 276 * MiB, WS_EIDX = 308 * MiB, WS_GATE = 312 * MiB, WS_UB = 316 * MiB, WS_VB = 380 * MiB, WS_END = 444 * MiB;
constexpr size_t WS_NV_H = 148 * MiB  , WS_NV_PS = 232 * MiB, WS_NV_KVM = 248 * MiB;

__device__ __forceinline__ void rope_cs(int pos, int j, float& c, float& s) {
    const double invf[8] = {1.0, 0.19392274474868576, 0.03760603093086393, 0.007292664737217109, 0.001414213562373095, 0.0002742481756762073, 5.318295896944988e-05, 1.031338537721246e-05};
    double f = j == 0 ? invf[0] : j == 1 ? invf[1] : j == 2 ? invf[2] : j == 3 ? invf[3] : j == 4 ? invf[4] : j == 5 ? invf[5] : j == 6 ? invf[6] : invf[7];
    double rev = (double)pos * f * 0.15915494309189533577;
    rev -= floor(rev);
    float fr = (float)rev;
    s = __builtin_amdgcn_sinf(fr); c = __builtin_amdgcn_cosf(fr);
}
__device__ __forceinline__ float gelu_erf(float h) { return 0.5f * h * (1.0f + erff(h * 0.70710678118654752440f)); }
__device__ __forceinline__ float wave_sum(float v) {
#pragma unroll
    for (int o = 1; o < 64; o <<= 1) v += __shfl_xor(v, o);
    return v;
}

namespace pg8 {
#define PG8_LAS __attribute__((address_space(3)))
typedef unsigned short bf16_t;
typedef short bf16x8 __attribute__((ext_vector_type(8)));
typedef float f32x4 __attribute__((ext_vector_type(4)));
typedef unsigned u32x4 __attribute__((ext_vector_type(4)));
constexpr int BM = 256, BK = 64, HALF = 128, HTB = HALF * BK * 2  , STAGE_BYTES = 8 * HTB, NXCD = 8, WGM = 8;

__host__ __device__ __forceinline__ int lds_byte(int r, int c) { const int st = (r >> 4) * 2 + (c >> 5), rr = r & 15, cc = c & 31, ob = rr * 64 + cc * 2; return st * 1024 + (ob ^ (((ob >> 9) & 1) << 5)); }
__host__ __device__ __forceinline__ void stage_rc(int b, int& R, int& C) { const int st = b / 1024, sb = b % 1024, swz = sb ^ (((sb >> 9) & 1) << 5); R = (st >> 1) * 16 + swz / 64; C = (st & 1) * 32 + (swz % 64) / 2; }
__host__ __device__ __forceinline__ int perm32(int rho) { const int n = rho >> 4, i = rho & 15; return 8 * (i >> 2) + 4 * n + (i & 3); }

struct Unit { int pm, pn; };
struct Gemm { const bf16_t* A; const bf16_t* Bt; int M, N, K; };

struct StaticOrder {
    int nM, nN, nwg, G, c;
    __host__ __device__ void init(int M, int N, int G_, int c_) { nM = M / BM; nN = N / BM; nwg = nM * nN; G = G_; c = c_; }
    __host__ __device__ bool next(int i, Unit& u) const {
        const long L = (long)i * G + c; if (L >= nwg) return false;
        int wgid = (int)L; { const int q = nwg / NXCD, r = nwg % NXCD, xcd = wgid % NXCD, off = wgid / NXCD; wgid = (xcd < r ? xcd * (q + 1) : r * (q + 1) + (xcd - r) * q) + off; }
        const int nig = WGM * nN, gid = wgid / nig, fm = gid * WGM, gsz = (nM - fm) < WGM ? (nM - fm) : WGM;
        u.pm = fm + ((wgid % nig) % gsz); u.pn = (wgid % nig) / gsz; return true;
    }
    __device__ __forceinline__ void a_ready(const Unit&) const {}
    __device__ __forceinline__ void done(const Unit&) const {}
};

__device__ __forceinline__ unsigned cvt_pk_bf16(float lo, float hi) { unsigned r; asm volatile("v_cvt_pk_bf16_f32 %0, %1, %2" : "=v"(r) : "v"(lo), "v"(hi)); return r; }
template <class Epi, class Sched, bool ALIGN_EPI = false, bool SP2 = false>
__device__ __forceinline__ void gemm_phase(PG8_LAS unsigned char* lds, const Gemm g, const Sched& S, const Epi& E) {
    const int tid = threadIdx.x, wid = __builtin_amdgcn_readfirstlane(tid >> 6), lane = tid & 63, wr = wid >> 2, wc = wid & 3, fr = lane & 15, fq = lane >> 4;
    const int K = g.K, nt = K / BK;
    unsigned voffA[2], voffB[2];
#pragma unroll
    for (int i = 0; i < 2; ++i) { int R, C; stage_rc(tid * 16 + i * 8192, R, C); const int Rb = Epi::PERM ? ((R & ~31) + perm32(R & 31)) : R;
        voffA[i] = (unsigned)(R * K + C) * 2u; voffB[i] = (unsigned)(Rb * K + C) * 2u; }
    const size_t kstep = (size_t)(BK * 2);
    const size_t hstep = (size_t)HALF * K * 2;
    const size_t tstep = 2 * hstep;
    const unsigned ldsw = (unsigned)wid * 1024u;
    const int aoff = lds_byte(wr * 64 + fr, fq * 8), boff = lds_byte(wc * 32 + fr, fq * 8);
#define PG8_SA(b, h) (((b) * 2 + (h)) * HTB)
#define PG8_SB(b, h) ((4 + (b) * 2 + (h)) * HTB)
#define PG8_STAGE(bufoff, gbase, voff) do { _Pragma("unroll") for (int _i = 0; _i < 2; ++_i) \
        __builtin_amdgcn_global_load_lds((const unsigned*)((const char*)(gbase) + (voff)[_i]), (PG8_LAS unsigned*)(lds + (bufoff) + ldsw + _i * 8192), 16, 0, 0); } while (0)
#define PG8_LDA(dst, b, h) do { _Pragma("unroll") for (int m = 0; m < 4; ++m) _Pragma("unroll") for (int k = 0; k < 2; ++k) dst[m][k] = *(const PG8_LAS bf16x8*)(lds + PG8_SA(b, h) + aoff + m * 2048 + k * 1024); } while (0)
#define PG8_LDB(dst, b, h) do { _Pragma("unroll") for (int n = 0; n < 2; ++n) _Pragma("unroll") for (int k = 0; k < 2; ++k) dst[n][k] = *(const PG8_LAS bf16x8*)(lds + PG8_SB(b, h) + boff + n * 2048 + k * 1024); } while (0)
#define PG8_MMA(ai, bj, At, Bt) do { __builtin_amdgcn_s_setprio(1); _Pragma("unroll") for (int m = 0; m < 4; ++m) _Pragma("unroll") for (int n = 0; n < 2; ++n) _Pragma("unroll") for (int k = 0; k < 2; ++k) \
        acc[ai][bj][m][n] = __builtin_amdgcn_mfma_f32_16x16x32_bf16(Bt[n][k], At[m][k], acc[ai][bj][m][n], 0, 0, 0); __builtin_amdgcn_s_setprio(0); } while (0)
#define PG8_WAIT_V(n) asm volatile("s_waitcnt vmcnt(" #n ")" ::: "memory")
#define PG8_WAIT_L(n) asm volatile("s_waitcnt lgkmcnt(" #n ")" ::: "memory")
#define PG8_BAR __builtin_amdgcn_s_barrier()
#define PG8_SCHED __builtin_amdgcn_sched_barrier(0)
    Unit cur, nxt; int ui = 0;
    if (!S.next(0, cur)) return;
    f32x4 acc[2][2][4][2];
#pragma unroll
    for (int a = 0; a < 2; ++a)
#pragma unroll
        for (int b = 0; b < 2; ++b)
#pragma unroll
            for (int m = 0; m < 4; ++m)
#pragma unroll
                for (int n = 0; n < 2; ++n) acc[a][b][m][n] = (f32x4){0.f, 0.f, 0.f, 0.f};
    bf16x8 At[4][2], B0[2][2], B1[2][2];
    const char* cA = (const char*)g.A + (size_t)cur.pm * tstep; const char* cB = (const char*)g.Bt + (size_t)cur.pn * tstep;
    S.a_ready(cur);
    if constexpr (SP2) {
        PG8_STAGE(PG8_SB(0, 0), cB, voffB); PG8_STAGE(PG8_SB(0, 1), cB + hstep, voffB); PG8_STAGE(PG8_SA(0, 0), cA, voffA); PG8_STAGE(PG8_SA(0, 1), cA + hstep, voffA);
        if (wr == 1) PG8_BAR;
        PG8_WAIT_V(2); PG8_BAR;
        PG8_STAGE(PG8_SB(1, 0), cB + kstep, voffB); PG8_STAGE(PG8_SA(1, 0), cA + kstep, voffA); PG8_STAGE(PG8_SB(1, 1), cB + hstep + kstep, voffB);
        PG8_WAIT_V(6); PG8_BAR;
    } else {
        PG8_STAGE(PG8_SB(0, 0), cB, voffB); PG8_STAGE(PG8_SA(0, 0), cA, voffA); PG8_STAGE(PG8_SB(0, 1), cB + hstep, voffB); PG8_STAGE(PG8_SA(0, 1), cA + hstep, voffA);
        if (wr == 1) PG8_BAR;
        PG8_WAIT_V(4); PG8_BAR;
        PG8_STAGE(PG8_SB(1, 0), cB + kstep, voffB); PG8_STAGE(PG8_SA(1, 0), cA + kstep, voffA); PG8_STAGE(PG8_SB(1, 1), cB + hstep + kstep, voffB);
        PG8_WAIT_V(6); PG8_BAR;
    }
    for (;;) {
        const bool has_next = S.next(ui + 1, nxt);
        const char* nA = has_next ? (const char*)g.A + (size_t)nxt.pm * tstep : cA; const char* nB = has_next ? (const char*)g.Bt + (size_t)nxt.pn * tstep : cB;
        for (int t = 0; t < nt; t += 2) {
            const bool last = (t == nt - 2);
            const char* a1 = cA + (size_t)(t + 1) * kstep;
            const char* a2 = last ? nA : cA + (size_t)(t + 2) * kstep; const char* b2 = last ? nB : cB + (size_t)(t + 2) * kstep;
            const char* a3 = a2 + kstep; const char* b3 = b2 + kstep;
            if (last && has_next) S.a_ready(nxt);
            if constexpr (SP2) {
            PG8_LDB(B0, 0, 0); PG8_LDB(B1, 0, 1); PG8_SCHED; PG8_LDA(At, 0, 0); PG8_STAGE(PG8_SA(1, 1), a1 + hstep, voffA);
            PG8_WAIT_V(8); PG8_WAIT_L(0); PG8_BAR; PG8_MMA(0, 0, At, B0); PG8_MMA(0, 1, At, B1); PG8_BAR; PG8_SCHED;
            PG8_LDA(At, 0, 1); PG8_STAGE(PG8_SB(0, 0), b2, voffB); PG8_STAGE(PG8_SB(0, 1), b2 + hstep, voffB); PG8_STAGE(PG8_SA(0, 0), a2, voffA);
            PG8_WAIT_V(8); PG8_WAIT_L(0); PG8_BAR; PG8_MMA(1, 0, At, B0); PG8_MMA(1, 1, At, B1); PG8_BAR; PG8_SCHED;
            PG8_LDB(B0, 1, 0); PG8_LDB(B1, 1, 1); PG8_SCHED; PG8_LDA(At, 1, 0); PG8_STAGE(PG8_SA(0, 1), a2 + hstep, voffA);
            PG8_WAIT_V(8); PG8_WAIT_L(0); PG8_BAR; PG8_MMA(0, 0, At, B0); PG8_MMA(0, 1, At, B1); PG8_BAR; PG8_SCHED;
            PG8_LDA(At, 1, 1); PG8_STAGE(PG8_SB(1, 0), b3, voffB); PG8_STAGE(PG8_SB(1, 1), b3 + hstep, voffB); PG8_STAGE(PG8_SA(1, 0), a3, voffA);
            PG8_WAIT_V(8); PG8_WAIT_L(0); PG8_BAR; PG8_MMA(1, 0, At, B0); PG8_MMA(1, 1, At, B1); PG8_BAR; PG8_SCHED;
            } else {
            PG8_LDB(B0, 0, 0); PG8_SCHED; PG8_LDA(At, 0, 0); PG8_STAGE(PG8_SA(1, 1), a1 + hstep, voffA);
            PG8_WAIT_L(8); PG8_BAR; PG8_WAIT_L(0); PG8_MMA(0, 0, At, B0); PG8_BAR; PG8_SCHED;
            PG8_LDB(B1, 0, 1); PG8_STAGE(PG8_SB(0, 0), b2, voffB);
            PG8_BAR; PG8_WAIT_L(0); PG8_MMA(0, 1, At, B1); PG8_BAR;
            PG8_LDA(At, 0, 1); PG8_STAGE(PG8_SA(0, 0), a2, voffA);
            PG8_BAR; PG8_WAIT_L(0); PG8_MMA(1, 0, At, B0); PG8_BAR; PG8_SCHED;
            PG8_STAGE(PG8_SB(0, 1), b2 + hstep, voffB);
            PG8_WAIT_V(6); PG8_BAR; PG8_MMA(1, 1, At, B1); PG8_BAR;
            PG8_LDB(B0, 1, 0); PG8_SCHED; PG8_LDA(At, 1, 0); PG8_STAGE(PG8_SA(0, 1), a2 + hstep, voffA);
            PG8_WAIT_L(8); PG8_BAR; PG8_WAIT_L(0); PG8_MMA(0, 0, At, B0); PG8_BAR; PG8_SCHED;
            PG8_LDB(B1, 1, 1); PG8_STAGE(PG8_SB(1, 0), b3, voffB);
            PG8_BAR; PG8_WAIT_L(0); PG8_MMA(0, 1, At, B1); PG8_BAR;
            PG8_LDA(At, 1, 1); PG8_STAGE(PG8_SA(1, 0), a3, voffA);
            PG8_BAR; PG8_WAIT_L(0); PG8_MMA(1, 0, At, B0); PG8_BAR; PG8_SCHED;
            PG8_STAGE(PG8_SB(1, 1), b3 + hstep, voffB);
            PG8_WAIT_V(6); PG8_BAR; PG8_MMA(1, 1, At, B1); PG8_BAR;
            }
        }
        if constexpr (ALIGN_EPI) { if (wr == 0) PG8_BAR; }
        if constexpr (!Epi::AFTER_DRAIN) { E(acc, cur, wr, wc, fr, fq); S.done(cur); }
        if (!has_next) break;
#pragma unroll
        for (int a = 0; a < 2; ++a)
#pragma unroll
            for (int b = 0; b < 2; ++b)
#pragma unroll
                for (int m = 0; m < 4; ++m)
#pragma unroll
                    for (int n = 0; n < 2; ++n) acc[a][b][m][n] = (f32x4){0.f, 0.f, 0.f, 0.f};
        cur = nxt; cA = nA; cB = nB; ++ui;
        if constexpr (ALIGN_EPI) { if (wr == 1) PG8_BAR; }
    }
    PG8_WAIT_V(0);
    if constexpr (!ALIGN_EPI) { if (wr == 0) PG8_BAR; }
    PG8_BAR;
    if constexpr (Epi::AFTER_DRAIN) { E.fused(acc, cur, wr, wc, fr, fq, lds, wid, lane); S.done(cur); }
#undef PG8_SA
#undef PG8_SB
#undef PG8_STAGE
#undef PG8_LDA
#undef PG8_LDB
#undef PG8_MMA
#undef PG8_WAIT_V
#undef PG8_WAIT_L
#undef PG8_BAR
#undef PG8_SCHED
}
}
#define GAS __attribute__((address_space(1)))
#define LAS __attribute__((address_space(3)))
typedef unsigned v4u __attribute__((ext_vector_type(4)));
typedef unsigned v2u __attribute__((ext_vector_type(2)));
typedef float f32x4 __attribute__((ext_vector_type(4)));
typedef float f32x2 __attribute__((ext_vector_type(2)));
typedef short bf16x8 __attribute__((ext_vector_type(8)));
typedef __bf16 bf16x2 __attribute__((ext_vector_type(2)));
constexpr int NWAVES = 8, NTHREADS = NWAVES * 64;
constexpr int LDS_BYTES = 147456, MISC_OFF = LDS_BYTES - 512;
constexpr int CW_BAR = 4096;
constexpr float LOG2E = 1.44269504088896340736f;

__device__ __forceinline__ unsigned cvtpk(float lo, float hi) { f32x2 v = {lo, hi}; bf16x2 b = __builtin_convertvector(v, bf16x2); return __builtin_bit_cast(unsigned, b); }
__device__ __forceinline__ f32x4 mfma16(bf16x8 a, bf16x8 b, f32x4 c) { return __builtin_amdgcn_mfma_f32_16x16x32_bf16(a, b, c, 0, 0, 0); }
__device__ __forceinline__ float dot2bf(unsigned w, unsigned x, float acc) { return __builtin_amdgcn_fdot2_f32_bf16(__builtin_bit_cast(bf16x2, w), __builtin_bit_cast(bf16x2, x), acc, false); }
__device__ __forceinline__ float fexp2(float x) { return __builtin_amdgcn_exp2f(x); }
#define LDS_WAIT() asm volatile("s_waitcnt lgkmcnt(0)" ::: "memory")

#define XB_TMO      128
#define XB_XCNT(j)  (256  + 64 * (j))
#define XB_XSUB(j)  (1280 + 64 * (j))
#define XB_XGEN(j)  (2304 + 64 * (j))
#define XB_TOP      3328
#define XB_TOPGEN   3392
#define XCD_BAR_WORDS 3456
#define XB_SPIN_CAP (1u << 18)
__device__ __forceinline__ unsigned xb_ld(unsigned* p)              { return __hip_atomic_load(p, __ATOMIC_RELAXED, __HIP_MEMORY_SCOPE_AGENT); }
__device__ __forceinline__ unsigned xb_add(unsigned* p, unsigned v) { return __hip_atomic_fetch_add(p, v, __ATOMIC_RELAXED, __HIP_MEMORY_SCOPE_AGENT); }
__device__ __forceinline__ unsigned xb_xcc_id() { return (unsigned)__builtin_amdgcn_s_getreg((3 << 11) | 20) & 0xFu; }
#define XB_SPIN(cond, bar) do { unsigned _sp = 0; while (cond) { __builtin_amdgcn_s_sleep(1); \
    if ((++_sp & 255u) == 0u) { if (xb_ld(&(bar)[XB_TMO])) break; if (_sp > XB_SPIN_CAP) { atomicAdd(&(bar)[XB_TMO], 1u); break; } } } } while (0)
struct XcdBarrier { unsigned* bar; unsigned x; volatile LAS unsigned* st; };
__device__ __forceinline__ XcdBarrier xcd_barrier_post(unsigned* bar, volatile LAS unsigned* st) {
    XcdBarrier b; b.bar = bar; b.x = xb_xcc_id(); b.st = st;
    if (threadIdx.x == 0) (void)xb_add(&bar[XB_XCNT(b.x)], 1u);
    return b;
}
__device__ __forceinline__ void xcd_barrier_complete(unsigned* bar, unsigned x, unsigned& nloc, unsigned& nx) {
    const unsigned G = gridDim.x * gridDim.y * gridDim.z;
    unsigned sum, cnt, mine, sp = 0u;
    for (;;) {
        sum = 0u; cnt = 0u; mine = 0u;
#pragma unroll
        for (unsigned j = 0; j < 16; ++j) { const unsigned c = xb_ld(&bar[XB_XCNT(j)]); sum += c; cnt += (c > 0u) ? 1u : 0u; mine = (j == x) ? c : mine; }
        if (sum == G) break;
        __builtin_amdgcn_s_sleep(1);
        if ((++sp & 255u) == 0u) { if (xb_ld(&bar[XB_TMO])) break; if (sp > XB_SPIN_CAP) { atomicAdd(&bar[XB_TMO], 1u); break; } }
    }
    nloc = mine > 0u ? mine : 1u; nx = cnt > 0u ? cnt : 1u;
}
__device__ __forceinline__ void xcd_barrier(const XcdBarrier& b) {
    asm volatile("s_waitcnt vmcnt(0)" ::: "memory");
    __syncthreads();
    if (threadIdx.x == 0) {
        unsigned* bar = b.bar;
        __builtin_amdgcn_s_waitcnt(0);
        unsigned nloc = b.st[0], nx = b.st[1];
        if (nloc == 0u) { xcd_barrier_complete(bar, b.x, nloc, nx); b.st[0] = nloc; b.st[1] = nx; }
        const unsigned old = xb_add(&bar[XB_XSUB(b.x)], 1u);
        const unsigned gen = old / nloc;
        if (old + 1u == (gen + 1u) * nloc) {
            __builtin_amdgcn_fence(__ATOMIC_RELEASE, "agent");
            asm volatile("s_waitcnt vmcnt(0)" ::: "memory");
            const unsigned og = xb_add(&bar[XB_TOP], 1u);
            const unsigned tg = og / nx;
            if (og + 1u == (tg + 1u) * nx) xb_add(&bar[XB_TOPGEN], 1u);
            else XB_SPIN(xb_ld(&bar[XB_TOPGEN]) == tg, bar);
            __builtin_amdgcn_fence(__ATOMIC_ACQUIRE, "agent");
            xb_add(&bar[XB_XGEN(b.x)], 1u);
            asm volatile("s_waitcnt vmcnt(0)" ::: "memory");
        } else {
            XB_SPIN(xb_ld(&bar[XB_XGEN(b.x)]) == gen, bar);
            __builtin_amdgcn_fence(__ATOMIC_ACQUIRE, "agent");
            asm volatile("s_waitcnt vmcnt(0)" ::: "memory");
        }
    }
    __syncthreads();
}

struct EpiStoreBf {
    static constexpr bool PERM = true, AFTER_DRAIN = false;
    bf16_t* O; int ldc;
    __device__ __forceinline__ void operator()(const pg8::f32x4 (&acc)[2][2][4][2], const pg8::Unit& u, int wr, int wc, int fr, int fq) const {
        const int row0 = u.pm * 256 + wr * 64 + fr, col0 = u.pn * 256 + wc * 32 + 8 * fq;
#pragma unroll
        for (int ai = 0; ai < 2; ++ai)
#pragma unroll
            for (int m = 0; m < 4; ++m) { bf16_t* rowp = O + (size_t)(row0 + ai * 128 + m * 16) * ldc + col0;
#pragma unroll
                for (int bj = 0; bj < 2; ++bj) { const pg8::f32x4 v0 = acc[ai][bj][m][0], v1 = acc[ai][bj][m][1];
                    v4u w; w.x = cvtpk(v0[0], v0[1]); w.y = cvtpk(v0[2], v0[3]); w.z = cvtpk(v1[0], v1[1]); w.w = cvtpk(v1[2], v1[3]);
                    *(v4u*)(rowp + bj * 128) = w; } }
    }
};
struct EpiY1 {
    static constexpr bool PERM = true, AFTER_DRAIN = false;
    const float* x; float* y;
    __device__ __forceinline__ void operator()(const pg8::f32x4 (&acc)[2][2][4][2], const pg8::Unit& u, int wr, int wc, int fr, int fq) const {
        const int row0 = u.pm * 256 + wr * 64 + fr, col0 = u.pn * 256 + wc * 32 + 8 * fq;
#pragma unroll
        for (int ai = 0; ai < 2; ++ai)
#pragma unroll
            for (int m = 0; m < 4; ++m) { const size_t off = (size_t)(row0 + ai * 128 + m * 16) * D_MODEL + col0;
#pragma unroll
                for (int bj = 0; bj < 2; ++bj) {
                    const f32x4 x0 = *(const f32x4*)(x + off + bj * 128), x1 = *(const f32x4*)(x + off + bj * 128 + 4);
                    *(f32x4*)(y + off + bj * 128) = x0 * ALPHA + acc[ai][bj][m][0]; *(f32x4*)(y + off + bj * 128 + 4) = x1 * ALPHA + acc[ai][bj][m][1]; } }
    }
};
struct EpiIn {
    static constexpr bool PERM = true, AFTER_DRAIN = false;
    float* POOLV; bf16_t *Q, *K, *V, *QM; const float* rope;
    __device__ __forceinline__ void operator()(const pg8::f32x4 (&acc)[2][2][4][2], const pg8::Unit& u, int wr, int wc, int fr, int fq) const {
        const int row0 = u.pm * 256 + wr * 64 + fr, cl = wc * 32 + 8 * fq, pn = u.pn;
        if (pn < 2) {
#pragma unroll
            for (int ai = 0; ai < 2; ++ai)
#pragma unroll
                for (int m = 0; m < 4; ++m) { float* rp = POOLV + (size_t)(row0 + ai * 128 + m * 16) * POOL_W + pn * 256 + cl;
#pragma unroll
                    for (int bj = 0; bj < 2; ++bj) { *(f32x4*)(rp + bj * 128) = acc[ai][bj][m][0]; *(f32x4*)(rp + bj * 128 + 4) = acc[ai][bj][m][1]; } }
            return;
        }
        bf16_t* base; int ld, c0; bool rot = false;
        if (pn < 6) { base = Q; ld = SWA_W; c0 = (pn - 2) * 256; rot = true; }
        else if (pn == 6) { base = K; ld = KV_W; c0 = 0; rot = true; }
        else if (pn == 7) { base = V; ld = KV_W; c0 = 0; }
        else { base = QM; ld = MEM_W; c0 = (pn - 8) * 256; }
        rot = rot && ((wc & 1) == 0);
#pragma unroll
        for (int ai = 0; ai < 2; ++ai)
#pragma unroll
            for (int m = 0; m < 4; ++m) {
                const int row = row0 + ai * 128 + m * 16;
                f32x4 v[2][2];
#pragma unroll
                for (int bj = 0; bj < 2; ++bj) { v[bj][0] = acc[ai][bj][m][0]; v[bj][1] = acc[ai][bj][m][1]; }
                if (rot) {
                    const f32x4* tp = (const f32x4*)(rope + (size_t)row * 16);
                    f32x4 cs[2][2]; cs[0][0] = tp[0]; cs[0][1] = tp[1]; cs[1][0] = tp[2]; cs[1][1] = tp[3];
#pragma unroll
                    for (int bj = 0; bj < 2; ++bj)
#pragma unroll
                        for (int n = 0; n < 2; ++n)
#pragma unroll
                            for (int i = 0; i < 4; ++i) {
                                const float xv = v[bj][n][i], pv = __shfl_xor(xv, 16);
                                const float c = cs[n][i >> 1][2 * (i & 1)], s = cs[n][i >> 1][2 * (i & 1) + 1];
                                const float o = fq == 0 ? xv * c - pv * s : (fq == 1 ? xv * c + pv * s : xv);
                                v[bj][n][i] = o; }
                }
                bf16_t* rowp = base + (size_t)row * ld + c0 + cl;
#pragma unroll
                for (int bj = 0; bj < 2; ++bj) { v4u w; w.x = cvtpk(v[bj][0][0], v[bj][0][1]); w.y = cvtpk(v[bj][0][2], v[bj][0][3]); w.z = cvtpk(v[bj][1][0], v[bj][1][1]); w.w = cvtpk(v[bj][1][2], v[bj][1][3]);
                    *(v4u*)(rowp + bj * 128) = w; }
            }
    }
};

__device__ __forceinline__ void p0_transpose_item(const float* W, int K, int N, bf16_t* WT, LAS float* scr, int item, int lane) {
    const int nblk = N / 32, kb = item / nblk, nb = item % nblk, k0 = 64 * kb, n0 = 32 * nb;
#pragma unroll 8
    for (int i = 0; i < 32; ++i) { const int kk = 2 * i + (lane >> 5); scr[kk * 33 + (lane & 31)] = W[(size_t)(k0 + kk) * N + n0 + (lane & 31)]; }
    LDS_WAIT(); asm volatile("" ::: "memory");
    const int c = lane & 7;
#pragma unroll
    for (int j = 0; j < 4; ++j) { const int n = (lane >> 3) + 8 * j; const LAS float* s = scr + (8 * c) * 33 + n;
        v4u o; o.x = cvtpk(s[0 * 33], s[1 * 33]); o.y = cvtpk(s[2 * 33], s[3 * 33]); o.z = cvtpk(s[4 * 33], s[5 * 33]); o.w = cvtpk(s[6 * 33], s[7 * 33]);
        *(v4u*)(WT + (size_t)(n0 + n) * K + k0 + 8 * c) = o; }
    LDS_WAIT(); asm volatile("" ::: "memory");
}
template <bool NT>
__device__ __forceinline__ void cvt_stream(const float* in, bf16_t* out, size_t n, int gw, int NGW, int lane) {
#pragma unroll 4
    for (size_t i = (size_t)gw * 512 + lane * 8; i < n; i += (size_t)NGW * 512) {
        f32x4 a, b;
        if (NT) { a = __builtin_nontemporal_load((const f32x4*)(in + i)); b = __builtin_nontemporal_load((const f32x4*)(in + i + 4)); }
        else { a = *(const f32x4*)(in + i); b = *(const f32x4*)(in + i + 4); }
        v4u o; o.x = cvtpk(a.x, a.y); o.y = cvtpk(a.z, a.w); o.z = cvtpk(b.x, b.y); o.w = cvtpk(b.z, b.w);
        *(v4u*)(out + i) = o;
    }
}

constexpr int SWA_KROW = 144, SWA_VROW = 528, SWA_VT_OFF = 256 * SWA_KROW;
__device__ __forceinline__ void swa_item(LAS unsigned char* lds, int item, const bf16_t* __restrict__ Q, const bf16_t* __restrict__ Kb, const bf16_t* __restrict__ Vb, const float* __restrict__ sinks,
                                         bf16_t* CONCAT, int tid, int wave, int lane) {
    const int qb = item & 31, kvh = (item >> 5) & 3, b = item >> 7;
    const int tok0 = b * SEQ + qb * 128;
    LAS unsigned char* Kl = lds; LAS unsigned char* Vt = lds + SWA_VT_OFF;
#pragma unroll
    for (int j = 0; j < 4; ++j) {
        const int c = tid + NTHREADS * j, row = c >> 3, part = c & 7;
        v4u kv = {0u, 0u, 0u, 0u}, vv = {0u, 0u, 0u, 0u};
        if (qb > 0 || row >= 128) { const size_t tk = (size_t)(tok0 - 128 + row); kv = *(const v4u*)(Kb + tk * KV_W + kvh * HD + part * 8); vv = *(const v4u*)(Vb + tk * KV_W + kvh * HD + part * 8); }
        *(LAS v4u*)(Kl + row * SWA_KROW + part * 16) = kv;
        LAS unsigned short* vp = (LAS unsigned short*)(Vt + (part * 8) * SWA_VROW + row * 2);
        vp[0 * (SWA_VROW / 2)] = (unsigned short)(vv.x & 0xffffu); vp[1 * (SWA_VROW / 2)] = (unsigned short)(vv.x >> 16);
        vp[2 * (SWA_VROW / 2)] = (unsigned short)(vv.y & 0xffffu); vp[3 * (SWA_VROW / 2)] = (unsigned short)(vv.y >> 16);
        vp[4 * (SWA_VROW / 2)] = (unsigned short)(vv.z & 0xffffu); vp[5 * (SWA_VROW / 2)] = (unsigned short)(vv.z >> 16);
        vp[6 * (SWA_VROW / 2)] = (unsigned short)(vv.w & 0xffffu); vp[7 * (SWA_VROW / 2)] = (unsigned short)(vv.w >> 16);
    }
    __syncthreads();
    const int g = wave & 3, h = kvh * 4 + g, q15 = lane & 15, qq = lane >> 4;
    const float sink2 = sinks[h] * LOG2E;
    const float SC = 0.125f * LOG2E;
#pragma unroll 1
    for (int cc = 0; cc < 2; ++cc) {
        const int c = 2 * (wave >> 2) + cc, kl0 = 32 * c;
        bf16x8 qf[2][2];
#pragma unroll
        for (int ni = 0; ni < 2; ++ni)
#pragma unroll
            for (int ks = 0; ks < 2; ++ks) qf[ni][ks] = *(const bf16x8*)(Q + (size_t)(tok0 + 32 * c + 16 * ni + q15) * SWA_W + h * HD + 32 * ks + 8 * qq);
        f32x4 s[10][2];
#pragma unroll
        for (int mi = 0; mi < 10; ++mi) { s[mi][0] = (f32x4){0.f, 0.f, 0.f, 0.f}; s[mi][1] = (f32x4){0.f, 0.f, 0.f, 0.f}; }
#pragma unroll
        for (int mi = 0; mi < 10; ++mi)
#pragma unroll
            for (int ks = 0; ks < 2; ++ks) {
                const bf16x8 kf = *(const LAS bf16x8*)(Kl + (kl0 + 16 * mi + q15) * SWA_KROW + (32 * ks + 8 * qq) * 2);
                s[mi][0] = mfma16(kf, qf[0][ks], s[mi][0]); s[mi][1] = mfma16(kf, qf[1][ks], s[mi][1]);
            }
        float rl[2];
#pragma unroll
        for (int ni = 0; ni < 2; ++ni) {
            const int ql = 32 * c + 16 * ni + q15;
            float mx = -INFINITY;
#pragma unroll
            for (int mi = 0; mi < 10; ++mi)
#pragma unroll
                for (int r = 0; r < 4; ++r) {
                    const int kl = kl0 + 16 * mi + 4 * qq + r;
                    const bool valid = (kl > ql) && (kl <= ql + 128) && (qb > 0 || kl >= 128);
                    const float t = valid ? s[mi][ni][r] * SC : -INFINITY;
                    s[mi][ni][r] = t; mx = fmaxf(mx, t);
                }
            mx = fmaxf(mx, __shfl_xor(mx, 16)); mx = fmaxf(mx, __shfl_xor(mx, 32)); mx = fmaxf(mx, sink2);
            float l = 0.f;
#pragma unroll
            for (int mi = 0; mi < 10; ++mi)
#pragma unroll
                for (int r = 0; r < 4; ++r) { const float p = fexp2(s[mi][ni][r] - mx); s[mi][ni][r] = p; l += p; }
            l += __shfl_xor(l, 16); l += __shfl_xor(l, 32); l += fexp2(sink2 - mx);
            rl[ni] = 1.0f / l;
        }
        f32x4 o[4][2];
#pragma unroll
        for (int dt = 0; dt < 4; ++dt) { o[dt][0] = (f32x4){0.f, 0.f, 0.f, 0.f}; o[dt][1] = (f32x4){0.f, 0.f, 0.f, 0.f}; }
#pragma unroll
        for (int kk = 0; kk < 5; ++kk) {
            bf16x8 pf[2];
#pragma unroll
            for (int ni = 0; ni < 2; ++ni) {
                v4u w; w.x = cvtpk(s[2 * kk][ni][0], s[2 * kk][ni][1]); w.y = cvtpk(s[2 * kk][ni][2], s[2 * kk][ni][3]);
                w.z = cvtpk(s[2 * kk + 1][ni][0], s[2 * kk + 1][ni][1]); w.w = cvtpk(s[2 * kk + 1][ni][2], s[2 * kk + 1][ni][3]);
                pf[ni] = __builtin_bit_cast(bf16x8, w);
            }
#pragma unroll
            for (int dt = 0; dt < 4; ++dt) {
                const LAS unsigned char* vb = Vt + (16 * dt + q15) * SWA_VROW + (kl0 + 32 * kk + 4 * qq) * 2;
                const v2u lo = *(const LAS v2u*)vb, hi = *(const LAS v2u*)(vb + 32);
                v4u w; w.x = lo.x; w.y = lo.y; w.z = hi.x; w.w = hi.y;
                const bf16x8 vf = __builtin_bit_cast(bf16x8, w);
                o[dt][0] = mfma16(vf, pf[0], o[dt][0]); o[dt][1] = mfma16(vf, pf[1], o[dt][1]);
            }
        }
#pragma unroll
        for (int ni = 0; ni < 2; ++ni) {
            bf16_t* orow = CONCAT + (size_t)(tok0 + 32 * c + 16 * ni + q15) * D_MODEL + POOL_W + h * HD + 4 * qq;
#pragma unroll
            for (int dt = 0; dt < 4; ++dt) { v2u w; w.x = cvtpk(o[dt][ni][0] * rl[ni], o[dt][ni][1] * rl[ni]); w.y = cvtpk(o[dt][ni][2] * rl[ni], o[dt][ni][3] * rl[ni]); *(v2u*)(orow + 16 * dt) = w; }
        }
    }
    __syncthreads();
}
constexpr int MEM_KROW = 272, MEM_VROW = 528, MEM_VT_OFF = 256 * MEM_KROW;
__device__ __forceinline__ void mem_item(LAS unsigned char* lds, int item, const bf16_t* __restrict__ QM, const bf16_t* __restrict__ KVM, bf16_t* CONCAT, int tid, int wave, int lane) {
    const int qt = item & 31, hm = (item >> 5) & 3, b = item >> 7;
    LAS unsigned char* Kl = lds; LAS unsigned char* Vt = lds + MEM_VT_OFF;
#pragma unroll
    for (int j = 0; j < 8; ++j) {
        const int c = tid + NTHREADS * j, row = c >> 4, part = c & 15;
        const bf16_t* src = KVM + (size_t)(b * MEM_LEN + row) * (2 * MEM_W) + hm * MHD + part * 8;
        const v4u kv = *(const v4u*)src, vv = *(const v4u*)(src + MEM_W);
        *(LAS v4u*)(Kl + row * MEM_KROW + part * 16) = kv;
        LAS unsigned short* vp = (LAS unsigned short*)(Vt + (part * 8) * MEM_VROW + row * 2);
        vp[0 * (MEM_VROW / 2)] = (unsigned short)(vv.x & 0xffffu); vp[1 * (MEM_VROW / 2)] = (unsigned short)(vv.x >> 16);
        vp[2 * (MEM_VROW / 2)] = (unsigned short)(vv.y & 0xffffu); vp[3 * (MEM_VROW / 2)] = (unsigned short)(vv.y >> 16);
        vp[4 * (MEM_VROW / 2)] = (unsigned short)(vv.z & 0xffffu); vp[5 * (MEM_VROW / 2)] = (unsigned short)(vv.z >> 16);
        vp[6 * (MEM_VROW / 2)] = (unsigned short)(vv.w & 0xffffu); vp[7 * (MEM_VROW / 2)] = (unsigned short)(vv.w >> 16);
    }
    __syncthreads();
    const int q15 = lane & 15, qq = lane >> 4;
    const int tok = b * SEQ + qt * 128 + wave * 16 + q15;
    const float SC = 0.08838834764831845f * LOG2E;
    bf16x8 qf[4];
#pragma unroll
    for (int ks = 0; ks < 4; ++ks) qf[ks] = *(const bf16x8*)(QM + (size_t)tok * MEM_W + hm * MHD + 32 * ks + 8 * qq);
    f32x4 s[16];
#pragma unroll
    for (int mi = 0; mi < 16; ++mi) s[mi] = (f32x4){0.f, 0.f, 0.f, 0.f};
#pragma unroll
    for (int mi = 0; mi < 16; ++mi)
#pragma unroll
        for (int ks = 0; ks < 4; ++ks) {
            const bf16x8 kf = *(const LAS bf16x8*)(Kl + (16 * mi + q15) * MEM_KROW + (32 * ks + 8 * qq) * 2);
            s[mi] = mfma16(kf, qf[ks], s[mi]);
        }
    float mx = -INFINITY;
#pragma unroll
    for (int mi = 0; mi < 16; ++mi)
#pragma unroll
        for (int r = 0; r < 4; ++r) { const float t = s[mi][r] * SC; s[mi][r] = t; mx = fmaxf(mx, t); }
    mx = fmaxf(mx, __shfl_xor(mx, 16)); mx = fmaxf(mx, __shfl_xor(mx, 32));
    float l = 0.f;
#pragma unroll
    for (int mi = 0; mi < 16; ++mi)
#pragma unroll
        for (int r = 0; r < 4; ++r) { const float p = fexp2(s[mi][r] - mx); s[mi][r] = p; l += p; }
    l += __shfl_xor(l, 16); l += __shfl_xor(l, 32);
    const float rl = 1.0f / l;
    f32x4 o[8];
#pragma unroll
    for (int dt = 0; dt < 8; ++dt) o[dt] = (f32x4){0.f, 0.f, 0.f, 0.f};
#pragma unroll
    for (int kk = 0; kk < 8; ++kk) {
        v4u pw; pw.x = cvtpk(s[2 * kk][0], s[2 * kk][1]); pw.y = cvtpk(s[2 * kk][2], s[2 * kk][3]); pw.z = cvtpk(s[2 * kk + 1][0], s[2 * kk + 1][1]); pw.w = cvtpk(s[2 * kk + 1][2], s[2 * kk + 1][3]);
        const bf16x8 pf = __builtin_bit_cast(bf16x8, pw);
#pragma unroll
        for (int dt = 0; dt < 8; ++dt) {
            const LAS unsigned char* vb = Vt + (16 * dt + q15) * MEM_VROW + (32 * kk + 4 * qq) * 2;
            const v2u lo = *(const LAS v2u*)vb, hi = *(const LAS v2u*)(vb + 32);
            v4u w; w.x = lo.x; w.y = lo.y; w.z = hi.x; w.w = hi.y;
            o[dt] = mfma16(__builtin_bit_cast(bf16x8, w), pf, o[dt]);
        }
    }
    bf16_t* orow = CONCAT + (size_t)tok * D_MODEL + POOL_W + SWA_W + hm * MHD + 4 * qq;
#pragma unroll
    for (int dt = 0; dt < 8; ++dt) { v2u w; w.x = cvtpk(o[dt][0] * rl, o[dt][1] * rl); w.y = cvtpk(o[dt][2] * rl, o[dt][3] * rl); *(v2u*)(orow + 16 * dt) = w; }
    __syncthreads();
}
__device__ __forceinline__ void pool_item(int item, const float* __restrict__ POOLV, const bf16_t* __restrict__ WPT, const float* __restrict__ pool_scale, bf16_t* CONCAT, int lane) {
    const int g = item & 3, t0 = (item >> 2) * 16, w = 2 << g, q15 = lane & 15, qq = lane >> 4;
    const int t = t0 + q15, sp = t & (SEQ - 1);
    const int cnt = (sp + 1) < w ? (sp + 1) : w;
    const float inv = 1.0f / (float)cnt;
    bf16x8 pf[4];
#pragma unroll
    for (int ks = 0; ks < 4; ++ks) {
        const float* p0 = POOLV + (size_t)t * POOL_W + g * 128 + 32 * ks + 8 * qq;
        const f32x4 c0 = *(const f32x4*)p0, c1 = *(const f32x4*)(p0 + 4);
        f32x4 a0 = c0, a1 = c1;
        for (int i = 1; i < cnt; ++i) { a0 += *(const f32x4*)(p0 - (size_t)i * POOL_W); a1 += *(const f32x4*)(p0 - (size_t)i * POOL_W + 4); }
        a0 = a0 * inv - c0; a1 = a1 * inv - c1;
        v4u pw; pw.x = cvtpk(a0.x, a0.y); pw.y = cvtpk(a0.z, a0.w); pw.z = cvtpk(a1.x, a1.y); pw.w = cvtpk(a1.z, a1.w);
        pf[ks] = __builtin_bit_cast(bf16x8, pw);
    }
    bf16_t* orow = CONCAT + (size_t)t * D_MODEL + g * 128 + 4 * qq;
#pragma unroll
    for (int mt = 0; mt < 8; ++mt) {
        f32x4 acc = {0.f, 0.f, 0.f, 0.f};
#pragma unroll
        for (int ks = 0; ks < 4; ++ks) { const bf16x8 wf = *(const bf16x8*)(WPT + (size_t)g * 16384 + (16 * mt + q15) * 128 + 32 * ks + 8 * qq); acc = mfma16(wf, pf[ks], acc); }
        const f32x4 sc = *(const f32x4*)(pool_scale + g * 128 + 16 * mt + 4 * qq);
        v2u wv; wv.x = cvtpk(acc[0] * sc[0], acc[1] * sc[1]); wv.y = cvtpk(acc[2] * sc[2], acc[3] * sc[3]);
        *(v2u*)(orow + 16 * mt) = wv;
    }
}

__device__ __forceinline__ void ln1_row(const float* __restrict__ yrow, const float* __restrict__ g, const float* __restrict__ bta, float* xo, bf16_t* xb, int lane) {
    f32x4 v[8]; float s = 0.f;
#pragma unroll
    for (int j = 0; j < 8; ++j) { v[j] = *(const f32x4*)(yrow + 256 * j + 4 * lane); s += (v[j].x + v[j].y) + (v[j].z + v[j].w); }
    const float mean = wave_sum(s) * (1.f / D_MODEL); float q = 0.f;
#pragma unroll
    for (int j = 0; j < 8; ++j) { v[j] = v[j] - mean; q += (v[j].x * v[j].x + v[j].y * v[j].y) + (v[j].z * v[j].z + v[j].w * v[j].w); }
    const float rstd = 1.0f / sqrtf(wave_sum(q) * (1.f / D_MODEL) + LN_EPS);
#pragma unroll
    for (int j = 0; j < 8; ++j) {
        const f32x4 gg = *(const f32x4*)(g + 256 * j + 4 * lane), bb = *(const f32x4*)(bta + 256 * j + 4 * lane);
        const f32x4 y = v[j] * rstd * gg + bb;
        *(f32x4*)(xo + 256 * j + 4 * lane) = y;
        v2u w; w.x = cvtpk(y.x, y.y); w.y = cvtpk(y.z, y.w); *(v2u*)(xb + 256 * j + 4 * lane) = w;
    }
}

__device__ __forceinline__ unsigned f2ord(float f) { const unsigned u = __float_as_uint(f); return u ^ ((unsigned)((int)u >> 31) | 0x80000000u); }
__device__ __forceinline__ float ord2f(unsigned o) { const unsigned u = (o & 0x80000000u) ? (o ^ 0x80000000u) : ~o; return __uint_as_float(u); }
__device__ __forceinline__ unsigned umax(unsigned a, unsigned b) { return a > b ? a : b; }
__device__ __forceinline__ void topk_item(int item, const bf16_t* __restrict__ QP, const bf16_t* __restrict__ K1B, const bf16_t* __restrict__ K2B, int* EIDX, float* GATE, int lane) {
    const int h = item & 7, t0 = (item >> 3) * 16, q15 = lane & 15, qq = lane >> 4;
    const int t = t0 + q15;
    unsigned top[2][16];
#pragma unroll
    for (int half = 0; half < 2; ++half) {
        const bf16_t* KB = half ? K2B : K1B;
        bf16x8 qf[4];
#pragma unroll
        for (int ks = 0; ks < 4; ++ks) qf[ks] = *(const bf16x8*)(QP + (size_t)t * D_MODEL + h * 256 + half * 128 + 32 * ks + 8 * qq);
        unsigned key[32];
#pragma unroll
        for (int mi = 0; mi < 8; ++mi) {
            f32x4 acc = {0.f, 0.f, 0.f, 0.f};
#pragma unroll
            for (int ks = 0; ks < 4; ++ks) { const bf16x8 kf = *(const bf16x8*)(KB + (16 * mi + q15) * 128 + 32 * ks + 8 * qq); acc = mfma16(kf, qf[ks], acc); }
#pragma unroll
            for (int r = 0; r < 4; ++r) key[mi * 4 + r] = (f2ord(acc[r]) & ~0x7Fu) | (unsigned)(127 - (16 * mi + 4 * qq + r));
        }
#pragma unroll
        for (int r = 0; r < 16; ++r) {
            unsigned M = key[0];
#pragma unroll
            for (int i = 1; i < 32; ++i) M = umax(M, key[i]);
            M = umax(M, (unsigned)__shfl_xor((int)M, 16)); M = umax(M, (unsigned)__shfl_xor((int)M, 32));
            top[half][r] = M;
#pragma unroll
            for (int i = 0; i < 32; ++i) key[i] = (key[i] == M) ? 0u : key[i];
            __builtin_amdgcn_sched_barrier(0);
        }
        __builtin_amdgcn_sched_barrier(0);
    }
    float v1[16], v2[16]; unsigned e1[16], e2[16];
#pragma unroll
    for (int r = 0; r < 16; ++r) { v1[r] = ord2f(top[0][r] & ~0x7Fu); v2[r] = ord2f(top[1][r] & ~0x7Fu); e1[r] = (127u - (top[0][r] & 0x7Fu)) * 128u; e2[r] = 127u - (top[1][r] & 0x7Fu); }
    unsigned ck[13], ce[13];
#pragma unroll
    for (int i = 0; i < 13; ++i) { ck[i] = 0u; ce[i] = 0u; }
    {
        int n = 0;
#pragma unroll
        for (int a = 0; a < 16; ++a)
#pragma unroll
            for (int bb = 0; bb < 16; ++bb)
                if ((a + 1) * (bb + 1) <= 16) {
                    const unsigned pk = (f2ord(v1[a] + v2[bb]) & ~0xFFu) | (unsigned)(255 - (a * 16 + bb));
                    const unsigned ee = e1[a] + e2[bb];
                    const bool me = (qq == (n & 3));
                    ck[n >> 2] = me ? pk : ck[n >> 2]; ce[n >> 2] = me ? ee : ce[n >> 2];
                    ++n;
                }
    }
    float sc[16];
#pragma unroll
    for (int r = 0; r < 16; ++r) {
        unsigned Lm = ck[0];
#pragma unroll
        for (int i = 1; i < 13; ++i) Lm = umax(Lm, ck[i]);
        unsigned M = umax(Lm, (unsigned)__shfl_xor((int)Lm, 16)); M = umax(M, (unsigned)__shfl_xor((int)M, 32));
        unsigned we = 0u;
#pragma unroll
        for (int i = 0; i < 13; ++i) { const bool hit = (ck[i] == M); we = hit ? ce[i] : we; ck[i] = hit ? 0u : ck[i]; }
        sc[r] = ord2f(M & ~0xFFu);
        if (Lm == M) EIDX[(size_t)t * EPT + h * TOPK + r] = (int)we;
        __builtin_amdgcn_sched_barrier(0);
    }
    const float smax = sc[0];
    float den = 0.f;
#pragma unroll
    for (int r = 0; r < 16; ++r) { sc[r] = fexp2((sc[r] - smax) * LOG2E); den += sc[r]; }
    const float rden = 1.0f / den;
    if (qq == 0) {
        float* gp = GATE + (size_t)t * EPT + h * TOPK;
#pragma unroll
        for (int r = 0; r < 16; r += 4) *(f32x4*)(gp + r) = (f32x4){sc[r] * rden, sc[r + 1] * rden, sc[r + 2] * rden, sc[r + 3] * rden};
    }
}

__device__ __forceinline__ float reduce16(const float (&p)[16], int lane) {
    const bool b5 = lane & 32, b4 = lane & 16, b3 = lane & 8, b2 = lane & 4;
    float r8[8], r4[4], r2[2];
#pragma unroll
    for (int k = 0; k < 8; ++k) { const float keep = b5 ? p[k + 8] : p[k], send = b5 ? p[k] : p[k + 8]; r8[k] = keep + __shfl_xor(send, 32); }
#pragma unroll
    for (int k = 0; k < 4; ++k) { const float keep = b4 ? r8[k + 4] : r8[k], send = b4 ? r8[k] : r8[k + 4]; r4[k] = keep + __shfl_xor(send, 16); }
#pragma unroll
    for (int k = 0; k < 2; ++k) { const float keep = b3 ? r4[k + 2] : r4[k], send = b3 ? r4[k] : r4[k + 2]; r2[k] = keep + __shfl_xor(send, 8); }
    const float keep = b2 ? r2[1] : r2[0], send = b2 ? r2[0] : r2[1];
    float r1 = keep + __shfl_xor(send, 4);
    r1 += __shfl_xor(r1, 2); r1 += __shfl_xor(r1, 1);
    return r1;
}
#define G_LANE_OF(e) ((((e) >> 3) & 1) * 32 + (((e) >> 2) & 1) * 16 + (((e) >> 1) & 1) * 8 + ((e) & 1) * 4)
#define G_ISSUE1(slot, TAB, idv, ln) do { const int _id = __builtin_amdgcn_readlane((idv), (ln)); const bf16_t* _rp = (TAB) + (size_t)_id * D_MODEL + 8 * lane; \
        _Pragma("unroll") for (int _i = 0; _i < 4; ++_i) buf[slot][_i] = *(const v4u*)(_rp + 512 * _i); } while (0)
#define G_DOT1(slot, pi) do { float _a = 0.f, _b = 0.f; \
        _Pragma("unroll") for (int _i = 0; _i < 4; ++_i) { _a = dot2bf(buf[slot][_i].x, xb[_i].x, _a); _b = dot2bf(buf[slot][_i].y, xb[_i].y, _b); _a = dot2bf(buf[slot][_i].z, xb[_i].z, _a); _b = dot2bf(buf[slot][_i].w, xb[_i].w, _b); } \
        part[pi] = _a + _b; } while (0)
#define G_FMA1(slot, e) do { const float _a = __int_as_float(__builtin_amdgcn_readlane(__float_as_int(aval), G_LANE_OF(e))); \
        _Pragma("unroll") for (int _i = 0; _i < 4; ++_i) { const v4u _w = buf[slot][_i]; \
            acc[_i][0] += (f32x4){__uint_as_float(_w.x << 16), __uint_as_float(_w.x & 0xffff0000u), __uint_as_float(_w.y << 16), __uint_as_float(_w.y & 0xffff0000u)} * _a; \
            acc[_i][1] += (f32x4){__uint_as_float(_w.z << 16), __uint_as_float(_w.z & 0xffff0000u), __uint_as_float(_w.w << 16), __uint_as_float(_w.w & 0xffff0000u)} * _a; } } while (0)
__device__ __forceinline__ void gather_token(int t, const float* __restrict__ X1, const bf16_t* __restrict__ X1B, const int* __restrict__ EIDX, const float* __restrict__ GATE,
                                             const bf16_t* __restrict__ UB, const bf16_t* __restrict__ VB, const float* __restrict__ g2, const float* __restrict__ b2, float* out, int lane) {
    v4u xb[4];
#pragma unroll
    for (int i = 0; i < 4; ++i) xb[i] = *(const v4u*)(X1B + (size_t)t * D_MODEL + 512 * i + 8 * lane);
    const int id_lo = EIDX[(size_t)t * EPT + lane], id_hi = EIDX[(size_t)t * EPT + 64 + lane];
    const float g_lo = GATE[(size_t)t * EPT + lane], g_hi = GATE[(size_t)t * EPT + 64 + lane];
    f32x4 acc[4][2];
#pragma unroll
    for (int i = 0; i < 4; ++i) { acc[i][0] = (f32x4){0.f, 0.f, 0.f, 0.f}; acc[i][1] = (f32x4){0.f, 0.f, 0.f, 0.f}; }
    const int e_me = ((lane >> 5) & 1) * 8 + ((lane >> 4) & 1) * 4 + ((lane >> 3) & 1) * 2 + ((lane >> 2) & 1);
    v4u buf[4][4];
#pragma unroll
    for (int e = 0; e < 4; ++e) G_ISSUE1(e, UB, id_lo, e);
#pragma unroll 1
    for (int hh = 0; hh < 8; ++hh) {
        const int idv = hh < 4 ? id_lo : id_hi; const float gv = hh < 4 ? g_lo : g_hi;
        const int lb = (hh & 3) * 16;
        const int hn = hh < 7 ? hh + 1 : 7; const int idn = hn < 4 ? id_lo : id_hi; const int lbn = (hn & 3) * 16;
        float part[16];
#pragma unroll
        for (int e = 0; e < 16; ++e) {
            G_DOT1(e & 3, e);
            if (e < 12) G_ISSUE1(e & 3, UB, idv, lb + e + 4); else G_ISSUE1(e & 3, VB, idv, lb + e - 12);
        }
        const float hval = reduce16(part, lane);
        const float gt = __shfl(gv, lb + e_me);
        const float aval = gt * gelu_erf(hval);
#pragma unroll
        for (int e = 0; e < 16; ++e) {
            G_FMA1(e & 3, e);
            if (e < 12) G_ISSUE1(e & 3, VB, idv, lb + e + 4); else G_ISSUE1(e & 3, UB, idn, lbn + e - 12);
        }
    }
    float s = 0.f;
#pragma unroll
    for (int i = 0; i < 4; ++i) {
        const f32x4 x0 = *(const f32x4*)(X1 + (size_t)t * D_MODEL + 512 * i + 8 * lane), x1 = *(const f32x4*)(X1 + (size_t)t * D_MODEL + 512 * i + 8 * lane + 4);
        acc[i][0] = x0 * ALPHA + acc[i][0]; acc[i][1] = x1 * ALPHA + acc[i][1];
        s += (acc[i][0].x + acc[i][0].y) + (acc[i][0].z + acc[i][0].w) + (acc[i][1].x + acc[i][1].y) + (acc[i][1].z + acc[i][1].w);
    }
    const float mean = wave_sum(s) * (1.f / D_MODEL); float q = 0.f;
#pragma unroll
    for (int i = 0; i < 4; ++i)
#pragma unroll
        for (int k = 0; k < 2; ++k) { acc[i][k] = acc[i][k] - mean; q += (acc[i][k].x * acc[i][k].x + acc[i][k].y * acc[i][k].y) + (acc[i][k].z * acc[i][k].z + acc[i][k].w * acc[i][k].w); }
    const float rstd = 1.0f / sqrtf(wave_sum(q) * (1.f / D_MODEL) + LN_EPS);
#pragma unroll
    for (int i = 0; i < 4; ++i)
#pragma unroll
        for (int k = 0; k < 2; ++k) {
            const int c = 512 * i + 8 * lane + 4 * k;
            const f32x4 gg = *(const f32x4*)(g2 + c), bb = *(const f32x4*)(b2 + c);
            *(f32x4*)(out + (size_t)t * D_MODEL + c) = acc[i][k] * rstd * gg + bb;
        }
}

struct Args { const void* in[18]; float* out; unsigned char* ws; int ph_lo, ph_hi, li, pad; };
constexpr int N_PHASES = 8;

__global__ void __launch_bounds__(NTHREADS, 2) mega_fwd(Args args) {
    extern __shared__ __attribute__((aligned(16))) unsigned char lds_raw[];
    LAS unsigned char* lds = (LAS unsigned char*)lds_raw;
    volatile LAS unsigned* MISC = (volatile LAS unsigned*)(lds + MISC_OFF);
    const int tid = threadIdx.x, lane = tid & 63, wave = __builtin_amdgcn_readfirstlane(tid >> 6);
    const int G = gridDim.x, bx = blockIdx.x;
    const int vcu = (G % 8 == 0) ? (bx % 8) * (G / 8) + bx / 8 : bx;
    const int gw = vcu * NWAVES + wave, NGW = G * NWAVES;
    unsigned char* ws = args.ws;
    const float* x = (const float*)args.in[0]; const float* mem = (const float*)args.in[1]; const int* positions = (const int*)args.in[2];
    const float* w_in = (const float*)args.in[3]; const float* w_mem_kv = (const float*)args.in[4]; const float* w_pool = (const float*)args.in[5];
    const float* pool_scale = (const float*)args.in[6]; const float* sinks = (const float*)args.in[7]; const float* w_out = (const float*)args.in[8];
    const float* ln1_g = (const float*)args.in[9]; const float* ln1_b = (const float*)args.in[10]; const float* w_peer_q = (const float*)args.in[11];
    const float* sk1 = (const float*)args.in[12]; const float* sk2 = (const float*)args.in[13]; const float* eu = (const float*)args.in[14]; const float* ev = (const float*)args.in[15];
    const float* ln2_g = (const float*)args.in[16]; const float* ln2_b = (const float*)args.in[17];
    bf16_t* WINT = (bf16_t*)(ws + WS_WINT); bf16_t* WKVT = (bf16_t*)(ws + WS_WKVT); bf16_t* WOT = (bf16_t*)(ws + WS_WOT); bf16_t* WQT = (bf16_t*)(ws + WS_WQT);
    bf16_t* WPT = (bf16_t*)(ws + WS_SMALL); bf16_t* K1B = (bf16_t*)(ws + WS_SMALL + 131072); bf16_t* K2B = (bf16_t*)(ws + WS_SMALL + 163840); float* ROPE = (float*)(ws + WS_SMALL + 262144);
    bf16_t* XB = (bf16_t*)(ws + WS_XB); bf16_t* X1B = (bf16_t*)(ws + WS_X1B); bf16_t* MEMB = (bf16_t*)(ws + WS_MEMB); bf16_t* KVM = (bf16_t*)(ws + WS_KVM);
    float* POOLV = (float*)(ws + WS_POOLV); bf16_t* Q = (bf16_t*)(ws + WS_Q); bf16_t* Kb = (bf16_t*)(ws + WS_K); bf16_t* Vb = (bf16_t*)(ws + WS_V); bf16_t* QM = (bf16_t*)(ws + WS_QM);
    bf16_t* CONCAT = (bf16_t*)(ws + WS_CONCAT); float* Y1 = (float*)(ws + WS_Y1); float* X1 = (float*)(ws + WS_X1); bf16_t* QP = (bf16_t*)(ws + WS_QP);
    int* EIDX = (int*)(ws + WS_EIDX); float* GATE = (float*)(ws + WS_GATE); bf16_t* UB = (bf16_t*)(ws + WS_UB); bf16_t* VB = (bf16_t*)(ws + WS_VB);

    for (int u = tid; u < (LDS_BYTES - MISC_OFF) / 4; u += NTHREADS) MISC[u] = 0u;
    __syncthreads();
    XcdBarrier bar = xcd_barrier_post((unsigned*)(ws + WS_CTL) + CW_BAR + args.li * XCD_BAR_WORDS, MISC + 8);
    const int lo = args.ph_lo, hi = args.ph_hi;
#ifndef ONLY_PHASES
#define ONLY_PHASES 255
#endif
#define IN(k) (((ONLY_PHASES >> (k)) & 1) && lo <= (k) && (k) < hi)
#define SEAM(k) do { if (IN(k) && IN((k) + 1)) xcd_barrier(bar); } while (0)

    if (IN(0)) {
        LAS float* scr = (LAS float*)(lds + wave * 16384);
        constexpr int I_IN = (D_MODEL / 64) * (IN_W / 32), I_KV = (D_MODEL / 64) * (2 * MEM_W / 32), I_O = (D_MODEL / 64) * (D_MODEL / 32), I_Q = I_O, I_P = 4 * 2 * 4;
        constexpr int NITEMS = I_IN + I_KV + I_O + I_Q + I_P;
        for (int it = gw; it < NITEMS; it += NGW) {
            int r = it;
            if (r < I_IN) { p0_transpose_item(w_in, D_MODEL, IN_W, WINT, scr, r, lane); continue; } r -= I_IN;
            if (r < I_KV) { p0_transpose_item(w_mem_kv, D_MODEL, 2 * MEM_W, WKVT, scr, r, lane); continue; } r -= I_KV;
            if (r < I_O) { p0_transpose_item(w_out, D_MODEL, D_MODEL, WOT, scr, r, lane); continue; } r -= I_O;
            if (r < I_Q) { p0_transpose_item(w_peer_q, D_MODEL, D_MODEL, WQT, scr, r, lane); continue; } r -= I_Q;
            { const int gpl = r >> 3; p0_transpose_item(w_pool + (size_t)gpl * 16384, 128, 128, WPT + (size_t)gpl * 16384, scr, r & 7, lane); }
        }
        cvt_stream<false>(x, XB, (size_t)MTOK * D_MODEL, gw, NGW, lane);
        cvt_stream<false>(mem, MEMB, (size_t)MMEM * D_MODEL, gw, NGW, lane);
        cvt_stream<false>(sk1, K1B, (size_t)NKEYS * 128, gw, NGW, lane);
        cvt_stream<false>(sk2, K2B, (size_t)NKEYS * 128, gw, NGW, lane);
        cvt_stream<true>(eu, UB, (size_t)NEXP * D_MODEL, gw, NGW, lane);
        cvt_stream<true>(ev, VB, (size_t)NEXP * D_MODEL, gw, NGW, lane);
        for (int i = gw * 64 + lane; i < MTOK * 8; i += NGW * 64) { float c, s; rope_cs(positions[i >> 3], i & 7, c, s); *(f32x2*)(ROPE + 2 * (size_t)i) = (f32x2){c, s}; }
    }
    SEAM(0);
    if (IN(1)) {
        { pg8::Gemm g{XB, WINT, MTOK, IN_W, D_MODEL}; pg8::StaticOrder S; S.init(MTOK, IN_W, G, bx);
          EpiIn E{POOLV, Q, Kb, Vb, QM, ROPE};
          pg8::gemm_phase<EpiIn, pg8::StaticOrder, true, true>(lds, g, S, E); }
        { pg8::Gemm g{MEMB, WKVT, MMEM, 2 * MEM_W, D_MODEL}; pg8::StaticOrder S; S.init(MMEM, 2 * MEM_W, G, (bx + G - 64) % G);
          EpiStoreBf E{KVM, 2 * MEM_W};
          pg8::gemm_phase<EpiStoreBf, pg8::StaticOrder, true, true>(lds, g, S, E); }
    }
    SEAM(1);
    if (IN(2)) {
        for (int it = vcu; it < 512; it += G) {
            if (it < 256) swa_item(lds, it, Q, Kb, Vb, sinks, CONCAT, tid, wave, lane);
            else mem_item(lds, it - 256, QM, KVM, CONCAT, tid, wave, lane);
        }
        for (int it = gw; it < (MTOK / 16) * 4; it += NGW) pool_item(it, POOLV, WPT, pool_scale, CONCAT, lane);
    }
    SEAM(2);
    if (IN(3)) {
        pg8::Gemm g{CONCAT, WOT, MTOK, D_MODEL, D_MODEL}; pg8::StaticOrder S; S.init(MTOK, D_MODEL, G, bx);
        EpiY1 E{x, Y1};
        pg8::gemm_phase<EpiY1, pg8::StaticOrder, true, true>(lds, g, S, E);
    }
    SEAM(3);
    if (IN(4)) { for (int r = gw; r < MTOK; r += NGW) ln1_row(Y1 + (size_t)r * D_MODEL, ln1_g, ln1_b, X1 + (size_t)r * D_MODEL, X1B + (size_t)r * D_MODEL, lane); }
    SEAM(4);
    if (IN(5)) {
        pg8::Gemm g{X1B, WQT, MTOK, D_MODEL, D_MODEL}; pg8::StaticOrder S; S.init(MTOK, D_MODEL, G, bx);
        EpiStoreBf E{QP, D_MODEL};
        pg8::gemm_phase<EpiStoreBf, pg8::StaticOrder, true, true>(lds, g, S, E);
    }
    SEAM(5);
    if (IN(6)) { for (int it = gw; it < (MTOK / 16) * PHEADS; it += NGW) topk_item(it, QP, K1B, K2B, EIDX, GATE, lane); }
    SEAM(6);
    if (IN(7)) { for (int t = gw; t < MTOK; t += NGW) gather_token(t, X1, X1B, EIDX, GATE, UB, VB, ln2_g, ln2_b, args.out, lane); }
#undef IN
#undef SEAM
}
#if NAIVE_MASK != 0
__device__ __forceinline__ float toF(float v) { return v; }
__device__ __forceinline__ float toF(bf16_t v) { return bf2f(v); }

struct NvEpiF32 { float* C; int ldc, pad; __device__ void operator()(int r, int c, float v) const { C[(size_t)r * ldc + c] = v; } };
struct NvEpiBf { bf16_t* C; int ldc, pad; __device__ void operator()(int r, int c, float v) const { C[(size_t)r * ldc + c] = f2bf(v); } };
struct NvEpiY1 { const float* x; float* y; __device__ void operator()(int r, int c, float v) const { y[(size_t)r * D_MODEL + c] = ALPHA * x[(size_t)r * D_MODEL + c] + v; } };

template <class TA, class Epi>
__global__ void __launch_bounds__(256) nv_gemm(const TA* __restrict__ A, const float* __restrict__ B, int M, int N, int K, Epi epi) {
    __shared__ float As[16][65];
    __shared__ float Bs[16][64];
    const int tx = threadIdx.x & 15, ty = threadIdx.x >> 4;
    const int m0 = blockIdx.y * 64, n0 = blockIdx.x * 64;
    float acc[4][4];
#pragma unroll
    for (int i = 0; i < 4; ++i)
#pragma unroll
        for (int j = 0; j < 4; ++j) acc[i][j] = 0.f;
    for (int k0 = 0; k0 < K; k0 += 16) {
        for (int i = threadIdx.x; i < 1024; i += 256) { const int r = i >> 4, c = i & 15; As[c][r] = toF(A[(size_t)(m0 + r) * K + k0 + c]); }
        for (int i = threadIdx.x; i < 1024; i += 256) { const int r = i >> 6, c = i & 63; Bs[r][c] = B[(size_t)(k0 + r) * N + n0 + c]; }
        __syncthreads();
#pragma unroll
        for (int kk = 0; kk < 16; ++kk) {
            float a[4], b[4];
#pragma unroll
            for (int i = 0; i < 4; ++i) { a[i] = As[kk][ty * 4 + i]; b[i] = Bs[kk][tx * 4 + i]; }
#pragma unroll
            for (int i = 0; i < 4; ++i)
#pragma unroll
                for (int j = 0; j < 4; ++j) acc[i][j] += a[i] * b[j];
        }
        __syncthreads();
    }
#pragma unroll
    for (int i = 0; i < 4; ++i)
#pragma unroll
        for (int j = 0; j < 4; ++j) epi(m0 + ty * 4 + i, n0 + tx * 4 + j, acc[i][j]);
}

__global__ void nv_post1(const float* __restrict__ H, const int* __restrict__ positions, float* POOLV, bf16_t* Q, bf16_t* Kb, bf16_t* Vb, bf16_t* QM) {
    const size_t gid = (size_t)blockIdx.x * blockDim.x + threadIdx.x;
    if (gid >= (size_t)MTOK * IN_W) return;
    const int t = (int)(gid / IN_W), col = (int)(gid % IN_W);
    const float* hr = H + (size_t)t * IN_W;
    const float v = hr[col];
    if (col < POOL_W) { POOLV[(size_t)t * POOL_W + col] = v; return; }
    if (col < POOL_W + SWA_W + KV_W) {
        const bool isq = col < POOL_W + SWA_W;
        const int c = isq ? col - POOL_W : col - POOL_W - SWA_W;
        const int d = c & 63;
        float o = v;
        if (d < 16) {
            const int j = d & 7; float cs, sn; rope_cs(positions[t], j, cs, sn);
            if (d < 8) o = v * cs - hr[col + 8] * sn; else o = v * cs + hr[col - 8] * sn;
        }
        if (isq) Q[(size_t)t * SWA_W + c] = f2bf(o); else Kb[(size_t)t * KV_W + c] = f2bf(o);
        return;
    }
    if (col < POOL_W + SWA_W + 2 * KV_W) { Vb[(size_t)t * KV_W + (col - POOL_W - SWA_W - KV_W)] = f2bf(v); return; }
    QM[(size_t)t * MEM_W + (col - POOL_W - SWA_W - 2 * KV_W)] = f2bf(v);
}
__global__ void nv_cvt_bf16(const float* __restrict__ in, bf16_t* out, size_t n) {
    const size_t gid = (size_t)blockIdx.x * blockDim.x + threadIdx.x;
    if (gid < n) out[gid] = f2bf(in[gid]);
}
__global__ void nv_pool1(const float* __restrict__ POOLV, float* PS) {
    const size_t gid = (size_t)blockIdx.x * blockDim.x + threadIdx.x;
    if (gid >= (size_t)MTOK * POOL_W) return;
    const int t = (int)(gid / POOL_W), ch = (int)(gid % POOL_W);
    const int g = ch >> 7, w = 2 << g, s = t & (SEQ - 1);
    const int cnt = (s + 1) < w ? (s + 1) : w;
    float sum = 0.f;
    for (int i = 0; i < cnt; ++i) sum += POOLV[(size_t)(t - i) * POOL_W + ch];
    PS[gid] = sum / (float)cnt - POOLV[gid];
}
__global__ void nv_pool2(const float* __restrict__ PS, const float* __restrict__ w_pool, const float* __restrict__ pool_scale, bf16_t* CONCAT) {
    const size_t gid = (size_t)blockIdx.x * blockDim.x + threadIdx.x;
    if (gid >= (size_t)MTOK * POOL_W) return;
    const int t = (int)(gid / POOL_W), ch = (int)(gid % POOL_W);
    const int g = ch >> 7, d = ch & 127;
    const float* p = PS + (size_t)t * POOL_W + g * 128;
    const float* w = w_pool + (size_t)g * 128 * 128 + d;
    float y = 0.f;
    for (int c = 0; c < 128; ++c) y += p[c] * w[(size_t)c * 128];
    CONCAT[(size_t)t * D_MODEL + ch] = f2bf(y * pool_scale[ch]);
}
__global__ void __launch_bounds__(256) nv_swa(const bf16_t* __restrict__ Q, const bf16_t* __restrict__ Kb, const bf16_t* __restrict__ Vb, const float* __restrict__ sinks, bf16_t* CONCAT) {
    const int wv = (int)((blockIdx.x * 256 + threadIdx.x) >> 6), lane = threadIdx.x & 63;
    if (wv >= MTOK * NHEAD) return;
    const int t = wv / NHEAD, h = wv % NHEAD, kvh = h >> 2, s = t & (SEQ - 1), tb = t - s;
    const float q = bf2f(Q[(size_t)t * SWA_W + h * HD + lane]);
    float m = sinks[h], l = 1.0f, o = 0.f;
    const int k0 = s - (WINDOW - 1) < 0 ? 0 : s - (WINDOW - 1);
    for (int kk = k0; kk <= s; ++kk) {
        const size_t kt = (size_t)(tb + kk);
        const float sc = wave_sum(q * bf2f(Kb[kt * KV_W + kvh * HD + lane])) * 0.125f;
        const float mn = fmaxf(m, sc), r = expf(m - mn), p = expf(sc - mn);
        l = l * r + p; o = o * r + p * bf2f(Vb[kt * KV_W + kvh * HD + lane]); m = mn;
    }
    CONCAT[(size_t)t * D_MODEL + POOL_W + h * HD + lane] = f2bf(o / l);
}
__global__ void __launch_bounds__(256) nv_mem(const bf16_t* __restrict__ QM, const bf16_t* __restrict__ KVM, bf16_t* CONCAT) {
    const int wv = (int)((blockIdx.x * 256 + threadIdx.x) >> 6), lane = threadIdx.x & 63;
    if (wv >= MTOK * MHEADS) return;
    const int t = wv / MHEADS, hm = wv % MHEADS, b = t / SEQ;
    const float q0 = bf2f(QM[(size_t)t * MEM_W + hm * MHD + lane]), q1 = bf2f(QM[(size_t)t * MEM_W + hm * MHD + 64 + lane]);
    float m = -1e30f, l = 0.f, o0 = 0.f, o1 = 0.f;
    const float scale = 0.08838834764831845f;
    for (int j = 0; j < MEM_LEN; ++j) {
        const bf16_t* kr = KVM + (size_t)(b * MEM_LEN + j) * (2 * MEM_W) + hm * MHD;
        const bf16_t* vr = kr + MEM_W;
        const float sc = wave_sum(q0 * bf2f(kr[lane]) + q1 * bf2f(kr[64 + lane])) * scale;
        const float mn = fmaxf(m, sc), r = expf(m - mn), p = expf(sc - mn);
        l = l * r + p; o0 = o0 * r + p * bf2f(vr[lane]); o1 = o1 * r + p * bf2f(vr[64 + lane]); m = mn;
    }
    bf16_t* orow = CONCAT + (size_t)t * D_MODEL + POOL_W + SWA_W + hm * MHD;
    orow[lane] = f2bf(o0 / l); orow[64 + lane] = f2bf(o1 / l);
}
__global__ void __launch_bounds__(256) nv_ln(const float* __restrict__ in, const float* __restrict__ g, const float* __restrict__ bta, float* outf, bf16_t* outb) {
    const int row = (int)((blockIdx.x * 256 + threadIdx.x) >> 6), lane = threadIdx.x & 63;
    if (row >= MTOK) return;
    const float* r = in + (size_t)row * D_MODEL;
    float v[32]; float s = 0.f;
#pragma unroll
    for (int i = 0; i < 32; ++i) { v[i] = r[lane + 64 * i]; s += v[i]; }
    const float mean = wave_sum(s) * (1.f / D_MODEL); float q = 0.f;
#pragma unroll
    for (int i = 0; i < 32; ++i) { v[i] -= mean; q += v[i] * v[i]; }
    const float rstd = 1.0f / sqrtf(wave_sum(q) * (1.f / D_MODEL) + LN_EPS);
#pragma unroll
    for (int i = 0; i < 32; ++i) {
        const int c = lane + 64 * i; const float y = v[i] * rstd * g[c] + bta[c];
        if (outf) outf[(size_t)row * D_MODEL + c] = y;
        if (outb) outb[(size_t)row * D_MODEL + c] = f2bf(y);
    }
}
__global__ void __launch_bounds__(32) nv_topk(const bf16_t* __restrict__ QP, const float* __restrict__ K1, const float* __restrict__ K2, int* EIDX, float* GATE) {
    __shared__ float sc[256][32];
    __shared__ float lv[32][32];
    __shared__ int li[32][32];
    const int tid = threadIdx.x, gid = blockIdx.x * 32 + tid;
    const int t = gid / PHEADS, h = gid % PHEADS;
    const bf16_t* q = QP + (size_t)t * D_MODEL + h * 256;
    for (int half = 0; half < 2; ++half) {
        const float* Kk = half ? K2 : K1;
        for (int k = 0; k < NKEYS; ++k) {
            float a = 0.f;
            for (int c = 0; c < 128; ++c) a += bf2f(q[half * 128 + c]) * Kk[k * 128 + c];
            sc[half * 128 + k][tid] = a;
        }
        for (int r = 0; r < TOPK; ++r) {
            float best = -INFINITY; int bi = 0;
            for (int k = 0; k < NKEYS; ++k) { const float v = sc[half * 128 + k][tid]; if (v > best) { best = v; bi = k; } }
            lv[half * 16 + r][tid] = best; li[half * 16 + r][tid] = bi; sc[half * 128 + bi][tid] = -INFINITY;
        }
    }
    for (int a = 0; a < 16; ++a) for (int b = 0; b < 16; ++b) sc[a * 16 + b][tid] = lv[a][tid] + lv[16 + b][tid];
    float mx = 0.f, den = 0.f;
    float tv[16]; int ti[16];
#pragma unroll
    for (int r = 0; r < TOPK; ++r) {
        float best = -INFINITY; int bi = 0;
        for (int k = 0; k < 256; ++k) { const float v = sc[k][tid]; if (v > best) { best = v; bi = k; } }
        sc[bi][tid] = -INFINITY;
        if (r == 0) mx = best;
        tv[r] = expf(best - mx); den += tv[r]; ti[r] = li[bi >> 4][tid] * NKEYS + li[16 + (bi & 15)][tid];
    }
#pragma unroll
    for (int r = 0; r < TOPK; ++r) { EIDX[(size_t)t * EPT + h * TOPK + r] = ti[r]; GATE[(size_t)t * EPT + h * TOPK + r] = tv[r] / den; }
}
__global__ void __launch_bounds__(256) nv_gather(const float* __restrict__ X1, const int* __restrict__ EIDX, const float* __restrict__ GATE, const float* __restrict__ EU, const float* __restrict__ EV,
                                                  const float* __restrict__ g, const float* __restrict__ bta, float* out) {
    const int t = (int)((blockIdx.x * 256 + threadIdx.x) >> 6), lane = threadIdx.x & 63;
    if (t >= MTOK) return;
    float x[32], acc[32];
#pragma unroll
    for (int i = 0; i < 32; ++i) { x[i] = X1[(size_t)t * D_MODEL + lane + 64 * i]; acc[i] = 0.f; }
    for (int e = 0; e < EPT; ++e) {
        const int id = EIDX[(size_t)t * EPT + e]; const float gt = GATE[(size_t)t * EPT + e];
        const float* u = EU + (size_t)id * D_MODEL; const float* vv = EV + (size_t)id * D_MODEL;
        float p = 0.f;
#pragma unroll
        for (int i = 0; i < 32; ++i) p += x[i] * u[lane + 64 * i];
        const float a = gt * gelu_erf(wave_sum(p));
#pragma unroll
        for (int i = 0; i < 32; ++i) acc[i] += a * vv[lane + 64 * i];
    }
    float s = 0.f;
#pragma unroll
    for (int i = 0; i < 32; ++i) { acc[i] = ALPHA * x[i] + acc[i]; s += acc[i]; }
    const float mean = wave_sum(s) * (1.f / D_MODEL); float q = 0.f;
#pragma unroll
    for (int i = 0; i < 32; ++i) { acc[i] -= mean; q += acc[i] * acc[i]; }
    const float rstd = 1.0f / sqrtf(wave_sum(q) * (1.f / D_MODEL) + LN_EPS);
#pragma unroll
    for (int i = 0; i < 32; ++i) { const int c = lane + 64 * i; out[(size_t)t * D_MODEL + c] = acc[i] * rstd * g[c] + bta[c]; }
}

#endif
extern "C" void kernel_launch(void* const* d_in, const int* in_sizes, int n_in, void* d_out, int out_size, void* d_ws, size_t ws_size, hipStream_t stream) {
    static int grid = 0;
    if (grid == 0) {
        if (n_in != 18 || in_sizes[0] != MTOK * D_MODEL || out_size != MTOK * D_MODEL || ws_size < WS_END) {
            fprintf(stderr, "kernel_launch: unexpected shapes (n_in %d, in0 %d, out %d, ws %zu)\n", n_in, n_in > 0 ? in_sizes[0] : -1, out_size, ws_size); grid = -1; return; }
        int dev = 0, cus = 0, per_cu = 0;
        if (hipGetDevice(&dev) != hipSuccess || hipDeviceGetAttribute(&cus, hipDeviceAttributeMultiprocessorCount, dev) != hipSuccess) { fprintf(stderr, "kernel_launch: device query failed\n"); grid = -1; return; }
        if (hipFuncSetAttribute((const void*)mega_fwd, hipFuncAttributeMaxDynamicSharedMemorySize, LDS_BYTES) != hipSuccess) { fprintf(stderr, "kernel_launch: hipFuncSetAttribute failed\n"); grid = -1; return; }
        if (hipOccupancyMaxActiveBlocksPerMultiprocessor(&per_cu, (const void*)mega_fwd, NTHREADS, LDS_BYTES) != hipSuccess || per_cu < 1) {
            fprintf(stderr, "kernel_launch: occupancy query reports %d workgroups per CU\n", per_cu); (void)hipGetLastError(); grid = -1; return; }
        grid = cus;
    }
    if (grid < 0) return;
    unsigned char* ws = (unsigned char*)d_ws;
    (void)hipMemsetAsync(ws + WS_CTL, 0, 1 * MiB, stream);
    Args a{};
    for (int i = 0; i < 18; ++i) a.in[i] = d_in[i];
    a.out = (float*)d_out; a.ws = ws;
#if NAIVE_MASK != 0
    const float* x = (const float*)d_in[0]; const float* mem = (const float*)d_in[1]; const int* positions = (const int*)d_in[2];
    const float* w_in = (const float*)d_in[3]; const float* w_mem_kv = (const float*)d_in[4]; const float* w_pool = (const float*)d_in[5];
    const float* pool_scale = (const float*)d_in[6]; const float* sinks = (const float*)d_in[7]; const float* w_out = (const float*)d_in[8];
    const float* ln1_g = (const float*)d_in[9]; const float* ln1_b = (const float*)d_in[10]; const float* w_peer_q = (const float*)d_in[11];
    const float* sk1 = (const float*)d_in[12]; const float* sk2 = (const float*)d_in[13]; const float* eu = (const float*)d_in[14]; const float* ev = (const float*)d_in[15];
    const float* ln2_g = (const float*)d_in[16]; const float* ln2_b = (const float*)d_in[17];
    float* out = (float*)d_out;
    float* POOLV = (float*)(ws + WS_POOLV); bf16_t* Q = (bf16_t*)(ws + WS_Q); bf16_t* Kb = (bf16_t*)(ws + WS_K); bf16_t* Vb = (bf16_t*)(ws + WS_V); bf16_t* QM = (bf16_t*)(ws + WS_QM);
    bf16_t* KVM = (bf16_t*)(ws + WS_KVM); bf16_t* CONCAT = (bf16_t*)(ws + WS_CONCAT); float* Y1 = (float*)(ws + WS_Y1); float* X1 = (float*)(ws + WS_X1); bf16_t* X1B = (bf16_t*)(ws + WS_X1B);
    bf16_t* QP = (bf16_t*)(ws + WS_QP); int* EIDX = (int*)(ws + WS_EIDX); float* GATE = (float*)(ws + WS_GATE);
    float* NVH = (float*)(ws + WS_NV_H); float* NVPS = (float*)(ws + WS_NV_PS); float* NVKVM = (float*)(ws + WS_NV_KVM);
#endif
    int li = 0;
    for (int p = 0; p < N_PHASES;) {
#if NAIVE_MASK != 0
        if ((NAIVE_MASK >> p) & 1) {
            switch (p) {
            case 1:
                nv_gemm<float, NvEpiF32><<<dim3(IN_W / 64, MTOK / 64), 256, 0, stream>>>(x, w_in, MTOK, IN_W, D_MODEL, NvEpiF32{NVH, IN_W, 0});
                nv_gemm<float, NvEpiF32><<<dim3(2 * MEM_W / 64, MMEM / 64), 256, 0, stream>>>(mem, w_mem_kv, MMEM, 2 * MEM_W, D_MODEL, NvEpiF32{NVKVM, 2 * MEM_W, 0});
                nv_post1<<<(unsigned)(((size_t)MTOK * IN_W + 255) / 256), 256, 0, stream>>>(NVH, positions, POOLV, Q, Kb, Vb, QM);
                nv_cvt_bf16<<<(MMEM * 2 * MEM_W + 255) / 256, 256, 0, stream>>>(NVKVM, KVM, (size_t)MMEM * 2 * MEM_W);
                break;
            case 2:
                nv_pool1<<<MTOK * POOL_W / 256, 256, 0, stream>>>(POOLV, NVPS);
                nv_pool2<<<MTOK * POOL_W / 256, 256, 0, stream>>>(NVPS, w_pool, pool_scale, CONCAT);
                nv_swa<<<MTOK * NHEAD / 4, 256, 0, stream>>>(Q, Kb, Vb, sinks, CONCAT);
                nv_mem<<<MTOK * MHEADS / 4, 256, 0, stream>>>(QM, KVM, CONCAT);
                break;
            case 3: nv_gemm<bf16_t, NvEpiY1><<<dim3(D_MODEL / 64, MTOK / 64), 256, 0, stream>>>(CONCAT, w_out, MTOK, D_MODEL, D_MODEL, NvEpiY1{x, Y1}); break;
            case 4: nv_ln<<<MTOK / 4, 256, 0, stream>>>(Y1, ln1_g, ln1_b, X1, X1B); break;
            case 5: nv_gemm<float, NvEpiBf><<<dim3(D_MODEL / 64, MTOK / 64), 256, 0, stream>>>(X1, w_peer_q, MTOK, D_MODEL, D_MODEL, NvEpiBf{QP, D_MODEL, 0}); break;
            case 6: nv_topk<<<MTOK * PHEADS / 32, 32, 0, stream>>>(QP, sk1, sk2, EIDX, GATE); break;
            case 7: nv_gather<<<MTOK / 4, 256, 0, stream>>>(X1, EIDX, GATE, eu, ev, ln2_g, ln2_b, out); break;
            default: break;
            }
            ++p; continue;
        }
#endif
        int q = p;
        while (q < N_PHASES && !((NAIVE_MASK >> q) & 1)) ++q;
        a.ph_lo = p; a.ph_hi = q; a.li = li++;
        hipLaunchKernelGGL(mega_fwd, dim3(grid), dim3(NTHREADS), LDS_BYTES, stream, a);
        const hipError_t le = hipPeekAtLastError();
        if (le != hipSuccess) { fprintf(stderr, "kernel_launch: launch failed: %s\n", hipGetErrorName(le)); break; }
        p = q;
    }
}
```

```cpp
#include <hip/hip_runtime.h>
#include <cstdint>
#include <cstdio>
#ifndef NAIVE_MASK
#define NAIVE_MASK 0
#endif

constexpr int D_MODEL = 2048, BATCH = 2, SEQ = 4096, MTOK = BATCH * SEQ, MEM_LEN = 256, MMEM = BATCH * MEM_LEN;
constexpr int POOL_W = 512, SWA_W = 1024, KV_W = 256, MEM_W = 512, IN_W = 2560;
constexpr int NHEAD = 16, NKV = 4, HD = 64, WINDOW = 128, MHEADS = 4, MHD = 128;
constexpr int PHEADS = 8, NKEYS = 128, TOPK = 16, NEXP = NKEYS * NKEYS, EPT = PHEADS * TOPK;
constexpr float ALPHA = 1.18920711500272106672f;
constexpr float LN_EPS = 1e-5f;

typedef unsigned short bf16_t;
__device__ __forceinline__ float bf2f(bf16_t v) { return __uint_as_float((unsigned)v << 16); }
__device__ __forceinline__ bf16_t f2bf(float f) { unsigned u = __float_as_uint(f); return (bf16_t)((u + 0x7fffu + ((u >> 16) & 1u)) >> 16); }

constexpr size_t MiB = 1u << 20;
constexpr size_t WS_CTL = 0, WS_WINT = 1 * MiB, WS_WKVT = 11 * MiB, WS_WOT = 15 * MiB, WS_WQT = 23 * MiB, WS_SMALL = 31 * MiB;
constexpr size_t WS_XB = 32 * MiB, WS_X1B = 32 * MiB  , WS_MEMB = 64 * MiB, WS_KVM = 66 * MiB;
constexpr size_t WS_POOLV = 68 * MiB, WS_Q = 84 * MiB, WS_K = 100 * MiB, WS_V = 104 * MiB, WS_QM = 108 * MiB, WS_CONCAT = 116 * MiB;
constexpr size_t WS_Y1 = 148 * MiB, WS_X1 = 212 * MiB, WS_QP = 276 * MiB, WS_EIDX = 308 * MiB, WS_GATE = 312 * MiB, WS_UB = 316 * MiB, WS_VB = 380 * MiB, WS_END = 444 * MiB;
constexpr size_t WS_NV_H = 148 * MiB  , WS_NV_PS = 232 * MiB, WS_NV_KVM = 248 * MiB;

__device__ __forceinline__ void rope_cs(int pos, int j, float& c, float& s) {
    const double invf[8] = {1.0, 0.19392274474868576, 0.03760603093086393, 0.007292664737217109, 0.001414213562373095, 0.0002742481756762073, 5.318295896944988e-05, 1.031338537721246e-05};
    double f = j == 0 ? invf[0] : j == 1 ? invf[1] : j == 2 ? invf[2] : j == 3 ? invf[3] : j == 4 ? invf[4] : j == 5 ? invf[5] : j == 6 ? invf[6] : invf[7];
    double rev = (double)pos * f * 0.15915494309189533577;
    rev -= floor(rev);
    float fr = (float)rev;
    s = __builtin_amdgcn_sinf(fr); c = __builtin_amdgcn_cosf(fr);
}
__device__ __forceinline__ float gelu_erf(float h) { return 0.5f * h * (1.0f + erff(h * 0.70710678118654752440f)); }
__device__ __forceinline__ float wave_sum(float v) {
#pragma unroll
    for (int o = 1; o < 64; o <<= 1) v += __shfl_xor(v, o);
    return v;
}

namespace pg8 {
#define PG8_LAS __attribute__((address_space(3)))
typedef unsigned short bf16_t;
typedef short bf16x8 __attribute__((ext_vector_type(8)));
typedef float f32x4 __attribute__((ext_vector_type(4)));
typedef unsigned u32x4 __attribute__((ext_vector_type(4)));
constexpr int BM = 256, BK = 64, HALF = 128, HTB = HALF * BK * 2  , STAGE_BYTES = 8 * HTB, NXCD = 8, WGM = 8;

__host__ __device__ __forceinline__ int lds_byte(int r, int c) { const int st = (r >> 4) * 2 + (c >> 5), rr = r & 15, cc = c & 31, ob = rr * 64 + cc * 2; return st * 1024 + (ob ^ (((ob >> 9) & 1) << 5)); }
__host__ __device__ __forceinline__ void stage_rc(int b, int& R, int& C) { const int st = b / 1024, sb = b % 1024, swz = sb ^ (((sb >> 9) & 1) << 5); R = (st >> 1) * 16 + swz / 64; C = (st & 1) * 32 + (swz % 64) / 2; }
__host__ __device__ __forceinline__ int perm32(int rho) { const int n = rho >> 4, i = rho & 15; return 8 * (i >> 2) + 4 * n + (i & 3); }

struct Unit { int pm, pn; };
struct Gemm { const bf16_t* A; const bf16_t* Bt; int M, N, K; };

struct StaticOrder {
    int nM, nN, nwg, G, c;
    __host__ __device__ void init(int M, int N, int G_, int c_) { nM = M / BM; nN = N / BM; nwg = nM * nN; G = G_; c = c_; }
    __host__ __device__ bool next(int i, Unit& u) const {
        const long L = (long)i * G + c; if (L >= nwg) return false;
        int wgid = (int)L; { const int q = nwg / NXCD, r = nwg % NXCD, xcd = wgid % NXCD, off = wgid / NXCD; wgid = (xcd < r ? xcd * (q + 1) : r * (q + 1) + (xcd - r) * q) + off; }
        const int nig = WGM * nN, gid = wgid / nig, fm = gid * WGM, gsz = (nM - fm) < WGM ? (nM - fm) : WGM;
        u.pm = fm + ((wgid % nig) % gsz); u.pn = (wgid % nig) / gsz; return true;
    }
    __device__ __forceinline__ void a_ready(const Unit&) const {}
    __device__ __forceinline__ void done(const Unit&) const {}
};

__device__ __forceinline__ unsigned cvt_pk_bf16(float lo, float hi) { unsigned r; asm volatile("v_cvt_pk_bf16_f32 %0, %1, %2" : "=v"(r) : "v"(lo), "v"(hi)); return r; }
template <class Epi, class Sched, bool ALIGN_EPI = false, bool SP2 = false>
__device__ __forceinline__ void gemm_phase(PG8_LAS unsigned char* lds, const Gemm g, const Sched& S, const Epi& E) {
    const int tid = threadIdx.x, wid = __builtin_amdgcn_readfirstlane(tid >> 6), lane = tid & 63, wr = wid >> 2, wc = wid & 3, fr = lane & 15, fq = lane >> 4;
    const int K = g.K, nt = K / BK;
    unsigned voffA[2], voffB[2];
#pragma unroll
    for (int i = 0; i < 2; ++i) { int R, C; stage_rc(tid * 16 + i * 8192, R, C); const int Rb = Epi::PERM ? ((R & ~31) + perm32(R & 31)) : R;
        voffA[i] = (unsigned)(R * K + C) * 2u; voffB[i] = (unsigned)(Rb * K + C) * 2u; }
    const size_t kstep = (size_t)(BK * 2);
    const size_t hstep = (size_t)HALF * K * 2;
    const size_t tstep = 2 * hstep;
    const unsigned ldsw = (unsigned)wid * 1024u;
    const int aoff = lds_byte(wr * 64 + fr, fq * 8), boff = lds_byte(wc * 32 + fr, fq * 8);
#define PG8_SA(b, h) (((b) * 2 + (h)) * HTB)
#define PG8_SB(b, h) ((4 + (b) * 2 + (h)) * HTB)
#define PG8_STAGE(bufoff, gbase, voff) do { _Pragma("unroll") for (int _i = 0; _i < 2; ++_i) \
        __builtin_amdgcn_global_load_lds((const unsigned*)((const char*)(gbase) + (voff)[_i]), (PG8_LAS unsigned*)(lds + (bufoff) + ldsw + _i * 8192), 16, 0, 0); } while (0)
#define PG8_LDA(dst, b, h) do { _Pragma("unroll") for (int m = 0; m < 4; ++m) _Pragma("unroll") for (int k = 0; k < 2; ++k) dst[m][k] = *(const PG8_LAS bf16x8*)(lds + PG8_SA(b, h) + aoff + m * 2048 + k * 1024); } while (0)
#define PG8_LDB(dst, b, h) do { _Pragma("unroll") for (int n = 0; n < 2; ++n) _Pragma("unroll") for (int k = 0; k < 2; ++k) dst[n][k] = *(const PG8_LAS bf16x8*)(lds + PG8_SB(b, h) + boff + n * 2048 + k * 1024); } while (0)
#define PG8_MMA(ai, bj, At, Bt) do { __builtin_amdgcn_s_setprio(1); _Pragma("unroll") for (int m = 0; m < 4; ++m) _Pragma("unroll") for (int n = 0; n < 2; ++n) _Pragma("unroll") for (int k = 0; k < 2; ++k) \
        acc[ai][bj][m][n] = __builtin_amdgcn_mfma_f32_16x16x32_bf16(Bt[n][k], At[m][k], acc[ai][bj][m][n], 0, 0, 0); __builtin_amdgcn_s_setprio(0); } while (0)
#define PG8_WAIT_V(n) asm volatile("s_waitcnt vmcnt(" #n ")" ::: "memory")
#define PG8_WAIT_L(n) asm volatile("s_waitcnt lgkmcnt(" #n ")" ::: "memory")
#define PG8_BAR __builtin_amdgcn_s_barrier()
#define PG8_SCHED __builtin_amdgcn_sched_barrier(0)
    Unit cur, nxt; int ui = 0;
    if (!S.next(0, cur)) return;
    f32x4 acc[2][2][4][2];
#pragma unroll
    for (int a = 0; a < 2; ++a)
#pragma unroll
        for (int b = 0; b < 2; ++b)
#pragma unroll
            for (int m = 0; m < 4; ++m)
#pragma unroll
                for (int n = 0; n < 2; ++n) acc[a][b][m][n] = (f32x4){0.f, 0.f, 0.f, 0.f};
    bf16x8 At[4][2], B0[2][2], B1[2][2];
    const char* cA = (const char*)g.A + (size_t)cur.pm * tstep; const char* cB = (const char*)g.Bt + (size_t)cur.pn * tstep;
    S.a_ready(cur);
    if constexpr (SP2) {
        PG8_STAGE(PG8_SB(0, 0), cB, voffB); PG8_STAGE(PG8_SB(0, 1), cB + hstep, voffB); PG8_STAGE(PG8_SA(0, 0), cA, voffA); PG8_STAGE(PG8_SA(0, 1), cA + hstep, voffA);
        if (wr == 1) PG8_BAR;
        PG8_WAIT_V(2); PG8_BAR;
        PG8_STAGE(PG8_SB(1, 0), cB + kstep, voffB); PG8_STAGE(PG8_SA(1, 0), cA + kstep, voffA); PG8_STAGE(PG8_SB(1, 1), cB + hstep + kstep, voffB);
        PG8_WAIT_V(6); PG8_BAR;
    } else {
        PG8_STAGE(PG8_SB(0, 0), cB, voffB); PG8_STAGE(PG8_SA(0, 0), cA, voffA); PG8_STAGE(PG8_SB(0, 1), cB + hstep, voffB); PG8_STAGE(PG8_SA(0, 1), cA + hstep, voffA);
        if (wr == 1) PG8_BAR;
        PG8_WAIT_V(4); PG8_BAR;
        PG8_STAGE(PG8_SB(1, 0), cB + kstep, voffB); PG8_STAGE(PG8_SA(1, 0), cA + kstep, voffA); PG8_STAGE(PG8_SB(1, 1), cB + hstep + kstep, voffB);
        PG8_WAIT_V(6); PG8_BAR;
    }
    for (;;) {
        const bool has_next = S.next(ui + 1, nxt);
        const char* nA = has_next ? (const char*)g.A + (size_t)nxt.pm * tstep : cA; const char* nB = has_next ? (const char*)g.Bt + (size_t)nxt.pn * tstep : cB;
        for (int t = 0; t < nt; t += 2) {
            const bool last = (t == nt - 2);
            const char* a1 = cA + (size_t)(t + 1) * kstep;
            const char* a2 = last ? nA : cA + (size_t)(t + 2) * kstep; const char* b2 = last ? nB : cB + (size_t)(t + 2) * kstep;
            const char* a3 = a2 + kstep; const char* b3 = b2 + kstep;
            if (last && has_next) S.a_ready(nxt);
            if constexpr (SP2) {
            PG8_LDB(B0, 0, 0); PG8_LDB(B1, 0, 1); PG8_SCHED; PG8_LDA(At, 0, 0); PG8_STAGE(PG8_SA(1, 1), a1 + hstep, voffA);
            PG8_WAIT_V(8); PG8_WAIT_L(0); PG8_BAR; PG8_MMA(0, 0, At, B0); PG8_MMA(0, 1, At, B1); PG8_BAR; PG8_SCHED;
            PG8_LDA(At, 0, 1); PG8_STAGE(PG8_SB(0, 0), b2, voffB); PG8_STAGE(PG8_SB(0, 1), b2 + hstep, voffB); PG8_STAGE(PG8_SA(0, 0), a2, voffA);
            PG8_WAIT_V(8); PG8_WAIT_L(0); PG8_BAR; PG8_MMA(1, 0, At, B0); PG8_MMA(1, 1, At, B1); PG8_BAR; PG8_SCHED;
            PG8_LDB(B0, 1, 0); PG8_LDB(B1, 1, 1); PG8_SCHED; PG8_LDA(At, 1, 0); PG8_STAGE(PG8_SA(0, 1), a2 + hstep, voffA);
            PG8_WAIT_V(8); PG8_WAIT_L(0); PG8_BAR; PG8_MMA(0, 0, At, B0); PG8_MMA(0, 1, At, B1); PG8_BAR; PG8_SCHED;
            PG8_LDA(At, 1, 1); PG8_STAGE(PG8_SB(1, 0), b3, voffB); PG8_STAGE(PG8_SB(1, 1), b3 + hstep, voffB); PG8_STAGE(PG8_SA(1, 0), a3, voffA);
            PG8_WAIT_V(8); PG8_WAIT_L(0); PG8_BAR; PG8_MMA(1, 0, At, B0); PG8_MMA(1, 1, At, B1); PG8_BAR; PG8_SCHED;
            } else {
            PG8_LDB(B0, 0, 0); PG8_SCHED; PG8_LDA(At, 0, 0); PG8_STAGE(PG8_SA(1, 1), a1 + hstep, voffA);
            PG8_WAIT_L(8); PG8_BAR; PG8_WAIT_L(0); PG8_MMA(0, 0, At, B0); PG8_BAR; PG8_SCHED;
            PG8_LDB(B1, 0, 1); PG8_STAGE(PG8_SB(0, 0), b2, voffB);
            PG8_BAR; PG8_WAIT_L(0); PG8_MMA(0, 1, At, B1); PG8_BAR;
            PG8_LDA(At, 0, 1); PG8_STAGE(PG8_SA(0, 0), a2, voffA);
            PG8_BAR; PG8_WAIT_L(0); PG8_MMA(1, 0, At, B0); PG8_BAR; PG8_SCHED;
            PG8_STAGE(PG8_SB(0, 1), b2 + hstep, voffB);
            PG8_WAIT_V(6); PG8_BAR; PG8_MMA(1, 1, At, B1); PG8_BAR;
            PG8_LDB(B0, 1, 0); PG8_SCHED; PG8_LDA(At, 1, 0); PG8_STAGE(PG8_SA(0, 1), a2 + hstep, voffA);
            PG8_WAIT_L(8); PG8_BAR; PG8_WAIT_L(0); PG8_MMA(0, 0, At, B0); PG8_BAR; PG8_SCHED;
            PG8_LDB(B1, 1, 1); PG8_STAGE(PG8_SB(1, 0), b3, voffB);
            PG8_BAR; PG8_WAIT_L(0); PG8_MMA(0, 1, At, B1); PG8_BAR;
            PG8_LDA(At, 1, 1); PG8_STAGE(PG8_SA(1, 0), a3, voffA);
            PG8_BAR; PG8_WAIT_L(0); PG8_MMA(1, 0, At, B0); PG8_BAR; PG8_SCHED;
            PG8_STAGE(PG8_SB(1, 1), b3 + hstep, voffB);
            PG8_WAIT_V(6); PG8_BAR; PG8_MMA(1, 1, At, B1); PG8_BAR;
            }
        }
        if constexpr (ALIGN_EPI) { if (wr == 0) PG8_BAR; }
        if constexpr (!Epi::AFTER_DRAIN) { E(acc, cur, wr, wc, fr, fq); S.done(cur); }
        if (!has_next) break;
#pragma unroll
        for (int a = 0; a < 2; ++a)
#pragma unroll
            for (int b = 0; b < 2; ++b)
#pragma unroll
                for (int m = 0; m < 4; ++m)
#pragma unroll
                    for (int n = 0; n < 2; ++n) acc[a][b][m][n] = (f32x4){0.f, 0.f, 0.f, 0.f};
        cur = nxt; cA = nA; cB = nB; ++ui;
        if constexpr (ALIGN_EPI) { if (wr == 1) PG8_BAR; }
    }
    PG8_WAIT_V(0);
    if constexpr (!ALIGN_EPI) { if (wr == 0) PG8_BAR; }
    PG8_BAR;
    if constexpr (Epi::AFTER_DRAIN) { E.fused(acc, cur, wr, wc, fr, fq, lds, wid, lane); S.done(cur); }
#undef PG8_SA
#undef PG8_SB
#undef PG8_STAGE
#undef PG8_LDA
#undef PG8_LDB
#undef PG8_MMA
#undef PG8_WAIT_V
#undef PG8_WAIT_L
#undef PG8_BAR
#undef PG8_SCHED
}
}
#define GAS __attribute__((address_space(1)))
#define LAS __attribute__((address_space(3)))
typedef unsigned v4u __attribute__((ext_vector_type(4)));
typedef unsigned v2u __attribute__((ext_vector_type(2)));
typedef float f32x4 __attribute__((ext_vector_type(4)));
typedef float f32x2 __attribute__((ext_vector_type(2)));
typedef short bf16x8 __attribute__((ext_vector_type(8)));
typedef __bf16 bf16x2 __attribute__((ext_vector_type(2)));
constexpr int NWAVES = 8, NTHREADS = NWAVES * 64;
constexpr int LDS_BYTES = 147456, MISC_OFF = LDS_BYTES - 512;
constexpr int CW_BAR = 4096;
constexpr float LOG2E = 1.44269504088896340736f;

__device__ __forceinline__ unsigned cvtpk(float lo, float hi) { f32x2 v = {lo, hi}; bf16x2 b = __builtin_convertvector(v, bf16x2); return __builtin_bit_cast(unsigned, b); }
__device__ __forceinline__ f32x4 mfma16(bf16x8 a, bf16x8 b, f32x4 c) { return __builtin_amdgcn_mfma_f32_16x16x32_bf16(a, b, c, 0, 0, 0); }
__device__ __forceinline__ float dot2bf(unsigned w, unsigned x, float acc) { return __builtin_amdgcn_fdot2_f32_bf16(__builtin_bit_cast(bf16x2, w), __builtin_bit_cast(bf16x2, x), acc, false); }
__device__ __forceinline__ float fexp2(float x) { return __builtin_amdgcn_exp2f(x); }
#define LDS_WAIT() asm volatile("s_waitcnt lgkmcnt(0)" ::: "memory")

#define XB_TMO      128
#define XB_XCNT(j)  (256  + 64 * (j))
#define XB_XSUB(j)  (1280 + 64 * (j))
#define XB_XGEN(j)  (2304 + 64 * (j))
#define XB_TOP      3328
#define XB_TOPGEN   3392
#define XCD_BAR_WORDS 3456
#define XB_SPIN_CAP (1u << 18)
__device__ __forceinline__ unsigned xb_ld(unsigned* p)              { return __hip_atomic_load(p, __ATOMIC_RELAXED, __HIP_MEMORY_SCOPE_AGENT); }
__device__ __forceinline__ unsigned xb_add(unsigned* p, unsigned v) { return __hip_atomic_fetch_add(p, v, __ATOMIC_RELAXED, __HIP_MEMORY_SCOPE_AGENT); }
__device__ __forceinline__ unsigned xb_xcc_id() { return (unsigned)__builtin_amdgcn_s_getreg((3 << 11) | 20) & 0xFu; }
#define XB_SPIN(cond, bar) do { unsigned _sp = 0; while (cond) { __builtin_amdgcn_s_sleep(1); \
    if ((++_sp & 255u) == 0u) { if (xb_ld(&(bar)[XB_TMO])) break; if (_sp > XB_SPIN_CAP) { atomicAdd(&(bar)[XB_TMO], 1u); break; } } } } while (0)
struct XcdBarrier { unsigned* bar; unsigned x; volatile LAS unsigned* st; };
__device__ __forceinline__ XcdBarrier xcd_barrier_post(unsigned* bar, volatile LAS unsigned* st) {
    XcdBarrier b; b.bar = bar; b.x = xb_xcc_id(); b.st = st;
    if (threadIdx.x == 0) (void)xb_add(&bar[XB_XCNT(b.x)], 1u);
    return b;
}
__device__ __forceinline__ void xcd_barrier_complete(unsigned* bar, unsigned x, unsigned& nloc, unsigned& nx) {
    const unsigned G = gridDim.x * gridDim.y * gridDim.z;
    unsigned sum, cnt, mine, sp = 0u;
    for (;;) {
        sum = 0u; cnt = 0u; mine = 0u;
#pragma unroll
        for (unsigned j = 0; j < 16; ++j) { const unsigned c = xb_ld(&bar[XB_XCNT(j)]); sum += c; cnt += (c > 0u) ? 1u : 0u; mine = (j == x) ? c : mine; }
        if (sum == G) break;
        __builtin_amdgcn_s_sleep(1);
        if ((++sp & 255u) == 0u) { if (xb_ld(&bar[XB_TMO])) break; if (sp > XB_SPIN_CAP) { atomicAdd(&bar[XB_TMO], 1u); break; } }
    }
    nloc = mine > 0u ? mine : 1u; nx = cnt > 0u ? cnt : 1u;
}
__device__ __forceinline__ void xcd_barrier(const XcdBarrier& b) {
    asm volatile("s_waitcnt vmcnt(0)" ::: "memory");
    __syncthreads();
    if (threadIdx.x == 0) {
        unsigned* bar = b.bar;
        __builtin_amdgcn_s_waitcnt(0);
        unsigned nloc = b.st[0], nx = b.st[1];
        if (nloc == 0u) { xcd_barrier_complete(bar, b.x, nloc, nx); b.st[0] = nloc; b.st[1] = nx; }
        const unsigned old = xb_add(&bar[XB_XSUB(b.x)], 1u);
        const unsigned gen = old / nloc;
        if (old + 1u == (gen + 1u) * nloc) {
            __builtin_amdgcn_fence(__ATOMIC_RELEASE, "agent");
            asm volatile("s_waitcnt vmcnt(0)" ::: "memory");
            const unsigned og = xb_add(&bar[XB_TOP], 1u);
            const unsigned tg = og / nx;
            if (og + 1u == (tg + 1u) * nx) xb_add(&bar[XB_TOPGEN], 1u);
            else XB_SPIN(xb_ld(&bar[XB_TOPGEN]) == tg, bar);
            __builtin_amdgcn_fence(__ATOMIC_ACQUIRE, "agent");
            xb_add(&bar[XB_XGEN(b.x)], 1u);
            asm volatile("s_waitcnt vmcnt(0)" ::: "memory");
        } else {
            XB_SPIN(xb_ld(&bar[XB_XGEN(b.x)]) == gen, bar);
            __builtin_amdgcn_fence(__ATOMIC_ACQUIRE, "agent");
            asm volatile("s_waitcnt vmcnt(0)" ::: "memory");
        }
    }
    __syncthreads();
}

struct EpiStoreBf {
    static constexpr bool PERM = true, AFTER_DRAIN = false;
    bf16_t* O; int ldc;
    __device__ __forceinline__ void operator()(const pg8::f32x4 (&acc)[2][2][4][2], const pg8::Unit& u, int wr, int wc, int fr, int fq) const {
        const int row0 = u.pm * 256 + wr * 64 + fr, col0 = u.pn * 256 + wc * 32 + 8 * fq;
#pragma unroll
        for (int ai = 0; ai < 2; ++ai)
#pragma unroll
            for (int m = 0; m < 4; ++m) { bf16_t* rowp = O + (size_t)(row0 + ai * 128 + m * 16) * ldc + col0;
#pragma unroll
                for (int bj = 0; bj < 2; ++bj) { const pg8::f32x4 v0 = acc[ai][bj][m][0], v1 = acc[ai][bj][m][1];
                    v4u w; w.x = cvtpk(v0[0], v0[1]); w.y = cvtpk(v0[2], v0[3]); w.z = cvtpk(v1[0], v1[1]); w.w = cvtpk(v1[2], v1[3]);
                    *(v4u*)(rowp + bj * 128) = w; } }
    }
};
struct EpiY1 {
    static constexpr bool PERM = true, AFTER_DRAIN = false;
    const float* x; float* y;
    __device__ __forceinline__ void operator()(const pg8::f32x4 (&acc)[2][2][4][2], const pg8::Unit& u, int wr, int wc, int fr, int fq) const {
        const int row0 = u.pm * 256 + wr * 64 + fr, col0 = u.pn * 256 + wc * 32 + 8 * fq;
#pragma unroll
        for (int ai = 0; ai < 2; ++ai)
#pragma unroll
            for (int m = 0; m < 4; ++m) { const size_t off = (size_t)(row0 + ai * 128 + m * 16) * D_MODEL + col0;
#pragma unroll
                for (int bj = 0; bj < 2; ++bj) {
                    const f32x4 x0 = *(const f32x4*)(x + off + bj * 128), x1 = *(const f32x4*)(x + off + bj * 128 + 4);
                    *(f32x4*)(y + off + bj * 128) = x0 * ALPHA + acc[ai][bj][m][0]; *(f32x4*)(y + off + bj * 128 + 4) = x1 * ALPHA + acc[ai][bj][m][1]; } }
    }
};
struct EpiIn {
    static constexpr bool PERM = true, AFTER_DRAIN = false;
    float* POOLV; bf16_t *Q, *K, *V, *QM; const float* rope;
    __device__ __forceinline__ void operator()(const pg8::f32x4 (&acc)[2][2][4][2], const pg8::Unit& u, int wr, int wc, int fr, int fq) const {
        const int row0 = u.pm * 256 + wr * 64 + fr, cl = wc * 32 + 8 * fq, pn = u.pn;
        if (pn < 2) {
#pragma unroll
            for (int ai = 0; ai < 2; ++ai)
#pragma unroll
                for (int m = 0; m < 4; ++m) { float* rp = POOLV + (size_t)(row0 + ai * 128 + m * 16) * POOL_W + pn * 256 + cl;
#pragma unroll
                    for (int bj = 0; bj < 2; ++bj) { *(f32x4*)(rp + bj * 128) = acc[ai][bj][m][0]; *(f32x4*)(rp + bj * 128 + 4) = acc[ai][bj][m][1]; } }
            return;
        }
        bf16_t* base; int ld, c0; bool rot = false;
        if (pn < 6) { base = Q; ld = SWA_W; c0 = (pn - 2) * 256; rot = true; }
        else if (pn == 6) { base = K; ld = KV_W; c0 = 0; rot = true; }
        else if (pn == 7) { base = V; ld = KV_W; c0 = 0; }
        else { base = QM; ld = MEM_W; c0 = (pn - 8) * 256; }
        rot = rot && ((wc & 1) == 0);
#pragma unroll
        for (int ai = 0; ai < 2; ++ai)
#pragma unroll
            for (int m = 0; m < 4; ++m) {
                const int row = row0 + ai * 128 + m * 16;
                f32x4 v[2][2];
#pragma unroll
                for (int bj = 0; bj < 2; ++bj) { v[bj][0] = acc[ai][bj][m][0]; v[bj][1] = acc[ai][bj][m][1]; }
                if (rot) {
                    const f32x4* tp = (const f32x4*)(rope + (size_t)row * 16);
                    f32x4 cs[2][2]; cs[0][0] = tp[0]; cs[0][1] = tp[1]; cs[1][0] = tp[2]; cs[1][1] = tp[3];
#pragma unroll
                    for (int bj = 0; bj < 2; ++bj)
#pragma unroll
                        for (int n = 0; n < 2; ++n)
#pragma unroll
                            for (int i = 0; i < 4; ++i) {
                                const float xv = v[bj][n][i], pv = __shfl_xor(xv, 16);
                                const float c = cs[n][i >> 1][2 * (i & 1)], s = cs[n][i >> 1][2 * (i & 1) + 1];
                                const float o = fq == 0 ? xv * c - pv * s : (fq == 1 ? xv * c + pv * s : xv);
                                v[bj][n][i] = o; }
                }
                bf16_t* rowp = base + (size_t)row * ld + c0 + cl;
#pragma unroll
                for (int bj = 0; bj < 2; ++bj) { v4u w; w.x = cvtpk(v[bj][0][0], v[bj][0][1]); w.y = cvtpk(v[bj][0][2], v[bj][0][3]); w.z = cvtpk(v[bj][1][0], v[bj][1][1]); w.w = cvtpk(v[bj][1][2], v[bj][1][3]);
                    *(v4u*)(rowp + bj * 128) = w; }
            }
    }
};

__device__ __forceinline__ void p0_transpose_item(const float* W, int K, int N, bf16_t* WT, LAS float* scr, int item, int lane) {
    const int nblk = N / 32, kb = item / nblk, nb = item % nblk, k0 = 64 * kb, n0 = 32 * nb;
#pragma unroll 8
    for (int i = 0; i < 32; ++i) { const int kk = 2 * i + (lane >> 5); scr[kk * 33 + (lane & 31)] = W[(size_t)(k0 + kk) * N + n0 + (lane & 31)]; }
    LDS_WAIT(); asm volatile("" ::: "memory");
    const int c = lane & 7;
#pragma unroll
    for (int j = 0; j < 4; ++j) { const int n = (lane >> 3) + 8 * j; const LAS float* s = scr + (8 * c) * 33 + n;
        v4u o; o.x = cvtpk(s[0 * 33], s[1 * 33]); o.y = cvtpk(s[2 * 33], s[3 * 33]); o.z = cvtpk(s[4 * 33], s[5 * 33]); o.w = cvtpk(s[6 * 33], s[7 * 33]);
        *(v4u*)(WT + (size_t)(n0 + n) * K + k0 + 8 * c) = o; }
    LDS_WAIT(); asm volatile("" ::: "memory");
}
template <bool NT>
__device__ __forceinline__ void cvt_stream(const float* in, bf16_t* out, size_t n, int gw, int NGW, int lane) {
#pragma unroll 4
    for (size_t i = (size_t)gw * 512 + lane * 8; i < n; i += (size_t)NGW * 512) {
        f32x4 a, b;
        if (NT) { a = __builtin_nontemporal_load((const f32x4*)(in + i)); b = __builtin_nontemporal_load((const f32x4*)(in + i + 4)); }
        else { a = *(const f32x4*)(in + i); b = *(const f32x4*)(in + i + 4); }
        v4u o; o.x = cvtpk(a.x, a.y); o.y = cvtpk(a.z, a.w); o.z = cvtpk(b.x, b.y); o.w = cvtpk(b.z, b.w);
        *(v4u*)(out + i) = o;
    }
}

constexpr int SWA_KROW = 144, SWA_VROW = 528, SWA_VT_OFF = 256 * SWA_KROW;
__device__ __forceinline__ void swa_item(LAS unsigned char* lds, int item, const bf16_t* __restrict__ Q, const bf16_t* __restrict__ Kb, const bf16_t* __restrict__ Vb, const float* __restrict__ sinks,
                                         bf16_t* CONCAT, int tid, int wave, int lane) {
    const int qb = item & 31, kvh = (item >> 5) & 3, b = item >> 7;
    const int tok0 = b * SEQ + qb * 128;
    LAS unsigned char* Kl = lds; LAS unsigned char* Vt = lds + SWA_VT_OFF;
#pragma unroll
    for (int j = 0; j < 4; ++j) {
        const int c = tid + NTHREADS * j, row = c >> 3, part = c & 7;
        v4u kv = {0u, 0u, 0u, 0u}, vv = {0u, 0u, 0u, 0u};
        if (qb > 0 || row >= 128) { const size_t tk = (size_t)(tok0 - 128 + row); kv = *(const v4u*)(Kb + tk * KV_W + kvh * HD + part * 8); vv = *(const v4u*)(Vb + tk * KV_W + kvh * HD + part * 8); }
        *(LAS v4u*)(Kl + row * SWA_KROW + part * 16) = kv;
        LAS unsigned short* vp = (LAS unsigned short*)(Vt + (part * 8) * SWA_VROW + row * 2);
        vp[0 * (SWA_VROW / 2)] = (unsigned short)(vv.x & 0xffffu); vp[1 * (SWA_VROW / 2)] = (unsigned short)(vv.x >> 16);
        vp[2 * (SWA_VROW / 2)] = (unsigned short)(vv.y & 0xffffu); vp[3 * (SWA_VROW / 2)] = (unsigned short)(vv.y >> 16);
        vp[4 * (SWA_VROW / 2)] = (unsigned short)(vv.z & 0xffffu); vp[5 * (SWA_VROW / 2)] = (unsigned short)(vv.z >> 16);
        vp[6 * (SWA_VROW / 2)] = (unsigned short)(vv.w & 0xffffu); vp[7 * (SWA_VROW / 2)] = (unsigned short)(vv.w >> 16);
    }
    __syncthreads();
    const int g = wave & 3, h = kvh * 4 + g, q15 = lane & 15, qq = lane >> 4;
    const float sink2 = sinks[h] * LOG2E;
    const float SC = 0.125f * LOG2E;
#pragma unroll 1
    for (int cc = 0; cc < 2; ++cc) {
        const int c = 2 * (wave >> 2) + cc, kl0 = 32 * c;
        bf16x8 qf[2][2];
#pragma unroll
        for (int ni = 0; ni < 2; ++ni)
#pragma unroll
            for (int ks = 0; ks < 2; ++ks) qf[ni][ks] = *(const bf16x8*)(Q + (size_t)(tok0 + 32 * c + 16 * ni + q15) * SWA_W + h * HD + 32 * ks + 8 * qq);
        f32x4 s[10][2];
#pragma unroll
        for (int mi = 0; mi < 10; ++mi) { s[mi][0] = (f32x4){0.f, 0.f, 0.f, 0.f}; s[mi][1] = (f32x4){0.f, 0.f, 0.f, 0.f}; }
#pragma unroll
        for (int mi = 0; mi < 10; ++mi)
#pragma unroll
            for (int ks = 0; ks < 2; ++ks) {
                const bf16x8 kf = *(const LAS bf16x8*)(Kl + (kl0 + 16 * mi + q15) * SWA_KROW + (32 * ks + 8 * qq) * 2);
                s[mi][0] = mfma16(kf, qf[0][ks], s[mi][0]); s[mi][1] = mfma16(kf, qf[1][ks], s[mi][1]);
            }
        float rl[2];
#pragma unroll
        for (int ni = 0; ni < 2; ++ni) {
            const int ql = 32 * c + 16 * ni + q15;
            float mx = -INFINITY;
#pragma unroll
            for (int mi = 0; mi < 10; ++mi)
#pragma unroll
                for (int r = 0; r < 4; ++r) {
                    const int kl = kl0 + 16 * mi + 4 * qq + r;
                    const bool valid = (kl > ql) && (kl <= ql + 128) && (qb > 0 || kl >= 128);
                    const float t = valid ? s[mi][ni][r] * SC : -INFINITY;
                    s[mi][ni][r] = t; mx = fmaxf(mx, t);
                }
            mx = fmaxf(mx, __shfl_xor(mx, 16)); mx = fmaxf(mx, __shfl_xor(mx, 32)); mx = fmaxf(mx, sink2);
            float l = 0.f;
#pragma unroll
            for (int mi = 0; mi < 10; ++mi)
#pragma unroll
                for (int r = 0; r < 4; ++r) { const float p = fexp2(s[mi][ni][r] - mx); s[mi][ni][r] = p; l += p; }
            l += __shfl_xor(l, 16); l += __shfl_xor(l, 32); l += fexp2(sink2 - mx);
            rl[ni] = 1.0f / l;
        }
        f32x4 o[4][2];
#pragma unroll
        for (int dt = 0; dt < 4; ++dt) { o[dt][0] = (f32x4){0.f, 0.f, 0.f, 0.f}; o[dt][1] = (f32x4){0.f, 0.f, 0.f, 0.f}; }
#pragma unroll
        for (int kk = 0; kk < 5; ++kk) {
            bf16x8 pf[2];
#pragma unroll
            for (int ni = 0; ni < 2; ++ni) {
                v4u w; w.x = cvtpk(s[2 * kk][ni][0], s[2 * kk][ni][1]); w.y = cvtpk(s[2 * kk][ni][2], s[2 * kk][ni][3]);
                w.z = cvtpk(s[2 * kk + 1][ni][0], s[2 * kk + 1][ni][1]); w.w = cvtpk(s[2 * kk + 1][ni][2], s[2 * kk + 1][ni][3]);
                pf[ni] = __builtin_bit_cast(bf16x8, w);
            }
#pragma unroll
            for (int dt = 0; dt < 4; ++dt) {
                const LAS unsigned char* vb = Vt + (16 * dt + q15) * SWA_VROW + (kl0 + 32 * kk + 4 * qq) * 2;
                const v2u lo = *(const LAS v2u*)vb, hi = *(const LAS v2u*)(vb + 32);
                v4u w; w.x = lo.x; w.y = lo.y; w.z = hi.x; w.w = hi.y;
                const bf16x8 vf = __builtin_bit_cast(bf16x8, w);
                o[dt][0] = mfma16(vf, pf[0], o[dt][0]); o[dt][1] = mfma16(vf, pf[1], o[dt][1]);
            }
        }
#pragma unroll
        for (int ni = 0; ni < 2; ++ni) {
            bf16_t* orow = CONCAT + (size_t)(tok0 + 32 * c + 16 * ni + q15) * D_MODEL + POOL_W + h * HD + 4 * qq;
#pragma unroll
            for (int dt = 0; dt < 4; ++dt) { v2u w; w.x = cvtpk(o[dt][ni][0] * rl[ni], o[dt][ni][1] * rl[ni]); w.y = cvtpk(o[dt][ni][2] * rl[ni], o[dt][ni][3] * rl[ni]); *(v2u*)(orow + 16 * dt) = w; }
        }
    }
    __syncthreads();
}
constexpr int MEM_KROW = 272, MEM_VROW = 528, MEM_VT_OFF = 256 * MEM_KROW;
__device__ __forceinline__ void mem_item(LAS unsigned char* lds, int item, const bf16_t* __restrict__ QM, const bf16_t* __restrict__ KVM, bf16_t* CONCAT, int tid, int wave, int lane) {
    const int qt = item & 31, hm = (item >> 5) & 3, b = item >> 7;
    LAS unsigned char* Kl = lds; LAS unsigned char* Vt = lds + MEM_VT_OFF;
#pragma unroll
    for (int j = 0; j < 8; ++j) {
        const int c = tid + NTHREADS * j, row = c >> 4, part = c & 15;
        const bf16_t* src = KVM + (size_t)(b * MEM_LEN + row) * (2 * MEM_W) + hm * MHD + part * 8;
        const v4u kv = *(const v4u*)src, vv = *(const v4u*)(src + MEM_W);
        *(LAS v4u*)(Kl + row * MEM_KROW + part * 16) = kv;
        LAS unsigned short* vp = (LAS unsigned short*)(Vt + (part * 8) * MEM_VROW + row * 2);
        vp[0 * (MEM_VROW / 2)] = (unsigned short)(vv.x & 0xffffu); vp[1 * (MEM_VROW / 2)] = (unsigned short)(vv.x >> 16);
        vp[2 * (MEM_VROW / 2)] = (unsigned short)(vv.y & 0xffffu); vp[3 * (MEM_VROW / 2)] = (unsigned short)(vv.y >> 16);
        vp[4 * (MEM_VROW / 2)] = (unsigned short)(vv.z & 0xffffu); vp[5 * (MEM_VROW / 2)] = (unsigned short)(vv.z >> 16);
        vp[6 * (MEM_VROW / 2)] = (unsigned short)(vv.w & 0xffffu); vp[7 * (MEM_VROW / 2)] = (unsigned short)(vv.w >> 16);
    }
    __syncthreads();
    const int q15 = lane & 15, qq = lane >> 4;
    const int tok = b * SEQ + qt * 128 + wave * 16 + q15;
    const float SC = 0.08838834764831845f * LOG2E;
    bf16x8 qf[4];
#pragma unroll
    for (int ks = 0; ks < 4; ++ks) qf[ks] = *(const bf16x8*)(QM + (size_t)tok * MEM_W + hm * MHD + 32 * ks + 8 * qq);
    f32x4 s[16];
#pragma unroll
    for (int mi = 0; mi < 16; ++mi) s[mi] = (f32x4){0.f, 0.f, 0.f, 0.f};
#pragma unroll
    for (int mi = 0; mi < 16; ++mi)
#pragma unroll
        for (int ks = 0; ks < 4; ++ks) {
            const bf16x8 kf = *(const LAS bf16x8*)(Kl + (16 * mi + q15) * MEM_KROW + (32 * ks + 8 * qq) * 2);
            s[mi] = mfma16(kf, qf[ks], s[mi]);
        }
    float mx = -INFINITY;
#pragma unroll
    for (int mi = 0; mi < 16; ++mi)
#pragma unroll
        for (int r = 0; r < 4; ++r) { const float t = s[mi][r] * SC; s[mi][r] = t; mx = fmaxf(mx, t); }
    mx = fmaxf(mx, __shfl_xor(mx, 16)); mx = fmaxf(mx, __shfl_xor(mx, 32));
    float l = 0.f;
#pragma unroll
    for (int mi = 0; mi < 16; ++mi)
#pragma unroll
        for (int r = 0; r < 4; ++r) { const float p = fexp2(s[mi][r] - mx); s[mi][r] = p; l += p; }
    l += __shfl_xor(l, 16); l += __shfl_xor(l, 32);
    const float rl = 1.0f / l;
    f32x4 o[8];
#pragma unroll
    for (int dt = 0; dt < 8; ++dt) o[dt] = (f32x4){0.f, 0.f, 0.f, 0.f};
#pragma unroll
    for (int kk = 0; kk < 8; ++kk) {
        v4u pw; pw.x = cvtpk(s[2 * kk][0], s[2 * kk][1]); pw.y = cvtpk(s[2 * kk][2], s[2 * kk][3]); pw.z = cvtpk(s[2 * kk + 1][0], s[2 * kk + 1][1]); pw.w = cvtpk(s[2 * kk + 1][2], s[2 * kk + 1][3]);
        const bf16x8 pf = __builtin_bit_cast(bf16x8, pw);
#pragma unroll
        for (int dt = 0; dt < 8; ++dt) {
            const LAS unsigned char* vb = Vt + (16 * dt + q15) * MEM_VROW + (32 * kk + 4 * qq) * 2;
            const v2u lo = *(const LAS v2u*)vb, hi = *(const LAS v2u*)(vb + 32);
            v4u w; w.x = lo.x; w.y = lo.y; w.z = hi.x; w.w = hi.y;
            o[dt] = mfma16(__builtin_bit_cast(bf16x8, w), pf, o[dt]);
        }
    }
    bf16_t* orow = CONCAT + (size_t)tok * D_MODEL + POOL_W + SWA_W + hm * MHD + 4 * qq;
#pragma unroll
    for (int dt = 0; dt < 8; ++dt) { v2u w; w.x = cvtpk(o[dt][0] * rl, o[dt][1] * rl); w.y = cvtpk(o[dt][2] * rl, o[dt][3] * rl); *(v2u*)(orow + 16 * dt) = w; }
    __syncthreads();
}
__device__ __forceinline__ void pool_item(int item, const float* __restrict__ POOLV, const bf16_t* __restrict__ WPT, const float* __restrict__ pool_scale, bf16_t* CONCAT, int lane) {
    const int g = item & 3, t0 = (item >> 2) * 16, w = 2 << g, q15 = lane & 15, qq = lane >> 4;
    const int t = t0 + q15, sp = t & (SEQ - 1);
    const int cnt = (sp + 1) < w ? (sp + 1) : w;
    const float inv = 1.0f / (float)cnt;
    bf16x8 pf[4];
#pragma unroll
    for (int ks = 0; ks < 4; ++ks) {
        const float* p0 = POOLV + (size_t)t * POOL_W + g * 128 + 32 * ks + 8 * qq;
        const f32x4 c0 = *(const f32x4*)p0, c1 = *(const f32x4*)(p0 + 4);
        f32x4 a0 = c0, a1 = c1;
        for (int i = 1; i < cnt; ++i) { a0 += *(const f32x4*)(p0 - (size_t)i * POOL_W); a1 += *(const f32x4*)(p0 - (size_t)i * POOL_W + 4); }
        a0 = a0 * inv - c0; a1 = a1 * inv - c1;
        v4u pw; pw.x = cvtpk(a0.x, a0.y); pw.y = cvtpk(a0.z, a0.w); pw.z = cvtpk(a1.x, a1.y); pw.w = cvtpk(a1.z, a1.w);
        pf[ks] = __builtin_bit_cast(bf16x8, pw);
    }
    bf16_t* orow = CONCAT + (size_t)t * D_MODEL + g * 128 + 4 * qq;
#pragma unroll
    for (int mt = 0; mt < 8; ++mt) {
        f32x4 acc = {0.f, 0.f, 0.f, 0.f};
#pragma unroll
        for (int ks = 0; ks < 4; ++ks) { const bf16x8 wf = *(const bf16x8*)(WPT + (size_t)g * 16384 + (16 * mt + q15) * 128 + 32 * ks + 8 * qq); acc = mfma16(wf, pf[ks], acc); }
        const f32x4 sc = *(const f32x4*)(pool_scale + g * 128 + 16 * mt + 4 * qq);
        v2u wv; wv.x = cvtpk(acc[0] * sc[0], acc[1] * sc[1]); wv.y = cvtpk(acc[2] * sc[2], acc[3] * sc[3]);
        *(v2u*)(orow + 16 * mt) = wv;
    }
}

__device__ __forceinline__ void ln1_row(const float* __restrict__ yrow, const float* __restrict__ g, const float* __restrict__ bta, float* xo, bf16_t* xb, int lane) {
    f32x4 v[8]; float s = 0.f;
#pragma unroll
    for (int j = 0; j < 8; ++j) { v[j] = *(const f32x4*)(yrow + 256 * j + 4 * lane); s += (v[j].x + v[j].y) + (v[j].z + v[j].w); }
    const float mean = wave_sum(s) * (1.f / D_MODEL); float q = 0.f;
#pragma unroll
    for (int j = 0; j < 8; ++j) { v[j] = v[j] - mean; q += (v[j].x * v[j].x + v[j].y * v[j].y) + (v[j].z * v[j].z + v[j].w * v[j].w); }
    const float rstd = 1.0f / sqrtf(wave_sum(q) * (1.f / D_MODEL) + LN_EPS);
#pragma unroll
    for (int j = 0; j < 8; ++j) {
        const f32x4 gg = *(const f32x4*)(g + 256 * j + 4 * lane), bb = *(const f32x4*)(bta + 256 * j + 4 * lane);
        const f32x4 y = v[j] * rstd * gg + bb;
        *(f32x4*)(xo + 256 * j + 4 * lane) = y;
        v2u w; w.x = cvtpk(y.x, y.y); w.y = cvtpk(y.z, y.w); *(v2u*)(xb + 256 * j + 4 * lane) = w;
    }
}

__device__ __forceinline__ unsigned f2ord(float f) { const unsigned u = __float_as_uint(f); return u ^ ((unsigned)((int)u >> 31) | 0x80000000u); }
__device__ __forceinline__ float ord2f(unsigned o) { const unsigned u = (o & 0x80000000u) ? (o ^ 0x80000000u) : ~o; return __uint_as_float(u); }
__device__ __forceinline__ unsigned umax(unsigned a, unsigned b) { return a > b ? a : b; }
__device__ __forceinline__ void topk_item(int item, const bf16_t* __restrict__ QP, const bf16_t* __restrict__ K1B, const bf16_t* __restrict__ K2B, int* EIDX, float* GATE, int lane) {
    const int h = item & 7, t0 = (item >> 3) * 16, q15 = lane & 15, qq = lane >> 4;
    const int t = t0 + q15;
    unsigned top[2][16];
#pragma unroll
    for (int half = 0; half < 2; ++half) {
        const bf16_t* KB = half ? K2B : K1B;
        bf16x8 qf[4];
#pragma unroll
        for (int ks = 0; ks < 4; ++ks) qf[ks] = *(const bf16x8*)(QP + (size_t)t * D_MODEL + h * 256 + half * 128 + 32 * ks + 8 * qq);
        unsigned key[32];
#pragma unroll
        for (int mi = 0; mi < 8; ++mi) {
            f32x4 acc = {0.f, 0.f, 0.f, 0.f};
#pragma unroll
            for (int ks = 0; ks < 4; ++ks) { const bf16x8 kf = *(const bf16x8*)(KB + (16 * mi + q15) * 128 + 32 * ks + 8 * qq); acc = mfma16(kf, qf[ks], acc); }
#pragma unroll
            for (int r = 0; r < 4; ++r) key[mi * 4 + r] = (f2ord(acc[r]) & ~0x7Fu) | (unsigned)(127 - (16 * mi + 4 * qq + r));
        }
#pragma unroll
        for (int r = 0; r < 16; ++r) {
            unsigned M = key[0];
#pragma unroll
            for (int i = 1; i < 32; ++i) M = umax(M, key[i]);
            M = umax(M, (unsigned)__shfl_xor((int)M, 16)); M = umax(M, (unsigned)__shfl_xor((int)M, 32));
            top[half][r] = M;
#pragma unroll
            for (int i = 0; i < 32; ++i) key[i] = (key[i] == M) ? 0u : key[i];
            __builtin_amdgcn_sched_barrier(0);
        }
        __builtin_amdgcn_sched_barrier(0);
    }
    float v1[16], v2[16]; unsigned e1[16], e2[16];
#pragma unroll
    for (int r = 0; r < 16; ++r) { v1[r] = ord2f(top[0][r] & ~0x7Fu); v2[r] = ord2f(top[1][r] & ~0x7Fu); e1[r] = (127u - (top[0][r] & 0x7Fu)) * 128u; e2[r] = 127u - (top[1][r] & 0x7Fu); }
    unsigned ck[13], ce[13];
#pragma unroll
    for (int i = 0; i < 13; ++i) { ck[i] = 0u; ce[i] = 0u; }
    {
        int n = 0;
#pragma unroll
        for (int a = 0; a < 16; ++a)
#pragma unroll
            for (int bb = 0; bb < 16; ++bb)
                if ((a + 1) * (bb + 1) <= 16) {
                    const unsigned pk = (f2ord(v1[a] + v2[bb]) & ~0xFFu) | (unsigned)(255 - (a * 16 + bb));
                    const unsigned ee = e1[a] + e2[bb];
                    const bool me = (qq == (n & 3));
                    ck[n >> 2] = me ? pk : ck[n >> 2]; ce[n >> 2] = me ? ee : ce[n >> 2];
                    ++n;
                }
    }
    float sc[16];
#pragma unroll
    for (int r = 0; r < 16; ++r) {
        unsigned Lm = ck[0];
#pragma unroll
        for (int i = 1; i < 13; ++i) Lm = umax(Lm, ck[i]);
        unsigned M = umax(Lm, (unsigned)__shfl_xor((int)Lm, 16)); M = umax(M, (unsigned)__shfl_xor((int)M, 32));
        unsigned we = 0u;
#pragma unroll
        for (int i = 0; i < 13; ++i) { const bool hit = (ck[i] == M); we = hit ? ce[i] : we; ck[i] = hit ? 0u : ck[i]; }
        sc[r] = ord2f(M & ~0xFFu);
        if (Lm == M) EIDX[(size_t)t * EPT + h * TOPK + r] = (int)we;
        __builtin_amdgcn_sched_barrier(0);
    }
    const float smax = sc[0];
    float den = 0.f;
#pragma unroll
    for (int r = 0; r < 16; ++r) { sc[r] = fexp2((sc[r] - smax) * LOG2E); den += sc[r]; }
    const float rden = 1.0f / den;
    if (qq == 0) {
        float* gp = GATE + (size_t)t * EPT + h * TOPK;
#pragma unroll
        for (int r = 0; r < 16; r += 4) *(f32x4*)(gp + r) = (f32x4){sc[r] * rden, sc[r + 1] * rden, sc[r + 2] * rden, sc[r + 3] * rden};
    }
}

__device__ __forceinline__ float reduce16(const float (&p)[16], int lane) {
    const bool b5 = lane & 32, b4 = lane & 16, b3 = lane & 8, b2 = lane & 4;
    float r8[8], r4[4], r2[2];
#pragma unroll
    for (int k = 0; k < 8; ++k) { const float keep = b5 ? p[k + 8] : p[k], send = b5 ? p[k] : p[k + 8]; r8[k] = keep + __shfl_xor(send, 32); }
#pragma unroll
    for (int k = 0; k < 4; ++k) { const float keep = b4 ? r8[k + 4] : r8[k], send = b4 ? r8[k] : r8[k + 4]; r4[k] = keep + __shfl_xor(send, 16); }
#pragma unroll
    for (int k = 0; k < 2; ++k) { const float keep = b3 ? r4[k + 2] : r4[k], send = b3 ? r4[k] : r4[k + 2]; r2[k] = keep + __shfl_xor(send, 8); }
    const float keep = b2 ? r2[1] : r2[0], send = b2 ? r2[0] : r2[1];
    float r1 = keep + __shfl_xor(send, 4);
    r1 += __shfl_xor(r1, 2); r1 += __shfl_xor(r1, 1);
    return r1;
}
#define G_LANE_OF(e) ((((e) >> 3) & 1) * 32 + (((e) >> 2) & 1) * 16 + (((e) >> 1) & 1) * 8 + ((e) & 1) * 4)
#define G_ISSUE1(slot, TAB, idv, ln) do { const int _id = __builtin_amdgcn_readlane((idv), (ln)); const bf16_t* _rp = (TAB) + (size_t)_id * D_MODEL + 8 * lane; \
        _Pragma("unroll") for (int _i = 0; _i < 4; ++_i) buf[slot][_i] = *(const v4u*)(_rp + 512 * _i); } while (0)
#define G_DOT1(slot, pi) do { float _a = 0.f, _b = 0.f; \
        _Pragma("unroll") for (int _i = 0; _i < 4; ++_i) { _a = dot2bf(buf[slot][_i].x, xb[_i].x, _a); _b = dot2bf(buf[slot][_i].y, xb[_i].y, _b); _a = dot2bf(buf[slot][_i].z, xb[_i].z, _a); _b = dot2bf(buf[slot][_i].w, xb[_i].w, _b); } \
        part[pi] = _a + _b; } while (0)
#define G_FMA1(slot, e) do { const float _a = __int_as_float(__builtin_amdgcn_readlane(__float_as_int(aval), G_LANE_OF(e))); \
        _Pragma("unroll") for (int _i = 0; _i < 4; ++_i) { const v4u _w = buf[slot][_i]; \
            acc[_i][0] += (f32x4){__uint_as_float(_w.x << 16), __uint_as_float(_w.x & 0xffff0000u), __uint_as_float(_w.y << 16), __uint_as_float(_w.y & 0xffff0000u)} * _a; \
            acc[_i][1] += (f32x4){__uint_as_float(_w.z << 16), __uint_as_float(_w.z & 0xffff0000u), __uint_as_float(_w.w << 16), __uint_as_float(_w.w & 0xffff0000u)} * _a; } } while (0)
__device__ __forceinline__ void gather_token(int t, const float* __restrict__ X1, const bf16_t* __restrict__ X1B, const int* __restrict__ EIDX, const float* __restrict__ GATE,
                                             const bf16_t* __restrict__ UB, const bf16_t* __restrict__ VB, const float* __restrict__ g2, const float* __restrict__ b2, float* out, int lane) {
    v4u xb[4];
#pragma unroll
    for (int i = 0; i < 4; ++i) xb[i] = *(const v4u*)(X1B + (size_t)t * D_MODEL + 512 * i + 8 * lane);
    const int id_lo = EIDX[(size_t)t * EPT + lane], id_hi = EIDX[(size_t)t * EPT + 64 + lane];
    const float g_lo = GATE[(size_t)t * EPT + lane], g_hi = GATE[(size_t)t * EPT + 64 + lane];
    f32x4 acc[4][2];
#pragma unroll
    for (int i = 0; i < 4; ++i) { acc[i][0] = (f32x4){0.f, 0.f, 0.f, 0.f}; acc[i][1] = (f32x4){0.f, 0.f, 0.f, 0.f}; }
    const int e_me = ((lane >> 5) & 1) * 8 + ((lane >> 4) & 1) * 4 + ((lane >> 3) & 1) * 2 + ((lane >> 2) & 1);
    v4u buf[4][4];
#pragma unroll
    for (int e = 0; e < 4; ++e) G_ISSUE1(e, UB, id_lo, e);
#pragma unroll 1
    for (int hh = 0; hh < 8; ++hh) {
        const int idv = hh < 4 ? id_lo : id_hi; const float gv = hh < 4 ? g_lo : g_hi;
        const int lb = (hh & 3) * 16;
        const int hn = hh < 7 ? hh + 1 : 7; const int idn = hn < 4 ? id_lo : id_hi; const int lbn = (hn & 3) * 16;
        float part[16];
#pragma unroll
        for (int e = 0; e < 16; ++e) {
            G_DOT1(e & 3, e);
            if (e < 12) G_ISSUE1(e & 3, UB, idv, lb + e + 4); else G_ISSUE1(e & 3, VB, idv, lb + e - 12);
        }
        const float hval = reduce16(part, lane);
        const float gt = __shfl(gv, lb + e_me);
        const float aval = gt * gelu_erf(hval);
#pragma unroll
        for (int e = 0; e < 16; ++e) {
            G_FMA1(e & 3, e);
            if (e < 12) G_ISSUE1(e & 3, VB, idv, lb + e + 4); else G_ISSUE1(e & 3, UB, idn, lbn + e - 12);
        }
    }
    float s = 0.f;
#pragma unroll
    for (int i = 0; i < 4; ++i) {
        const f32x4 x0 = *(const f32x4*)(X1 + (size_t)t * D_MODEL + 512 * i + 8 * lane), x1 = *(const f32x4*)(X1 + (size_t)t * D_MODEL + 512 * i + 8 * lane + 4);
        acc[i][0] = x0 * ALPHA + acc[i][0]; acc[i][1] = x1 * ALPHA + acc[i][1];
        s += (acc[i][0].x + acc[i][0].y) + (acc[i][0].z + acc[i][0].w) + (acc[i][1].x + acc[i][1].y) + (acc[i][1].z + acc[i][1].w);
    }
    const float mean = wave_sum(s) * (1.f / D_MODEL); float q = 0.f;
#pragma unroll
    for (int i = 0; i < 4; ++i)
#pragma unroll
        for (int k = 0; k < 2; ++k) { acc[i][k] = acc[i][k] - mean; q += (acc[i][k].x * acc[i][k].x + acc[i][k].y * acc[i][k].y) + (acc[i][k].z * acc[i][k].z + acc[i][k].w * acc[i][k].w); }
    const float rstd = 1.0f / sqrtf(wave_sum(q) * (1.f / D_MODEL) + LN_EPS);
#pragma unroll
    for (int i = 0; i < 4; ++i)
#pragma unroll
        for (int k = 0; k < 2; ++k) {
            const int c = 512 * i + 8 * lane + 4 * k;
            const f32x4 gg = *(const f32x4*)(g2 + c), bb = *(const f32x4*)(b2 + c);
            *(f32x4*)(out + (size_t)t * D_MODEL + c) = acc[i][k] * rstd * gg + bb;
        }
}

struct Args { const void* in[18]; float* out; unsigned char* ws; int ph_lo, ph_hi, li, pad; };
constexpr int N_PHASES = 8;

#define P_IN(T, i) ((const T*)args.in[i])
#define P_WS(T, off) ((T*)(ws + (off)))
#define x_in P_IN(float, 0)
#define mem_in P_IN(float, 1)
#define positions P_IN(int, 2)
#define w_in P_IN(float, 3)
#define w_mem_kv P_IN(float, 4)
#define w_pool P_IN(float, 5)
#define pool_scale P_IN(float, 6)
#define sinks P_IN(float, 7)
#define w_out P_IN(float, 8)
#define ln1_g P_IN(float, 9)
#define ln1_b P_IN(float, 10)
#define w_peer_q P_IN(float, 11)
#define sk1 P_IN(float, 12)
#define sk2 P_IN(float, 13)
#define eu P_IN(float, 14)
#define ev P_IN(float, 15)
#define ln2_g P_IN(float, 16)
#define ln2_b P_IN(float, 17)
#define WINT P_WS(bf16_t, WS_WINT)
#define WKVT P_WS(bf16_t, WS_WKVT)
#define WOT P_WS(bf16_t, WS_WOT)
#define WQT P_WS(bf16_t, WS_WQT)
#define WPT P_WS(bf16_t, WS_SMALL)
#define K1B P_WS(bf16_t, WS_SMALL + 131072)
#define K2B P_WS(bf16_t, WS_SMALL + 163840)
#define ROPE P_WS(float, WS_SMALL + 262144)
#define XB P_WS(bf16_t, WS_XB)
#define X1B P_WS(bf16_t, WS_X1B)
#define MEMB P_WS(bf16_t, WS_MEMB)
#define KVM P_WS(bf16_t, WS_KVM)
#define POOLV P_WS(float, WS_POOLV)
#define Q P_WS(bf16_t, WS_Q)
#define Kb P_WS(bf16_t, WS_K)
#define Vb P_WS(bf16_t, WS_V)
#define QM P_WS(bf16_t, WS_QM)
#define CONCAT P_WS(bf16_t, WS_CONCAT)
#define Y1 P_WS(float, WS_Y1)
#define X1 P_WS(float, WS_X1)
#define QP P_WS(bf16_t, WS_QP)
#define EIDX P_WS(int, WS_EIDX)
#define GATE P_WS(float, WS_GATE)
#define UB P_WS(bf16_t, WS_UB)
#define VB P_WS(bf16_t, WS_VB)
__global__ void __launch_bounds__(NTHREADS, 2) mega_fwd(Args args) {
    extern __shared__ __attribute__((aligned(16))) unsigned char lds_raw[];
    LAS unsigned char* lds = (LAS unsigned char*)lds_raw;
    volatile LAS unsigned* MISC = (volatile LAS unsigned*)(lds + MISC_OFF);
    const int tid = threadIdx.x, lane = tid & 63, wave = __builtin_amdgcn_readfirstlane(tid >> 6);
    const int G = gridDim.x, bx = blockIdx.x;
    const int vcu = (G % 8 == 0) ? (bx % 8) * (G / 8) + bx / 8 : bx;
    const int gw = vcu * NWAVES + wave, NGW = G * NWAVES;
    unsigned char* ws = args.ws;
    for (int u = tid; u < (LDS_BYTES - MISC_OFF) / 4; u += NTHREADS) MISC[u] = 0u;
    __syncthreads();
    XcdBarrier bar = xcd_barrier_post((unsigned*)(ws + WS_CTL) + CW_BAR + args.li * XCD_BAR_WORDS, MISC + 8);
    const int lo = args.ph_lo, hi = args.ph_hi;
#ifndef ONLY_PHASES
#define ONLY_PHASES 255
#endif
#define IN(k) (((ONLY_PHASES >> (k)) & 1) && lo <= (k) && (k) < hi)
#ifndef REPEAT_MASK
#define REPEAT_MASK 0
#endif
#define REP(k) for (int _rep = 0; _rep < 1 + ((REPEAT_MASK >> (k)) & 1); ++_rep)
#define SEAM(k) do { if (IN(k) && IN((k) + 1)) xcd_barrier(bar); } while (0)

    if (IN(0)) REP(0) {
        LAS float* scr = (LAS float*)(lds + wave * 16384);
        constexpr int I_IN = (D_MODEL / 64) * (IN_W / 32), I_KV = (D_MODEL / 64) * (2 * MEM_W / 32), I_O = (D_MODEL / 64) * (D_MODEL / 32), I_Q = I_O, I_P = 4 * 2 * 4;
        constexpr int NITEMS = I_IN + I_KV + I_O + I_Q + I_P;
        for (int it = gw; it < NITEMS; it += NGW) {
            int r = it;
            if (r < I_IN) { p0_transpose_item(w_in, D_MODEL, IN_W, WINT, scr, r, lane); continue; } r -= I_IN;
            if (r < I_KV) { p0_transpose_item(w_mem_kv, D_MODEL, 2 * MEM_W, WKVT, scr, r, lane); continue; } r -= I_KV;
            if (r < I_O) { p0_transpose_item(w_out, D_MODEL, D_MODEL, WOT, scr, r, lane); continue; } r -= I_O;
            if (r < I_Q) { p0_transpose_item(w_peer_q, D_MODEL, D_MODEL, WQT, scr, r, lane); continue; } r -= I_Q;
            { const int gpl = r >> 3; p0_transpose_item(w_pool + (size_t)gpl * 16384, 128, 128, WPT + (size_t)gpl * 16384, scr, r & 7, lane); }
        }
        cvt_stream<false>(x_in, XB, (size_t)MTOK * D_MODEL, gw, NGW, lane);
        cvt_stream<false>(mem_in, MEMB, (size_t)MMEM * D_MODEL, gw, NGW, lane);
        cvt_stream<false>(sk1, K1B, (size_t)NKEYS * 128, gw, NGW, lane);
        cvt_stream<false>(sk2, K2B, (size_t)NKEYS * 128, gw, NGW, lane);
        cvt_stream<true>(eu, UB, (size_t)NEXP * D_MODEL, gw, NGW, lane);
        cvt_stream<true>(ev, VB, (size_t)NEXP * D_MODEL, gw, NGW, lane);
        for (int i = gw * 64 + lane; i < MTOK * 8; i += NGW * 64) { float c, s; rope_cs(positions[i >> 3], i & 7, c, s); *(f32x2*)(ROPE + 2 * (size_t)i) = (f32x2){c, s}; }
    }
    SEAM(0);
    if (IN(1)) REP(1) {
        { pg8::Gemm g{XB, WINT, MTOK, IN_W, D_MODEL}; pg8::StaticOrder S; S.init(MTOK, IN_W, G, bx);
          EpiIn E{POOLV, Q, Kb, Vb, QM, ROPE};
          pg8::gemm_phase<EpiIn, pg8::StaticOrder, true, true>(lds, g, S, E); }
        { pg8::Gemm g{MEMB, WKVT, MMEM, 2 * MEM_W, D_MODEL}; pg8::StaticOrder S; S.init(MMEM, 2 * MEM_W, G, (bx + G - 64) % G);
          EpiStoreBf E{KVM, 2 * MEM_W};
          pg8::gemm_phase<EpiStoreBf, pg8::StaticOrder, true, true>(lds, g, S, E); }
    }
    SEAM(1);
    if (IN(2)) REP(2) {
        for (int it = vcu; it < 512; it += G) {
            if (it < 256) swa_item(lds, it, Q, Kb, Vb, sinks, CONCAT, tid, wave, lane);
            else mem_item(lds, it - 256, QM, KVM, CONCAT, tid, wave, lane);
        }
        for (int it = gw; it < (MTOK / 16) * 4; it += NGW) pool_item(it, POOLV, WPT, pool_scale, CONCAT, lane);
    }
    SEAM(2);
    if (IN(3)) REP(3) {
        pg8::Gemm g{CONCAT, WOT, MTOK, D_MODEL, D_MODEL}; pg8::StaticOrder S; S.init(MTOK, D_MODEL, G, bx);
        EpiY1 E{x_in, Y1};
        pg8::gemm_phase<EpiY1, pg8::StaticOrder, true, true>(lds, g, S, E);
    }
    SEAM(3);
    if (IN(4)) REP(4) { for (int r = gw; r < MTOK; r += NGW) ln1_row(Y1 + (size_t)r * D_MODEL, ln1_g, ln1_b, X1 + (size_t)r * D_MODEL, X1B + (size_t)r * D_MODEL, lane); }
    SEAM(4);
    if (IN(5)) REP(5) {
        pg8::Gemm g{X1B, WQT, MTOK, D_MODEL, D_MODEL}; pg8::StaticOrder S; S.init(MTOK, D_MODEL, G, bx);
        EpiStoreBf E{QP, D_MODEL};
        pg8::gemm_phase<EpiStoreBf, pg8::StaticOrder, true, true>(lds, g, S, E);
    }
    SEAM(5);
    if (IN(6)) REP(6) { for (int it = gw; it < (MTOK / 16) * PHEADS; it += NGW) topk_item(it, QP, K1B, K2B, EIDX, GATE, lane); }
    SEAM(6);
    if (IN(7)) REP(7) { for (int t = gw; t < MTOK; t += NGW) gather_token(t, X1, X1B, EIDX, GATE, UB, VB, ln2_g, ln2_b, args.out, lane); }
#undef IN
#undef SEAM
}
#undef P_IN(T,
#undef P_WS(T,
#undef x_in
#undef mem_in
#undef positions
#undef w_in
#undef w_mem_kv
#undef w_pool
#undef pool_scale
#undef sinks
#undef w_out
#undef ln1_g
#undef ln1_b
#undef w_peer_q
#undef sk1
#undef sk2
#undef eu
#undef ev
#undef ln2_g
#undef ln2_b
#undef WINT
#undef WKVT
#undef WOT
#undef WQT
#undef WPT
#undef K1B
#undef K2B
#undef ROPE
#undef XB
#undef X1B
#undef MEMB
#undef KVM
#undef POOLV
#undef Q
#undef Kb
#undef Vb
#undef QM
#undef CONCAT
#undef Y1
#undef X1
#undef QP
#undef EIDX
#undef GATE
#undef UB
#undef VB

#if NAIVE_MASK != 0
__device__ __forceinline__ float toF(float v) { return v; }
__device__ __forceinline__ float toF(bf16_t v) { return bf2f(v); }

struct NvEpiF32 { float* C; int ldc, pad; __device__ void operator()(int r, int c, float v) const { C[(size_t)r * ldc + c] = v; } };
struct NvEpiBf { bf16_t* C; int ldc, pad; __device__ void operator()(int r, int c, float v) const { C[(size_t)r * ldc + c] = f2bf(v); } };
struct NvEpiY1 { const float* x; float* y; __device__ void operator()(int r, int c, float v) const { y[(size_t)r * D_MODEL + c] = ALPHA * x[(size_t)r * D_MODEL + c] + v; } };

template <class TA, class Epi>
__global__ void __launch_bounds__(256) nv_gemm(const TA* __restrict__ A, const float* __restrict__ B, int M, int N, int K, Epi epi) {
    __shared__ float As[16][65];
    __shared__ float Bs[16][64];
    const int tx = threadIdx.x & 15, ty = threadIdx.x >> 4;
    const int m0 = blockIdx.y * 64, n0 = blockIdx.x * 64;
    float acc[4][4];
#pragma unroll
    for (int i = 0; i < 4; ++i)
#pragma unroll
        for (int j = 0; j < 4; ++j) acc[i][j] = 0.f;
    for (int k0 = 0; k0 < K; k0 += 16) {
        for (int i = threadIdx.x; i < 1024; i += 256) { const int r = i >> 4, c = i & 15; As[c][r] = toF(A[(size_t)(m0 + r) * K + k0 + c]); }
        for (int i = threadIdx.x; i < 1024; i += 256) { const int r = i >> 6, c = i & 63; Bs[r][c] = B[(size_t)(k0 + r) * N + n0 + c]; }
        __syncthreads();
#pragma unroll
        for (int kk = 0; kk < 16; ++kk) {
            float a[4], b[4];
#pragma unroll
            for (int i = 0; i < 4; ++i) { a[i] = As[kk][ty * 4 + i]; b[i] = Bs[kk][tx * 4 + i]; }
#pragma unroll
            for (int i = 0; i < 4; ++i)
#pragma unroll
                for (int j = 0; j < 4; ++j) acc[i][j] += a[i] * b[j];
        }
        __syncthreads();
    }
#pragma unroll
    for (int i = 0; i < 4; ++i)
#pragma unroll
        for (int j = 0; j < 4; ++j) epi(m0 + ty * 4 + i, n0 + tx * 4 + j, acc[i][j]);
}

__global__ void nv_post1(const float* __restrict__ H, const int* __restrict__ positions, float* POOLV, bf16_t* Q, bf16_t* Kb, bf16_t* Vb, bf16_t* QM) {
    const size_t gid = (size_t)blockIdx.x * blockDim.x + threadIdx.x;
    if (gid >= (size_t)MTOK * IN_W) return;
    const int t = (int)(gid / IN_W), col = (int)(gid % IN_W);
    const float* hr = H + (size_t)t * IN_W;
    const float v = hr[col];
    if (col < POOL_W) { POOLV[(size_t)t * POOL_W + col] = v; return; }
    if (col < POOL_W + SWA_W + KV_W) {
        const bool isq = col < POOL_W + SWA_W;
        const int c = isq ? col - POOL_W : col - POOL_W - SWA_W;
        const int d = c & 63;
        float o = v;
        if (d < 16) {
            const int j = d & 7; float cs, sn; rope_cs(positions[t], j, cs, sn);
            if (d < 8) o = v * cs - hr[col + 8] * sn; else o = v * cs + hr[col - 8] * sn;
        }
        if (isq) Q[(size_t)t * SWA_W + c] = f2bf(o); else Kb[(size_t)t * KV_W + c] = f2bf(o);
        return;
    }
    if (col < POOL_W + SWA_W + 2 * KV_W) { Vb[(size_t)t * KV_W + (col - POOL_W - SWA_W - KV_W)] = f2bf(v); return; }
    QM[(size_t)t * MEM_W + (col - POOL_W - SWA_W - 2 * KV_W)] = f2bf(v);
}
__global__ void nv_cvt_bf16(const float* __restrict__ in, bf16_t* out, size_t n) {
    const size_t gid = (size_t)blockIdx.x * blockDim.x + threadIdx.x;
    if (gid < n) out[gid] = f2bf(in[gid]);
}
__global__ void nv_pool1(const float* __restrict__ POOLV, float* PS) {
    const size_t gid = (size_t)blockIdx.x * blockDim.x + threadIdx.x;
    if (gid >= (size_t)MTOK * POOL_W) return;
    const int t = (int)(gid / POOL_W), ch = (int)(gid % POOL_W);
    const int g = ch >> 7, w = 2 << g, s = t & (SEQ - 1);
    const int cnt = (s + 1) < w ? (s + 1) : w;
    float sum = 0.f;
    for (int i = 0; i < cnt; ++i) sum += POOLV[(size_t)(t - i) * POOL_W + ch];
    PS[gid] = sum / (float)cnt - POOLV[gid];
}
__global__ void nv_pool2(const float* __restrict__ PS, const float* __restrict__ w_pool, const float* __restrict__ pool_scale, bf16_t* CONCAT) {
    const size_t gid = (size_t)blockIdx.x * blockDim.x + threadIdx.x;
    if (gid >= (size_t)MTOK * POOL_W) return;
    const int t = (int)(gid / POOL_W), ch = (int)(gid % POOL_W);
    const int g = ch >> 7, d = ch & 127;
    const float* p = PS + (size_t)t * POOL_W + g * 128;
    const float* w = w_pool + (size_t)g * 128 * 128 + d;
    float y = 0.f;
    for (int c = 0; c < 128; ++c) y += p[c] * w[(size_t)c * 128];
    CONCAT[(size_t)t * D_MODEL + ch] = f2bf(y * pool_scale[ch]);
}
__global__ void __launch_bounds__(256) nv_swa(const bf16_t* __restrict__ Q, const bf16_t* __restrict__ Kb, const bf16_t* __restrict__ Vb, const float* __restrict__ sinks, bf16_t* CONCAT) {
    const int wv = (int)((blockIdx.x * 256 + threadIdx.x) >> 6), lane = threadIdx.x & 63;
    if (wv >= MTOK * NHEAD) return;
    const int t = wv / NHEAD, h = wv % NHEAD, kvh = h >> 2, s = t & (SEQ - 1), tb = t - s;
    const float q = bf2f(Q[(size_t)t * SWA_W + h * HD + lane]);
    float m = sinks[h], l = 1.0f, o = 0.f;
    const int k0 = s - (WINDOW - 1) < 0 ? 0 : s - (WINDOW - 1);
    for (int kk = k0; kk <= s; ++kk) {
        const size_t kt = (size_t)(tb + kk);
        const float sc = wave_sum(q * bf2f(Kb[kt * KV_W + kvh * HD + lane])) * 0.125f;
        const float mn = fmaxf(m, sc), r = expf(m - mn), p = expf(sc - mn);
        l = l * r + p; o = o * r + p * bf2f(Vb[kt * KV_W + kvh * HD + lane]); m = mn;
    }
    CONCAT[(size_t)t * D_MODEL + POOL_W + h * HD + lane] = f2bf(o / l);
}
__global__ void __launch_bounds__(256) nv_mem(const bf16_t* __restrict__ QM, const bf16_t* __restrict__ KVM, bf16_t* CONCAT) {
    const int wv = (int)((blockIdx.x * 256 + threadIdx.x) >> 6), lane = threadIdx.x & 63;
    if (wv >= MTOK * MHEADS) return;
    const int t = wv / MHEADS, hm = wv % MHEADS, b = t / SEQ;
    const float q0 = bf2f(QM[(size_t)t * MEM_W + hm * MHD + lane]), q1 = bf2f(QM[(size_t)t * MEM_W + hm * MHD + 64 + lane]);
    float m = -1e30f, l = 0.f, o0 = 0.f, o1 = 0.f;
    const float scale = 0.08838834764831845f;
    for (int j = 0; j < MEM_LEN; ++j) {
        const bf16_t* kr = KVM + (size_t)(b * MEM_LEN + j) * (2 * MEM_W) + hm * MHD;
        const bf16_t* vr = kr + MEM_W;
        const float sc = wave_sum(q0 * bf2f(kr[lane]) + q1 * bf2f(kr[64 + lane])) * scale;
        const float mn = fmaxf(m, sc), r = expf(m - mn), p = expf(sc - mn);
        l = l * r + p; o0 = o0 * r + p * bf2f(vr[lane]); o1 = o1 * r + p * bf2f(vr[64 + lane]); m = mn;
    }
    bf16_t* orow = CONCAT + (size_t)t * D_MODEL + POOL_W + SWA_W + hm * MHD;
    orow[lane] = f2bf(o0 / l); orow[64 + lane] = f2bf(o1 / l);
}
__global__ void __launch_bounds__(256) nv_ln(const float* __restrict__ in, const float* __restrict__ g, const float* __restrict__ bta, float* outf, bf16_t* outb) {
    const int row = (int)((blockIdx.x * 256 + threadIdx.x) >> 6), lane = threadIdx.x & 63;
    if (row >= MTOK) return;
    const float* r = in + (size_t)row * D_MODEL;
    float v[32]; float s = 0.f;
#pragma unroll
    for (int i = 0; i < 32; ++i) { v[i] = r[lane + 64 * i]; s += v[i]; }
    const float mean = wave_sum(s) * (1.f / D_MODEL); float q = 0.f;
#pragma unroll
    for (int i = 0; i < 32; ++i) { v[i] -= mean; q += v[i] * v[i]; }
    const float rstd = 1.0f / sqrtf(wave_sum(q) * (1.f / D_MODEL) + LN_EPS);
#pragma unroll
    for (int i = 0; i < 32; ++i) {
        const int c = lane + 64 * i; const float y = v[i] * rstd * g[c] + bta[c];
        if (outf) outf[(size_t)row * D_MODEL + c] = y;
        if (outb) outb[(size_t)row * D_MODEL + c] = f2bf(y);
    }
}
__global__ void __launch_bounds__(32) nv_topk(const bf16_t* __restrict__ QP, const float* __restrict__ K1, const float* __restrict__ K2, int* EIDX, float* GATE) {
    __shared__ float sc[256][32];
    __shared__ float lv[32][32];
    __shared__ int li[32][32];
    const int tid = threadIdx.x, gid = blockIdx.x * 32 + tid;
    const int t = gid / PHEADS, h = gid % PHEADS;
    const bf16_t* q = QP + (size_t)t * D_MODEL + h * 256;
    for (int half = 0; half < 2; ++half) {
        const float* Kk = half ? K2 : K1;
        for (int k = 0; k < NKEYS; ++k) {
            float a = 0.f;
            for (int c = 0; c < 128; ++c) a += bf2f(q[half * 128 + c]) * Kk[k * 128 + c];
            sc[half * 128 + k][tid] = a;
        }
        for (int r = 0; r < TOPK; ++r) {
            float best = -INFINITY; int bi = 0;
            for (int k = 0; k < NKEYS; ++k) { const float v = sc[half * 128 + k][tid]; if (v > best) { best = v; bi = k; } }
            lv[half * 16 + r][tid] = best; li[half * 16 + r][tid] = bi; sc[half * 128 + bi][tid] = -INFINITY;
        }
    }
    for (int a = 0; a < 16; ++a) for (int b = 0; b < 16; ++b) sc[a * 16 + b][tid] = lv[a][tid] + lv[16 + b][tid];
    float mx = 0.f, den = 0.f;
    float tv[16]; int ti[16];
#pragma unroll
    for (int r = 0; r < TOPK; ++r) {
        float best = -INFINITY; int bi = 0;
        for (int k = 0; k < 256; ++k) { const float v = sc[k][tid]; if (v > best) { best = v; bi = k; } }
        sc[bi][tid] = -INFINITY;
        if (r == 0) mx = best;
        tv[r] = expf(best - mx); den += tv[r]; ti[r] = li[bi >> 4][tid] * NKEYS + li[16 + (bi & 15)][tid];
    }
#pragma unroll
    for (int r = 0; r < TOPK; ++r) { EIDX[(size_t)t * EPT + h * TOPK + r] = ti[r]; GATE[(size_t)t * EPT + h * TOPK + r] = tv[r] / den; }
}
__global__ void __launch_bounds__(256) nv_gather(const float* __restrict__ X1, const int* __restrict__ EIDX, const float* __restrict__ GATE, const float* __restrict__ EU, const float* __restrict__ EV,
                                                  const float* __restrict__ g, const float* __restrict__ bta, float* out) {
    const int t = (int)((blockIdx.x * 256 + threadIdx.x) >> 6), lane = threadIdx.x & 63;
    if (t >= MTOK) return;
    float x[32], acc[32];
#pragma unroll
    for (int i = 0; i < 32; ++i) { x[i] = X1[(size_t)t * D_MODEL + lane + 64 * i]; acc[i] = 0.f; }
    for (int e = 0; e < EPT; ++e) {
        const int id = EIDX[(size_t)t * EPT + e]; const float gt = GATE[(size_t)t * EPT + e];
        const float* u = EU + (size_t)id * D_MODEL; const float* vv = EV + (size_t)id * D_MODEL;
        float p = 0.f;
#pragma unroll
        for (int i = 0; i < 32; ++i) p += x[i] * u[lane + 64 * i];
        const float a = gt * gelu_erf(wave_sum(p));
#pragma unroll
        for (int i = 0; i < 32; ++i) acc[i] += a * vv[lane + 64 * i];
    }
    float s = 0.f;
#pragma unroll
    for (int i = 0; i < 32; ++i) { acc[i] = ALPHA * x[i] + acc[i]; s += acc[i]; }
    const float mean = wave_sum(s) * (1.f / D_MODEL); float q = 0.f;
#pragma unroll
    for (int i = 0; i < 32; ++i) { acc[i] -= mean; q += acc[i] * acc[i]; }
    const float rstd = 1.0f / sqrtf(wave_sum(q) * (1.f / D_MODEL) + LN_EPS);
#pragma unroll
    for (int i = 0; i < 32; ++i) { const int c = lane + 64 * i; out[(size_t)t * D_MODEL + c] = acc[i] * rstd * g[c] + bta[c]; }
}

#endif
extern "C" void kernel_launch(void* const* d_in, const int* in_sizes, int n_in, void* d_out, int out_size, void* d_ws, size_t ws_size, hipStream_t stream) {
    static int grid = 0;
    if (grid == 0) {
        if (n_in != 18 || in_sizes[0] != MTOK * D_MODEL || out_size != MTOK * D_MODEL || ws_size < WS_END) {
            fprintf(stderr, "kernel_launch: unexpected shapes (n_in %d, in0 %d, out %d, ws %zu)\n", n_in, n_in > 0 ? in_sizes[0] : -1, out_size, ws_size); grid = -1; return; }
        int dev = 0, cus = 0, per_cu = 0;
        if (hipGetDevice(&dev) != hipSuccess || hipDeviceGetAttribute(&cus, hipDeviceAttributeMultiprocessorCount, dev) != hipSuccess) { fprintf(stderr, "kernel_launch: device query failed\n"); grid = -1; return; }
        if (hipFuncSetAttribute((const void*)mega_fwd, hipFuncAttributeMaxDynamicSharedMemorySize, LDS_BYTES) != hipSuccess) { fprintf(stderr, "kernel_launch: hipFuncSetAttribute failed\n"); grid = -1; return; }
        if (hipOccupancyMaxActiveBlocksPerMultiprocessor(&per_cu, (const void*)mega_fwd, NTHREADS, LDS_BYTES) != hipSuccess || per_cu < 1) {
            fprintf(stderr, "kernel_launch: occupancy query reports %d workgroups per CU\n", per_cu); (void)hipGetLastError(); grid = -1; return; }
        grid = cus;
    }
    if (grid < 0) return;
    unsigned char* ws = (unsigned char*)d_ws;
    (void)hipMemsetAsync(ws + WS_CTL, 0, 1 * MiB, stream);
    Args a{};
    for (int i = 0; i < 18; ++i) a.in[i] = d_in[i];
    a.out = (float*)d_out; a.ws = ws;
#if NAIVE_MASK != 0
    const float* x = (const float*)d_in[0]; const float* mem = (const float*)d_in[1]; const int* positions = (const int*)d_in[2];
    const float* w_in = (const float*)d_in[3]; const float* w_mem_kv = (const float*)d_in[4]; const float* w_pool = (const float*)d_in[5];
    const float* pool_scale = (const float*)d_in[6]; const float* sinks = (const float*)d_in[7]; const float* w_out = (const float*)d_in[8];
    const float* ln1_g = (const float*)d_in[9]; const float* ln1_b = (const float*)d_in[10]; const float* w_peer_q = (const float*)d_in[11];
    const float* sk1 = (const float*)d_in[12]; const float* sk2 = (const float*)d_in[13]; const float* eu = (const float*)d_in[14]; const float* ev = (const float*)d_in[15];
    const float* ln2_g = (const float*)d_in[16]; const float* ln2_b = (const float*)d_in[17];
    float* out = (float*)d_out;
    float* POOLV = (float*)(ws + WS_POOLV); bf16_t* Q = (bf16_t*)(ws + WS_Q); bf16_t* Kb = (bf16_t*)(ws + WS_K); bf16_t* Vb = (bf16_t*)(ws + WS_V); bf16_t* QM = (bf16_t*)(ws + WS_QM);
    bf16_t* KVM = (bf16_t*)(ws + WS_KVM); bf16_t* CONCAT = (bf16_t*)(ws + WS_CONCAT); float* Y1 = (float*)(ws + WS_Y1); float* X1 = (float*)(ws + WS_X1); bf16_t* X1B = (bf16_t*)(ws + WS_X1B);
    bf16_t* QP = (bf16_t*)(ws + WS_QP); int* EIDX = (int*)(ws + WS_EIDX); float* GATE = (float*)(ws + WS_GATE);
    float* NVH = (float*)(ws + WS_NV_H); float* NVPS = (float*)(ws + WS_NV_PS); float* NVKVM = (float*)(ws + WS_NV_KVM);
#endif
    int li = 0;
    for (int p = 0; p < N_PHASES;) {
#if NAIVE_MASK != 0
        if ((NAIVE_MASK >> p) & 1) {
            switch (p) {
            case 1:
                nv_gemm<float, NvEpiF32><<<dim3(IN_W / 64, MTOK / 64), 256, 0, stream>>>(x, w_in, MTOK, IN_W, D_MODEL, NvEpiF32{NVH, IN_W, 0});
                nv_gemm<float, NvEpiF32><<<dim3(2 * MEM_W / 64, MMEM / 64), 256, 0, stream>>>(mem, w_mem_kv, MMEM, 2 * MEM_W, D_MODEL, NvEpiF32{NVKVM, 2 * MEM_W, 0});
                nv_post1<<<(unsigned)(((size_t)MTOK * IN_W + 255) / 256), 256, 0, stream>>>(NVH, positions, POOLV, Q, Kb, Vb, QM);
                nv_cvt_bf16<<<(MMEM * 2 * MEM_W + 255) / 256, 256, 0, stream>>>(NVKVM, KVM, (size_t)MMEM * 2 * MEM_W);
                break;
            case 2:
                nv_pool1<<<MTOK * POOL_W / 256, 256, 0, stream>>>(POOLV, NVPS);
                nv_pool2<<<MTOK * POOL_W / 256, 256, 0, stream>>>(NVPS, w_pool, pool_scale, CONCAT);
                nv_swa<<<MTOK * NHEAD / 4, 256, 0, stream>>>(Q, Kb, Vb, sinks, CONCAT);
                nv_mem<<<MTOK * MHEADS / 4, 256, 0, stream>>>(QM, KVM, CONCAT);
                break;
            case 3: nv_gemm<bf16_t, NvEpiY1><<<dim3(D_MODEL / 64, MTOK / 64), 256, 0, stream>>>(CONCAT, w_out, MTOK, D_MODEL, D_MODEL, NvEpiY1{x, Y1}); break;
            case 4: nv_ln<<<MTOK / 4, 256, 0, stream>>>(Y1, ln1_g, ln1_b, X1, X1B); break;
            case 5: nv_gemm<float, NvEpiBf><<<dim3(D_MODEL / 64, MTOK / 64), 256, 0, stream>>>(X1, w_peer_q, MTOK, D_MODEL, D_MODEL, NvEpiBf{QP, D_MODEL, 0}); break;
            case 6: nv_topk<<<MTOK * PHEADS / 32, 32, 0, stream>>>(QP, sk1, sk2, EIDX, GATE); break;
            case 7: nv_gather<<<MTOK / 4, 256, 0, stream>>>(X1, EIDX, GATE, eu, ev, ln2_g, ln2_b, out); break;
            default: break;
            }
            ++p; continue;
        }
#endif
        int q = p;
        while (q < N_PHASES && !((NAIVE_MASK >> q) & 1)) ++q;
        a.ph_lo = p; a.ph_hi = q; a.li = li++;
        hipLaunchKernelGGL(mega_fwd, dim3(grid), dim3(NTHREADS), LDS_BYTES, stream, a);
        const hipError_t le = hipPeekAtLastError();
        if (le != hipSuccess) { fprintf(stderr, "kernel_launch: launch failed: %s\n", hipGetErrorName(le)); break; }
        p = q;
    }
#ifdef PROBE_EXTRA_LO
    a.ph_lo = PROBE_EXTRA_LO; a.ph_hi = PROBE_EXTRA_HI; a.li = li++;
    hipLaunchKernelGGL(mega_fwd, dim3(grid), dim3(NTHREADS), LDS_BYTES, stream, a);
#endif
}
```

```cpp
#include <hip/hip_runtime.h>
#include <cstdint>
#include <cstdio>
#ifndef NAIVE_MASK
#define NAIVE_MASK 0
#endif

constexpr int D_MODEL = 2048, BATCH = 2, SEQ = 4096, MTOK = BATCH * SEQ, MEM_LEN = 256, MMEM = BATCH * MEM_LEN;
constexpr int POOL_W = 512, SWA_W = 1024, KV_W = 256, MEM_W = 512, IN_W = 2560;
constexpr int NHEAD = 16, NKV = 4, HD = 64, WINDOW = 128, MHEADS = 4, MHD = 128;
constexpr int PHEADS = 8, NKEYS = 128, TOPK = 16, NEXP = NKEYS * NKEYS, EPT = PHEADS * TOPK;
constexpr float ALPHA = 1.18920711500272106672f;
constexpr float LN_EPS = 1e-5f;

typedef unsigned short bf16_t;
__device__ __forceinline__ float bf2f(bf16_t v) { return __uint_as_float((unsigned)v << 16); }
__device__ __forceinline__ bf16_t f2bf(float f) { unsigned u = __float_as_uint(f); return (bf16_t)((u + 0x7fffu + ((u >> 16) & 1u)) >> 16); }

constexpr size_t MiB = 1u << 20;
constexpr size_t WS_CTL = 0, WS_WINT = 1 * MiB, WS_WKVT = 11 * MiB, WS_WOT = 15 * MiB, WS_WQT = 23 * MiB, WS_SMALL = 31 * MiB;
constexpr size_t WS_XB = 32 * MiB, WS_X1B = 32 * MiB  , WS_MEMB = 64 * MiB, WS_KVM = 66 * MiB;
constexpr size_t WS_POOLV = 68 * MiB, WS_Q = 84 * MiB, WS_K = 100 * MiB, WS_V = 104 * MiB, WS_QM = 108 * MiB, WS_CONCAT = 116 * MiB;
constexpr size_t WS_Y1 = 148 * MiB, WS_X1 = 212 * MiB, WS_QP = 276 * MiB, WS_EIDX = 308 * MiB, WS_GATE = 312 * MiB, WS_UB = 316 * MiB, WS_VB = 380 * MiB, WS_END = 444 * MiB;
constexpr size_t WS_NV_H = 148 * MiB  , WS_NV_PS = 232 * MiB, WS_NV_KVM = 248 * MiB;

__device__ __forceinline__ void rope_cs(int pos, int j, float& c, float& s) {
    const double invf[8] = {1.0, 0.19392274474868576, 0.03760603093086393, 0.007292664737217109, 0.001414213562373095, 0.0002742481756762073, 5.318295896944988e-05, 1.031338537721246e-05};
    double f = j == 0 ? invf[0] : j == 1 ? invf[1] : j == 2 ? invf[2] : j == 3 ? invf[3] : j == 4 ? invf[4] : j == 5 ? invf[5] : j == 6 ? invf[6] : invf[7];
    double rev = (double)pos * f * 0.15915494309189533577;
    rev -= floor(rev);
    float fr = (float)rev;
    s = __builtin_amdgcn_sinf(fr); c = __builtin_amdgcn_cosf(fr);
}
__device__ __forceinline__ float gelu_erf(float h) { return 0.5f * h * (1.0f + erff(h * 0.70710678118654752440f)); }
__device__ __forceinline__ float wave_sum(float v) {
#pragma unroll
    for (int o = 1; o < 64; o <<= 1) v += __shfl_xor(v, o);
    return v;
}

namespace pg8 {
#define PG8_LAS __attribute__((address_space(3)))
typedef unsigned short bf16_t;
typedef short bf16x8 __attribute__((ext_vector_type(8)));
typedef float f32x4 __attribute__((ext_vector_type(4)));
typedef unsigned u32x4 __attribute__((ext_vector_type(4)));
constexpr int BM = 256, BK = 64, HALF = 128, HTB = HALF * BK * 2  , STAGE_BYTES = 8 * HTB, NXCD = 8, WGM = 8;

__host__ __device__ __forceinline__ int lds_byte(int r, int c) { const int st = (r >> 4) * 2 + (c >> 5), rr = r & 15, cc = c & 31, ob = rr * 64 + cc * 2; return st * 1024 + (ob ^ (((ob >> 9) & 1) << 5)); }
__host__ __device__ __forceinline__ void stage_rc(int b, int& R, int& C) { const int st = b / 1024, sb = b % 1024, swz = sb ^ (((sb >> 9) & 1) << 5); R = (st >> 1) * 16 + swz / 64; C = (st & 1) * 32 + (swz % 64) / 2; }
__host__ __device__ __forceinline__ int perm32(int rho) { const int n = rho >> 4, i = rho & 15; return 8 * (i >> 2) + 4 * n + (i & 3); }

struct Unit { int pm, pn; };
struct Gemm { const bf16_t* A; const bf16_t* Bt; int M, N, K; };

struct StaticOrder {
    int nM, nN, nwg, G, c;
    __host__ __device__ void init(int M, int N, int G_, int c_) { nM = M / BM; nN = N / BM; nwg = nM * nN; G = G_; c = c_; }
    __host__ __device__ bool next(int i, Unit& u) const {
        const long L = (long)i * G + c; if (L >= nwg) return false;
        int wgid = (int)L; { const int q = nwg / NXCD, r = nwg % NXCD, xcd = wgid % NXCD, off = wgid / NXCD; wgid = (xcd < r ? xcd * (q + 1) : r * (q + 1) + (xcd - r) * q) + off; }
        const int nig = WGM * nN, gid = wgid / nig, fm = gid * WGM, gsz = (nM - fm) < WGM ? (nM - fm) : WGM;
        u.pm = fm + ((wgid % nig) % gsz); u.pn = (wgid % nig) / gsz; return true;
    }
    __device__ __forceinline__ void a_ready(const Unit&) const {}
    __device__ __forceinline__ void done(const Unit&) const {}
};

__device__ __forceinline__ unsigned cvt_pk_bf16(float lo, float hi) { unsigned r; asm volatile("v_cvt_pk_bf16_f32 %0, %1, %2" : "=v"(r) : "v"(lo), "v"(hi)); return r; }
template <class Epi, class Sched, bool ALIGN_EPI = false, bool SP2 = false>
__device__ __forceinline__ void gemm_phase(PG8_LAS unsigned char* lds, const Gemm g, const Sched& S, const Epi& E) {
    const int tid = threadIdx.x, wid = __builtin_amdgcn_readfirstlane(tid >> 6), lane = tid & 63, wr = wid >> 2, wc = wid & 3, fr = lane & 15, fq = lane >> 4;
    const int K = g.K, nt = K / BK;
    unsigned voffA[2], voffB[2];
#pragma unroll
    for (int i = 0; i < 2; ++i) { int R, C; stage_rc(tid * 16 + i * 8192, R, C); const int Rb = Epi::PERM ? ((R & ~31) + perm32(R & 31)) : R;
        voffA[i] = (unsigned)(R * K + C) * 2u; voffB[i] = (unsigned)(Rb * K + C) * 2u; }
    const size_t kstep = (size_t)(BK * 2);
    const size_t hstep = (size_t)HALF * K * 2;
    const size_t tstep = 2 * hstep;
    const unsigned ldsw = (unsigned)wid * 1024u;
    const int aoff = lds_byte(wr * 64 + fr, fq * 8), boff = lds_byte(wc * 32 + fr, fq * 8);
#define PG8_SA(b, h) (((b) * 2 + (h)) * HTB)
#define PG8_SB(b, h) ((4 + (b) * 2 + (h)) * HTB)
#define PG8_STAGE(bufoff, gbase, voff) do { _Pragma("unroll") for (int _i = 0; _i < 2; ++_i) \
        __builtin_amdgcn_global_load_lds((const unsigned*)((const char*)(gbase) + (voff)[_i]), (PG8_LAS unsigned*)(lds + (bufoff) + ldsw + _i * 8192), 16, 0, 0); } while (0)
#define PG8_LDA(dst, b, h) do { _Pragma("unroll") for (int m = 0; m < 4; ++m) _Pragma("unroll") for (int k = 0; k < 2; ++k) dst[m][k] = *(const PG8_LAS bf16x8*)(lds + PG8_SA(b, h) + aoff + m * 2048 + k * 1024); } while (0)
#define PG8_LDB(dst, b, h) do { _Pragma("unroll") for (int n = 0; n < 2; ++n) _Pragma("unroll") for (int k = 0; k < 2; ++k) dst[n][k] = *(const PG8_LAS bf16x8*)(lds + PG8_SB(b, h) + boff + n * 2048 + k * 1024); } while (0)
#define PG8_MMA(ai, bj, At, Bt) do { __builtin_amdgcn_s_setprio(1); _Pragma("unroll") for (int m = 0; m < 4; ++m) _Pragma("unroll") for (int n = 0; n < 2; ++n) _Pragma("unroll") for (int k = 0; k < 2; ++k) \
        acc[ai][bj][m][n] = __builtin_amdgcn_mfma_f32_16x16x32_bf16(Bt[n][k], At[m][k], acc[ai][bj][m][n], 0, 0, 0); __builtin_amdgcn_s_setprio(0); } while (0)
#define PG8_WAIT_V(n) asm volatile("s_waitcnt vmcnt(" #n ")" ::: "memory")
#define PG8_WAIT_L(n) asm volatile("s_waitcnt lgkmcnt(" #n ")" ::: "memory")
#define PG8_BAR __builtin_amdgcn_s_barrier()
#define PG8_SCHED __builtin_amdgcn_sched_barrier(0)
    Unit cur, nxt; int ui = 0;
    if (!S.next(0, cur)) return;
    f32x4 acc[2][2][4][2];
#pragma unroll
    for (int a = 0; a < 2; ++a)
#pragma unroll
        for (int b = 0; b < 2; ++b)
#pragma unroll
            for (int m = 0; m < 4; ++m)
#pragma unroll
                for (int n = 0; n < 2; ++n) acc[a][b][m][n] = (f32x4){0.f, 0.f, 0.f, 0.f};
    bf16x8 At[4][2], B0[2][2], B1[2][2];
    const char* cA = (const char*)g.A + (size_t)cur.pm * tstep; const char* cB = (const char*)g.Bt + (size_t)cur.pn * tstep;
    S.a_ready(cur);
    if constexpr (SP2) {
        PG8_STAGE(PG8_SB(0, 0), cB, voffB); PG8_STAGE(PG8_SB(0, 1), cB + hstep, voffB); PG8_STAGE(PG8_SA(0, 0), cA, voffA); PG8_STAGE(PG8_SA(0, 1), cA + hstep, voffA);
        if (wr == 1) PG8_BAR;
        PG8_WAIT_V(2); PG8_BAR;
        PG8_STAGE(PG8_SB(1, 0), cB + kstep, voffB); PG8_STAGE(PG8_SA(1, 0), cA + kstep, voffA); PG8_STAGE(PG8_SB(1, 1), cB + hstep + kstep, voffB);
        PG8_WAIT_V(6); PG8_BAR;
    } else {
        PG8_STAGE(PG8_SB(0, 0), cB, voffB); PG8_STAGE(PG8_SA(0, 0), cA, voffA); PG8_STAGE(PG8_SB(0, 1), cB + hstep, voffB); PG8_STAGE(PG8_SA(0, 1), cA + hstep, voffA);
        if (wr == 1) PG8_BAR;
        PG8_WAIT_V(4); PG8_BAR;
        PG8_STAGE(PG8_SB(1, 0), cB + kstep, voffB); PG8_STAGE(PG8_SA(1, 0), cA + kstep, voffA); PG8_STAGE(PG8_SB(1, 1), cB + hstep + kstep, voffB);
        PG8_WAIT_V(6); PG8_BAR;
    }
    for (;;) {
        const bool has_next = S.next(ui + 1, nxt);
        const char* nA = has_next ? (const char*)g.A + (size_t)nxt.pm * tstep : cA; const char* nB = has_next ? (const char*)g.Bt + (size_t)nxt.pn * tstep : cB;
        for (int t = 0; t < nt; t += 2) {
            const bool last = (t == nt - 2);
            const char* a1 = cA + (size_t)(t + 1) * kstep;
            const char* a2 = last ? nA : cA + (size_t)(t + 2) * kstep; const char* b2 = last ? nB : cB + (size_t)(t + 2) * kstep;
            const char* a3 = a2 + kstep; const char* b3 = b2 + kstep;
            if (last && has_next) S.a_ready(nxt);
            if constexpr (SP2) {
            PG8_LDB(B0, 0, 0); PG8_LDB(B1, 0, 1); PG8_SCHED; PG8_LDA(At, 0, 0); PG8_STAGE(PG8_SA(1, 1), a1 + hstep, voffA);
            PG8_WAIT_V(8); PG8_WAIT_L(0); PG8_BAR; PG8_MMA(0, 0, At, B0); PG8_MMA(0, 1, At, B1); PG8_BAR; PG8_SCHED;
            PG8_LDA(At, 0, 1); PG8_STAGE(PG8_SB(0, 0), b2, voffB); PG8_STAGE(PG8_SB(0, 1), b2 + hstep, voffB); PG8_STAGE(PG8_SA(0, 0), a2, voffA);
            PG8_WAIT_V(8); PG8_WAIT_L(0); PG8_BAR; PG8_MMA(1, 0, At, B0); PG8_MMA(1, 1, At, B1); PG8_BAR; PG8_SCHED;
            PG8_LDB(B0, 1, 0); PG8_LDB(B1, 1, 1); PG8_SCHED; PG8_LDA(At, 1, 0); PG8_STAGE(PG8_SA(0, 1), a2 + hstep, voffA);
            PG8_WAIT_V(8); PG8_WAIT_L(0); PG8_BAR; PG8_MMA(0, 0, At, B0); PG8_MMA(0, 1, At, B1); PG8_BAR; PG8_SCHED;
            PG8_LDA(At, 1, 1); PG8_STAGE(PG8_SB(1, 0), b3, voffB); PG8_STAGE(PG8_SB(1, 1), b3 + hstep, voffB); PG8_STAGE(PG8_SA(1, 0), a3, voffA);
            PG8_WAIT_V(8); PG8_WAIT_L(0); PG8_BAR; PG8_MMA(1, 0, At, B0); PG8_MMA(1, 1, At, B1); PG8_BAR; PG8_SCHED;
            } else {
            PG8_LDB(B0, 0, 0); PG8_SCHED; PG8_LDA(At, 0, 0); PG8_STAGE(PG8_SA(1, 1), a1 + hstep, voffA);
            PG8_WAIT_L(8); PG8_BAR; PG8_WAIT_L(0); PG8_MMA(0, 0, At, B0); PG8_BAR; PG8_SCHED;
            PG8_LDB(B1, 0, 1); PG8_STAGE(PG8_SB(0, 0), b2, voffB);
            PG8_BAR; PG8_WAIT_L(0); PG8_MMA(0, 1, At, B1); PG8_BAR;
            PG8_LDA(At, 0, 1); PG8_STAGE(PG8_SA(0, 0), a2, voffA);
            PG8_BAR; PG8_WAIT_L(0); PG8_MMA(1, 0, At, B0); PG8_BAR; PG8_SCHED;
            PG8_STAGE(PG8_SB(0, 1), b2 + hstep, voffB);
            PG8_WAIT_V(6); PG8_BAR; PG8_MMA(1, 1, At, B1); PG8_BAR;
            PG8_LDB(B0, 1, 0); PG8_SCHED; PG8_LDA(At, 1, 0); PG8_STAGE(PG8_SA(0, 1), a2 + hstep, voffA);
            PG8_WAIT_L(8); PG8_BAR; PG8_WAIT_L(0); PG8_MMA(0, 0, At, B0); PG8_BAR; PG8_SCHED;
            PG8_LDB(B1, 1, 1); PG8_STAGE(PG8_SB(1, 0), b3, voffB);
            PG8_BAR; PG8_WAIT_L(0); PG8_MMA(0, 1, At, B1); PG8_BAR;
            PG8_LDA(At, 1, 1); PG8_STAGE(PG8_SA(1, 0), a3, voffA);
            PG8_BAR; PG8_WAIT_L(0); PG8_MMA(1, 0, At, B0); PG8_BAR; PG8_SCHED;
            PG8_STAGE(PG8_SB(1, 1), b3 + hstep, voffB);
            PG8_WAIT_V(6); PG8_BAR; PG8_MMA(1, 1, At, B1); PG8_BAR;
            }
        }
        if constexpr (ALIGN_EPI) { if (wr == 0) PG8_BAR; }
        if constexpr (!Epi::AFTER_DRAIN) { E(acc, cur, wr, wc, fr, fq); S.done(cur); }
        if (!has_next) break;
#pragma unroll
        for (int a = 0; a < 2; ++a)
#pragma unroll
            for (int b = 0; b < 2; ++b)
#pragma unroll
                for (int m = 0; m < 4; ++m)
#pragma unroll
                    for (int n = 0; n < 2; ++n) acc[a][b][m][n] = (f32x4){0.f, 0.f, 0.f, 0.f};
        cur = nxt; cA = nA; cB = nB; ++ui;
        if constexpr (ALIGN_EPI) { if (wr == 1) PG8_BAR; }
    }
    PG8_WAIT_V(0);
    if constexpr (!ALIGN_EPI) { if (wr == 0) PG8_BAR; }
    PG8_BAR;
    if constexpr (Epi::AFTER_DRAIN) { E.fused(acc, cur, wr, wc, fr, fq, lds, wid, lane); S.done(cur); }
#undef PG8_SA
#undef PG8_SB
#undef PG8_STAGE
#undef PG8_LDA
#undef PG8_LDB
#undef PG8_MMA
#undef PG8_WAIT_V
#undef PG8_WAIT_L
#undef PG8_BAR
#undef PG8_SCHED
}
}
#define GAS __attribute__((address_space(1)))
#define LAS __attribute__((address_space(3)))
typedef unsigned v4u __attribute__((ext_vector_type(4)));
typedef unsigned v2u __attribute__((ext_vector_type(2)));
typedef float f32x4 __attribute__((ext_vector_type(4)));
typedef float f32x2 __attribute__((ext_vector_type(2)));
typedef short bf16x8 __attribute__((ext_vector_type(8)));
typedef __bf16 bf16x2 __attribute__((ext_vector_type(2)));
constexpr int NWAVES = 8, NTHREADS = NWAVES * 64;
constexpr int LDS_BYTES = 147456, MISC_OFF = LDS_BYTES - 512;
constexpr int CW_BAR = 4096;
constexpr float LOG2E = 1.44269504088896340736f;

__device__ __forceinline__ unsigned cvtpk(float lo, float hi) { f32x2 v = {lo, hi}; bf16x2 b = __builtin_convertvector(v, bf16x2); return __builtin_bit_cast(unsigned, b); }
__device__ __forceinline__ f32x4 mfma16(bf16x8 a, bf16x8 b, f32x4 c) { return __builtin_amdgcn_mfma_f32_16x16x32_bf16(a, b, c, 0, 0, 0); }
__device__ __forceinline__ float dot2bf(unsigned w, unsigned x, float acc) { return __builtin_amdgcn_fdot2_f32_bf16(__builtin_bit_cast(bf16x2, w), __builtin_bit_cast(bf16x2, x), acc, false); }
__device__ __forceinline__ float fexp2(float x) { return __builtin_amdgcn_exp2f(x); }
#define LDS_WAIT() asm volatile("s_waitcnt lgkmcnt(0)" ::: "memory")

#define XB_TMO      128
#define XB_XCNT(j)  (256  + 64 * (j))
#define XB_XSUB(j)  (1280 + 64 * (j))
#define XB_XGEN(j)  (2304 + 64 * (j))
#define XB_TOP      3328
#define XB_TOPGEN   3392
#define XCD_BAR_WORDS 3456
#define XB_SPIN_CAP (1u << 18)
__device__ __forceinline__ unsigned xb_ld(unsigned* p)              { return __hip_atomic_load(p, __ATOMIC_RELAXED, __HIP_MEMORY_SCOPE_AGENT); }
__device__ __forceinline__ unsigned xb_add(unsigned* p, unsigned v) { return __hip_atomic_fetch_add(p, v, __ATOMIC_RELAXED, __HIP_MEMORY_SCOPE_AGENT); }
__device__ __forceinline__ unsigned xb_xcc_id() { return (unsigned)__builtin_amdgcn_s_getreg((3 << 11) | 20) & 0xFu; }
#define XB_SPIN(cond, bar) do { unsigned _sp = 0; while (cond) { __builtin_amdgcn_s_sleep(1); \
    if ((++_sp & 255u) == 0u) { if (xb_ld(&(bar)[XB_TMO])) break; if (_sp > XB_SPIN_CAP) { atomicAdd(&(bar)[XB_TMO], 1u); break; } } } } while (0)
struct XcdBarrier { unsigned* bar; unsigned x; volatile LAS unsigned* st; };
__device__ __forceinline__ XcdBarrier xcd_barrier_post(unsigned* bar, volatile LAS unsigned* st) {
    XcdBarrier b; b.bar = bar; b.x = xb_xcc_id(); b.st = st;
    if (threadIdx.x == 0) (void)xb_add(&bar[XB_XCNT(b.x)], 1u);
    return b;
}
__device__ __forceinline__ void xcd_barrier_complete(unsigned* bar, unsigned x, unsigned& nloc, unsigned& nx) {
    const unsigned G = gridDim.x * gridDim.y * gridDim.z;
    unsigned sum, cnt, mine, sp = 0u;
    for (;;) {
        sum = 0u; cnt = 0u; mine = 0u;
#pragma unroll
        for (unsigned j = 0; j < 16; ++j) { const unsigned c = xb_ld(&bar[XB_XCNT(j)]); sum += c; cnt += (c > 0u) ? 1u : 0u; mine = (j == x) ? c : mine; }
        if (sum == G) break;
        __builtin_amdgcn_s_sleep(1);
        if ((++sp & 255u) == 0u) { if (xb_ld(&bar[XB_TMO])) break; if (sp > XB_SPIN_CAP) { atomicAdd(&bar[XB_TMO], 1u); break; } }
    }
    nloc = mine > 0u ? mine : 1u; nx = cnt > 0u ? cnt : 1u;
}
__device__ __forceinline__ void xcd_barrier(const XcdBarrier& b) {
    asm volatile("s_waitcnt vmcnt(0)" ::: "memory");
    __syncthreads();
    if (threadIdx.x == 0) {
        unsigned* bar = b.bar;
        __builtin_amdgcn_s_waitcnt(0);
        unsigned nloc = b.st[0], nx = b.st[1];
        if (nloc == 0u) { xcd_barrier_complete(bar, b.x, nloc, nx); b.st[0] = nloc; b.st[1] = nx; }
        const unsigned old = xb_add(&bar[XB_XSUB(b.x)], 1u);
        const unsigned gen = old / nloc;
        if (old + 1u == (gen + 1u) * nloc) {
            __builtin_amdgcn_fence(__ATOMIC_RELEASE, "agent");
            asm volatile("s_waitcnt vmcnt(0)" ::: "memory");
            const unsigned og = xb_add(&bar[XB_TOP], 1u);
            const unsigned tg = og / nx;
            if (og + 1u == (tg + 1u) * nx) xb_add(&bar[XB_TOPGEN], 1u);
            else XB_SPIN(xb_ld(&bar[XB_TOPGEN]) == tg, bar);
            __builtin_amdgcn_fence(__ATOMIC_ACQUIRE, "agent");
            xb_add(&bar[XB_XGEN(b.x)], 1u);
            asm volatile("s_waitcnt vmcnt(0)" ::: "memory");
        } else {
            XB_SPIN(xb_ld(&bar[XB_XGEN(b.x)]) == gen, bar);
            __builtin_amdgcn_fence(__ATOMIC_ACQUIRE, "agent");
            asm volatile("s_waitcnt vmcnt(0)" ::: "memory");
        }
    }
    __syncthreads();
}

struct EpiStoreBf {
    static constexpr bool PERM = true, AFTER_DRAIN = false;
    bf16_t* O; int ldc;
    __device__ __forceinline__ void operator()(const pg8::f32x4 (&acc)[2][2][4][2], const pg8::Unit& u, int wr, int wc, int fr, int fq) const {
        const int row0 = u.pm * 256 + wr * 64 + fr, col0 = u.pn * 256 + wc * 32 + 8 * fq;
#pragma unroll
        for (int ai = 0; ai < 2; ++ai)
#pragma unroll
            for (int m = 0; m < 4; ++m) { bf16_t* rowp = O + (size_t)(row0 + ai * 128 + m * 16) * ldc + col0;
#pragma unroll
                for (int bj = 0; bj < 2; ++bj) { const pg8::f32x4 v0 = acc[ai][bj][m][0], v1 = acc[ai][bj][m][1];
                    v4u w; w.x = cvtpk(v0[0], v0[1]); w.y = cvtpk(v0[2], v0[3]); w.z = cvtpk(v1[0], v1[1]); w.w = cvtpk(v1[2], v1[3]);
                    *(v4u*)(rowp + bj * 128) = w; } }
    }
};
struct EpiY1 {
    static constexpr bool PERM = true, AFTER_DRAIN = false;
    const float* x; float* y;
    __device__ __forceinline__ void operator()(const pg8::f32x4 (&acc)[2][2][4][2], const pg8::Unit& u, int wr, int wc, int fr, int fq) const {
        const int row0 = u.pm * 256 + wr * 64 + fr, col0 = u.pn * 256 + wc * 32 + 8 * fq;
#pragma unroll
        for (int ai = 0; ai < 2; ++ai)
#pragma unroll
            for (int m = 0; m < 4; ++m) { const size_t off = (size_t)(row0 + ai * 128 + m * 16) * D_MODEL + col0;
#pragma unroll
                for (int bj = 0; bj < 2; ++bj) {
                    const f32x4 x0 = *(const f32x4*)(x + off + bj * 128), x1 = *(const f32x4*)(x + off + bj * 128 + 4);
                    *(f32x4*)(y + off + bj * 128) = x0 * ALPHA + acc[ai][bj][m][0]; *(f32x4*)(y + off + bj * 128 + 4) = x1 * ALPHA + acc[ai][bj][m][1]; } }
    }
};
struct EpiIn {
    static constexpr bool PERM = true, AFTER_DRAIN = false;
    float* POOLV; bf16_t *Q, *K, *V, *QM; const float* rope;
    __device__ __forceinline__ void operator()(const pg8::f32x4 (&acc)[2][2][4][2], const pg8::Unit& u, int wr, int wc, int fr, int fq) const {
        const int row0 = u.pm * 256 + wr * 64 + fr, cl = wc * 32 + 8 * fq, pn = u.pn;
        if (pn < 2) {
#pragma unroll
            for (int ai = 0; ai < 2; ++ai)
#pragma unroll
                for (int m = 0; m < 4; ++m) { float* rp = POOLV + (size_t)(row0 + ai * 128 + m * 16) * POOL_W + pn * 256 + cl;
#pragma unroll
                    for (int bj = 0; bj < 2; ++bj) { *(f32x4*)(rp + bj * 128) = acc[ai][bj][m][0]; *(f32x4*)(rp + bj * 128 + 4) = acc[ai][bj][m][1]; } }
            return;
        }
        bf16_t* base; int ld, c0; bool rot = false;
        if (pn < 6) { base = Q; ld = SWA_W; c0 = (pn - 2) * 256; rot = true; }
        else if (pn == 6) { base = K; ld = KV_W; c0 = 0; rot = true; }
        else if (pn == 7) { base = V; ld = KV_W; c0 = 0; }
        else { base = QM; ld = MEM_W; c0 = (pn - 8) * 256; }
        rot = rot && ((wc & 1) == 0);
#pragma unroll
        for (int ai = 0; ai < 2; ++ai)
#pragma unroll
            for (int m = 0; m < 4; ++m) {
                const int row = row0 + ai * 128 + m * 16;
                f32x4 v[2][2];
#pragma unroll
                for (int bj = 0; bj < 2; ++bj) { v[bj][0] = acc[ai][bj][m][0]; v[bj][1] = acc[ai][bj][m][1]; }
                if (rot) {
                    const f32x4* tp = (const f32x4*)(rope + (size_t)row * 16);
                    f32x4 cs[2][2]; cs[0][0] = tp[0]; cs[0][1] = tp[1]; cs[1][0] = tp[2]; cs[1][1] = tp[3];
#pragma unroll
                    for (int bj = 0; bj < 2; ++bj)
#pragma unroll
                        for (int n = 0; n < 2; ++n)
#pragma unroll
                            for (int i = 0; i < 4; ++i) {
                                const float xv = v[bj][n][i], pv = __shfl_xor(xv, 16);
                                const float c = cs[n][i >> 1][2 * (i & 1)], s = cs[n][i >> 1][2 * (i & 1) + 1];
                                const float o = fq == 0 ? xv * c - pv * s : (fq == 1 ? xv * c + pv * s : xv);
                                v[bj][n][i] = o; }
                }
                bf16_t* rowp = base + (size_t)row * ld + c0 + cl;
#pragma unroll
                for (int bj = 0; bj < 2; ++bj) { v4u w; w.x = cvtpk(v[bj][0][0], v[bj][0][1]); w.y = cvtpk(v[bj][0][2], v[bj][0][3]); w.z = cvtpk(v[bj][1][0], v[bj][1][1]); w.w = cvtpk(v[bj][1][2], v[bj][1][3]);
                    *(v4u*)(rowp + bj * 128) = w; }
            }
    }
};

__device__ __forceinline__ void p0_transpose_item(const float* W, int K, int N, bf16_t* WT, LAS float* scr, int item, int lane) {
    const int nblk = N / 32, kb = item / nblk, nb = item % nblk, k0 = 64 * kb, n0 = 32 * nb;
#pragma unroll 8
    for (int i = 0; i < 32; ++i) { const int kk = 2 * i + (lane >> 5); scr[kk * 33 + (lane & 31)] = W[(size_t)(k0 + kk) * N + n0 + (lane & 31)]; }
    LDS_WAIT(); asm volatile("" ::: "memory");
    const int c = lane & 7;
#pragma unroll
    for (int j = 0; j < 4; ++j) { const int n = (lane >> 3) + 8 * j; const LAS float* s = scr + (8 * c) * 33 + n;
        v4u o; o.x = cvtpk(s[0 * 33], s[1 * 33]); o.y = cvtpk(s[2 * 33], s[3 * 33]); o.z = cvtpk(s[4 * 33], s[5 * 33]); o.w = cvtpk(s[6 * 33], s[7 * 33]);
        *(v4u*)(WT + (size_t)(n0 + n) * K + k0 + 8 * c) = o; }
    LDS_WAIT(); asm volatile("" ::: "memory");
}
template <bool NT>
__device__ __forceinline__ void cvt_stream(const float* in, bf16_t* out, size_t n, int gw, int NGW, int lane) {
#pragma unroll 4
    for (size_t i = (size_t)gw * 512 + lane * 8; i < n; i += (size_t)NGW * 512) {
        f32x4 a, b;
        if (NT) { a = __builtin_nontemporal_load((const f32x4*)(in + i)); b = __builtin_nontemporal_load((const f32x4*)(in + i + 4)); }
        else { a = *(const f32x4*)(in + i); b = *(const f32x4*)(in + i + 4); }
        v4u o; o.x = cvtpk(a.x, a.y); o.y = cvtpk(a.z, a.w); o.z = cvtpk(b.x, b.y); o.w = cvtpk(b.z, b.w);
        *(v4u*)(out + i) = o;
    }
}

constexpr int SWA_KROW = 144, SWA_VROW = 528, SWA_VT_OFF = 256 * SWA_KROW;
__device__ __forceinline__ void swa_item(LAS unsigned char* lds, int item, const bf16_t* __restrict__ Q, const bf16_t* __restrict__ Kb, const bf16_t* __restrict__ Vb, const float* __restrict__ sinks,
                                         bf16_t* CONCAT, int tid, int wave, int lane) {
    const int qb = item & 31, kvh = (item >> 5) & 3, b = item >> 7;
    const int tok0 = b * SEQ + qb * 128;
    LAS unsigned char* Kl = lds; LAS unsigned char* Vt = lds + SWA_VT_OFF;
#pragma unroll
    for (int j = 0; j < 4; ++j) {
        const int c = tid + NTHREADS * j, row = c >> 3, part = c & 7;
        v4u kv = {0u, 0u, 0u, 0u}, vv = {0u, 0u, 0u, 0u};
        if (qb > 0 || row >= 128) { const size_t tk = (size_t)(tok0 - 128 + row); kv = *(const v4u*)(Kb + tk * KV_W + kvh * HD + part * 8); vv = *(const v4u*)(Vb + tk * KV_W + kvh * HD + part * 8); }
        *(LAS v4u*)(Kl + row * SWA_KROW + part * 16) = kv;
        LAS unsigned short* vp = (LAS unsigned short*)(Vt + (part * 8) * SWA_VROW + row * 2);
        vp[0 * (SWA_VROW / 2)] = (unsigned short)(vv.x & 0xffffu); vp[1 * (SWA_VROW / 2)] = (unsigned short)(vv.x >> 16);
        vp[2 * (SWA_VROW / 2)] = (unsigned short)(vv.y & 0xffffu); vp[3 * (SWA_VROW / 2)] = (unsigned short)(vv.y >> 16);
        vp[4 * (SWA_VROW / 2)] = (unsigned short)(vv.z & 0xffffu); vp[5 * (SWA_VROW / 2)] = (unsigned short)(vv.z >> 16);
        vp[6 * (SWA_VROW / 2)] = (unsigned short)(vv.w & 0xffffu); vp[7 * (SWA_VROW / 2)] = (unsigned short)(vv.w >> 16);
    }
    __syncthreads();
    const int g = wave & 3, h = kvh * 4 + g, q15 = lane & 15, qq = lane >> 4;
    const float sink2 = sinks[h] * LOG2E;
    const float SC = 0.125f * LOG2E;
#pragma unroll 1
    for (int cc = 0; cc < 2; ++cc) {
        const int c = 2 * (wave >> 2) + cc, kl0 = 32 * c;
        bf16x8 qf[2][2];
#pragma unroll
        for (int ni = 0; ni < 2; ++ni)
#pragma unroll
            for (int ks = 0; ks < 2; ++ks) qf[ni][ks] = *(const bf16x8*)(Q + (size_t)(tok0 + 32 * c + 16 * ni + q15) * SWA_W + h * HD + 32 * ks + 8 * qq);
        f32x4 s[10][2];
#pragma unroll
        for (int mi = 0; mi < 10; ++mi) { s[mi][0] = (f32x4){0.f, 0.f, 0.f, 0.f}; s[mi][1] = (f32x4){0.f, 0.f, 0.f, 0.f}; }
#pragma unroll
        for (int mi = 0; mi < 10; ++mi)
#pragma unroll
            for (int ks = 0; ks < 2; ++ks) {
                const bf16x8 kf = *(const LAS bf16x8*)(Kl + (kl0 + 16 * mi + q15) * SWA_KROW + (32 * ks + 8 * qq) * 2);
                s[mi][0] = mfma16(kf, qf[0][ks], s[mi][0]); s[mi][1] = mfma16(kf, qf[1][ks], s[mi][1]);
            }
        float rl[2];
#pragma unroll
        for (int ni = 0; ni < 2; ++ni) {
            const int ql = 32 * c + 16 * ni + q15;
            float mx = -INFINITY;
#pragma unroll
            for (int mi = 0; mi < 10; ++mi)
#pragma unroll
                for (int r = 0; r < 4; ++r) {
                    const int kl = kl0 + 16 * mi + 4 * qq + r;
                    const bool valid = (kl > ql) && (kl <= ql + 128) && (qb > 0 || kl >= 128);
                    const float t = valid ? s[mi][ni][r] * SC : -INFINITY;
                    s[mi][ni][r] = t; mx = fmaxf(mx, t);
                }
            mx = fmaxf(mx, __shfl_xor(mx, 16)); mx = fmaxf(mx, __shfl_xor(mx, 32)); mx = fmaxf(mx, sink2);
            float l = 0.f;
#pragma unroll
            for (int mi = 0; mi < 10; ++mi)
#pragma unroll
                for (int r = 0; r < 4; ++r) { const float p = fexp2(s[mi][ni][r] - mx); s[mi][ni][r] = p; l += p; }
            l += __shfl_xor(l, 16); l += __shfl_xor(l, 32); l += fexp2(sink2 - mx);
            rl[ni] = 1.0f / l;
        }
        f32x4 o[4][2];
#pragma unroll
        for (int dt = 0; dt < 4; ++dt) { o[dt][0] = (f32x4){0.f, 0.f, 0.f, 0.f}; o[dt][1] = (f32x4){0.f, 0.f, 0.f, 0.f}; }
#pragma unroll
        for (int kk = 0; kk < 5; ++kk) {
            bf16x8 pf[2];
#pragma unroll
            for (int ni = 0; ni < 2; ++ni) {
                v4u w; w.x = cvtpk(s[2 * kk][ni][0], s[2 * kk][ni][1]); w.y = cvtpk(s[2 * kk][ni][2], s[2 * kk][ni][3]);
                w.z = cvtpk(s[2 * kk + 1][ni][0], s[2 * kk + 1][ni][1]); w.w = cvtpk(s[2 * kk + 1][ni][2], s[2 * kk + 1][ni][3]);
                pf[ni] = __builtin_bit_cast(bf16x8, w);
            }
#pragma unroll
            for (int dt = 0; dt < 4; ++dt) {
                const LAS unsigned char* vb = Vt + (16 * dt + q15) * SWA_VROW + (kl0 + 32 * kk + 4 * qq) * 2;
                const v2u lo = *(const LAS v2u*)vb, hi = *(const LAS v2u*)(vb + 32);
                v4u w; w.x = lo.x; w.y = lo.y; w.z = hi.x; w.w = hi.y;
                const bf16x8 vf = __builtin_bit_cast(bf16x8, w);
                o[dt][0] = mfma16(vf, pf[0], o[dt][0]); o[dt][1] = mfma16(vf, pf[1], o[dt][1]);
            }
        }
#pragma unroll
        for (int ni = 0; ni < 2; ++ni) {
            bf16_t* orow = CONCAT + (size_t)(tok0 + 32 * c + 16 * ni + q15) * D_MODEL + POOL_W + h * HD + 4 * qq;
#pragma unroll
            for (int dt = 0; dt < 4; ++dt) { v2u w; w.x = cvtpk(o[dt][ni][0] * rl[ni], o[dt][ni][1] * rl[ni]); w.y = cvtpk(o[dt][ni][2] * rl[ni], o[dt][ni][3] * rl[ni]); *(v2u*)(orow + 16 * dt) = w; }
        }
    }
    __syncthreads();
}
constexpr int MEM_KROW = 272, MEM_VROW = 528, MEM_VT_OFF = 256 * MEM_KROW;
__device__ __forceinline__ void mem_item(LAS unsigned char* lds, int item, const bf16_t* __restrict__ QM, const bf16_t* __restrict__ KVM, bf16_t* CONCAT, int tid, int wave, int lane) {
    const int qt = item & 31, hm = (item >> 5) & 3, b = item >> 7;
    LAS unsigned char* Kl = lds; LAS unsigned char* Vt = lds + MEM_VT_OFF;
#pragma unroll
    for (int j = 0; j < 8; ++j) {
        const int c = tid + NTHREADS * j, row = c >> 4, part = c & 15;
        const bf16_t* src = KVM + (size_t)(b * MEM_LEN + row) * (2 * MEM_W) + hm * MHD + part * 8;
        const v4u kv = *(const v4u*)src, vv = *(const v4u*)(src + MEM_W);
        *(LAS v4u*)(Kl + row * MEM_KROW + part * 16) = kv;
        LAS unsigned short* vp = (LAS unsigned short*)(Vt + (part * 8) * MEM_VROW + row * 2);
        vp[0 * (MEM_VROW / 2)] = (unsigned short)(vv.x & 0xffffu); vp[1 * (MEM_VROW / 2)] = (unsigned short)(vv.x >> 16);
        vp[2 * (MEM_VROW / 2)] = (unsigned short)(vv.y & 0xffffu); vp[3 * (MEM_VROW / 2)] = (unsigned short)(vv.y >> 16);
        vp[4 * (MEM_VROW / 2)] = (unsigned short)(vv.z & 0xffffu); vp[5 * (MEM_VROW / 2)] = (unsigned short)(vv.z >> 16);
        vp[6 * (MEM_VROW / 2)] = (unsigned short)(vv.w & 0xffffu); vp[7 * (MEM_VROW / 2)] = (unsigned short)(vv.w >> 16);
    }
    __syncthreads();
    const int q15 = lane & 15, qq = lane >> 4;
    const int tok = b * SEQ + qt * 128 + wave * 16 + q15;
    const float SC = 0.08838834764831845f * LOG2E;
    bf16x8 qf[4];
#pragma unroll
    for (int ks = 0; ks < 4; ++ks) qf[ks] = *(const bf16x8*)(QM + (size_t)tok * MEM_W + hm * MHD + 32 * ks + 8 * qq);
    f32x4 s[16];
#pragma unroll
    for (int mi = 0; mi < 16; ++mi) s[mi] = (f32x4){0.f, 0.f, 0.f, 0.f};
#pragma unroll
    for (int mi = 0; mi < 16; ++mi)
#pragma unroll
        for (int ks = 0; ks < 4; ++ks) {
            const bf16x8 kf = *(const LAS bf16x8*)(Kl + (16 * mi + q15) * MEM_KROW + (32 * ks + 8 * qq) * 2);
            s[mi] = mfma16(kf, qf[ks], s[mi]);
        }
    float mx = -INFINITY;
#pragma unroll
    for (int mi = 0; mi < 16; ++mi)
#pragma unroll
        for (int r = 0; r < 4; ++r) { const float t = s[mi][r] * SC; s[mi][r] = t; mx = fmaxf(mx, t); }
    mx = fmaxf(mx, __shfl_xor(mx, 16)); mx = fmaxf(mx, __shfl_xor(mx, 32));
    float l = 0.f;
#pragma unroll
    for (int mi = 0; mi < 16; ++mi)
#pragma unroll
        for (int r = 0; r < 4; ++r) { const float p = fexp2(s[mi][r] - mx); s[mi][r] = p; l += p; }
    l += __shfl_xor(l, 16); l += __shfl_xor(l, 32);
    const float rl = 1.0f / l;
    f32x4 o[8];
#pragma unroll
    for (int dt = 0; dt < 8; ++dt) o[dt] = (f32x4){0.f, 0.f, 0.f, 0.f};
#pragma unroll
    for (int kk = 0; kk < 8; ++kk) {
        v4u pw; pw.x = cvtpk(s[2 * kk][0], s[2 * kk][1]); pw.y = cvtpk(s[2 * kk][2], s[2 * kk][3]); pw.z = cvtpk(s[2 * kk + 1][0], s[2 * kk + 1][1]); pw.w = cvtpk(s[2 * kk + 1][2], s[2 * kk + 1][3]);
        const bf16x8 pf = __builtin_bit_cast(bf16x8, pw);
#pragma unroll
        for (int dt = 0; dt < 8; ++dt) {
            const LAS unsigned char* vb = Vt + (16 * dt + q15) * MEM_VROW + (32 * kk + 4 * qq) * 2;
            const v2u lo = *(const LAS v2u*)vb, hi = *(const LAS v2u*)(vb + 32);
            v4u w; w.x = lo.x; w.y = lo.y; w.z = hi.x; w.w = hi.y;
            o[dt] = mfma16(__builtin_bit_cast(bf16x8, w), pf, o[dt]);
        }
    }
    bf16_t* orow = CONCAT + (size_t)tok * D_MODEL + POOL_W + SWA_W + hm * MHD + 4 * qq;
#pragma unroll
    for (int dt = 0; dt < 8; ++dt) { v2u w; w.x = cvtpk(o[dt][0] * rl, o[dt][1] * rl); w.y = cvtpk(o[dt][2] * rl, o[dt][3] * rl); *(v2u*)(orow + 16 * dt) = w; }
    __syncthreads();
}
__device__ __forceinline__ void pool_item(int item, const float* __restrict__ POOLV, const bf16_t* __restrict__ WPT, const float* __restrict__ pool_scale, bf16_t* CONCAT, int lane) {
    const int g = item & 3, t0 = (item >> 2) * 16, w = 2 << g, q15 = lane & 15, qq = lane >> 4;
    const int t = t0 + q15, sp = t & (SEQ - 1);
    const int cnt = (sp + 1) < w ? (sp + 1) : w;
    const float inv = 1.0f / (float)cnt;
    bf16x8 pf[4];
#pragma unroll
    for (int ks = 0; ks < 4; ++ks) {
        const float* p0 = POOLV + (size_t)t * POOL_W + g * 128 + 32 * ks + 8 * qq;
        const f32x4 c0 = *(const f32x4*)p0, c1 = *(const f32x4*)(p0 + 4);
        f32x4 a0 = c0, a1 = c1;
        for (int i = 1; i < cnt; ++i) { a0 += *(const f32x4*)(p0 - (size_t)i * POOL_W); a1 += *(const f32x4*)(p0 - (size_t)i * POOL_W + 4); }
        a0 = a0 * inv - c0; a1 = a1 * inv - c1;
        v4u pw; pw.x = cvtpk(a0.x, a0.y); pw.y = cvtpk(a0.z, a0.w); pw.z = cvtpk(a1.x, a1.y); pw.w = cvtpk(a1.z, a1.w);
        pf[ks] = __builtin_bit_cast(bf16x8, pw);
    }
    bf16_t* orow = CONCAT + (size_t)t * D_MODEL + g * 128 + 4 * qq;
#pragma unroll
    for (int mt = 0; mt < 8; ++mt) {
        f32x4 acc = {0.f, 0.f, 0.f, 0.f};
#pragma unroll
        for (int ks = 0; ks < 4; ++ks) { const bf16x8 wf = *(const bf16x8*)(WPT + (size_t)g * 16384 + (16 * mt + q15) * 128 + 32 * ks + 8 * qq); acc = mfma16(wf, pf[ks], acc); }
        const f32x4 sc = *(const f32x4*)(pool_scale + g * 128 + 16 * mt + 4 * qq);
        v2u wv; wv.x = cvtpk(acc[0] * sc[0], acc[1] * sc[1]); wv.y = cvtpk(acc[2] * sc[2], acc[3] * sc[3]);
        *(v2u*)(orow + 16 * mt) = wv;
    }
}

__device__ __forceinline__ void ln1_row(const float* __restrict__ yrow, const float* __restrict__ g, const float* __restrict__ bta, float* xo, bf16_t* xb, int lane) {
    f32x4 v[8]; float s = 0.f;
#pragma unroll
    for (int j = 0; j < 8; ++j) { v[j] = *(const f32x4*)(yrow + 256 * j + 4 * lane); s += (v[j].x + v[j].y) + (v[j].z + v[j].w); }
    const float mean = wave_sum(s) * (1.f / D_MODEL); float q = 0.f;
#pragma unroll
    for (int j = 0; j < 8; ++j) { v[j] = v[j] - mean; q += (v[j].x * v[j].x + v[j].y * v[j].y) + (v[j].z * v[j].z + v[j].w * v[j].w); }
    const float rstd = 1.0f / sqrtf(wave_sum(q) * (1.f / D_MODEL) + LN_EPS);
#pragma unroll
    for (int j = 0; j < 8; ++j) {
        const f32x4 gg = *(const f32x4*)(g + 256 * j + 4 * lane), bb = *(const f32x4*)(bta + 256 * j + 4 * lane);
        const f32x4 y = v[j] * rstd * gg + bb;
        *(f32x4*)(xo + 256 * j + 4 * lane) = y;
        v2u w; w.x = cvtpk(y.x, y.y); w.y = cvtpk(y.z, y.w); *(v2u*)(xb + 256 * j + 4 * lane) = w;
    }
}

__device__ __forceinline__ unsigned f2ord(float f) { const unsigned u = __float_as_uint(f); return u ^ ((unsigned)((int)u >> 31) | 0x80000000u); }
__device__ __forceinline__ float ord2f(unsigned o) { const unsigned u = (o & 0x80000000u) ? (o ^ 0x80000000u) : ~o; return __uint_as_float(u); }
__device__ __forceinline__ unsigned umax(unsigned a, unsigned b) { return a > b ? a : b; }
__device__ __forceinline__ void topk_item(int item, const bf16_t* __restrict__ QP, const bf16_t* __restrict__ K1B, const bf16_t* __restrict__ K2B, int* EIDX, float* GATE, int lane) {
    const int h = item & 7, t0 = (item >> 3) * 16, q15 = lane & 15, qq = lane >> 4;
    const int t = t0 + q15;
    unsigned top[2][16];
#pragma unroll
    for (int half = 0; half < 2; ++half) {
        const bf16_t* KB = half ? K2B : K1B;
        bf16x8 qf[4];
#pragma unroll
        for (int ks = 0; ks < 4; ++ks) qf[ks] = *(const bf16x8*)(QP + (size_t)t * D_MODEL + h * 256 + half * 128 + 32 * ks + 8 * qq);
        unsigned key[32];
#pragma unroll
        for (int mi = 0; mi < 8; ++mi) {
            f32x4 acc = {0.f, 0.f, 0.f, 0.f};
#pragma unroll
            for (int ks = 0; ks < 4; ++ks) { const bf16x8 kf = *(const bf16x8*)(KB + (16 * mi + q15) * 128 + 32 * ks + 8 * qq); acc = mfma16(kf, qf[ks], acc); }
#pragma unroll
            for (int r = 0; r < 4; ++r) key[mi * 4 + r] = (f2ord(acc[r]) & ~0x7Fu) | (unsigned)(127 - (16 * mi + 4 * qq + r));
        }
#pragma unroll
        for (int r = 0; r < 16; ++r) {
            unsigned M = key[0];
#pragma unroll
            for (int i = 1; i < 32; ++i) M = umax(M, key[i]);
            M = umax(M, (unsigned)__shfl_xor((int)M, 16)); M = umax(M, (unsigned)__shfl_xor((int)M, 32));
            top[half][r] = M;
#pragma unroll
            for (int i = 0; i < 32; ++i) key[i] = (key[i] == M) ? 0u : key[i];
            __builtin_amdgcn_sched_barrier(0);
        }
        __builtin_amdgcn_sched_barrier(0);
    }
    float v1[16], v2[16]; unsigned e1[16], e2[16];
#pragma unroll
    for (int r = 0; r < 16; ++r) { v1[r] = ord2f(top[0][r] & ~0x7Fu); v2[r] = ord2f(top[1][r] & ~0x7Fu); e1[r] = (127u - (top[0][r] & 0x7Fu)) * 128u; e2[r] = 127u - (top[1][r] & 0x7Fu); }
    unsigned ck[13], ce[13];
#pragma unroll
    for (int i = 0; i < 13; ++i) { ck[i] = 0u; ce[i] = 0u; }
    {
        int n = 0;
#pragma unroll
        for (int a = 0; a < 16; ++a)
#pragma unroll
            for (int bb = 0; bb < 16; ++bb)
                if ((a + 1) * (bb + 1) <= 16) {
                    const unsigned pk = (f2ord(v1[a] + v2[bb]) & ~0xFFu) | (unsigned)(255 - (a * 16 + bb));
                    const unsigned ee = e1[a] + e2[bb];
                    const bool me = (qq == (n & 3));
                    ck[n >> 2] = me ? pk : ck[n >> 2]; ce[n >> 2] = me ? ee : ce[n >> 2];
                    ++n;
                }
    }
    float sc[16];
#pragma unroll
    for (int r = 0; r < 16; ++r) {
        unsigned Lm = ck[0];
#pragma unroll
        for (int i = 1; i < 13; ++i) Lm = umax(Lm, ck[i]);
        unsigned M = umax(Lm, (unsigned)__shfl_xor((int)Lm, 16)); M = umax(M, (unsigned)__shfl_xor((int)M, 32));
        unsigned we = 0u;
#pragma unroll
        for (int i = 0; i < 13; ++i) { const bool hit = (ck[i] == M); we = hit ? ce[i] : we; ck[i] = hit ? 0u : ck[i]; }
        sc[r] = ord2f(M & ~0xFFu);
        if (Lm == M) EIDX[(size_t)t * EPT + h * TOPK + r] = (int)we;
        __builtin_amdgcn_sched_barrier(0);
    }
    const float smax = sc[0];
    float den = 0.f;
#pragma unroll
    for (int r = 0; r < 16; ++r) { sc[r] = fexp2((sc[r] - smax) * LOG2E); den += sc[r]; }
    const float rden = 1.0f / den;
    if (qq == 0) {
        float* gp = GATE + (size_t)t * EPT + h * TOPK;
#pragma unroll
        for (int r = 0; r < 16; r += 4) *(f32x4*)(gp + r) = (f32x4){sc[r] * rden, sc[r + 1] * rden, sc[r + 2] * rden, sc[r + 3] * rden};
    }
}

__device__ __forceinline__ float reduce16(const float (&p)[16], int lane) {
    const bool b5 = lane & 32, b4 = lane & 16, b3 = lane & 8, b2 = lane & 4;
    float r8[8], r4[4], r2[2];
#pragma unroll
    for (int k = 0; k < 8; ++k) { const float keep = b5 ? p[k + 8] : p[k], send = b5 ? p[k] : p[k + 8]; r8[k] = keep + __shfl_xor(send, 32); }
#pragma unroll
    for (int k = 0; k < 4; ++k) { const float keep = b4 ? r8[k + 4] : r8[k], send = b4 ? r8[k] : r8[k + 4]; r4[k] = keep + __shfl_xor(send, 16); }
#pragma unroll
    for (int k = 0; k < 2; ++k) { const float keep = b3 ? r4[k + 2] : r4[k], send = b3 ? r4[k] : r4[k + 2]; r2[k] = keep + __shfl_xor(send, 8); }
    const float keep = b2 ? r2[1] : r2[0], send = b2 ? r2[0] : r2[1];
    float r1 = keep + __shfl_xor(send, 4);
    r1 += __shfl_xor(r1, 2); r1 += __shfl_xor(r1, 1);
    return r1;
}
#define G_LANE_OF(e) ((((e) >> 3) & 1) * 32 + (((e) >> 2) & 1) * 16 + (((e) >> 1) & 1) * 8 + ((e) & 1) * 4)
#define G_ISSUE1(slot, TAB, idv, ln) do { const int _id = __builtin_amdgcn_readlane((idv), (ln)); const unsigned char* _rp = (TAB) + (size_t)_id * D_MODEL + 16 * lane; \
        buf[slot][0] = *(const v4u*)_rp; buf[slot][1] = *(const v4u*)(_rp + 1024); } while (0)
#define G_DOT1(slot, pi) do { float _a = 0.f, _b = 0.f; \
        _Pragma("unroll") for (int _i = 0; _i < 2; ++_i) _Pragma("unroll") for (int _j = 0; _j < 4; ++_j) { const unsigned _w = buf[slot][_i][_j]; \
            _a = __builtin_amdgcn_fdot2_f32_bf16(__builtin_amdgcn_cvt_scalef32_pk_bf16_fp8(_w, 1.0f, false), __builtin_bit_cast(bf16x2, xb[_i][2 * _j]), _a, false); \
            _b = __builtin_amdgcn_fdot2_f32_bf16(__builtin_amdgcn_cvt_scalef32_pk_bf16_fp8(_w, 1.0f, true), __builtin_bit_cast(bf16x2, xb[_i][2 * _j + 1]), _b, false); } \
        part[pi] = _a + _b; } while (0)
#define G_FMA1(slot, e) do { const float _a = __int_as_float(__builtin_amdgcn_readlane(__float_as_int(aval), G_LANE_OF(e))); \
        _Pragma("unroll") for (int _i = 0; _i < 2; ++_i) _Pragma("unroll") for (int _j = 0; _j < 4; ++_j) { const unsigned _w = buf[slot][_i][_j]; \
            const f32x2 _lo = __builtin_amdgcn_cvt_pk_f32_fp8(_w, false), _hi = __builtin_amdgcn_cvt_pk_f32_fp8(_w, true); \
            acc[_i][_j] += (f32x4){_lo.x, _lo.y, _hi.x, _hi.y} * _a; } } while (0)
__device__ __forceinline__ void gather_token(int t, const float* __restrict__ X1, const bf16_t* __restrict__ X1B, const int* __restrict__ EIDX, const float* __restrict__ GATE,
                                             const unsigned char* __restrict__ U8, const unsigned char* __restrict__ V8, const float* __restrict__ SU, const float* __restrict__ SV,
                                             const float* __restrict__ g2, const float* __restrict__ b2, float* out, int lane) {
    unsigned xb[2][8];
#pragma unroll
    for (int i = 0; i < 2; ++i) {
        const v4u a = *(const v4u*)(X1B + (size_t)t * D_MODEL + 1024 * i + 16 * lane), b = *(const v4u*)(X1B + (size_t)t * D_MODEL + 1024 * i + 16 * lane + 8);
        xb[i][0] = a.x; xb[i][1] = a.y; xb[i][2] = a.z; xb[i][3] = a.w; xb[i][4] = b.x; xb[i][5] = b.y; xb[i][6] = b.z; xb[i][7] = b.w;
    }
    const int id_lo = EIDX[(size_t)t * EPT + lane], id_hi = EIDX[(size_t)t * EPT + 64 + lane];
    const float g_lo = GATE[(size_t)t * EPT + lane], g_hi = GATE[(size_t)t * EPT + 64 + lane];
    const float su_lo = SU[id_lo], su_hi = SU[id_hi], sv_lo = SV[id_lo], sv_hi = SV[id_hi];
    f32x4 acc[2][4];
#pragma unroll
    for (int i = 0; i < 2; ++i)
#pragma unroll
        for (int j = 0; j < 4; ++j) acc[i][j] = (f32x4){0.f, 0.f, 0.f, 0.f};
    const int e_me = ((lane >> 5) & 1) * 8 + ((lane >> 4) & 1) * 4 + ((lane >> 3) & 1) * 2 + ((lane >> 2) & 1);
    v4u buf[8][2];
#pragma unroll
    for (int e = 0; e < 8; ++e) G_ISSUE1(e, U8, id_lo, e);
#pragma unroll 1
    for (int hh = 0; hh < 8; ++hh) {
        const int idv = hh < 4 ? id_lo : id_hi; const float gv = hh < 4 ? g_lo : g_hi, suv = hh < 4 ? su_lo : su_hi, svv = hh < 4 ? sv_lo : sv_hi;
        const int lb = (hh & 3) * 16;
        const int hn = hh < 7 ? hh + 1 : 7; const int idn = hn < 4 ? id_lo : id_hi; const int lbn = (hn & 3) * 16;
        float part[16];
#pragma unroll
        for (int e = 0; e < 16; ++e) {
            G_DOT1(e & 7, e);
            if (e < 8) G_ISSUE1(e & 7, U8, idv, lb + e + 8); else G_ISSUE1(e & 7, V8, idv, lb + e - 8);
        }
        const float hval = reduce16(part, lane) * __shfl(suv, lb + e_me);
        const float aval = __shfl(gv, lb + e_me) * gelu_erf(hval) * __shfl(svv, lb + e_me);
#pragma unroll
        for (int e = 0; e < 16; ++e) {
            G_FMA1(e & 7, e);
            if (e < 8) G_ISSUE1(e & 7, V8, idv, lb + e + 8); else G_ISSUE1(e & 7, U8, idn, lbn + e - 8);
        }
    }
    float s = 0.f;
#pragma unroll
    for (int i = 0; i < 2; ++i)
#pragma unroll
        for (int j = 0; j < 4; ++j) {
            const f32x4 x0 = *(const f32x4*)(X1 + (size_t)t * D_MODEL + 1024 * i + 16 * lane + 4 * j);
            acc[i][j] = x0 * ALPHA + acc[i][j];
            s += (acc[i][j].x + acc[i][j].y) + (acc[i][j].z + acc[i][j].w);
        }
    const float mean = wave_sum(s) * (1.f / D_MODEL); float q = 0.f;
#pragma unroll
    for (int i = 0; i < 2; ++i)
#pragma unroll
        for (int j = 0; j < 4; ++j) { acc[i][j] = acc[i][j] - mean; q += (acc[i][j].x * acc[i][j].x + acc[i][j].y * acc[i][j].y) + (acc[i][j].z * acc[i][j].z + acc[i][j].w * acc[i][j].w); }
    const float rstd = 1.0f / sqrtf(wave_sum(q) * (1.f / D_MODEL) + LN_EPS);
#pragma unroll
    for (int i = 0; i < 2; ++i)
#pragma unroll
        for (int j = 0; j < 4; ++j) {
            const int c = 1024 * i + 16 * lane + 4 * j;
            const f32x4 gg = *(const f32x4*)(g2 + c), bb = *(const f32x4*)(b2 + c);
            *(f32x4*)(out + (size_t)t * D_MODEL + c) = acc[i][j] * rstd * gg + bb;
        }
}
__device__ __forceinline__ void cvt_row_fp8(const float* __restrict__ in, unsigned char* out8, float* sc, int row, int lane) {
    const float* r = in + (size_t)row * D_MODEL + 16 * lane;
    f32x4 v[2][4]; float am = 0.f;
#pragma unroll
    for (int i = 0; i < 2; ++i)
#pragma unroll
        for (int j = 0; j < 4; ++j) { v[i][j] = __builtin_nontemporal_load((const f32x4*)(r + 1024 * i + 4 * j)); am = fmaxf(am, fmaxf(fmaxf(fabsf(v[i][j].x), fabsf(v[i][j].y)), fmaxf(fabsf(v[i][j].z), fabsf(v[i][j].w)))); }
#pragma unroll
    for (int o = 1; o < 64; o <<= 1) am = fmaxf(am, __shfl_xor(am, o));
    const float inv = am > 0.f ? 256.0f / am : 1.0f, scale = am > 0.f ? am * (1.0f / 256.0f) : 1.0f;
#pragma unroll
    for (int i = 0; i < 2; ++i) {
        v4u o;
#pragma unroll
        for (int j = 0; j < 4; ++j) { int w = 0; w = __builtin_amdgcn_cvt_pk_fp8_f32(v[i][j].x * inv, v[i][j].y * inv, w, false); w = __builtin_amdgcn_cvt_pk_fp8_f32(v[i][j].z * inv, v[i][j].w * inv, w, true); o[j] = (unsigned)w; }
        *(v4u*)(out8 + (size_t)row * D_MODEL + 1024 * i + 16 * lane) = o;
    }
    if (lane == 0) sc[row] = scale;
}

struct Args { const void* in[18]; float* out; unsigned char* ws; int ph_lo, ph_hi, li, pad; };
constexpr int N_PHASES = 8;

#define P_IN(T, i) ((const T*)args.in[i])
#define P_WS(T, off) ((T*)(ws + (off)))
#define x_in P_IN(float, 0)
#define mem_in P_IN(float, 1)
#define positions P_IN(int, 2)
#define w_in P_IN(float, 3)
#define w_mem_kv P_IN(float, 4)
#define w_pool P_IN(float, 5)
#define pool_scale P_IN(float, 6)
#define sinks P_IN(float, 7)
#define w_out P_IN(float, 8)
#define ln1_g P_IN(float, 9)
#define ln1_b P_IN(float, 10)
#define w_peer_q P_IN(float, 11)
#define sk1 P_IN(float, 12)
#define sk2 P_IN(float, 13)
#define eu P_IN(float, 14)
#define ev P_IN(float, 15)
#define ln2_g P_IN(float, 16)
#define ln2_b P_IN(float, 17)
#define WINT P_WS(bf16_t, WS_WINT)
#define WKVT P_WS(bf16_t, WS_WKVT)
#define WOT P_WS(bf16_t, WS_WOT)
#define WQT P_WS(bf16_t, WS_WQT)
#define WPT P_WS(bf16_t, WS_SMALL)
#define K1B P_WS(bf16_t, WS_SMALL + 131072)
#define K2B P_WS(bf16_t, WS_SMALL + 163840)
#define ROPE P_WS(float, WS_SMALL + 262144)
#define XB P_WS(bf16_t, WS_XB)
#define X1B P_WS(bf16_t, WS_X1B)
#define MEMB P_WS(bf16_t, WS_MEMB)
#define KVM P_WS(bf16_t, WS_KVM)
#define POOLV P_WS(float, WS_POOLV)
#define Q P_WS(bf16_t, WS_Q)
#define Kb P_WS(bf16_t, WS_K)
#define Vb P_WS(bf16_t, WS_V)
#define QM P_WS(bf16_t, WS_QM)
#define CONCAT P_WS(bf16_t, WS_CONCAT)
#define Y1 P_WS(float, WS_Y1)
#define X1 P_WS(float, WS_X1)
#define QP P_WS(bf16_t, WS_QP)
#define EIDX P_WS(int, WS_EIDX)
#define GATE P_WS(float, WS_GATE)
#define U8 P_WS(unsigned char, WS_UB)
#define V8 P_WS(unsigned char, WS_VB)
#define SU P_WS(float, WS_UB + 48 * MiB)
#define SV P_WS(float, WS_VB + 48 * MiB)
__global__ void __launch_bounds__(NTHREADS, 2) mega_fwd(Args args) {
    extern __shared__ __attribute__((aligned(16))) unsigned char lds_raw[];
    LAS unsigned char* lds = (LAS unsigned char*)lds_raw;
    volatile LAS unsigned* MISC = (volatile LAS unsigned*)(lds + MISC_OFF);
    const int tid = threadIdx.x, lane = tid & 63, wave = __builtin_amdgcn_readfirstlane(tid >> 6);
    const int G = gridDim.x, bx = blockIdx.x;
    const int vcu = (G % 8 == 0) ? (bx % 8) * (G / 8) + bx / 8 : bx;
    const int gw = vcu * NWAVES + wave, NGW = G * NWAVES;
    unsigned char* ws = args.ws;
    for (int u = tid; u < (LDS_BYTES - MISC_OFF) / 4; u += NTHREADS) MISC[u] = 0u;
    __syncthreads();
    XcdBarrier bar = xcd_barrier_post((unsigned*)(ws + WS_CTL) + CW_BAR + args.li * XCD_BAR_WORDS, MISC + 8);
    const int lo = args.ph_lo, hi = args.ph_hi;
#ifndef ONLY_PHASES
#define ONLY_PHASES 255
#endif
#define IN(k) (((ONLY_PHASES >> (k)) & 1) && lo <= (k) && (k) < hi)
#ifndef REPEAT_MASK
#define REPEAT_MASK 0
#endif
#define REP(k) for (int _rep = 0; _rep < 1 + ((REPEAT_MASK >> (k)) & 1); ++_rep)
#define SEAM(k) do { if (IN(k) && IN((k) + 1)) xcd_barrier(bar); } while (0)

    if (IN(0)) REP(0) {
        LAS float* scr = (LAS float*)(lds + wave * 16384);
        constexpr int I_IN = (D_MODEL / 64) * (IN_W / 32), I_KV = (D_MODEL / 64) * (2 * MEM_W / 32), I_O = (D_MODEL / 64) * (D_MODEL / 32), I_Q = I_O, I_P = 4 * 2 * 4;
        constexpr int NITEMS = I_IN + I_KV + I_O + I_Q + I_P;
        for (int it = gw; it < NITEMS; it += NGW) {
            int r = it;
            if (r < I_IN) { p0_transpose_item(w_in, D_MODEL, IN_W, WINT, scr, r, lane); continue; } r -= I_IN;
            if (r < I_KV) { p0_transpose_item(w_mem_kv, D_MODEL, 2 * MEM_W, WKVT, scr, r, lane); continue; } r -= I_KV;
            if (r < I_O) { p0_transpose_item(w_out, D_MODEL, D_MODEL, WOT, scr, r, lane); continue; } r -= I_O;
            if (r < I_Q) { p0_transpose_item(w_peer_q, D_MODEL, D_MODEL, WQT, scr, r, lane); continue; } r -= I_Q;
            { const int gpl = r >> 3; p0_transpose_item(w_pool + (size_t)gpl * 16384, 128, 128, WPT + (size_t)gpl * 16384, scr, r & 7, lane); }
        }
        cvt_stream<false>(x_in, XB, (size_t)MTOK * D_MODEL, gw, NGW, lane);
        cvt_stream<false>(mem_in, MEMB, (size_t)MMEM * D_MODEL, gw, NGW, lane);
        cvt_stream<false>(sk1, K1B, (size_t)NKEYS * 128, gw, NGW, lane);
        cvt_stream<false>(sk2, K2B, (size_t)NKEYS * 128, gw, NGW, lane);
        for (int r = gw; r < 2 * NEXP; r += NGW) { if (r < NEXP) cvt_row_fp8(eu, U8, SU, r, lane); else cvt_row_fp8(ev, V8, SV, r - NEXP, lane); }
        for (int i = gw * 64 + lane; i < MTOK * 8; i += NGW * 64) { float c, s; rope_cs(positions[i >> 3], i & 7, c, s); *(f32x2*)(ROPE + 2 * (size_t)i) = (f32x2){c, s}; }
    }
    SEAM(0);
    if (IN(1)) REP(1) {
        { pg8::Gemm g{XB, WINT, MTOK, IN_W, D_MODEL}; pg8::StaticOrder S; S.init(MTOK, IN_W, G, bx);
          EpiIn E{POOLV, Q, Kb, Vb, QM, ROPE};
          pg8::gemm_phase<EpiIn, pg8::StaticOrder, true, true>(lds, g, S, E); }
        { pg8::Gemm g{MEMB, WKVT, MMEM, 2 * MEM_W, D_MODEL}; pg8::StaticOrder S; S.init(MMEM, 2 * MEM_W, G, (bx + G - 64) % G);
          EpiStoreBf E{KVM, 2 * MEM_W};
          pg8::gemm_phase<EpiStoreBf, pg8::StaticOrder, true, true>(lds, g, S, E); }
    }
    SEAM(1);
    if (IN(2)) REP(2) {
        for (int it = vcu; it < 512; it += G) {
            if (it < 256) swa_item(lds, it, Q, Kb, Vb, sinks, CONCAT, tid, wave, lane);
            else mem_item(lds, it - 256, QM, KVM, CONCAT, tid, wave, lane);
        }
        for (int it = gw; it < (MTOK / 16) * 4; it += NGW) pool_item(it, POOLV, WPT, pool_scale, CONCAT, lane);
    }
    SEAM(2);
    if (IN(3)) REP(3) {
        pg8::Gemm g{CONCAT, WOT, MTOK, D_MODEL, D_MODEL}; pg8::StaticOrder S; S.init(MTOK, D_MODEL, G, bx);
        EpiY1 E{x_in, Y1};
        pg8::gemm_phase<EpiY1, pg8::StaticOrder, true, true>(lds, g, S, E);
    }
    SEAM(3);
    if (IN(4)) REP(4) { for (int r = gw; r < MTOK; r += NGW) ln1_row(Y1 + (size_t)r * D_MODEL, ln1_g, ln1_b, X1 + (size_t)r * D_MODEL, X1B + (size_t)r * D_MODEL, lane); }
    SEAM(4);
    if (IN(5)) REP(5) {
        pg8::Gemm g{X1B, WQT, MTOK, D_MODEL, D_MODEL}; pg8::StaticOrder S; S.init(MTOK, D_MODEL, G, bx);
        EpiStoreBf E{QP, D_MODEL};
        pg8::gemm_phase<EpiStoreBf, pg8::StaticOrder, true, true>(lds, g, S, E);
    }
    SEAM(5);
    if (IN(6)) REP(6) { for (int it = gw; it < (MTOK / 16) * PHEADS; it += NGW) topk_item(it, QP, K1B, K2B, EIDX, GATE, lane); }
    SEAM(6);
    if (IN(7)) REP(7) { for (int t = gw; t < MTOK; t += NGW) gather_token(t, X1, X1B, EIDX, GATE, U8, V8, SU, SV, ln2_g, ln2_b, args.out, lane); }
#undef IN
#undef SEAM
}
#undef P_IN(T,
#undef P_WS(T,
#undef x_in
#undef mem_in
#undef positions
#undef w_in
#undef w_mem_kv
#undef w_pool
#undef pool_scale
#undef sinks
#undef w_out
#undef ln1_g
#undef ln1_b
#undef w_peer_q
#undef sk1
#undef sk2
#undef eu
#undef ev
#undef ln2_g
#undef ln2_b
#undef WINT
#undef WKVT
#undef WOT
#undef WQT
#undef WPT
#undef K1B
#undef K2B
#undef ROPE
#undef XB
#undef X1B
#undef MEMB
#undef KVM
#undef POOLV
#undef Q
#undef Kb
#undef Vb
#undef QM
#undef CONCAT
#undef Y1
#undef X1
#undef QP
#undef EIDX
#undef GATE
#undef U8
#undef V8
#undef SU
#undef SV

#if NAIVE_MASK != 0
__device__ __forceinline__ float toF(float v) { return v; }
__device__ __forceinline__ float toF(bf16_t v) { return bf2f(v); }

struct NvEpiF32 { float* C; int ldc, pad; __device__ void operator()(int r, int c, float v) const { C[(size_t)r * ldc + c] = v; } };
struct NvEpiBf { bf16_t* C; int ldc, pad; __device__ void operator()(int r, int c, float v) const { C[(size_t)r * ldc + c] = f2bf(v); } };
struct NvEpiY1 { const float* x; float* y; __device__ void operator()(int r, int c, float v) const { y[(size_t)r * D_MODEL + c] = ALPHA * x[(size_t)r * D_MODEL + c] + v; } };

template <class TA, class Epi>
__global__ void __launch_bounds__(256) nv_gemm(const TA* __restrict__ A, const float* __restrict__ B, int M, int N, int K, Epi epi) {
    __shared__ float As[16][65];
    __shared__ float Bs[16][64];
    const int tx = threadIdx.x & 15, ty = threadIdx.x >> 4;
    const int m0 = blockIdx.y * 64, n0 = blockIdx.x * 64;
    float acc[4][4];
#pragma unroll
    for (int i = 0; i < 4; ++i)
#pragma unroll
        for (int j = 0; j < 4; ++j) acc[i][j] = 0.f;
    for (int k0 = 0; k0 < K; k0 += 16) {
        for (int i = threadIdx.x; i < 1024; i += 256) { const int r = i >> 4, c = i & 15; As[c][r] = toF(A[(size_t)(m0 + r) * K + k0 + c]); }
        for (int i = threadIdx.x; i < 1024; i += 256) { const int r = i >> 6, c = i & 63; Bs[r][c] = B[(size_t)(k0 + r) * N + n0 + c]; }
        __syncthreads();
#pragma unroll
        for (int kk = 0; kk < 16; ++kk) {
            float a[4], b[4];
#pragma unroll
            for (int i = 0; i < 4; ++i) { a[i] = As[kk][ty * 4 + i]; b[i] = Bs[kk][tx * 4 + i]; }
#pragma unroll
            for (int i = 0; i < 4; ++i)
#pragma unroll
                for (int j = 0; j < 4; ++j) acc[i][j] += a[i] * b[j];
        }
        __syncthreads();
    }
#pragma unroll
    for (int i = 0; i < 4; ++i)
#pragma unroll
        for (int j = 0; j < 4; ++j) epi(m0 + ty * 4 + i, n0 + tx * 4 + j, acc[i][j]);
}

__global__ void nv_post1(const float* __restrict__ H, const int* __restrict__ positions, float* POOLV, bf16_t* Q, bf16_t* Kb, bf16_t* Vb, bf16_t* QM) {
    const size_t gid = (size_t)blockIdx.x * blockDim.x + threadIdx.x;
    if (gid >= (size_t)MTOK * IN_W) return;
    const int t = (int)(gid / IN_W), col = (int)(gid % IN_W);
    const float* hr = H + (size_t)t * IN_W;
    const float v = hr[col];
    if (col < POOL_W) { POOLV[(size_t)t * POOL_W + col] = v; return; }
    if (col < POOL_W + SWA_W + KV_W) {
        const bool isq = col < POOL_W + SWA_W;
        const int c = isq ? col - POOL_W : col - POOL_W - SWA_W;
        const int d = c & 63;
        float o = v;
        if (d < 16) {
            const int j = d & 7; float cs, sn; rope_cs(positions[t], j, cs, sn);
            if (d < 8) o = v * cs - hr[col + 8] * sn; else o = v * cs + hr[col - 8] * sn;
        }
        if (isq) Q[(size_t)t * SWA_W + c] = f2bf(o); else Kb[(size_t)t * KV_W + c] = f2bf(o);
        return;
    }
    if (col < POOL_W + SWA_W + 2 * KV_W) { Vb[(size_t)t * KV_W + (col - POOL_W - SWA_W - KV_W)] = f2bf(v); return; }
    QM[(size_t)t * MEM_W + (col - POOL_W - SWA_W - 2 * KV_W)] = f2bf(v);
}
__global__ void nv_cvt_bf16(const float* __restrict__ in, bf16_t* out, size_t n) {
    const size_t gid = (size_t)blockIdx.x * blockDim.x + threadIdx.x;
    if (gid < n) out[gid] = f2bf(in[gid]);
}
__global__ void nv_pool1(const float* __restrict__ POOLV, float* PS) {
    const size_t gid = (size_t)blockIdx.x * blockDim.x + threadIdx.x;
    if (gid >= (size_t)MTOK * POOL_W) return;
    const int t = (int)(gid / POOL_W), ch = (int)(gid % POOL_W);
    const int g = ch >> 7, w = 2 << g, s = t & (SEQ - 1);
    const int cnt = (s + 1) < w ? (s + 1) : w;
    float sum = 0.f;
    for (int i = 0; i < cnt; ++i) sum += POOLV[(size_t)(t - i) * POOL_W + ch];
    PS[gid] = sum / (float)cnt - POOLV[gid];
}
__global__ void nv_pool2(const float* __restrict__ PS, const float* __restrict__ w_pool, const float* __restrict__ pool_scale, bf16_t* CONCAT) {
    const size_t gid = (size_t)blockIdx.x * blockDim.x + threadIdx.x;
    if (gid >= (size_t)MTOK * POOL_W) return;
    const int t = (int)(gid / POOL_W), ch = (int)(gid % POOL_W);
    const int g = ch >> 7, d = ch & 127;
    const float* p = PS + (size_t)t * POOL_W + g * 128;
    const float* w = w_pool + (size_t)g * 128 * 128 + d;
    float y = 0.f;
    for (int c = 0; c < 128; ++c) y += p[c] * w[(size_t)c * 128];
    CONCAT[(size_t)t * D_MODEL + ch] = f2bf(y * pool_scale[ch]);
}
__global__ void __launch_bounds__(256) nv_swa(const bf16_t* __restrict__ Q, const bf16_t* __restrict__ Kb, const bf16_t* __restrict__ Vb, const float* __restrict__ sinks, bf16_t* CONCAT) {
    const int wv = (int)((blockIdx.x * 256 + threadIdx.x) >> 6), lane = threadIdx.x & 63;
    if (wv >= MTOK * NHEAD) return;
    const int t = wv / NHEAD, h = wv % NHEAD, kvh = h >> 2, s = t & (SEQ - 1), tb = t - s;
    const float q = bf2f(Q[(size_t)t * SWA_W + h * HD + lane]);
    float m = sinks[h], l = 1.0f, o = 0.f;
    const int k0 = s - (WINDOW - 1) < 0 ? 0 : s - (WINDOW - 1);
    for (int kk = k0; kk <= s; ++kk) {
        const size_t kt = (size_t)(tb + kk);
        const float sc = wave_sum(q * bf2f(Kb[kt * KV_W + kvh * HD + lane])) * 0.125f;
        const float mn = fmaxf(m, sc), r = expf(m - mn), p = expf(sc - mn);
        l = l * r + p; o = o * r + p * bf2f(Vb[kt * KV_W + kvh * HD + lane]); m = mn;
    }
    CONCAT[(size_t)t * D_MODEL + POOL_W + h * HD + lane] = f2bf(o / l);
}
__global__ void __launch_bounds__(256) nv_mem(const bf16_t* __restrict__ QM, const bf16_t* __restrict__ KVM, bf16_t* CONCAT) {
    const int wv = (int)((blockIdx.x * 256 + threadIdx.x) >> 6), lane = threadIdx.x & 63;
    if (wv >= MTOK * MHEADS) return;
    const int t = wv / MHEADS, hm = wv % MHEADS, b = t / SEQ;
    const float q0 = bf2f(QM[(size_t)t * MEM_W + hm * MHD + lane]), q1 = bf2f(QM[(size_t)t * MEM_W + hm * MHD + 64 + lane]);
    float m = -1e30f, l = 0.f, o0 = 0.f, o1 = 0.f;
    const float scale = 0.08838834764831845f;
    for (int j = 0; j < MEM_LEN; ++j) {
        const bf16_t* kr = KVM + (size_t)(b * MEM_LEN + j) * (2 * MEM_W) + hm * MHD;
        const bf16_t* vr = kr + MEM_W;
        const float sc = wave_sum(q0 * bf2f(kr[lane]) + q1 * bf2f(kr[64 + lane])) * scale;
        const float mn = fmaxf(m, sc), r = expf(m - mn), p = expf(sc - mn);
        l = l * r + p; o0 = o0 * r + p * bf2f(vr[lane]); o1 = o1 * r + p * bf2f(vr[64 + lane]); m = mn;
    }
    bf16_t* orow = CONCAT + (size_t)t * D_MODEL + POOL_W + SWA_W + hm * MHD;
    orow[lane] = f2bf(o0 / l); orow[64 + lane] = f2bf(o1 / l);
}
__global__ void __launch_bounds__(256) nv_ln(const float* __restrict__ in, const float* __restrict__ g, const float* __restrict__ bta, float* outf, bf16_t* outb) {
    const int row = (int)((blockIdx.x * 256 + threadIdx.x) >> 6), lane = threadIdx.x & 63;
    if (row >= MTOK) return;
    const float* r = in + (size_t)row * D_MODEL;
    float v[32]; float s = 0.f;
#pragma unroll
    for (int i = 0; i < 32; ++i) { v[i] = r[lane + 64 * i]; s += v[i]; }
    const float mean = wave_sum(s) * (1.f / D_MODEL); float q = 0.f;
#pragma unroll
    for (int i = 0; i < 32; ++i) { v[i] -= mean; q += v[i] * v[i]; }
    const float rstd = 1.0f / sqrtf(wave_sum(q) * (1.f / D_MODEL) + LN_EPS);
#pragma unroll
    for (int i = 0; i < 32; ++i) {
        const int c = lane + 64 * i; const float y = v[i] * rstd * g[c] + bta[c];
        if (outf) outf[(size_t)row * D_MODEL + c] = y;
        if (outb) outb[(size_t)row * D_MODEL + c] = f2bf(y);
    }
}
__global__ void __launch_bounds__(32) nv_topk(const bf16_t* __restrict__ QP, const float* __restrict__ K1, const float* __restrict__ K2, int* EIDX, float* GATE) {
    __shared__ float sc[256][32];
    __shared__ float lv[32][32];
    __shared__ int li[32][32];
    const int tid = threadIdx.x, gid = blockIdx.x * 32 + tid;
    const int t = gid / PHEADS, h = gid % PHEADS;
    const bf16_t* q = QP + (size_t)t * D_MODEL + h * 256;
    for (int half = 0; half < 2; ++half) {
        const float* Kk = half ? K2 : K1;
        for (int k = 0; k < NKEYS; ++k) {
            float a = 0.f;
            for (int c = 0; c < 128; ++c) a += bf2f(q[half * 128 + c]) * Kk[k * 128 + c];
            sc[half * 128 + k][tid] = a;
        }
        for (int r = 0; r < TOPK; ++r) {
            float best = -INFINITY; int bi = 0;
            for (int k = 0; k < NKEYS; ++k) { const float v = sc[half * 128 + k][tid]; if (v > best) { best = v; bi = k; } }
            lv[half * 16 + r][tid] = best; li[half * 16 + r][tid] = bi; sc[half * 128 + bi][tid] = -INFINITY;
        }
    }
    for (int a = 0; a < 16; ++a) for (int b = 0; b < 16; ++b) sc[a * 16 + b][tid] = lv[a][tid] + lv[16 + b][tid];
    float mx = 0.f, den = 0.f;
    float tv[16]; int ti[16];
#pragma unroll
    for (int r = 0; r < TOPK; ++r) {
        float best = -INFINITY; int bi = 0;
        for (int k = 0; k < 256; ++k) { const float v = sc[k][tid]; if (v > best) { best = v; bi = k; } }
        sc[bi][tid] = -INFINITY;
        if (r == 0) mx = best;
        tv[r] = expf(best - mx); den += tv[r]; ti[r] = li[bi >> 4][tid] * NKEYS + li[16 + (bi & 15)][tid];
    }
#pragma unroll
    for (int r = 0; r < TOPK; ++r) { EIDX[(size_t)t * EPT + h * TOPK + r] = ti[r]; GATE[(size_t)t * EPT + h * TOPK + r] = tv[r] / den; }
}
__global__ void __launch_bounds__(256) nv_gather(const float* __restrict__ X1, const int* __restrict__ EIDX, const float* __restrict__ GATE, const float* __restrict__ EU, const float* __restrict__ EV,
                                                  const float* __restrict__ g, const float* __restrict__ bta, float* out) {
    const int t = (int)((blockIdx.x * 256 + threadIdx.x) >> 6), lane = threadIdx.x & 63;
    if (t >= MTOK) return;
    float x[32], acc[32];
#pragma unroll
    for (int i = 0; i < 32; ++i) { x[i] = X1[(size_t)t * D_MODEL + lane + 64 * i]; acc[i] = 0.f; }
    for (int e = 0; e < EPT; ++e) {
        const int id = EIDX[(size_t)t * EPT + e]; const float gt = GATE[(size_t)t * EPT + e];
        const float* u = EU + (size_t)id * D_MODEL; const float* vv = EV + (size_t)id * D_MODEL;
        float p = 0.f;
#pragma unroll
        for (int i = 0; i < 32; ++i) p += x[i] * u[lane + 64 * i];
        const float a = gt * gelu_erf(wave_sum(p));
#pragma unroll
        for (int i = 0; i < 32; ++i) acc[i] += a * vv[lane + 64 * i];
    }
    float s = 0.f;
#pragma unroll
    for (int i = 0; i < 32; ++i) { acc[i] = ALPHA * x[i] + acc[i]; s += acc[i]; }
    const float mean = wave_sum(s) * (1.f / D_MODEL); float q = 0.f;
#pragma unroll
    for (int i = 0; i < 32; ++i) { acc[i] -= mean; q += acc[i] * acc[i]; }
    const float rstd = 1.0f / sqrtf(wave_sum(q) * (1.f / D_MODEL) + LN_EPS);
#pragma unroll
    for (int i = 0; i < 32; ++i) { const int c = lane + 64 * i; out[(size_t)t * D_MODEL + c] = acc[i] * rstd * g[c] + bta[c]; }
}

#endif
extern "C" void kernel_launch(void* const* d_in, const int* in_sizes, int n_in, void* d_out, int out_size, void* d_ws, size_t ws_size, hipStream_t stream) {
    static int grid = 0;
    if (grid == 0) {
        if (n_in != 18 || in_sizes[0] != MTOK * D_MODEL || out_size != MTOK * D_MODEL || ws_size < WS_END) {
            fprintf(stderr, "kernel_launch: unexpected shapes (n_in %d, in0 %d, out %d, ws %zu)\n", n_in, n_in > 0 ? in_sizes[0] : -1, out_size, ws_size); grid = -1; return; }
        int dev = 0, cus = 0, per_cu = 0;
        if (hipGetDevice(&dev) != hipSuccess || hipDeviceGetAttribute(&cus, hipDeviceAttributeMultiprocessorCount, dev) != hipSuccess) { fprintf(stderr, "kernel_launch: device query failed\n"); grid = -1; return; }
        if (hipFuncSetAttribute((const void*)mega_fwd, hipFuncAttributeMaxDynamicSharedMemorySize, LDS_BYTES) != hipSuccess) { fprintf(stderr, "kernel_launch: hipFuncSetAttribute failed\n"); grid = -1; return; }
        if (hipOccupancyMaxActiveBlocksPerMultiprocessor(&per_cu, (const void*)mega_fwd, NTHREADS, LDS_BYTES) != hipSuccess || per_cu < 1) {
            fprintf(stderr, "kernel_launch: occupancy query reports %d workgroups per CU\n", per_cu); (void)hipGetLastError(); grid = -1; return; }
        grid = cus;
    }
    if (grid < 0) return;
    unsigned char* ws = (unsigned char*)d_ws;
    (void)hipMemsetAsync(ws + WS_CTL, 0, 1 * MiB, stream);
    Args a{};
    for (int i = 0; i < 18; ++i) a.in[i] = d_in[i];
    a.out = (float*)d_out; a.ws = ws;
#if NAIVE_MASK != 0
    const float* x = (const float*)d_in[0]; const float* mem = (const float*)d_in[1]; const int* positions = (const int*)d_in[2];
    const float* w_in = (const float*)d_in[3]; const float* w_mem_kv = (const float*)d_in[4]; const float* w_pool = (const float*)d_in[5];
    const float* pool_scale = (const float*)d_in[6]; const float* sinks = (const float*)d_in[7]; const float* w_out = (const float*)d_in[8];
    const float* ln1_g = (const float*)d_in[9]; const float* ln1_b = (const float*)d_in[10]; const float* w_peer_q = (const float*)d_in[11];
    const float* sk1 = (const float*)d_in[12]; const float* sk2 = (const float*)d_in[13]; const float* eu = (const float*)d_in[14]; const float* ev = (const float*)d_in[15];
    const float* ln2_g = (const float*)d_in[16]; const float* ln2_b = (const float*)d_in[17];
    float* out = (float*)d_out;
    float* POOLV = (float*)(ws + WS_POOLV); bf16_t* Q = (bf16_t*)(ws + WS_Q); bf16_t* Kb = (bf16_t*)(ws + WS_K); bf16_t* Vb = (bf16_t*)(ws + WS_V); bf16_t* QM = (bf16_t*)(ws + WS_QM);
    bf16_t* KVM = (bf16_t*)(ws + WS_KVM); bf16_t* CONCAT = (bf16_t*)(ws + WS_CONCAT); float* Y1 = (float*)(ws + WS_Y1); float* X1 = (float*)(ws + WS_X1); bf16_t* X1B = (bf16_t*)(ws + WS_X1B);
    bf16_t* QP = (bf16_t*)(ws + WS_QP); int* EIDX = (int*)(ws + WS_EIDX); float* GATE = (float*)(ws + WS_GATE);
    float* NVH = (float*)(ws + WS_NV_H); float* NVPS = (float*)(ws + WS_NV_PS); float* NVKVM = (float*)(ws + WS_NV_KVM);
#endif
    int li = 0;
    for (int p = 0; p < N_PHASES;) {
#if NAIVE_MASK != 0
        if ((NAIVE_MASK >> p) & 1) {
            switch (p) {
            case 1:
                nv_gemm<float, NvEpiF32><<<dim3(IN_W / 64, MTOK / 64), 256, 0, stream>>>(x, w_in, MTOK, IN_W, D_MODEL, NvEpiF32{NVH, IN_W, 0});
                nv_gemm<float, NvEpiF32><<<dim3(2 * MEM_W / 64, MMEM / 64), 256, 0, stream>>>(mem, w_mem_kv, MMEM, 2 * MEM_W, D_MODEL, NvEpiF32{NVKVM, 2 * MEM_W, 0});
                nv_post1<<<(unsigned)(((size_t)MTOK * IN_W + 255) / 256), 256, 0, stream>>>(NVH, positions, POOLV, Q, Kb, Vb, QM);
                nv_cvt_bf16<<<(MMEM * 2 * MEM_W + 255) / 256, 256, 0, stream>>>(NVKVM, KVM, (size_t)MMEM * 2 * MEM_W);
                break;
            case 2:
                nv_pool1<<<MTOK * POOL_W / 256, 256, 0, stream>>>(POOLV, NVPS);
                nv_pool2<<<MTOK * POOL_W / 256, 256, 0, stream>>>(NVPS, w_pool, pool_scale, CONCAT);
                nv_swa<<<MTOK * NHEAD / 4, 256, 0, stream>>>(Q, Kb, Vb, sinks, CONCAT);
                nv_mem<<<MTOK * MHEADS / 4, 256, 0, stream>>>(QM, KVM, CONCAT);
                break;
            case 3: nv_gemm<bf16_t, NvEpiY1><<<dim3(D_MODEL / 64, MTOK / 64), 256, 0, stream>>>(CONCAT, w_out, MTOK, D_MODEL, D_MODEL, NvEpiY1{x, Y1}); break;
            case 4: nv_ln<<<MTOK / 4, 256, 0, stream>>>(Y1, ln1_g, ln1_b, X1, X1B); break;
            case 5: nv_gemm<float, NvEpiBf><<<dim3(D_MODEL / 64, MTOK / 64), 256, 0, stream>>>(X1, w_peer_q, MTOK, D_MODEL, D_MODEL, NvEpiBf{QP, D_MODEL, 0}); break;
            case 6: nv_topk<<<MTOK * PHEADS / 32, 32, 0, stream>>>(QP, sk1, sk2, EIDX, GATE); break;
            case 7: nv_gather<<<MTOK / 4, 256, 0, stream>>>(X1, EIDX, GATE, eu, ev, ln2_g, ln2_b, out); break;
            default: break;
            }
            ++p; continue;
        }
#endif
        int q = p;
        while (q < N_PHASES && !((NAIVE_MASK >> q) & 1)) ++q;
        a.ph_lo = p; a.ph_hi = q; a.li = li++;
        hipLaunchKernelGGL(mega_fwd, dim3(grid), dim3(NTHREADS), LDS_BYTES, stream, a);
        const hipError_t le = hipPeekAtLastError();
        if (le != hipSuccess) { fprintf(stderr, "kernel_launch: launch failed: %s\n", hipGetErrorName(le)); break; }
        p = q;
    }
#ifdef PROBE_EXTRA_LO
    a.ph_lo = PROBE_EXTRA_LO; a.ph_hi = PROBE_EXTRA_HI; a.li = li++;
    hipLaunchKernelGGL(mega_fwd, dim3(grid), dim3(NTHREADS), LDS_BYTES, stream, a);
#endif
}
```

```cpp
#include <hip/hip_runtime.h>
#include <cstdint>
#include <cstdio>
#ifndef NAIVE_MASK
#define NAIVE_MASK 0
#endif

constexpr int D_MODEL = 2048, BATCH = 2, SEQ = 4096, MTOK = BATCH * SEQ, MEM_LEN = 256, MMEM = BATCH * MEM_LEN;
constexpr int POOL_W = 512, SWA_W = 1024, KV_W = 256, MEM_W = 512, IN_W = 2560;
constexpr int NHEAD = 16, NKV = 4, HD = 64, WINDOW = 128, MHEADS = 4, MHD = 128;
constexpr int PHEADS = 8, NKEYS = 128, TOPK = 16, NEXP = NKEYS * NKEYS, EPT = PHEADS * TOPK;
constexpr float ALPHA = 1.18920711500272106672f;
constexpr float LN_EPS = 1e-5f;

typedef unsigned short bf16_t;
__device__ __forceinline__ float bf2f(bf16_t v) { return __uint_as_float((unsigned)v << 16); }
__device__ __forceinline__ bf16_t f2bf(float f) { unsigned u = __float_as_uint(f); return (bf16_t)((u + 0x7fffu + ((u >> 16) & 1u)) >> 16); }

constexpr size_t MiB = 1u << 20;
constexpr size_t WS_CTL = 0, WS_WINT = 1 * MiB, WS_WKVT = 11 * MiB, WS_WOT = 15 * MiB, WS_WQT = 23 * MiB, WS_SMALL = 31 * MiB;
constexpr size_t WS_XB = 32 * MiB, WS_X1B = 32 * MiB  , WS_MEMB = 64 * MiB, WS_KVM = 66 * MiB;
constexpr size_t WS_POOLV = 68 * MiB, WS_Q = 84 * MiB, WS_K = 100 * MiB, WS_V = 104 * MiB, WS_QM = 108 * MiB, WS_CONCAT = 116 * MiB;
constexpr size_t WS_Y1 = 148 * MiB, WS_X1 = 212 * MiB, WS_QP = 276 * MiB, WS_EIDX = 308 * MiB, WS_GATE = 312 * MiB, WS_UB = 316 * MiB, WS_VB = 380 * MiB, WS_END = 444 * MiB;
constexpr size_t WS_NV_H = 148 * MiB  , WS_NV_PS = 232 * MiB, WS_NV_KVM = 248 * MiB;

__device__ __forceinline__ void rope_cs(int pos, int j, float& c, float& s) {
    const double invf[8] = {1.0, 0.19392274474868576, 0.03760603093086393, 0.007292664737217109, 0.001414213562373095, 0.0002742481756762073, 5.318295896944988e-05, 1.031338537721246e-05};
    double f = j == 0 ? invf[0] : j == 1 ? invf[1] : j == 2 ? invf[2] : j == 3 ? invf[3] : j == 4 ? invf[4] : j == 5 ? invf[5] : j == 6 ? invf[6] : invf[7];
    double rev = (double)pos * f * 0.15915494309189533577;
    rev -= floor(rev);
    float fr = (float)rev;
    s = __builtin_amdgcn_sinf(fr); c = __builtin_amdgcn_cosf(fr);
}
__device__ __forceinline__ float gelu_erf(float h) { return 0.5f * h * (1.0f + erff(h * 0.70710678118654752440f)); }
__device__ __forceinline__ float wave_sum(float v) {
#pragma unroll
    for (int o = 1; o < 64; o <<= 1) v += __shfl_xor(v, o);
    return v;
}

namespace pg8 {
#define PG8_LAS __attribute__((address_space(3)))
typedef unsigned short bf16_t;
typedef short bf16x8 __attribute__((ext_vector_type(8)));
typedef float f32x4 __attribute__((ext_vector_type(4)));
typedef unsigned u32x4 __attribute__((ext_vector_type(4)));
constexpr int BM = 256, BK = 64, HALF = 128, HTB = HALF * BK * 2  , STAGE_BYTES = 8 * HTB, NXCD = 8, WGM = 8;

__host__ __device__ __forceinline__ int lds_byte(int r, int c) { const int st = (r >> 4) * 2 + (c >> 5), rr = r & 15, cc = c & 31, ob = rr * 64 + cc * 2; return st * 1024 + (ob ^ (((ob >> 9) & 1) << 5)); }
__host__ __device__ __forceinline__ void stage_rc(int b, int& R, int& C) { const int st = b / 1024, sb = b % 1024, swz = sb ^ (((sb >> 9) & 1) << 5); R = (st >> 1) * 16 + swz / 64; C = (st & 1) * 32 + (swz % 64) / 2; }
__host__ __device__ __forceinline__ int perm32(int rho) { const int n = rho >> 4, i = rho & 15; return 8 * (i >> 2) + 4 * n + (i & 3); }

struct Unit { int pm, pn; };
struct Gemm { const bf16_t* A; const bf16_t* Bt; int M, N, K; };

struct StaticOrder {
    int nM, nN, nwg, G, c;
    __host__ __device__ void init(int M, int N, int G_, int c_) { nM = M / BM; nN = N / BM; nwg = nM * nN; G = G_; c = c_; }
    __host__ __device__ bool next(int i, Unit& u) const {
        const long L = (long)i * G + c; if (L >= nwg) return false;
        int wgid = (int)L; { const int q = nwg / NXCD, r = nwg % NXCD, xcd = wgid % NXCD, off = wgid / NXCD; wgid = (xcd < r ? xcd * (q + 1) : r * (q + 1) + (xcd - r) * q) + off; }
        const int nig = WGM * nN, gid = wgid / nig, fm = gid * WGM, gsz = (nM - fm) < WGM ? (nM - fm) : WGM;
        u.pm = fm + ((wgid % nig) % gsz); u.pn = (wgid % nig) / gsz; return true;
    }
    __device__ __forceinline__ void a_ready(const Unit&) const {}
    __device__ __forceinline__ void done(const Unit&) const {}
};

__device__ __forceinline__ unsigned cvt_pk_bf16(float lo, float hi) { unsigned r; asm volatile("v_cvt_pk_bf16_f32 %0, %1, %2" : "=v"(r) : "v"(lo), "v"(hi)); return r; }
template <class Epi, class Sched, bool ALIGN_EPI = false, bool SP2 = false>
__device__ __forceinline__ void gemm_phase(PG8_LAS unsigned char* lds, const Gemm g, const Sched& S, const Epi& E) {
    const int tid = threadIdx.x, wid = __builtin_amdgcn_readfirstlane(tid >> 6), lane = tid & 63, wr = wid >> 2, wc = wid & 3, fr = lane & 15, fq = lane >> 4;
    const int K = g.K, nt = K / BK;
    unsigned voffA[2], voffB[2];
#pragma unroll
    for (int i = 0; i < 2; ++i) { int R, C; stage_rc(tid * 16 + i * 8192, R, C); const int Rb = Epi::PERM ? ((R & ~31) + perm32(R & 31)) : R;
        voffA[i] = (unsigned)(R * K + C) * 2u; voffB[i] = (unsigned)(Rb * K + C) * 2u; }
    const size_t kstep = (size_t)(BK * 2);
    const size_t hstep = (size_t)HALF * K * 2;
    const size_t tstep = 2 * hstep;
    const unsigned ldsw = (unsigned)wid * 1024u;
    const int aoff = lds_byte(wr * 64 + fr, fq * 8), boff = lds_byte(wc * 32 + fr, fq * 8);
#define PG8_SA(b, h) (((b) * 2 + (h)) * HTB)
#define PG8_SB(b, h) ((4 + (b) * 2 + (h)) * HTB)
#define PG8_STAGE(bufoff, gbase, voff) do { _Pragma("unroll") for (int _i = 0; _i < 2; ++_i) \
        __builtin_amdgcn_global_load_lds((const unsigned*)((const char*)(gbase) + (voff)[_i]), (PG8_LAS unsigned*)(lds + (bufoff) + ldsw + _i * 8192), 16, 0, 0); } while (0)
#define PG8_LDA(dst, b, h) do { _Pragma("unroll") for (int m = 0; m < 4; ++m) _Pragma("unroll") for (int k = 0; k < 2; ++k) dst[m][k] = *(const PG8_LAS bf16x8*)(lds + PG8_SA(b, h) + aoff + m * 2048 + k * 1024); } while (0)
#define PG8_LDB(dst, b, h) do { _Pragma("unroll") for (int n = 0; n < 2; ++n) _Pragma("unroll") for (int k = 0; k < 2; ++k) dst[n][k] = *(const PG8_LAS bf16x8*)(lds + PG8_SB(b, h) + boff + n * 2048 + k * 1024); } while (0)
#define PG8_MMA(ai, bj, At, Bt) do { __builtin_amdgcn_s_setprio(1); _Pragma("unroll") for (int m = 0; m < 4; ++m) _Pragma("unroll") for (int n = 0; n < 2; ++n) _Pragma("unroll") for (int k = 0; k < 2; ++k) \
        acc[ai][bj][m][n] = __builtin_amdgcn_mfma_f32_16x16x32_bf16(Bt[n][k], At[m][k], acc[ai][bj][m][n], 0, 0, 0); __builtin_amdgcn_s_setprio(0); } while (0)
#define PG8_WAIT_V(n) asm volatile("s_waitcnt vmcnt(" #n ")" ::: "memory")
#define PG8_WAIT_L(n) asm volatile("s_waitcnt lgkmcnt(" #n ")" ::: "memory")
#define PG8_BAR __builtin_amdgcn_s_barrier()
#define PG8_SCHED __builtin_amdgcn_sched_barrier(0)
    Unit cur, nxt; int ui = 0;
    if (!S.next(0, cur)) return;
    f32x4 acc[2][2][4][2];
#pragma unroll
    for (int a = 0; a < 2; ++a)
#pragma unroll
        for (int b = 0; b < 2; ++b)
#pragma unroll
            for (int m = 0; m < 4; ++m)
#pragma unroll
                for (int n = 0; n < 2; ++n) acc[a][b][m][n] = (f32x4){0.f, 0.f, 0.f, 0.f};
    bf16x8 At[4][2], B0[2][2], B1[2][2];
    const char* cA = (const char*)g.A + (size_t)cur.pm * tstep; const char* cB = (const char*)g.Bt + (size_t)cur.pn * tstep;
    S.a_ready(cur);
    if constexpr (SP2) {
        PG8_STAGE(PG8_SB(0, 0), cB, voffB); PG8_STAGE(PG8_SB(0, 1), cB + hstep, voffB); PG8_STAGE(PG8_SA(0, 0), cA, voffA); PG8_STAGE(PG8_SA(0, 1), cA + hstep, voffA);
        if (wr == 1) PG8_BAR;
        PG8_WAIT_V(2); PG8_BAR;
        PG8_STAGE(PG8_SB(1, 0), cB + kstep, voffB); PG8_STAGE(PG8_SA(1, 0), cA + kstep, voffA); PG8_STAGE(PG8_SB(1, 1), cB + hstep + kstep, voffB);
        PG8_WAIT_V(6); PG8_BAR;
    } else {
        PG8_STAGE(PG8_SB(0, 0), cB, voffB); PG8_STAGE(PG8_SA(0, 0), cA, voffA); PG8_STAGE(PG8_SB(0, 1), cB + hstep, voffB); PG8_STAGE(PG8_SA(0, 1), cA + hstep, voffA);
        if (wr == 1) PG8_BAR;
        PG8_WAIT_V(4); PG8_BAR;
        PG8_STAGE(PG8_SB(1, 0), cB + kstep, voffB); PG8_STAGE(PG8_SA(1, 0), cA + kstep, voffA); PG8_STAGE(PG8_SB(1, 1), cB + hstep + kstep, voffB);
        PG8_WAIT_V(6); PG8_BAR;
    }
    for (;;) {
        const bool has_next = S.next(ui + 1, nxt);
        const char* nA = has_next ? (const char*)g.A + (size_t)nxt.pm * tstep : cA; const char* nB = has_next ? (const char*)g.Bt + (size_t)nxt.pn * tstep : cB;
        for (int t = 0; t < nt; t += 2) {
            const bool last = (t == nt - 2);
            const char* a1 = cA + (size_t)(t + 1) * kstep;
            const char* a2 = last ? nA : cA + (size_t)(t + 2) * kstep; const char* b2 = last ? nB : cB + (size_t)(t + 2) * kstep;
            const char* a3 = a2 + kstep; const char* b3 = b2 + kstep;
            if (last && has_next) S.a_ready(nxt);
            if constexpr (SP2) {
            PG8_LDB(B0, 0, 0); PG8_LDB(B1, 0, 1); PG8_SCHED; PG8_LDA(At, 0, 0); PG8_STAGE(PG8_SA(1, 1), a1 + hstep, voffA);
            PG8_WAIT_V(8); PG8_WAIT_L(0); PG8_BAR; PG8_MMA(0, 0, At, B0); PG8_MMA(0, 1, At, B1); PG8_BAR; PG8_SCHED;
            PG8_LDA(At, 0, 1); PG8_STAGE(PG8_SB(0, 0), b2, voffB); PG8_STAGE(PG8_SB(0, 1), b2 + hstep, voffB); PG8_STAGE(PG8_SA(0, 0), a2, voffA);
            PG8_WAIT_V(8); PG8_WAIT_L(0); PG8_BAR; PG8_MMA(1, 0, At, B0); PG8_MMA(1, 1, At, B1); PG8_BAR; PG8_SCHED;
            PG8_LDB(B0, 1, 0); PG8_LDB(B1, 1, 1); PG8_SCHED; PG8_LDA(At, 1, 0); PG8_STAGE(PG8_SA(0, 1), a2 + hstep, voffA);
            PG8_WAIT_V(8); PG8_WAIT_L(0); PG8_BAR; PG8_MMA(0, 0, At, B0); PG8_MMA(0, 1, At, B1); PG8_BAR; PG8_SCHED;
            PG8_LDA(At, 1, 1); PG8_STAGE(PG8_SB(1, 0), b3, voffB); PG8_STAGE(PG8_SB(1, 1), b3 + hstep, voffB); PG8_STAGE(PG8_SA(1, 0), a3, voffA);
            PG8_WAIT_V(8); PG8_WAIT_L(0); PG8_BAR; PG8_MMA(1, 0, At, B0); PG8_MMA(1, 1, At, B1); PG8_BAR; PG8_SCHED;
            } else {
            PG8_LDB(B0, 0, 0); PG8_SCHED; PG8_LDA(At, 0, 0); PG8_STAGE(PG8_SA(1, 1), a1 + hstep, voffA);
            PG8_WAIT_L(8); PG8_BAR; PG8_WAIT_L(0); PG8_MMA(0, 0, At, B0); PG8_BAR; PG8_SCHED;
            PG8_LDB(B1, 0, 1); PG8_STAGE(PG8_SB(0, 0), b2, voffB);
            PG8_BAR; PG8_WAIT_L(0); PG8_MMA(0, 1, At, B1); PG8_BAR;
            PG8_LDA(At, 0, 1); PG8_STAGE(PG8_SA(0, 0), a2, voffA);
            PG8_BAR; PG8_WAIT_L(0); PG8_MMA(1, 0, At, B0); PG8_BAR; PG8_SCHED;
            PG8_STAGE(PG8_SB(0, 1), b2 + hstep, voffB);
            PG8_WAIT_V(6); PG8_BAR; PG8_MMA(1, 1, At, B1); PG8_BAR;
            PG8_LDB(B0, 1, 0); PG8_SCHED; PG8_LDA(At, 1, 0); PG8_STAGE(PG8_SA(0, 1), a2 + hstep, voffA);
            PG8_WAIT_L(8); PG8_BAR; PG8_WAIT_L(0); PG8_MMA(0, 0, At, B0); PG8_BAR; PG8_SCHED;
            PG8_LDB(B1, 1, 1); PG8_STAGE(PG8_SB(1, 0), b3, voffB);
            PG8_BAR; PG8_WAIT_L(0); PG8_MMA(0, 1, At, B1); PG8_BAR;
            PG8_LDA(At, 1, 1); PG8_STAGE(PG8_SA(1, 0), a3, voffA);
            PG8_BAR; PG8_WAIT_L(0); PG8_MMA(1, 0, At, B0); PG8_BAR; PG8_SCHED;
            PG8_STAGE(PG8_SB(1, 1), b3 + hstep, voffB);
            PG8_WAIT_V(6); PG8_BAR; PG8_MMA(1, 1, At, B1); PG8_BAR;
            }
        }
        if constexpr (ALIGN_EPI) { if (wr == 0) PG8_BAR; }
        if constexpr (!Epi::AFTER_DRAIN) { E(acc, cur, wr, wc, fr, fq); S.done(cur); }
        if (!has_next) break;
#pragma unroll
        for (int a = 0; a < 2; ++a)
#pragma unroll
            for (int b = 0; b < 2; ++b)
#pragma unroll
                for (int m = 0; m < 4; ++m)
#pragma unroll
                    for (int n = 0; n < 2; ++n) acc[a][b][m][n] = (f32x4){0.f, 0.f, 0.f, 0.f};
        cur = nxt; cA = nA; cB = nB; ++ui;
        if constexpr (ALIGN_EPI) { if (wr == 1) PG8_BAR; }
    }
    PG8_WAIT_V(0);
    if constexpr (!ALIGN_EPI) { if (wr == 0) PG8_BAR; }
    PG8_BAR;
    if constexpr (Epi::AFTER_DRAIN) { E.fused(acc, cur, wr, wc, fr, fq, lds, wid, lane); S.done(cur); }
#undef PG8_SA
#undef PG8_SB
#undef PG8_STAGE
#undef PG8_LDA
#undef PG8_LDB
#undef PG8_MMA
#undef PG8_WAIT_V
#undef PG8_WAIT_L
#undef PG8_BAR
#undef PG8_SCHED
}
}
#define GAS __attribute__((address_space(1)))
#define LAS __attribute__((address_space(3)))
typedef unsigned v4u __attribute__((ext_vector_type(4)));
typedef unsigned v2u __attribute__((ext_vector_type(2)));
typedef float f32x4 __attribute__((ext_vector_type(4)));
typedef float f32x2 __attribute__((ext_vector_type(2)));
typedef short bf16x8 __attribute__((ext_vector_type(8)));
typedef __bf16 bf16x2 __attribute__((ext_vector_type(2)));
constexpr int NWAVES = 8, NTHREADS = NWAVES * 64;
constexpr int LDS_BYTES = 147456, MISC_OFF = LDS_BYTES - 512;
constexpr int CW_BAR = 4096;
constexpr float LOG2E = 1.44269504088896340736f;

__device__ __forceinline__ unsigned cvtpk(float lo, float hi) { f32x2 v = {lo, hi}; bf16x2 b = __builtin_convertvector(v, bf16x2); return __builtin_bit_cast(unsigned, b); }
__device__ __forceinline__ f32x4 mfma16(bf16x8 a, bf16x8 b, f32x4 c) { return __builtin_amdgcn_mfma_f32_16x16x32_bf16(a, b, c, 0, 0, 0); }
__device__ __forceinline__ float dot2bf(unsigned w, unsigned x, float acc) { return __builtin_amdgcn_fdot2_f32_bf16(__builtin_bit_cast(bf16x2, w), __builtin_bit_cast(bf16x2, x), acc, false); }
__device__ __forceinline__ float fexp2(float x) { return __builtin_amdgcn_exp2f(x); }
#define LDS_WAIT() asm volatile("s_waitcnt lgkmcnt(0)" ::: "memory")
__device__ __forceinline__ unsigned umax(unsigned a, unsigned b) { return a > b ? a : b; }
__device__ __forceinline__ unsigned xmax4(unsigned m) { auto r = __builtin_amdgcn_permlane16_swap(m, m, false, false); m = umax(r[0], r[1]); auto q = __builtin_amdgcn_permlane32_swap(m, m, false, false); return umax(q[0], q[1]); }
__device__ __forceinline__ float xfmax4(float v) { unsigned m = __float_as_uint(v); auto r = __builtin_amdgcn_permlane16_swap(m, m, false, false); v = fmaxf(__uint_as_float(r[0]), __uint_as_float(r[1])); m = __float_as_uint(v);
    auto q = __builtin_amdgcn_permlane32_swap(m, m, false, false); return fmaxf(__uint_as_float(q[0]), __uint_as_float(q[1])); }
__device__ __forceinline__ float xfsum4(float v) { unsigned m = __float_as_uint(v); auto r = __builtin_amdgcn_permlane16_swap(m, m, false, false); v = __uint_as_float(r[0]) + __uint_as_float(r[1]); m = __float_as_uint(v);
    auto q = __builtin_amdgcn_permlane32_swap(m, m, false, false); return __uint_as_float(q[0]) + __uint_as_float(q[1]); }

#define XB_TMO      128
#define XB_XCNT(j)  (256  + 64 * (j))
#define XB_XSUB(j)  (1280 + 64 * (j))
#define XB_XGEN(j)  (2304 + 64 * (j))
#define XB_TOP      3328
#define XB_TOPGEN   3392
#define XCD_BAR_WORDS 3456
#define XB_SPIN_CAP (1u << 18)
__device__ __forceinline__ unsigned xb_ld(unsigned* p)              { return __hip_atomic_load(p, __ATOMIC_RELAXED, __HIP_MEMORY_SCOPE_AGENT); }
__device__ __forceinline__ unsigned xb_add(unsigned* p, unsigned v) { return __hip_atomic_fetch_add(p, v, __ATOMIC_RELAXED, __HIP_MEMORY_SCOPE_AGENT); }
__device__ __forceinline__ unsigned xb_xcc_id() { return (unsigned)__builtin_amdgcn_s_getreg((3 << 11) | 20) & 0xFu; }
#define XB_SPIN(cond, bar) do { unsigned _sp = 0; while (cond) { __builtin_amdgcn_s_sleep(1); \
    if ((++_sp & 255u) == 0u) { if (xb_ld(&(bar)[XB_TMO])) break; if (_sp > XB_SPIN_CAP) { atomicAdd(&(bar)[XB_TMO], 1u); break; } } } } while (0)
struct XcdBarrier { unsigned* bar; unsigned x; volatile LAS unsigned* st; };
__device__ __forceinline__ XcdBarrier xcd_barrier_post(unsigned* bar, volatile LAS unsigned* st) {
    XcdBarrier b; b.bar = bar; b.x = xb_xcc_id(); b.st = st;
    if (threadIdx.x == 0) (void)xb_add(&bar[XB_XCNT(b.x)], 1u);
    return b;
}
__device__ __forceinline__ void xcd_barrier_complete(unsigned* bar, unsigned x, unsigned& nloc, unsigned& nx) {
    const unsigned G = gridDim.x * gridDim.y * gridDim.z;
    unsigned sum, cnt, mine, sp = 0u;
    for (;;) {
        sum = 0u; cnt = 0u; mine = 0u;
#pragma unroll
        for (unsigned j = 0; j < 16; ++j) { const unsigned c = xb_ld(&bar[XB_XCNT(j)]); sum += c; cnt += (c > 0u) ? 1u : 0u; mine = (j == x) ? c : mine; }
        if (sum == G) break;
        __builtin_amdgcn_s_sleep(1);
        if ((++sp & 255u) == 0u) { if (xb_ld(&bar[XB_TMO])) break; if (sp > XB_SPIN_CAP) { atomicAdd(&bar[XB_TMO], 1u); break; } }
    }
    nloc = mine > 0u ? mine : 1u; nx = cnt > 0u ? cnt : 1u;
}
__device__ __forceinline__ void xcd_barrier(const XcdBarrier& b) {
    asm volatile("s_waitcnt vmcnt(0)" ::: "memory");
    __syncthreads();
    if (threadIdx.x == 0) {
        unsigned* bar = b.bar;
        __builtin_amdgcn_s_waitcnt(0);
        unsigned nloc = b.st[0], nx = b.st[1];
        if (nloc == 0u) { xcd_barrier_complete(bar, b.x, nloc, nx); b.st[0] = nloc; b.st[1] = nx; }
        const unsigned old = xb_add(&bar[XB_XSUB(b.x)], 1u);
        const unsigned gen = old / nloc;
        if (old + 1u == (gen + 1u) * nloc) {
            __builtin_amdgcn_fence(__ATOMIC_RELEASE, "agent");
            asm volatile("s_waitcnt vmcnt(0)" ::: "memory");
            const unsigned og = xb_add(&bar[XB_TOP], 1u);
            const unsigned tg = og / nx;
            if (og + 1u == (tg + 1u) * nx) xb_add(&bar[XB_TOPGEN], 1u);
            else XB_SPIN(xb_ld(&bar[XB_TOPGEN]) == tg, bar);
            __builtin_amdgcn_fence(__ATOMIC_ACQUIRE, "agent");
            xb_add(&bar[XB_XGEN(b.x)], 1u);
            asm volatile("s_waitcnt vmcnt(0)" ::: "memory");
        } else {
            XB_SPIN(xb_ld(&bar[XB_XGEN(b.x)]) == gen, bar);
            __builtin_amdgcn_fence(__ATOMIC_ACQUIRE, "agent");
            asm volatile("s_waitcnt vmcnt(0)" ::: "memory");
        }
    }
    __syncthreads();
}

struct EpiStoreBf {
    static constexpr bool PERM = true, AFTER_DRAIN = false;
    bf16_t* O; int ldc;
    __device__ __forceinline__ void operator()(const pg8::f32x4 (&acc)[2][2][4][2], const pg8::Unit& u, int wr, int wc, int fr, int fq) const {
        const int row0 = u.pm * 256 + wr * 64 + fr, col0 = u.pn * 256 + wc * 32 + 8 * fq;
#pragma unroll
        for (int ai = 0; ai < 2; ++ai)
#pragma unroll
            for (int m = 0; m < 4; ++m) { bf16_t* rowp = O + (size_t)(row0 + ai * 128 + m * 16) * ldc + col0;
#pragma unroll
                for (int bj = 0; bj < 2; ++bj) { const pg8::f32x4 v0 = acc[ai][bj][m][0], v1 = acc[ai][bj][m][1];
                    v4u w; w.x = cvtpk(v0[0], v0[1]); w.y = cvtpk(v0[2], v0[3]); w.z = cvtpk(v1[0], v1[1]); w.w = cvtpk(v1[2], v1[3]);
                    *(v4u*)(rowp + bj * 128) = w; } }
    }
};
struct EpiY1 {
    static constexpr bool PERM = true, AFTER_DRAIN = false;
    const float* x; float* y;
    __device__ __forceinline__ void operator()(const pg8::f32x4 (&acc)[2][2][4][2], const pg8::Unit& u, int wr, int wc, int fr, int fq) const {
        const int row0 = u.pm * 256 + wr * 64 + fr, col0 = u.pn * 256 + wc * 32 + 8 * fq;
#pragma unroll
        for (int ai = 0; ai < 2; ++ai)
#pragma unroll
            for (int m = 0; m < 4; ++m) { const size_t off = (size_t)(row0 + ai * 128 + m * 16) * D_MODEL + col0;
#pragma unroll
                for (int bj = 0; bj < 2; ++bj) {
                    const f32x4 x0 = *(const f32x4*)(x + off + bj * 128), x1 = *(const f32x4*)(x + off + bj * 128 + 4);
                    *(f32x4*)(y + off + bj * 128) = x0 * ALPHA + acc[ai][bj][m][0]; *(f32x4*)(y + off + bj * 128 + 4) = x1 * ALPHA + acc[ai][bj][m][1]; } }
    }
};
struct EpiIn {
    static constexpr bool PERM = true, AFTER_DRAIN = false;
    float* POOLV; bf16_t *Q, *K, *V, *QM; const float* rope;
    __device__ __forceinline__ void operator()(const pg8::f32x4 (&acc)[2][2][4][2], const pg8::Unit& u, int wr, int wc, int fr, int fq) const {
        const int row0 = u.pm * 256 + wr * 64 + fr, cl = wc * 32 + 8 * fq, pn = u.pn;
        if (pn < 2) {
#pragma unroll
            for (int ai = 0; ai < 2; ++ai)
#pragma unroll
                for (int m = 0; m < 4; ++m) { float* rp = POOLV + (size_t)(row0 + ai * 128 + m * 16) * POOL_W + pn * 256 + cl;
#pragma unroll
                    for (int bj = 0; bj < 2; ++bj) { *(f32x4*)(rp + bj * 128) = acc[ai][bj][m][0]; *(f32x4*)(rp + bj * 128 + 4) = acc[ai][bj][m][1]; } }
            return;
        }
        bf16_t* base; int ld, c0; bool rot = false;
        if (pn < 6) { base = Q; ld = SWA_W; c0 = (pn - 2) * 256; rot = true; }
        else if (pn == 6) { base = K; ld = KV_W; c0 = 0; rot = true; }
        else if (pn == 7) { base = V; ld = KV_W; c0 = 0; }
        else { base = QM; ld = MEM_W; c0 = (pn - 8) * 256; }
        rot = rot && ((wc & 1) == 0);
#pragma unroll
        for (int ai = 0; ai < 2; ++ai)
#pragma unroll
            for (int m = 0; m < 4; ++m) {
                const int row = row0 + ai * 128 + m * 16;
                f32x4 v[2][2];
#pragma unroll
                for (int bj = 0; bj < 2; ++bj) { v[bj][0] = acc[ai][bj][m][0]; v[bj][1] = acc[ai][bj][m][1]; }
                if (rot) {
                    const f32x4* tp = (const f32x4*)(rope + (size_t)row * 16);
                    f32x4 cs[2][2]; cs[0][0] = tp[0]; cs[0][1] = tp[1]; cs[1][0] = tp[2]; cs[1][1] = tp[3];
#pragma unroll
                    for (int bj = 0; bj < 2; ++bj)
#pragma unroll
                        for (int n = 0; n < 2; ++n)
#pragma unroll
                            for (int i = 0; i < 4; ++i) {
                                const float xv = v[bj][n][i], pv = __shfl_xor(xv, 16);
                                const float c = cs[n][i >> 1][2 * (i & 1)], s = cs[n][i >> 1][2 * (i & 1) + 1];
                                const float o = fq == 0 ? xv * c - pv * s : (fq == 1 ? xv * c + pv * s : xv);
                                v[bj][n][i] = o; }
                }
                bf16_t* rowp = base + (size_t)row * ld + c0 + cl;
#pragma unroll
                for (int bj = 0; bj < 2; ++bj) { v4u w; w.x = cvtpk(v[bj][0][0], v[bj][0][1]); w.y = cvtpk(v[bj][0][2], v[bj][0][3]); w.z = cvtpk(v[bj][1][0], v[bj][1][1]); w.w = cvtpk(v[bj][1][2], v[bj][1][3]);
                    *(v4u*)(rowp + bj * 128) = w; }
            }
    }
};

__device__ __forceinline__ void p0_transpose_item(const float* W, int K, int N, bf16_t* WT, LAS float* scr, int item, int lane) {
    const int nblk = N / 32, kb = item / nblk, nb = item % nblk, k0 = 64 * kb, n0 = 32 * nb;
#pragma unroll 8
    for (int i = 0; i < 32; ++i) { const int kk = 2 * i + (lane >> 5); scr[kk * 33 + (lane & 31)] = W[(size_t)(k0 + kk) * N + n0 + (lane & 31)]; }
    LDS_WAIT(); asm volatile("" ::: "memory");
    const int c = lane & 7;
#pragma unroll
    for (int j = 0; j < 4; ++j) { const int n = (lane >> 3) + 8 * j; const LAS float* s = scr + (8 * c) * 33 + n;
        v4u o; o.x = cvtpk(s[0 * 33], s[1 * 33]); o.y = cvtpk(s[2 * 33], s[3 * 33]); o.z = cvtpk(s[4 * 33], s[5 * 33]); o.w = cvtpk(s[6 * 33], s[7 * 33]);
        *(v4u*)(WT + (size_t)(n0 + n) * K + k0 + 8 * c) = o; }
    LDS_WAIT(); asm volatile("" ::: "memory");
}
template <bool NT>
__device__ __forceinline__ void cvt_stream(const float* in, bf16_t* out, size_t n, int gw, int NGW, int lane) {
#pragma unroll 4
    for (size_t i = (size_t)gw * 512 + lane * 8; i < n; i += (size_t)NGW * 512) {
        f32x4 a, b;
        if (NT) { a = __builtin_nontemporal_load((const f32x4*)(in + i)); b = __builtin_nontemporal_load((const f32x4*)(in + i + 4)); }
        else { a = *(const f32x4*)(in + i); b = *(const f32x4*)(in + i + 4); }
        v4u o; o.x = cvtpk(a.x, a.y); o.y = cvtpk(a.z, a.w); o.z = cvtpk(b.x, b.y); o.w = cvtpk(b.z, b.w);
        *(v4u*)(out + i) = o;
    }
}

constexpr int SWA_KROW = 144, SWA_VROW = 528, SWA_VT_OFF = 256 * SWA_KROW;
__device__ __forceinline__ void swa_item(LAS unsigned char* lds, int item, const bf16_t* __restrict__ Q, const bf16_t* __restrict__ Kb, const bf16_t* __restrict__ Vb, const float* __restrict__ sinks,
                                         bf16_t* CONCAT, int tid, int wave, int lane) {
    const int qb = item & 31, kvh = (item >> 5) & 3, b = item >> 7;
    const int tok0 = b * SEQ + qb * 128;
    LAS unsigned char* Kl = lds; LAS unsigned char* Vt = lds + SWA_VT_OFF;
#pragma unroll
    for (int j = 0; j < 4; ++j) {
        const int c = tid + NTHREADS * j, row = c >> 3, part = c & 7;
        v4u kv = {0u, 0u, 0u, 0u}, vv = {0u, 0u, 0u, 0u};
        if (qb > 0 || row >= 128) { const size_t tk = (size_t)(tok0 - 128 + row); kv = *(const v4u*)(Kb + tk * KV_W + kvh * HD + part * 8); vv = *(const v4u*)(Vb + tk * KV_W + kvh * HD + part * 8); }
        *(LAS v4u*)(Kl + row * SWA_KROW + part * 16) = kv;
        LAS unsigned short* vp = (LAS unsigned short*)(Vt + (part * 8) * SWA_VROW + row * 2);
        vp[0 * (SWA_VROW / 2)] = (unsigned short)(vv.x & 0xffffu); vp[1 * (SWA_VROW / 2)] = (unsigned short)(vv.x >> 16);
        vp[2 * (SWA_VROW / 2)] = (unsigned short)(vv.y & 0xffffu); vp[3 * (SWA_VROW / 2)] = (unsigned short)(vv.y >> 16);
        vp[4 * (SWA_VROW / 2)] = (unsigned short)(vv.z & 0xffffu); vp[5 * (SWA_VROW / 2)] = (unsigned short)(vv.z >> 16);
        vp[6 * (SWA_VROW / 2)] = (unsigned short)(vv.w & 0xffffu); vp[7 * (SWA_VROW / 2)] = (unsigned short)(vv.w >> 16);
    }
    __syncthreads();
    const int g = wave & 3, h = kvh * 4 + g, q15 = lane & 15, qq = lane >> 4;
    const float sink2 = sinks[h] * LOG2E;
    const float SC = 0.125f * LOG2E;
#pragma unroll 1
    for (int cc = 0; cc < 2; ++cc) {
        const int c = 2 * (wave >> 2) + cc, kl0 = 32 * c;
        bf16x8 qf[2][2];
#pragma unroll
        for (int ni = 0; ni < 2; ++ni)
#pragma unroll
            for (int ks = 0; ks < 2; ++ks) qf[ni][ks] = *(const bf16x8*)(Q + (size_t)(tok0 + 32 * c + 16 * ni + q15) * SWA_W + h * HD + 32 * ks + 8 * qq);
        f32x4 s[10][2];
#pragma unroll
        for (int mi = 0; mi < 10; ++mi) { s[mi][0] = (f32x4){0.f, 0.f, 0.f, 0.f}; s[mi][1] = (f32x4){0.f, 0.f, 0.f, 0.f}; }
#pragma unroll
        for (int mi = 0; mi < 10; ++mi)
#pragma unroll
            for (int ks = 0; ks < 2; ++ks) {
                const bf16x8 kf = *(const LAS bf16x8*)(Kl + (kl0 + 16 * mi + q15) * SWA_KROW + (32 * ks + 8 * qq) * 2);
                s[mi][0] = mfma16(kf, qf[0][ks], s[mi][0]); s[mi][1] = mfma16(kf, qf[1][ks], s[mi][1]);
            }
        float rl[2];
#pragma unroll
        for (int ni = 0; ni < 2; ++ni) {
            const int ql = 32 * c + 16 * ni + q15;
            float mx = -INFINITY;
#pragma unroll
            for (int mi = 0; mi < 10; ++mi)
#pragma unroll
                for (int r = 0; r < 4; ++r) {
                    const int kl = kl0 + 16 * mi + 4 * qq + r;
                    const bool valid = (kl > ql) && (kl <= ql + 128) && (qb > 0 || kl >= 128);
                    const float t = valid ? s[mi][ni][r] * SC : -INFINITY;
                    s[mi][ni][r] = t; mx = fmaxf(mx, t);
                }
            mx = fmaxf(xfmax4(mx), sink2);
            float l = 0.f;
#pragma unroll
            for (int mi = 0; mi < 10; ++mi)
#pragma unroll
                for (int r = 0; r < 4; ++r) { const float p = fexp2(s[mi][ni][r] - mx); s[mi][ni][r] = p; l += p; }
            l = xfsum4(l) + fexp2(sink2 - mx);
            rl[ni] = 1.0f / l;
        }
        f32x4 o[4][2];
#pragma unroll
        for (int dt = 0; dt < 4; ++dt) { o[dt][0] = (f32x4){0.f, 0.f, 0.f, 0.f}; o[dt][1] = (f32x4){0.f, 0.f, 0.f, 0.f}; }
#pragma unroll
        for (int kk = 0; kk < 5; ++kk) {
            bf16x8 pf[2];
#pragma unroll
            for (int ni = 0; ni < 2; ++ni) {
                v4u w; w.x = cvtpk(s[2 * kk][ni][0], s[2 * kk][ni][1]); w.y = cvtpk(s[2 * kk][ni][2], s[2 * kk][ni][3]);
                w.z = cvtpk(s[2 * kk + 1][ni][0], s[2 * kk + 1][ni][1]); w.w = cvtpk(s[2 * kk + 1][ni][2], s[2 * kk + 1][ni][3]);
                pf[ni] = __builtin_bit_cast(bf16x8, w);
            }
#pragma unroll
            for (int dt = 0; dt < 4; ++dt) {
                const LAS unsigned char* vb = Vt + (16 * dt + q15) * SWA_VROW + (kl0 + 32 * kk + 4 * qq) * 2;
                const v2u lo = *(const LAS v2u*)vb, hi = *(const LAS v2u*)(vb + 32);
                v4u w; w.x = lo.x; w.y = lo.y; w.z = hi.x; w.w = hi.y;
                const bf16x8 vf = __builtin_bit_cast(bf16x8, w);
                o[dt][0] = mfma16(vf, pf[0], o[dt][0]); o[dt][1] = mfma16(vf, pf[1], o[dt][1]);
            }
        }
#pragma unroll
        for (int ni = 0; ni < 2; ++ni) {
            bf16_t* orow = CONCAT + (size_t)(tok0 + 32 * c + 16 * ni + q15) * D_MODEL + POOL_W + h * HD + 4 * qq;
#pragma unroll
            for (int dt = 0; dt < 4; ++dt) { v2u w; w.x = cvtpk(o[dt][ni][0] * rl[ni], o[dt][ni][1] * rl[ni]); w.y = cvtpk(o[dt][ni][2] * rl[ni], o[dt][ni][3] * rl[ni]); *(v2u*)(orow + 16 * dt) = w; }
        }
    }
    __syncthreads();
}
constexpr int MEM_KROW = 272, MEM_VROW = 528, MEM_VT_OFF = 256 * MEM_KROW;
__device__ __forceinline__ void mem_item(LAS unsigned char* lds, int item, const bf16_t* __restrict__ QM, const bf16_t* __restrict__ KVM, bf16_t* CONCAT, int tid, int wave, int lane) {
    const int qt = item & 31, hm = (item >> 5) & 3, b = item >> 7;
    LAS unsigned char* Kl = lds; LAS unsigned char* Vt = lds + MEM_VT_OFF;
#pragma unroll
    for (int j = 0; j < 8; ++j) {
        const int c = tid + NTHREADS * j, row = c >> 4, part = c & 15;
        const bf16_t* src = KVM + (size_t)(b * MEM_LEN + row) * (2 * MEM_W) + hm * MHD + part * 8;
        const v4u kv = *(const v4u*)src, vv = *(const v4u*)(src + MEM_W);
        *(LAS v4u*)(Kl + row * MEM_KROW + part * 16) = kv;
        LAS unsigned short* vp = (LAS unsigned short*)(Vt + (part * 8) * MEM_VROW + row * 2);
        vp[0 * (MEM_VROW / 2)] = (unsigned short)(vv.x & 0xffffu); vp[1 * (MEM_VROW / 2)] = (unsigned short)(vv.x >> 16);
        vp[2 * (MEM_VROW / 2)] = (unsigned short)(vv.y & 0xffffu); vp[3 * (MEM_VROW / 2)] = (unsigned short)(vv.y >> 16);
        vp[4 * (MEM_VROW / 2)] = (unsigned short)(vv.z & 0xffffu); vp[5 * (MEM_VROW / 2)] = (unsigned short)(vv.z >> 16);
        vp[6 * (MEM_VROW / 2)] = (unsigned short)(vv.w & 0xffffu); vp[7 * (MEM_VROW / 2)] = (unsigned short)(vv.w >> 16);
    }
    __syncthreads();
    const int q15 = lane & 15, qq = lane >> 4;
    const int tok = b * SEQ + qt * 128 + wave * 16 + q15;
    const float SC = 0.08838834764831845f * LOG2E;
    bf16x8 qf[4];
#pragma unroll
    for (int ks = 0; ks < 4; ++ks) qf[ks] = *(const bf16x8*)(QM + (size_t)tok * MEM_W + hm * MHD + 32 * ks + 8 * qq);
    f32x4 s[16];
#pragma unroll
    for (int mi = 0; mi < 16; ++mi) s[mi] = (f32x4){0.f, 0.f, 0.f, 0.f};
#pragma unroll
    for (int mi = 0; mi < 16; ++mi)
#pragma unroll
        for (int ks = 0; ks < 4; ++ks) {
            const bf16x8 kf = *(const LAS bf16x8*)(Kl + (16 * mi + q15) * MEM_KROW + (32 * ks + 8 * qq) * 2);
            s[mi] = mfma16(kf, qf[ks], s[mi]);
        }
    float mx = -INFINITY;
#pragma unroll
    for (int mi = 0; mi < 16; ++mi)
#pragma unroll
        for (int r = 0; r < 4; ++r) { const float t = s[mi][r] * SC; s[mi][r] = t; mx = fmaxf(mx, t); }
    mx = xfmax4(mx);
    float l = 0.f;
#pragma unroll
    for (int mi = 0; mi < 16; ++mi)
#pragma unroll
        for (int r = 0; r < 4; ++r) { const float p = fexp2(s[mi][r] - mx); s[mi][r] = p; l += p; }
    l = xfsum4(l);
    const float rl = 1.0f / l;
    f32x4 o[8];
#pragma unroll
    for (int dt = 0; dt < 8; ++dt) o[dt] = (f32x4){0.f, 0.f, 0.f, 0.f};
#pragma unroll
    for (int kk = 0; kk < 8; ++kk) {
        v4u pw; pw.x = cvtpk(s[2 * kk][0], s[2 * kk][1]); pw.y = cvtpk(s[2 * kk][2], s[2 * kk][3]); pw.z = cvtpk(s[2 * kk + 1][0], s[2 * kk + 1][1]); pw.w = cvtpk(s[2 * kk + 1][2], s[2 * kk + 1][3]);
        const bf16x8 pf = __builtin_bit_cast(bf16x8, pw);
#pragma unroll
        for (int dt = 0; dt < 8; ++dt) {
            const LAS unsigned char* vb = Vt + (16 * dt + q15) * MEM_VROW + (32 * kk + 4 * qq) * 2;
            const v2u lo = *(const LAS v2u*)vb, hi = *(const LAS v2u*)(vb + 32);
            v4u w; w.x = lo.x; w.y = lo.y; w.z = hi.x; w.w = hi.y;
            o[dt] = mfma16(__builtin_bit_cast(bf16x8, w), pf, o[dt]);
        }
    }
    bf16_t* orow = CONCAT + (size_t)tok * D_MODEL + POOL_W + SWA_W + hm * MHD + 4 * qq;
#pragma unroll
    for (int dt = 0; dt < 8; ++dt) { v2u w; w.x = cvtpk(o[dt][0] * rl, o[dt][1] * rl); w.y = cvtpk(o[dt][2] * rl, o[dt][3] * rl); *(v2u*)(orow + 16 * dt) = w; }
    __syncthreads();
}
__device__ __forceinline__ void pool_item(int item, const float* __restrict__ POOLV, const bf16_t* __restrict__ WPT, const float* __restrict__ pool_scale, bf16_t* CONCAT, int lane) {
    const int g = item & 3, t0 = (item >> 2) * 16, w = 2 << g, q15 = lane & 15, qq = lane >> 4;
    const int t = t0 + q15, sp = t & (SEQ - 1);
    const int cnt = (sp + 1) < w ? (sp + 1) : w;
    const float inv = 1.0f / (float)cnt;
    bf16x8 pf[4];
#pragma unroll
    for (int ks = 0; ks < 4; ++ks) {
        const float* p0 = POOLV + (size_t)t * POOL_W + g * 128 + 32 * ks + 8 * qq;
        const f32x4 c0 = *(const f32x4*)p0, c1 = *(const f32x4*)(p0 + 4);
        f32x4 a0 = c0, a1 = c1;
        for (int i = 1; i < cnt; ++i) { a0 += *(const f32x4*)(p0 - (size_t)i * POOL_W); a1 += *(const f32x4*)(p0 - (size_t)i * POOL_W + 4); }
        a0 = a0 * inv - c0; a1 = a1 * inv - c1;
        v4u pw; pw.x = cvtpk(a0.x, a0.y); pw.y = cvtpk(a0.z, a0.w); pw.z = cvtpk(a1.x, a1.y); pw.w = cvtpk(a1.z, a1.w);
        pf[ks] = __builtin_bit_cast(bf16x8, pw);
    }
    bf16_t* orow = CONCAT + (size_t)t * D_MODEL + g * 128 + 4 * qq;
#pragma unroll
    for (int mt = 0; mt < 8; ++mt) {
        f32x4 acc = {0.f, 0.f, 0.f, 0.f};
#pragma unroll
        for (int ks = 0; ks < 4; ++ks) { const bf16x8 wf = *(const bf16x8*)(WPT + (size_t)g * 16384 + (16 * mt + q15) * 128 + 32 * ks + 8 * qq); acc = mfma16(wf, pf[ks], acc); }
        const f32x4 sc = *(const f32x4*)(pool_scale + g * 128 + 16 * mt + 4 * qq);
        v2u wv; wv.x = cvtpk(acc[0] * sc[0], acc[1] * sc[1]); wv.y = cvtpk(acc[2] * sc[2], acc[3] * sc[3]);
        *(v2u*)(orow + 16 * mt) = wv;
    }
}

__device__ __forceinline__ void ln1_row(const float* __restrict__ yrow, const float* __restrict__ g, const float* __restrict__ bta, float* xo, bf16_t* xb, int lane) {
    f32x4 v[8]; float s = 0.f;
#pragma unroll
    for (int j = 0; j < 8; ++j) { v[j] = *(const f32x4*)(yrow + 256 * j + 4 * lane); s += (v[j].x + v[j].y) + (v[j].z + v[j].w); }
    const float mean = wave_sum(s) * (1.f / D_MODEL); float q = 0.f;
#pragma unroll
    for (int j = 0; j < 8; ++j) { v[j] = v[j] - mean; q += (v[j].x * v[j].x + v[j].y * v[j].y) + (v[j].z * v[j].z + v[j].w * v[j].w); }
    const float rstd = 1.0f / sqrtf(wave_sum(q) * (1.f / D_MODEL) + LN_EPS);
#pragma unroll
    for (int j = 0; j < 8; ++j) {
        const f32x4 gg = *(const f32x4*)(g + 256 * j + 4 * lane), bb = *(const f32x4*)(bta + 256 * j + 4 * lane);
        const f32x4 y = v[j] * rstd * gg + bb;
        *(f32x4*)(xo + 256 * j + 4 * lane) = y;
        v2u w; w.x = cvtpk(y.x, y.y); w.y = cvtpk(y.z, y.w); *(v2u*)(xb + 256 * j + 4 * lane) = w;
    }
}

__device__ __forceinline__ unsigned f2ord(float f) { const unsigned u = __float_as_uint(f); return u ^ ((unsigned)((int)u >> 31) | 0x80000000u); }
__device__ __forceinline__ float ord2f(unsigned o) { const unsigned u = (o & 0x80000000u) ? (o ^ 0x80000000u) : ~o; return __uint_as_float(u); }
__device__ __forceinline__ void topk_item(int item, const bf16_t* __restrict__ QP, const bf16_t* __restrict__ K1B, const bf16_t* __restrict__ K2B, int* EIDX, float* GATE, int lane) {
    const int h = item & 7, t0 = (item >> 3) * 16, q15 = lane & 15, qq = lane >> 4;
    const int t = t0 + q15;
    unsigned top[2][16];
#pragma unroll
    for (int half = 0; half < 2; ++half) {
        const bf16_t* KB = half ? K2B : K1B;
        bf16x8 qf[4];
#pragma unroll
        for (int ks = 0; ks < 4; ++ks) qf[ks] = *(const bf16x8*)(QP + (size_t)t * D_MODEL + h * 256 + half * 128 + 32 * ks + 8 * qq);
        unsigned key[32];
#pragma unroll
        for (int mi = 0; mi < 8; ++mi) {
            f32x4 acc = {0.f, 0.f, 0.f, 0.f};
#pragma unroll
            for (int ks = 0; ks < 4; ++ks) { const bf16x8 kf = *(const bf16x8*)(KB + (16 * mi + q15) * 128 + 32 * ks + 8 * qq); acc = mfma16(kf, qf[ks], acc); }
#pragma unroll
            for (int r = 0; r < 4; ++r) key[mi * 4 + r] = (f2ord(acc[r]) & ~0x7Fu) | (unsigned)(127 - (16 * mi + 4 * qq + r));
        }
#pragma unroll
        for (int r = 0; r < 16; ++r) {
            unsigned t1[11];
#pragma unroll
            for (int i = 0; i < 10; ++i) t1[i] = umax(umax(key[3 * i], key[3 * i + 1]), key[3 * i + 2]);
            t1[10] = umax(key[30], key[31]);
            const unsigned u0 = umax(umax(t1[0], t1[1]), t1[2]), u1 = umax(umax(t1[3], t1[4]), t1[5]), u2 = umax(umax(t1[6], t1[7]), t1[8]), u3 = umax(t1[9], t1[10]);
            const unsigned M = xmax4(umax(umax(umax(u0, u1), u2), u3));
            top[half][r] = M;
#pragma unroll
            for (int i = 0; i < 32; ++i) key[i] = (key[i] == M) ? 0u : key[i];
            __builtin_amdgcn_sched_barrier(0);
        }
        __builtin_amdgcn_sched_barrier(0);
    }
    float v1[16], v2[16]; unsigned e1[16], e2[16];
#pragma unroll
    for (int r = 0; r < 16; ++r) { v1[r] = ord2f(top[0][r] & ~0x7Fu); v2[r] = ord2f(top[1][r] & ~0x7Fu); e1[r] = (127u - (top[0][r] & 0x7Fu)) * 128u; e2[r] = 127u - (top[1][r] & 0x7Fu); }
    unsigned ck[13], ce[13];
#pragma unroll
    for (int i = 0; i < 13; ++i) { ck[i] = 0u; ce[i] = 0u; }
    {
        int n = 0;
#pragma unroll
        for (int a = 0; a < 16; ++a)
#pragma unroll
            for (int bb = 0; bb < 16; ++bb)
                if ((a + 1) * (bb + 1) <= 16) {
                    const unsigned pk = (f2ord(v1[a] + v2[bb]) & ~0xFFu) | (unsigned)(255 - (a * 16 + bb));
                    const unsigned ee = e1[a] + e2[bb];
                    const bool me = (qq == (n & 3));
                    ck[n >> 2] = me ? pk : ck[n >> 2]; ce[n >> 2] = me ? ee : ce[n >> 2];
                    ++n;
                }
    }
    float sc[16];
#pragma unroll
    for (int r = 0; r < 16; ++r) {
        const unsigned c0 = umax(umax(ck[0], ck[1]), ck[2]), c1 = umax(umax(ck[3], ck[4]), ck[5]), c2 = umax(umax(ck[6], ck[7]), ck[8]), c3 = umax(umax(ck[9], ck[10]), ck[11]);
        const unsigned Lm = umax(umax(umax(c0, c1), umax(c2, c3)), ck[12]);
        const unsigned M = xmax4(Lm);
        unsigned we = 0u;
#pragma unroll
        for (int i = 0; i < 13; ++i) { const bool hit = (ck[i] == M); we = hit ? ce[i] : we; ck[i] = hit ? 0u : ck[i]; }
        sc[r] = ord2f(M & ~0xFFu);
        if (Lm == M) EIDX[(size_t)t * EPT + h * TOPK + r] = (int)we;
        __builtin_amdgcn_sched_barrier(0);
    }
    const float smax = sc[0];
    float den = 0.f;
#pragma unroll
    for (int r = 0; r < 16; ++r) { sc[r] = fexp2((sc[r] - smax) * LOG2E); den += sc[r]; }
    const float rden = 1.0f / den;
    if (qq == 0) {
        float* gp = GATE + (size_t)t * EPT + h * TOPK;
#pragma unroll
        for (int r = 0; r < 16; r += 4) *(f32x4*)(gp + r) = (f32x4){sc[r] * rden, sc[r + 1] * rden, sc[r + 2] * rden, sc[r + 3] * rden};
    }
}

__device__ __forceinline__ float reduce16(const float (&p)[16], int lane) {
    const bool b3 = lane & 8, b2 = lane & 4;
    float r8[8], r4[4], r2[2];
#pragma unroll
    for (int k = 0; k < 8; ++k) { auto r = __builtin_amdgcn_permlane32_swap(__float_as_uint(p[k]), __float_as_uint(p[k + 8]), false, false); r8[k] = __uint_as_float(r[0]) + __uint_as_float(r[1]); }
#pragma unroll
    for (int k = 0; k < 4; ++k) { auto r = __builtin_amdgcn_permlane16_swap(__float_as_uint(r8[k]), __float_as_uint(r8[k + 4]), false, false); r4[k] = __uint_as_float(r[0]) + __uint_as_float(r[1]); }
#pragma unroll
    for (int k = 0; k < 2; ++k) { const float keep = b3 ? r4[k + 2] : r4[k], send = b3 ? r4[k] : r4[k + 2]; r2[k] = keep + __shfl_xor(send, 8); }
    const float keep = b2 ? r2[1] : r2[0], send = b2 ? r2[0] : r2[1];
    float r1 = keep + __shfl_xor(send, 4);
    r1 += __shfl_xor(r1, 2); r1 += __shfl_xor(r1, 1);
    return r1;
}
#define G_LANE_OF(e) ((((e) >> 3) & 1) * 32 + (((e) >> 2) & 1) * 16 + (((e) >> 1) & 1) * 8 + ((e) & 1) * 4)
#define G_ISSUE1(slot, TAB, idv, ln) do { const int _id = __builtin_amdgcn_readlane((idv), (ln)); const unsigned char* _rp = (TAB) + (size_t)_id * D_MODEL + 16 * lane; \
        buf[slot][0] = *(const v4u*)_rp; buf[slot][1] = *(const v4u*)(_rp + 1024); } while (0)
#define G_DOT1(slot, pi) do { float _a = 0.f, _b = 0.f; \
        _Pragma("unroll") for (int _i = 0; _i < 2; ++_i) _Pragma("unroll") for (int _j = 0; _j < 4; ++_j) { const unsigned _w = buf[slot][_i][_j]; \
            _a = __builtin_amdgcn_fdot2_f32_bf16(__builtin_amdgcn_cvt_scalef32_pk_bf16_fp8(_w, 1.0f, false), __builtin_bit_cast(bf16x2, xb[_i][2 * _j]), _a, false); \
            _b = __builtin_amdgcn_fdot2_f32_bf16(__builtin_amdgcn_cvt_scalef32_pk_bf16_fp8(_w, 1.0f, true), __builtin_bit_cast(bf16x2, xb[_i][2 * _j + 1]), _b, false); } \
        part[pi] = _a + _b; } while (0)
#define G_FMA1(slot, e) do { const float _a = __int_as_float(__builtin_amdgcn_readlane(__float_as_int(aval), G_LANE_OF(e))); \
        _Pragma("unroll") for (int _i = 0; _i < 2; ++_i) _Pragma("unroll") for (int _j = 0; _j < 4; ++_j) { const unsigned _w = buf[slot][_i][_j]; \
            const f32x2 _lo = __builtin_amdgcn_cvt_pk_f32_fp8(_w, false), _hi = __builtin_amdgcn_cvt_pk_f32_fp8(_w, true); \
            acc[_i][_j] += (f32x4){_lo.x, _lo.y, _hi.x, _hi.y} * _a; } } while (0)
__device__ __forceinline__ void gather_token(int t, const float* __restrict__ X1, const bf16_t* __restrict__ X1B, const int* __restrict__ EIDX, const float* __restrict__ GATE,
                                             const unsigned char* __restrict__ U8, const unsigned char* __restrict__ V8, const float* __restrict__ SU, const float* __restrict__ SV,
                                             const float* __restrict__ g2, const float* __restrict__ b2, float* out, int lane) {
    unsigned xb[2][8];
#pragma unroll
    for (int i = 0; i < 2; ++i) {
        const v4u a = *(const v4u*)(X1B + (size_t)t * D_MODEL + 1024 * i + 16 * lane), b = *(const v4u*)(X1B + (size_t)t * D_MODEL + 1024 * i + 16 * lane + 8);
        xb[i][0] = a.x; xb[i][1] = a.y; xb[i][2] = a.z; xb[i][3] = a.w; xb[i][4] = b.x; xb[i][5] = b.y; xb[i][6] = b.z; xb[i][7] = b.w;
    }
    const int id_lo = EIDX[(size_t)t * EPT + lane], id_hi = EIDX[(size_t)t * EPT + 64 + lane];
    const float g_lo = GATE[(size_t)t * EPT + lane], g_hi = GATE[(size_t)t * EPT + 64 + lane];
    const float su_lo = SU[id_lo], su_hi = SU[id_hi], sv_lo = SV[id_lo], sv_hi = SV[id_hi];
    f32x4 acc[2][4];
#pragma unroll
    for (int i = 0; i < 2; ++i)
#pragma unroll
        for (int j = 0; j < 4; ++j) acc[i][j] = (f32x4){0.f, 0.f, 0.f, 0.f};
    const int e_me = ((lane >> 5) & 1) * 8 + ((lane >> 4) & 1) * 4 + ((lane >> 3) & 1) * 2 + ((lane >> 2) & 1);
    v4u buf[8][2];
#pragma unroll
    for (int e = 0; e < 8; ++e) G_ISSUE1(e, U8, id_lo, e);
#pragma unroll 1
    for (int hh = 0; hh < 8; ++hh) {
        const int idv = hh < 4 ? id_lo : id_hi; const float gv = hh < 4 ? g_lo : g_hi, suv = hh < 4 ? su_lo : su_hi, svv = hh < 4 ? sv_lo : sv_hi;
        const int lb = (hh & 3) * 16;
        const int hn = hh < 7 ? hh + 1 : 7; const int idn = hn < 4 ? id_lo : id_hi; const int lbn = (hn & 3) * 16;
        float part[16];
#pragma unroll
        for (int e = 0; e < 16; ++e) {
            G_DOT1(e & 7, e);
            if (e < 8) G_ISSUE1(e & 7, U8, idv, lb + e + 8); else G_ISSUE1(e & 7, V8, idv, lb + e - 8);
        }
        const float hval = reduce16(part, lane) * __shfl(suv, lb + e_me);
        const float aval = __shfl(gv, lb + e_me) * gelu_erf(hval) * __shfl(svv, lb + e_me);
#pragma unroll
        for (int e = 0; e < 16; ++e) {
            G_FMA1(e & 7, e);
            if (e < 8) G_ISSUE1(e & 7, V8, idv, lb + e + 8); else G_ISSUE1(e & 7, U8, idn, lbn + e - 8);
        }
    }
    float s = 0.f;
#pragma unroll
    for (int i = 0; i < 2; ++i)
#pragma unroll
        for (int j = 0; j < 4; ++j) {
            const f32x4 x0 = *(const f32x4*)(X1 + (size_t)t * D_MODEL + 1024 * i + 16 * lane + 4 * j);
            acc[i][j] = x0 * ALPHA + acc[i][j];
            s += (acc[i][j].x + acc[i][j].y) + (acc[i][j].z + acc[i][j].w);
        }
    const float mean = wave_sum(s) * (1.f / D_MODEL); float q = 0.f;
#pragma unroll
    for (int i = 0; i < 2; ++i)
#pragma unroll
        for (int j = 0; j < 4; ++j) { acc[i][j] = acc[i][j] - mean; q += (acc[i][j].x * acc[i][j].x + acc[i][j].y * acc[i][j].y) + (acc[i][j].z * acc[i][j].z + acc[i][j].w * acc[i][j].w); }
    const float rstd = 1.0f / sqrtf(wave_sum(q) * (1.f / D_MODEL) + LN_EPS);
#pragma unroll
    for (int i = 0; i < 2; ++i)
#pragma unroll
        for (int j = 0; j < 4; ++j) {
            const int c = 1024 * i + 16 * lane + 4 * j;
            const f32x4 gg = *(const f32x4*)(g2 + c), bb = *(const f32x4*)(b2 + c);
            *(f32x4*)(out + (size_t)t * D_MODEL + c) = acc[i][j] * rstd * gg + bb;
        }
}
__device__ __forceinline__ void cvt_row_fp8(const float* __restrict__ in, unsigned char* out8, float* sc, int row, int lane) {
    const float* r = in + (size_t)row * D_MODEL + 16 * lane;
    f32x4 v[2][4]; float am = 0.f;
#pragma unroll
    for (int i = 0; i < 2; ++i)
#pragma unroll
        for (int j = 0; j < 4; ++j) { v[i][j] = __builtin_nontemporal_load((const f32x4*)(r + 1024 * i + 4 * j)); am = fmaxf(am, fmaxf(fmaxf(fabsf(v[i][j].x), fabsf(v[i][j].y)), fmaxf(fabsf(v[i][j].z), fabsf(v[i][j].w)))); }
#pragma unroll
    for (int o = 1; o < 64; o <<= 1) am = fmaxf(am, __shfl_xor(am, o));
    const float inv = am > 0.f ? 256.0f / am : 1.0f, scale = am > 0.f ? am * (1.0f / 256.0f) : 1.0f;
#pragma unroll
    for (int i = 0; i < 2; ++i) {
        v4u o;
#pragma unroll
        for (int j = 0; j < 4; ++j) { int w = 0; w = __builtin_amdgcn_cvt_pk_fp8_f32(v[i][j].x * inv, v[i][j].y * inv, w, false); w = __builtin_amdgcn_cvt_pk_fp8_f32(v[i][j].z * inv, v[i][j].w * inv, w, true); o[j] = (unsigned)w; }
        *(v4u*)(out8 + (size_t)row * D_MODEL + 1024 * i + 16 * lane) = o;
    }
    if (lane == 0) sc[row] = scale;
}

struct Args { const void* in[18]; float* out; unsigned char* ws; int ph_lo, ph_hi, li, pad; };
constexpr int N_PHASES = 8;

#define P_IN(T, i) ((const T*)args.in[i])
#define P_WS(T, off) ((T*)(ws + (off)))
#define x_in P_IN(float, 0)
#define mem_in P_IN(float, 1)
#define positions P_IN(int, 2)
#define w_in P_IN(float, 3)
#define w_mem_kv P_IN(float, 4)
#define w_pool P_IN(float, 5)
#define pool_scale P_IN(float, 6)
#define sinks P_IN(float, 7)
#define w_out P_IN(float, 8)
#define ln1_g P_IN(float, 9)
#define ln1_b P_IN(float, 10)
#define w_peer_q P_IN(float, 11)
#define sk1 P_IN(float, 12)
#define sk2 P_IN(float, 13)
#define eu P_IN(float, 14)
#define ev P_IN(float, 15)
#define ln2_g P_IN(float, 16)
#define ln2_b P_IN(float, 17)
#define WINT P_WS(bf16_t, WS_WINT)
#define WKVT P_WS(bf16_t, WS_WKVT)
#define WOT P_WS(bf16_t, WS_WOT)
#define WQT P_WS(bf16_t, WS_WQT)
#define WPT P_WS(bf16_t, WS_SMALL)
#define K1B P_WS(bf16_t, WS_SMALL + 131072)
#define K2B P_WS(bf16_t, WS_SMALL + 163840)
#define ROPE P_WS(float, WS_SMALL + 262144)
#define XB P_WS(bf16_t, WS_XB)
#define X1B P_WS(bf16_t, WS_X1B)
#define MEMB P_WS(bf16_t, WS_MEMB)
#define KVM P_WS(bf16_t, WS_KVM)
#define POOLV P_WS(float, WS_POOLV)
#define Q P_WS(bf16_t, WS_Q)
#define Kb P_WS(bf16_t, WS_K)
#define Vb P_WS(bf16_t, WS_V)
#define QM P_WS(bf16_t, WS_QM)
#define CONCAT P_WS(bf16_t, WS_CONCAT)
#define Y1 P_WS(float, WS_Y1)
#define X1 P_WS(float, WS_X1)
#define QP P_WS(bf16_t, WS_QP)
#define EIDX P_WS(int, WS_EIDX)
#define GATE P_WS(float, WS_GATE)
#define U8 P_WS(unsigned char, WS_UB)
#define V8 P_WS(unsigned char, WS_VB)
#define SU P_WS(float, WS_UB + 48 * MiB)
#define SV P_WS(float, WS_VB + 48 * MiB)
__global__ void __launch_bounds__(NTHREADS, 2) mega_fwd(Args args) {
    extern __shared__ __attribute__((aligned(16))) unsigned char lds_raw[];
    LAS unsigned char* lds = (LAS unsigned char*)lds_raw;
    volatile LAS unsigned* MISC = (volatile LAS unsigned*)(lds + MISC_OFF);
    const int tid = threadIdx.x, lane = tid & 63, wave = __builtin_amdgcn_readfirstlane(tid >> 6);
    const int G = gridDim.x, bx = blockIdx.x;
    const int vcu = (G % 8 == 0) ? (bx % 8) * (G / 8) + bx / 8 : bx;
    const int gw = vcu * NWAVES + wave, NGW = G * NWAVES;
    unsigned char* ws = args.ws;
    for (int u = tid; u < (LDS_BYTES - MISC_OFF) / 4; u += NTHREADS) MISC[u] = 0u;
    __syncthreads();
    XcdBarrier bar = xcd_barrier_post((unsigned*)(ws + WS_CTL) + CW_BAR + args.li * XCD_BAR_WORDS, MISC + 8);
    const int lo = args.ph_lo, hi = args.ph_hi;
#ifndef ONLY_PHASES
#define ONLY_PHASES 255
#endif
#define IN(k) (((ONLY_PHASES >> (k)) & 1) && lo <= (k) && (k) < hi)
#ifndef REPEAT_MASK
#define REPEAT_MASK 0
#endif
#define REP(k) for (int _rep = 0; _rep < 1 + ((REPEAT_MASK >> (k)) & 1); ++_rep)
#define SEAM(k) do { if (IN(k) && IN((k) + 1)) xcd_barrier(bar); } while (0)

    if (IN(0)) REP(0) {
        LAS float* scr = (LAS float*)(lds + wave * 16384);
        constexpr int I_IN = (D_MODEL / 64) * (IN_W / 32), I_KV = (D_MODEL / 64) * (2 * MEM_W / 32), I_O = (D_MODEL / 64) * (D_MODEL / 32), I_Q = I_O, I_P = 4 * 2 * 4;
        constexpr int NITEMS = I_IN + I_KV + I_O + I_Q + I_P;
        for (int it = gw; it < NITEMS; it += NGW) {
            int r = it;
            if (r < I_IN) { p0_transpose_item(w_in, D_MODEL, IN_W, WINT, scr, r, lane); continue; } r -= I_IN;
            if (r < I_KV) { p0_transpose_item(w_mem_kv, D_MODEL, 2 * MEM_W, WKVT, scr, r, lane); continue; } r -= I_KV;
            if (r < I_O) { p0_transpose_item(w_out, D_MODEL, D_MODEL, WOT, scr, r, lane); continue; } r -= I_O;
            if (r < I_Q) { p0_transpose_item(w_peer_q, D_MODEL, D_MODEL, WQT, scr, r, lane); continue; } r -= I_Q;
            { const int gpl = r >> 3; p0_transpose_item(w_pool + (size_t)gpl * 16384, 128, 128, WPT + (size_t)gpl * 16384, scr, r & 7, lane); }
        }
        cvt_stream<false>(x_in, XB, (size_t)MTOK * D_MODEL, gw, NGW, lane);
        cvt_stream<false>(mem_in, MEMB, (size_t)MMEM * D_MODEL, gw, NGW, lane);
        cvt_stream<false>(sk1, K1B, (size_t)NKEYS * 128, gw, NGW, lane);
        cvt_stream<false>(sk2, K2B, (size_t)NKEYS * 128, gw, NGW, lane);
        for (int i = gw * 64 + lane; i < MTOK * 8; i += NGW * 64) { float c, s; rope_cs(positions[i >> 3], i & 7, c, s); *(f32x2*)(ROPE + 2 * (size_t)i) = (f32x2){c, s}; }
    }
    SEAM(0);
    if (IN(1)) REP(1) {
        { pg8::Gemm g{XB, WINT, MTOK, IN_W, D_MODEL}; pg8::StaticOrder S; S.init(MTOK, IN_W, G, bx);
          EpiIn E{POOLV, Q, Kb, Vb, QM, ROPE};
          pg8::gemm_phase<EpiIn, pg8::StaticOrder, true, true>(lds, g, S, E); }
        { pg8::Gemm g{MEMB, WKVT, MMEM, 2 * MEM_W, D_MODEL}; pg8::StaticOrder S; S.init(MMEM, 2 * MEM_W, G, (bx + G - 64) % G);
          EpiStoreBf E{KVM, 2 * MEM_W};
          pg8::gemm_phase<EpiStoreBf, pg8::StaticOrder, true, true>(lds, g, S, E); }
        { const int f0 = (G == 256) ? 72 : 0;
          if (bx >= f0) { const int fw = (bx - f0) * NWAVES + wave, NFW = (G - f0) * NWAVES;
            for (int r = fw; r < 2 * NEXP; r += NFW) { if (r < NEXP) cvt_row_fp8(eu, U8, SU, r, lane); else cvt_row_fp8(ev, V8, SV, r - NEXP, lane); } } }
    }
    SEAM(1);
    if (IN(2)) REP(2) {
        for (int it = vcu; it < 512; it += G) {
            if (it < 256) swa_item(lds, it, Q, Kb, Vb, sinks, CONCAT, tid, wave, lane);
            else mem_item(lds, it - 256, QM, KVM, CONCAT, tid, wave, lane);
        }
        for (int it = gw; it < (MTOK / 16) * 4; it += NGW) pool_item(it, POOLV, WPT, pool_scale, CONCAT, lane);
    }
    SEAM(2);
    if (IN(3)) REP(3) {
        pg8::Gemm g{CONCAT, WOT, MTOK, D_MODEL, D_MODEL}; pg8::StaticOrder S; S.init(MTOK, D_MODEL, G, bx);
        EpiY1 E{x_in, Y1};
        pg8::gemm_phase<EpiY1, pg8::StaticOrder, true, true>(lds, g, S, E);
    }
    SEAM(3);
    if (IN(4)) REP(4) { for (int r = gw; r < MTOK; r += NGW) ln1_row(Y1 + (size_t)r * D_MODEL, ln1_g, ln1_b, X1 + (size_t)r * D_MODEL, X1B + (size_t)r * D_MODEL, lane); }
    SEAM(4);
    if (IN(5)) REP(5) {
        pg8::Gemm g{X1B, WQT, MTOK, D_MODEL, D_MODEL}; pg8::StaticOrder S; S.init(MTOK, D_MODEL, G, bx);
        EpiStoreBf E{QP, D_MODEL};
        pg8::gemm_phase<EpiStoreBf, pg8::StaticOrder, true, true>(lds, g, S, E);
    }
    SEAM(5);
    if (IN(6)) REP(6) { for (int it = gw; it < (MTOK / 16) * PHEADS; it += NGW) topk_item(it, QP, K1B, K2B, EIDX, GATE, lane); }
    SEAM(6);
    if (IN(7)) REP(7) { for (int t = gw; t < MTOK; t += NGW) gather_token(t, X1, X1B, EIDX, GATE, U8, V8, SU, SV, ln2_g, ln2_b, args.out, lane); }
#undef IN
#undef SEAM
}
#undef P_IN(T,
#undef P_WS(T,
#undef x_in
#undef mem_in
#undef positions
#undef w_in
#undef w_mem_kv
#undef w_pool
#undef pool_scale
#undef sinks
#undef w_out
#undef ln1_g
#undef ln1_b
#undef w_peer_q
#undef sk1
#undef sk2
#undef eu
#undef ev
#undef ln2_g
#undef ln2_b
#undef WINT
#undef WKVT
#undef WOT
#undef WQT
#undef WPT
#undef K1B
#undef K2B
#undef ROPE
#undef XB
#undef X1B
#undef MEMB
#undef KVM
#undef POOLV
#undef Q
#undef Kb
#undef Vb
#undef QM
#undef CONCAT
#undef Y1
#undef X1
#undef QP
#undef EIDX
#undef GATE
#undef U8
#undef V8
#undef SU
#undef SV

#if NAIVE_MASK != 0
__device__ __forceinline__ float toF(float v) { return v; }
__device__ __forceinline__ float toF(bf16_t v) { return bf2f(v); }

struct NvEpiF32 { float* C; int ldc, pad; __device__ void operator()(int r, int c, float v) const { C[(size_t)r * ldc + c] = v; } };
struct NvEpiBf { bf16_t* C; int ldc, pad; __device__ void operator()(int r, int c, float v) const { C[(size_t)r * ldc + c] = f2bf(v); } };
struct NvEpiY1 { const float* x; float* y; __device__ void operator()(int r, int c, float v) const { y[(size_t)r * D_MODEL + c] = ALPHA * x[(size_t)r * D_MODEL + c] + v; } };

template <class TA, class Epi>
__global__ void __launch_bounds__(256) nv_gemm(const TA* __restrict__ A, const float* __restrict__ B, int M, int N, int K, Epi epi) {
    __shared__ float As[16][65];
    __shared__ float Bs[16][64];
    const int tx = threadIdx.x & 15, ty = threadIdx.x >> 4;
    const int m0 = blockIdx.y * 64, n0 = blockIdx.x * 64;
    float acc[4][4];
#pragma unroll
    for (int i = 0; i < 4; ++i)
#pragma unroll
        for (int j = 0; j < 4; ++j) acc[i][j] = 0.f;
    for (int k0 = 0; k0 < K; k0 += 16) {
        for (int i = threadIdx.x; i < 1024; i += 256) { const int r = i >> 4, c = i & 15; As[c][r] = toF(A[(size_t)(m0 + r) * K + k0 + c]); }
        for (int i = threadIdx.x; i < 1024; i += 256) { const int r = i >> 6, c = i & 63; Bs[r][c] = B[(size_t)(k0 + r) * N + n0 + c]; }
        __syncthreads();
#pragma unroll
        for (int kk = 0; kk < 16; ++kk) {
            float a[4], b[4];
#pragma unroll
            for (int i = 0; i < 4; ++i) { a[i] = As[kk][ty * 4 + i]; b[i] = Bs[kk][tx * 4 + i]; }
#pragma unroll
            for (int i = 0; i < 4; ++i)
#pragma unroll
                for (int j = 0; j < 4; ++j) acc[i][j] += a[i] * b[j];
        }
        __syncthreads();
    }
#pragma unroll
    for (int i = 0; i < 4; ++i)
#pragma unroll
        for (int j = 0; j < 4; ++j) epi(m0 + ty * 4 + i, n0 + tx * 4 + j, acc[i][j]);
}

__global__ void nv_post1(const float* __restrict__ H, const int* __restrict__ positions, float* POOLV, bf16_t* Q, bf16_t* Kb, bf16_t* Vb, bf16_t* QM) {
    const size_t gid = (size_t)blockIdx.x * blockDim.x + threadIdx.x;
    if (gid >= (size_t)MTOK * IN_W) return;
    const int t = (int)(gid / IN_W), col = (int)(gid % IN_W);
    const float* hr = H + (size_t)t * IN_W;
    const float v = hr[col];
    if (col < POOL_W) { POOLV[(size_t)t * POOL_W + col] = v; return; }
    if (col < POOL_W + SWA_W + KV_W) {
        const bool isq = col < POOL_W + SWA_W;
        const int c = isq ? col - POOL_W : col - POOL_W - SWA_W;
        const int d = c & 63;
        float o = v;
        if (d < 16) {
            const int j = d & 7; float cs, sn; rope_cs(positions[t], j, cs, sn);
            if (d < 8) o = v * cs - hr[col + 8] * sn; else o = v * cs + hr[col - 8] * sn;
        }
        if (isq) Q[(size_t)t * SWA_W + c] = f2bf(o); else Kb[(size_t)t * KV_W + c] = f2bf(o);
        return;
    }
    if (col < POOL_W + SWA_W + 2 * KV_W) { Vb[(size_t)t * KV_W + (col - POOL_W - SWA_W - KV_W)] = f2bf(v); return; }
    QM[(size_t)t * MEM_W + (col - POOL_W - SWA_W - 2 * KV_W)] = f2bf(v);
}
__global__ void nv_cvt_bf16(const float* __restrict__ in, bf16_t* out, size_t n) {
    const size_t gid = (size_t)blockIdx.x * blockDim.x + threadIdx.x;
    if (gid < n) out[gid] = f2bf(in[gid]);
}
__global__ void nv_pool1(const float* __restrict__ POOLV, float* PS) {
    const size_t gid = (size_t)blockIdx.x * blockDim.x + threadIdx.x;
    if (gid >= (size_t)MTOK * POOL_W) return;
    const int t = (int)(gid / POOL_W), ch = (int)(gid % POOL_W);
    const int g = ch >> 7, w = 2 << g, s = t & (SEQ - 1);
    const int cnt = (s + 1) < w ? (s + 1) : w;
    float sum = 0.f;
    for (int i = 0; i < cnt; ++i) sum += POOLV[(size_t)(t - i) * POOL_W + ch];
    PS[gid] = sum / (float)cnt - POOLV[gid];
}
__global__ void nv_pool2(const float* __restrict__ PS, const float* __restrict__ w_pool, const float* __restrict__ pool_scale, bf16_t* CONCAT) {
    const size_t gid = (size_t)blockIdx.x * blockDim.x + threadIdx.x;
    if (gid >= (size_t)MTOK * POOL_W) return;
    const int t = (int)(gid / POOL_W), ch = (int)(gid % POOL_W);
    const int g = ch >> 7, d = ch & 127;
    const float* p = PS + (size_t)t * POOL_W + g * 128;
    const float* w = w_pool + (size_t)g * 128 * 128 + d;
    float y = 0.f;
    for (int c = 0; c < 128; ++c) y += p[c] * w[(size_t)c * 128];
    CONCAT[(size_t)t * D_MODEL + ch] = f2bf(y * pool_scale[ch]);
}
__global__ void __launch_bounds__(256) nv_swa(const bf16_t* __restrict__ Q, const bf16_t* __restrict__ Kb, const bf16_t* __restrict__ Vb, const float* __restrict__ sinks, bf16_t* CONCAT) {
    const int wv = (int)((blockIdx.x * 256 + threadIdx.x) >> 6), lane = threadIdx.x & 63;
    if (wv >= MTOK * NHEAD) return;
    const int t = wv / NHEAD, h = wv % NHEAD, kvh = h >> 2, s = t & (SEQ - 1), tb = t - s;
    const float q = bf2f(Q[(size_t)t * SWA_W + h * HD + lane]);
    float m = sinks[h], l = 1.0f, o = 0.f;
    const int k0 = s - (WINDOW - 1) < 0 ? 0 : s - (WINDOW - 1);
    for (int kk = k0; kk <= s; ++kk) {
        const size_t kt = (size_t)(tb + kk);
        const float sc = wave_sum(q * bf2f(Kb[kt * KV_W + kvh * HD + lane])) * 0.125f;
        const float mn = fmaxf(m, sc), r = expf(m - mn), p = expf(sc - mn);
        l = l * r + p; o = o * r + p * bf2f(Vb[kt * KV_W + kvh * HD + lane]); m = mn;
    }
    CONCAT[(size_t)t * D_MODEL + POOL_W + h * HD + lane] = f2bf(o / l);
}
__global__ void __launch_bounds__(256) nv_mem(const bf16_t* __restrict__ QM, const bf16_t* __restrict__ KVM, bf16_t* CONCAT) {
    const int wv = (int)((blockIdx.x * 256 + threadIdx.x) >> 6), lane = threadIdx.x & 63;
    if (wv >= MTOK * MHEADS) return;
    const int t = wv / MHEADS, hm = wv % MHEADS, b = t / SEQ;
    const float q0 = bf2f(QM[(size_t)t * MEM_W + hm * MHD + lane]), q1 = bf2f(QM[(size_t)t * MEM_W + hm * MHD + 64 + lane]);
    float m = -1e30f, l = 0.f, o0 = 0.f, o1 = 0.f;
    const float scale = 0.08838834764831845f;
    for (int j = 0; j < MEM_LEN; ++j) {
        const bf16_t* kr = KVM + (size_t)(b * MEM_LEN + j) * (2 * MEM_W) + hm * MHD;
        const bf16_t* vr = kr + MEM_W;
        const float sc = wave_sum(q0 * bf2f(kr[lane]) + q1 * bf2f(kr[64 + lane])) * scale;
        const float mn = fmaxf(m, sc), r = expf(m - mn), p = expf(sc - mn);
        l = l * r + p; o0 = o0 * r + p * bf2f(vr[lane]); o1 = o1 * r + p * bf2f(vr[64 + lane]); m = mn;
    }
    bf16_t* orow = CONCAT + (size_t)t * D_MODEL + POOL_W + SWA_W + hm * MHD;
    orow[lane] = f2bf(o0 / l); orow[64 + lane] = f2bf(o1 / l);
}
__global__ void __launch_bounds__(256) nv_ln(const float* __restrict__ in, const float* __restrict__ g, const float* __restrict__ bta, float* outf, bf16_t* outb) {
    const int row = (int)((blockIdx.x * 256 + threadIdx.x) >> 6), lane = threadIdx.x & 63;
    if (row >= MTOK) return;
    const float* r = in + (size_t)row * D_MODEL;
    float v[32]; float s = 0.f;
#pragma unroll
    for (int i = 0; i < 32; ++i) { v[i] = r[lane + 64 * i]; s += v[i]; }
    const float mean = wave_sum(s) * (1.f / D_MODEL); float q = 0.f;
#pragma unroll
    for (int i = 0; i < 32; ++i) { v[i] -= mean; q += v[i] * v[i]; }
    const float rstd = 1.0f / sqrtf(wave_sum(q) * (1.f / D_MODEL) + LN_EPS);
#pragma unroll
    for (int i = 0; i < 32; ++i) {
        const int c = lane + 64 * i; const float y = v[i] * rstd * g[c] + bta[c];
        if (outf) outf[(size_t)row * D_MODEL + c] = y;
        if (outb) outb[(size_t)row * D_MODEL + c] = f2bf(y);
    }
}
__global__ void __launch_bounds__(32) nv_topk(const bf16_t* __restrict__ QP, const float* __restrict__ K1, const float* __restrict__ K2, int* EIDX, float* GATE) {
    __shared__ float sc[256][32];
    __shared__ float lv[32][32];
    __shared__ int li[32][32];
    const int tid = threadIdx.x, gid = blockIdx.x * 32 + tid;
    const int t = gid / PHEADS, h = gid % PHEADS;
    const bf16_t* q = QP + (size_t)t * D_MODEL + h * 256;
    for (int half = 0; half < 2; ++half) {
        const float* Kk = half ? K2 : K1;
        for (int k = 0; k < NKEYS; ++k) {
            float a = 0.f;
            for (int c = 0; c < 128; ++c) a += bf2f(q[half * 128 + c]) * Kk[k * 128 + c];
            sc[half * 128 + k][tid] = a;
        }
        for (int r = 0; r < TOPK; ++r) {
            float best = -INFINITY; int bi = 0;
            for (int k = 0; k < NKEYS; ++k) { const float v = sc[half * 128 + k][tid]; if (v > best) { best = v; bi = k; } }
            lv[half * 16 + r][tid] = best; li[half * 16 + r][tid] = bi; sc[half * 128 + bi][tid] = -INFINITY;
        }
    }
    for (int a = 0; a < 16; ++a) for (int b = 0; b < 16; ++b) sc[a * 16 + b][tid] = lv[a][tid] + lv[16 + b][tid];
    float mx = 0.f, den = 0.f;
    float tv[16]; int ti[16];
#pragma unroll
    for (int r = 0; r < TOPK; ++r) {
        float best = -INFINITY; int bi = 0;
        for (int k = 0; k < 256; ++k) { const float v = sc[k][tid]; if (v > best) { best = v; bi = k; } }
        sc[bi][tid] = -INFINITY;
        if (r == 0) mx = best;
        tv[r] = expf(best - mx); den += tv[r]; ti[r] = li[bi >> 4][tid] * NKEYS + li[16 + (bi & 15)][tid];
    }
#pragma unroll
    for (int r = 0; r < TOPK; ++r) { EIDX[(size_t)t * EPT + h * TOPK + r] = ti[r]; GATE[(size_t)t * EPT + h * TOPK + r] = tv[r] / den; }
}
__global__ void __launch_bounds__(256) nv_gather(const float* __restrict__ X1, const int* __restrict__ EIDX, const float* __restrict__ GATE, const float* __restrict__ EU, const float* __restrict__ EV,
                                                  const float* __restrict__ g, const float* __restrict__ bta, float* out) {
    const int t = (int)((blockIdx.x * 256 + threadIdx.x) >> 6), lane = threadIdx.x & 63;
    if (t >= MTOK) return;
    float x[32], acc[32];
#pragma unroll
    for (int i = 0; i < 32; ++i) { x[i] = X1[(size_t)t * D_MODEL + lane + 64 * i]; acc[i] = 0.f; }
    for (int e = 0; e < EPT; ++e) {
        const int id = EIDX[(size_t)t * EPT + e]; const float gt = GATE[(size_t)t * EPT + e];
        const float* u = EU + (size_t)id * D_MODEL; const float* vv = EV + (size_t)id * D_MODEL;
        float p = 0.f;
#pragma unroll
        for (int i = 0; i < 32; ++i) p += x[i] * u[lane + 64 * i];
        const float a = gt * gelu_erf(wave_sum(p));
#pragma unroll
        for (int i = 0; i < 32; ++i) acc[i] += a * vv[lane + 64 * i];
    }
    float s = 0.f;
#pragma unroll
    for (int i = 0; i < 32; ++i) { acc[i] = ALPHA * x[i] + acc[i]; s += acc[i]; }
    const float mean = wave_sum(s) * (1.f / D_MODEL); float q = 0.f;
#pragma unroll
    for (int i = 0; i < 32; ++i) { acc[i] -= mean; q += acc[i] * acc[i]; }
    const float rstd = 1.0f / sqrtf(wave_sum(q) * (1.f / D_MODEL) + LN_EPS);
#pragma unroll
    for (int i = 0; i < 32; ++i) { const int c = lane + 64 * i; out[(size_t)t * D_MODEL + c] = acc[i] * rstd * g[c] + bta[c]; }
}

#endif
extern "C" void kernel_launch(void* const* d_in, const int* in_sizes, int n_in, void* d_out, int out_size, void* d_ws, size_t ws_size, hipStream_t stream) {
    static int grid = 0;
    if (grid == 0) {
        if (n_in != 18 || in_sizes[0] != MTOK * D_MODEL || out_size != MTOK * D_MODEL || ws_size < WS_END) {
            fprintf(stderr, "kernel_launch: unexpected shapes (n_in %d, in0 %d, out %d, ws %zu)\n", n_in, n_in > 0 ? in_sizes[0] : -1, out_size, ws_size); grid = -1; return; }
        int dev = 0, cus = 0, per_cu = 0;
        if (hipGetDevice(&dev) != hipSuccess || hipDeviceGetAttribute(&cus, hipDeviceAttributeMultiprocessorCount, dev) != hipSuccess) { fprintf(stderr, "kernel_launch: device query failed\n"); grid = -1; return; }
        if (hipFuncSetAttribute((const void*)mega_fwd, hipFuncAttributeMaxDynamicSharedMemorySize, LDS_BYTES) != hipSuccess) { fprintf(stderr, "kernel_launch: hipFuncSetAttribute failed\n"); grid = -1; return; }
        if (hipOccupancyMaxActiveBlocksPerMultiprocessor(&per_cu, (const void*)mega_fwd, NTHREADS, LDS_BYTES) != hipSuccess || per_cu < 1) {
            fprintf(stderr, "kernel_launch: occupancy query reports %d workgroups per CU\n", per_cu); (void)hipGetLastError(); grid = -1; return; }
        grid = cus;
    }
    if (grid < 0) return;
    unsigned char* ws = (unsigned char*)d_ws;
    (void)hipMemsetAsync(ws + WS_CTL, 0, 1 * MiB, stream);
    Args a{};
    for (int i = 0; i < 18; ++i) a.in[i] = d_in[i];
    a.out = (float*)d_out; a.ws = ws;
#if NAIVE_MASK != 0
    const float* x = (const float*)d_in[0]; const float* mem = (const float*)d_in[1]; const int* positions = (const int*)d_in[2];
    const float* w_in = (const float*)d_in[3]; const float* w_mem_kv = (const float*)d_in[4]; const float* w_pool = (const float*)d_in[5];
    const float* pool_scale = (const float*)d_in[6]; const float* sinks = (const float*)d_in[7]; const float* w_out = (const float*)d_in[8];
    const float* ln1_g = (const float*)d_in[9]; const float* ln1_b = (const float*)d_in[10]; const float* w_peer_q = (const float*)d_in[11];
    const float* sk1 = (const float*)d_in[12]; const float* sk2 = (const float*)d_in[13]; const float* eu = (const float*)d_in[14]; const float* ev = (const float*)d_in[15];
    const float* ln2_g = (const float*)d_in[16]; const float* ln2_b = (const float*)d_in[17];
    float* out = (float*)d_out;
    float* POOLV = (float*)(ws + WS_POOLV); bf16_t* Q = (bf16_t*)(ws + WS_Q); bf16_t* Kb = (bf16_t*)(ws + WS_K); bf16_t* Vb = (bf16_t*)(ws + WS_V); bf16_t* QM = (bf16_t*)(ws + WS_QM);
    bf16_t* KVM = (bf16_t*)(ws + WS_KVM); bf16_t* CONCAT = (bf16_t*)(ws + WS_CONCAT); float* Y1 = (float*)(ws + WS_Y1); float* X1 = (float*)(ws + WS_X1); bf16_t* X1B = (bf16_t*)(ws + WS_X1B);
    bf16_t* QP = (bf16_t*)(ws + WS_QP); int* EIDX = (int*)(ws + WS_EIDX); float* GATE = (float*)(ws + WS_GATE);
    float* NVH = (float*)(ws + WS_NV_H); float* NVPS = (float*)(ws + WS_NV_PS); float* NVKVM = (float*)(ws + WS_NV_KVM);
#endif
    int li = 0;
    for (int p = 0; p < N_PHASES;) {
#if NAIVE_MASK != 0
        if ((NAIVE_MASK >> p) & 1) {
            switch (p) {
            case 1:
                nv_gemm<float, NvEpiF32><<<dim3(IN_W / 64, MTOK / 64), 256, 0, stream>>>(x, w_in, MTOK, IN_W, D_MODEL, NvEpiF32{NVH, IN_W, 0});
                nv_gemm<float, NvEpiF32><<<dim3(2 * MEM_W / 64, MMEM / 64), 256, 0, stream>>>(mem, w_mem_kv, MMEM, 2 * MEM_W, D_MODEL, NvEpiF32{NVKVM, 2 * MEM_W, 0});
                nv_post1<<<(unsigned)(((size_t)MTOK * IN_W + 255) / 256), 256, 0, stream>>>(NVH, positions, POOLV, Q, Kb, Vb, QM);
                nv_cvt_bf16<<<(MMEM * 2 * MEM_W + 255) / 256, 256, 0, stream>>>(NVKVM, KVM, (size_t)MMEM * 2 * MEM_W);
                break;
            case 2:
                nv_pool1<<<MTOK * POOL_W / 256, 256, 0, stream>>>(POOLV, NVPS);
                nv_pool2<<<MTOK * POOL_W / 256, 256, 0, stream>>>(NVPS, w_pool, pool_scale, CONCAT);
                nv_swa<<<MTOK * NHEAD / 4, 256, 0, stream>>>(Q, Kb, Vb, sinks, CONCAT);
                nv_mem<<<MTOK * MHEADS / 4, 256, 0, stream>>>(QM, KVM, CONCAT);
                break;
            case 3: nv_gemm<bf16_t, NvEpiY1><<<dim3(D_MODEL / 64, MTOK / 64), 256, 0, stream>>>(CONCAT, w_out, MTOK, D_MODEL, D_MODEL, NvEpiY1{x, Y1}); break;
            case 4: nv_ln<<<MTOK / 4, 256, 0, stream>>>(Y1, ln1_g, ln1_b, X1, X1B); break;
            case 5: nv_gemm<float, NvEpiBf><<<dim3(D_MODEL / 64, MTOK / 64), 256, 0, stream>>>(X1, w_peer_q, MTOK, D_MODEL, D_MODEL, NvEpiBf{QP, D_MODEL, 0}); break;
            case 6: nv_topk<<<MTOK * PHEADS / 32, 32, 0, stream>>>(QP, sk1, sk2, EIDX, GATE); break;
            case 7: nv_gather<<<MTOK / 4, 256, 0, stream>>>(X1, EIDX, GATE, eu, ev, ln2_g, ln2_b, out); break;
            default: break;
            }
            ++p; continue;
        }
#endif
        int q = p;
        while (q < N_PHASES && !((NAIVE_MASK >> q) & 1)) ++q;
        a.ph_lo = p; a.ph_hi = q; a.li = li++;
        hipLaunchKernelGGL(mega_fwd, dim3(grid), dim3(NTHREADS), LDS_BYTES, stream, a);
        const hipError_t le = hipPeekAtLastError();
        if (le != hipSuccess) { fprintf(stderr, "kernel_launch: launch failed: %s\n", hipGetErrorName(le)); break; }
        p = q;
    }
#ifdef PROBE_EXTRA_LO
    a.ph_lo = PROBE_EXTRA_LO; a.ph_hi = PROBE_EXTRA_HI; a.li = li++;
    hipLaunchKernelGGL(mega_fwd, dim3(grid), dim3(NTHREADS), LDS_BYTES, stream, a);
#endif
}
```

```cpp
#include <hip/hip_runtime.h>
#include <cstdint>
#include <cstdio>
#ifndef NAIVE_MASK
#define NAIVE_MASK 0
#endif

constexpr int D_MODEL = 2048, BATCH = 2, SEQ = 4096, MTOK = BATCH * SEQ, MEM_LEN = 256, MMEM = BATCH * MEM_LEN;
constexpr int POOL_W = 512, SWA_W = 1024, KV_W = 256, MEM_W = 512, IN_W = 2560;
constexpr int NHEAD = 16, NKV = 4, HD = 64, WINDOW = 128, MHEADS = 4, MHD = 128;
constexpr int PHEADS = 8, NKEYS = 128, TOPK = 16, NEXP = NKEYS * NKEYS, EPT = PHEADS * TOPK;
constexpr float ALPHA = 1.18920711500272106672f;
constexpr float LN_EPS = 1e-5f;

typedef unsigned short bf16_t;
__device__ __forceinline__ float bf2f(bf16_t v) { return __uint_as_float((unsigned)v << 16); }
__device__ __forceinline__ bf16_t f2bf(float f) { unsigned u = __float_as_uint(f); return (bf16_t)((u + 0x7fffu + ((u >> 16) & 1u)) >> 16); }

constexpr size_t MiB = 1u << 20;
constexpr size_t WS_CTL = 0, WS_WINT = 1 * MiB, WS_WKVT = 11 * MiB, WS_WOT = 15 * MiB, WS_WQT = 23 * MiB, WS_SMALL = 31 * MiB;
constexpr size_t WS_XB = 32 * MiB, WS_X1B = 32 * MiB  , WS_MEMB = 64 * MiB, WS_KVM = 66 * MiB;
constexpr size_t WS_POOLV = 68 * MiB, WS_Q = 84 * MiB, WS_K = 100 * MiB, WS_V = 104 * MiB, WS_QM = 108 * MiB, WS_CONCAT = 116 * MiB;
constexpr size_t WS_Y1 = 148 * MiB, WS_X1 = 212 * MiB, WS_QP = 276 * MiB, WS_EIDX = 308 * MiB, WS_GATE = 312 * MiB, WS_UB = 316 * MiB, WS_VB = 380 * MiB, WS_END = 444 * MiB;
constexpr size_t WS_NV_H = 148 * MiB  , WS_NV_PS = 232 * MiB, WS_NV_KVM = 248 * MiB;

__device__ __forceinline__ void rope_cs(int pos, int j, float& c, float& s) {
    const double invf[8] = {1.0, 0.19392274474868576, 0.03760603093086393, 0.007292664737217109, 0.001414213562373095, 0.0002742481756762073, 5.318295896944988e-05, 1.031338537721246e-05};
    double f = j == 0 ? invf[0] : j == 1 ? invf[1] : j == 2 ? invf[2] : j == 3 ? invf[3] : j == 4 ? invf[4] : j == 5 ? invf[5] : j == 6 ? invf[6] : invf[7];
    double rev = (double)pos * f * 0.15915494309189533577;
    rev -= floor(rev);
    float fr = (float)rev;
    s = __builtin_amdgcn_sinf(fr); c = __builtin_amdgcn_cosf(fr);
}
__device__ __forceinline__ float gelu_erf(float h) { return 0.5f * h * (1.0f + erff(h * 0.70710678118654752440f)); }
__device__ __forceinline__ float wave_sum(float v) {
#pragma unroll
    for (int o = 1; o < 64; o <<= 1) v += __shfl_xor(v, o);
    return v;
}

namespace pg8 {
#define PG8_LAS __attribute__((address_space(3)))
typedef unsigned short bf16_t;
typedef short bf16x8 __attribute__((ext_vector_type(8)));
typedef float f32x4 __attribute__((ext_vector_type(4)));
typedef unsigned u32x4 __attribute__((ext_vector_type(4)));
constexpr int BM = 256, BK = 64, HALF = 128, HTB = HALF * BK * 2  , STAGE_BYTES = 8 * HTB, NXCD = 8, WGM = 8;

__host__ __device__ __forceinline__ int lds_byte(int r, int c) { const int st = (r >> 4) * 2 + (c >> 5), rr = r & 15, cc = c & 31, ob = rr * 64 + cc * 2; return st * 1024 + (ob ^ (((ob >> 9) & 1) << 5)); }
__host__ __device__ __forceinline__ void stage_rc(int b, int& R, int& C) { const int st = b / 1024, sb = b % 1024, swz = sb ^ (((sb >> 9) & 1) << 5); R = (st >> 1) * 16 + swz / 64; C = (st & 1) * 32 + (swz % 64) / 2; }
__host__ __device__ __forceinline__ int perm32(int rho) { const int n = rho >> 4, i = rho & 15; return 8 * (i >> 2) + 4 * n + (i & 3); }

struct Unit { int pm, pn; };
struct Gemm { const bf16_t* A; const bf16_t* Bt; int M, N, K; };

struct StaticOrder {
    int nM, nN, nwg, G, c;
    __host__ __device__ void init(int M, int N, int G_, int c_) { nM = M / BM; nN = N / BM; nwg = nM * nN; G = G_; c = c_; }
    __host__ __device__ bool next(int i, Unit& u) const {
        const long L = (long)i * G + c; if (L >= nwg) return false;
        int wgid = (int)L; { const int q = nwg / NXCD, r = nwg % NXCD, xcd = wgid % NXCD, off = wgid / NXCD; wgid = (xcd < r ? xcd * (q + 1) : r * (q + 1) + (xcd - r) * q) + off; }
        const int nig = WGM * nN, gid = wgid / nig, fm = gid * WGM, gsz = (nM - fm) < WGM ? (nM - fm) : WGM;
        u.pm = fm + ((wgid % nig) % gsz); u.pn = (wgid % nig) / gsz; return true;
    }
    __device__ __forceinline__ void a_ready(const Unit&) const {}
    __device__ __forceinline__ void done(const Unit&) const {}
};

__device__ __forceinline__ unsigned cvt_pk_bf16(float lo, float hi) { unsigned r; asm volatile("v_cvt_pk_bf16_f32 %0, %1, %2" : "=v"(r) : "v"(lo), "v"(hi)); return r; }
template <class Epi, class Sched, bool ALIGN_EPI = false, bool SP2 = false>
__device__ __forceinline__ void gemm_phase(PG8_LAS unsigned char* lds, const Gemm g, const Sched& S, const Epi& E) {
    const int tid = threadIdx.x, wid = __builtin_amdgcn_readfirstlane(tid >> 6), lane = tid & 63, wr = wid >> 2, wc = wid & 3, fr = lane & 15, fq = lane >> 4;
    const int K = g.K, nt = K / BK;
    unsigned voffA[2], voffB[2];
#pragma unroll
    for (int i = 0; i < 2; ++i) { int R, C; stage_rc(tid * 16 + i * 8192, R, C); const int Rb = Epi::PERM ? ((R & ~31) + perm32(R & 31)) : R;
        voffA[i] = (unsigned)(R * K + C) * 2u; voffB[i] = (unsigned)(Rb * K + C) * 2u; }
    const size_t kstep = (size_t)(BK * 2);
    const size_t hstep = (size_t)HALF * K * 2;
    const size_t tstep = 2 * hstep;
    const unsigned ldsw = (unsigned)wid * 1024u;
    const int aoff = lds_byte(wr * 64 + fr, fq * 8), boff = lds_byte(wc * 32 + fr, fq * 8);
#define PG8_SA(b, h) (((b) * 2 + (h)) * HTB)
#define PG8_SB(b, h) ((4 + (b) * 2 + (h)) * HTB)
#define PG8_STAGE(bufoff, gbase, voff) do { _Pragma("unroll") for (int _i = 0; _i < 2; ++_i) \
        __builtin_amdgcn_global_load_lds((const unsigned*)((const char*)(gbase) + (voff)[_i]), (PG8_LAS unsigned*)(lds + (bufoff) + ldsw + _i * 8192), 16, 0, 0); } while (0)
#define PG8_LDA(dst, b, h) do { _Pragma("unroll") for (int m = 0; m < 4; ++m) _Pragma("unroll") for (int k = 0; k < 2; ++k) dst[m][k] = *(const PG8_LAS bf16x8*)(lds + PG8_SA(b, h) + aoff + m * 2048 + k * 1024); } while (0)
#define PG8_LDB(dst, b, h) do { _Pragma("unroll") for (int n = 0; n < 2; ++n) _Pragma("unroll") for (int k = 0; k < 2; ++k) dst[n][k] = *(const PG8_LAS bf16x8*)(lds + PG8_SB(b, h) + boff + n * 2048 + k * 1024); } while (0)
#define PG8_MMA(ai, bj, At, Bt) do { __builtin_amdgcn_s_setprio(1); _Pragma("unroll") for (int m = 0; m < 4; ++m) _Pragma("unroll") for (int n = 0; n < 2; ++n) _Pragma("unroll") for (int k = 0; k < 2; ++k) \
        acc[ai][bj][m][n] = __builtin_amdgcn_mfma_f32_16x16x32_bf16(Bt[n][k], At[m][k], acc[ai][bj][m][n], 0, 0, 0); __builtin_amdgcn_s_setprio(0); } while (0)
#define PG8_WAIT_V(n) asm volatile("s_waitcnt vmcnt(" #n ")" ::: "memory")
#define PG8_WAIT_L(n) asm volatile("s_waitcnt lgkmcnt(" #n ")" ::: "memory")
#define PG8_BAR __builtin_amdgcn_s_barrier()
#define PG8_SCHED __builtin_amdgcn_sched_barrier(0)
    Unit cur, nxt; int ui = 0;
    if (!S.next(0, cur)) return;
    f32x4 acc[2][2][4][2];
#pragma unroll
    for (int a = 0; a < 2; ++a)
#pragma unroll
        for (int b = 0; b < 2; ++b)
#pragma unroll
            for (int m = 0; m < 4; ++m)
#pragma unroll
                for (int n = 0; n < 2; ++n) acc[a][b][m][n] = (f32x4){0.f, 0.f, 0.f, 0.f};
    bf16x8 At[4][2], B0[2][2], B1[2][2];
    const char* cA = (const char*)g.A + (size_t)cur.pm * tstep; const char* cB = (const char*)g.Bt + (size_t)cur.pn * tstep;
    S.a_ready(cur);
    if constexpr (SP2) {
        PG8_STAGE(PG8_SB(0, 0), cB, voffB); PG8_STAGE(PG8_SB(0, 1), cB + hstep, voffB); PG8_STAGE(PG8_SA(0, 0), cA, voffA); PG8_STAGE(PG8_SA(0, 1), cA + hstep, voffA);
        if (wr == 1) PG8_BAR;
        PG8_WAIT_V(2); PG8_BAR;
        PG8_STAGE(PG8_SB(1, 0), cB + kstep, voffB); PG8_STAGE(PG8_SA(1, 0), cA + kstep, voffA); PG8_STAGE(PG8_SB(1, 1), cB + hstep + kstep, voffB);
        PG8_WAIT_V(6); PG8_BAR;
    } else {
        PG8_STAGE(PG8_SB(0, 0), cB, voffB); PG8_STAGE(PG8_SA(0, 0), cA, voffA); PG8_STAGE(PG8_SB(0, 1), cB + hstep, voffB); PG8_STAGE(PG8_SA(0, 1), cA + hstep, voffA);
        if (wr == 1) PG8_BAR;
        PG8_WAIT_V(4); PG8_BAR;
        PG8_STAGE(PG8_SB(1, 0), cB + kstep, voffB); PG8_STAGE(PG8_SA(1, 0), cA + kstep, voffA); PG8_STAGE(PG8_SB(1, 1), cB + hstep + kstep, voffB);
        PG8_WAIT_V(6); PG8_BAR;
    }
    for (;;) {
        const bool has_next = S.next(ui + 1, nxt);
        const char* nA = has_next ? (const char*)g.A + (size_t)nxt.pm * tstep : cA; const char* nB = has_next ? (const char*)g.Bt + (size_t)nxt.pn * tstep : cB;
        for (int t = 0; t < nt; t += 2) {
            const bool last = (t == nt - 2);
            const char* a1 = cA + (size_t)(t + 1) * kstep;
            const char* a2 = last ? nA : cA + (size_t)(t + 2) * kstep; const char* b2 = last ? nB : cB + (size_t)(t + 2) * kstep;
            const char* a3 = a2 + kstep; const char* b3 = b2 + kstep;
            if (last && has_next) S.a_ready(nxt);
            if constexpr (SP2) {
            PG8_LDB(B0, 0, 0); PG8_LDB(B1, 0, 1); PG8_SCHED; PG8_LDA(At, 0, 0); PG8_STAGE(PG8_SA(1, 1), a1 + hstep, voffA);
            PG8_WAIT_V(8); PG8_WAIT_L(0); PG8_BAR; PG8_MMA(0, 0, At, B0); PG8_MMA(0, 1, At, B1); PG8_BAR; PG8_SCHED;
            PG8_LDA(At, 0, 1); PG8_STAGE(PG8_SB(0, 0), b2, voffB); PG8_STAGE(PG8_SB(0, 1), b2 + hstep, voffB); PG8_STAGE(PG8_SA(0, 0), a2, voffA);
            PG8_WAIT_V(8); PG8_WAIT_L(0); PG8_BAR; PG8_MMA(1, 0, At, B0); PG8_MMA(1, 1, At, B1); PG8_BAR; PG8_SCHED;
            PG8_LDB(B0, 1, 0); PG8_LDB(B1, 1, 1); PG8_SCHED; PG8_LDA(At, 1, 0); PG8_STAGE(PG8_SA(0, 1), a2 + hstep, voffA);
            PG8_WAIT_V(8); PG8_WAIT_L(0); PG8_BAR; PG8_MMA(0, 0, At, B0); PG8_MMA(0, 1, At, B1); PG8_BAR; PG8_SCHED;
            PG8_LDA(At, 1, 1); PG8_STAGE(PG8_SB(1, 0), b3, voffB); PG8_STAGE(PG8_SB(1, 1), b3 + hstep, voffB); PG8_STAGE(PG8_SA(1, 0), a3, voffA);
            PG8_WAIT_V(8); PG8_WAIT_L(0); PG8_BAR; PG8_MMA(1, 0, At, B0); PG8_MMA(1, 1, At, B1); PG8_BAR; PG8_SCHED;
            } else {
            PG8_LDB(B0, 0, 0); PG8_SCHED; PG8_LDA(At, 0, 0); PG8_STAGE(PG8_SA(1, 1), a1 + hstep, voffA);
            PG8_WAIT_L(8); PG8_BAR; PG8_WAIT_L(0); PG8_MMA(0, 0, At, B0); PG8_BAR; PG8_SCHED;
            PG8_LDB(B1, 0, 1); PG8_STAGE(PG8_SB(0, 0), b2, voffB);
            PG8_BAR; PG8_WAIT_L(0); PG8_MMA(0, 1, At, B1); PG8_BAR;
            PG8_LDA(At, 0, 1); PG8_STAGE(PG8_SA(0, 0), a2, voffA);
            PG8_BAR; PG8_WAIT_L(0); PG8_MMA(1, 0, At, B0); PG8_BAR; PG8_SCHED;
            PG8_STAGE(PG8_SB(0, 1), b2 + hstep, voffB);
            PG8_WAIT_V(6); PG8_BAR; PG8_MMA(1, 1, At, B1); PG8_BAR;
            PG8_LDB(B0, 1, 0); PG8_SCHED; PG8_LDA(At, 1, 0); PG8_STAGE(PG8_SA(0, 1), a2 + hstep, voffA);
            PG8_WAIT_L(8); PG8_BAR; PG8_WAIT_L(0); PG8_MMA(0, 0, At, B0); PG8_BAR; PG8_SCHED;
            PG8_LDB(B1, 1, 1); PG8_STAGE(PG8_SB(1, 0), b3, voffB);
            PG8_BAR; PG8_WAIT_L(0); PG8_MMA(0, 1, At, B1); PG8_BAR;
            PG8_LDA(At, 1, 1); PG8_STAGE(PG8_SA(1, 0), a3, voffA);
            PG8_BAR; PG8_WAIT_L(0); PG8_MMA(1, 0, At, B0); PG8_BAR; PG8_SCHED;
            PG8_STAGE(PG8_SB(1, 1), b3 + hstep, voffB);
            PG8_WAIT_V(6); PG8_BAR; PG8_MMA(1, 1, At, B1); PG8_BAR;
            }
        }
        if constexpr (ALIGN_EPI) { if (wr == 0) PG8_BAR; }
        if constexpr (!Epi::AFTER_DRAIN) { E(acc, cur, wr, wc, fr, fq); S.done(cur); }
        if (!has_next) break;
#pragma unroll
        for (int a = 0; a < 2; ++a)
#pragma unroll
            for (int b = 0; b < 2; ++b)
#pragma unroll
                for (int m = 0; m < 4; ++m)
#pragma unroll
                    for (int n = 0; n < 2; ++n) acc[a][b][m][n] = (f32x4){0.f, 0.f, 0.f, 0.f};
        cur = nxt; cA = nA; cB = nB; ++ui;
        if constexpr (ALIGN_EPI) { if (wr == 1) PG8_BAR; }
    }
    PG8_WAIT_V(0);
    if constexpr (!ALIGN_EPI) { if (wr == 0) PG8_BAR; }
    PG8_BAR;
    if constexpr (Epi::AFTER_DRAIN) { E.fused(acc, cur, wr, wc, fr, fq, lds, wid, lane); S.done(cur); }
#undef PG8_SA
#undef PG8_SB
#undef PG8_STAGE
#undef PG8_LDA
#undef PG8_LDB
#undef PG8_MMA
#undef PG8_WAIT_V
#undef PG8_WAIT_L
#undef PG8_BAR
#undef PG8_SCHED
}
}
#define GAS __attribute__((address_space(1)))
#define LAS __attribute__((address_space(3)))
typedef unsigned v4u __attribute__((ext_vector_type(4)));
typedef unsigned v2u __attribute__((ext_vector_type(2)));
typedef float f32x4 __attribute__((ext_vector_type(4)));
typedef float f32x2 __attribute__((ext_vector_type(2)));
typedef short bf16x8 __attribute__((ext_vector_type(8)));
typedef __bf16 bf16x2 __attribute__((ext_vector_type(2)));
constexpr int NWAVES = 8, NTHREADS = NWAVES * 64;
constexpr int LDS_BYTES = 147456, MISC_OFF = LDS_BYTES - 512;
constexpr int CW_BAR = 4096;
constexpr float LOG2E = 1.44269504088896340736f;

__device__ __forceinline__ unsigned cvtpk(float lo, float hi) { f32x2 v = {lo, hi}; bf16x2 b = __builtin_convertvector(v, bf16x2); return __builtin_bit_cast(unsigned, b); }
__device__ __forceinline__ f32x4 mfma16(bf16x8 a, bf16x8 b, f32x4 c) { return __builtin_amdgcn_mfma_f32_16x16x32_bf16(a, b, c, 0, 0, 0); }
__device__ __forceinline__ float dot2bf(unsigned w, unsigned x, float acc) { return __builtin_amdgcn_fdot2_f32_bf16(__builtin_bit_cast(bf16x2, w), __builtin_bit_cast(bf16x2, x), acc, false); }
__device__ __forceinline__ float fexp2(float x) { return __builtin_amdgcn_exp2f(x); }
#define LDS_WAIT() asm volatile("s_waitcnt lgkmcnt(0)" ::: "memory")
__device__ __forceinline__ unsigned umax(unsigned a, unsigned b) { return a > b ? a : b; }
__device__ __forceinline__ unsigned xmax4(unsigned m) { auto r = __builtin_amdgcn_permlane16_swap(m, m, false, false); m = umax(r[0], r[1]); auto q = __builtin_amdgcn_permlane32_swap(m, m, false, false); return umax(q[0], q[1]); }
__device__ __forceinline__ float xfmax4(float v) { unsigned m = __float_as_uint(v); auto r = __builtin_amdgcn_permlane16_swap(m, m, false, false); v = fmaxf(__uint_as_float(r[0]), __uint_as_float(r[1])); m = __float_as_uint(v);
    auto q = __builtin_amdgcn_permlane32_swap(m, m, false, false); return fmaxf(__uint_as_float(q[0]), __uint_as_float(q[1])); }
__device__ __forceinline__ float xfsum4(float v) { unsigned m = __float_as_uint(v); auto r = __builtin_amdgcn_permlane16_swap(m, m, false, false); v = __uint_as_float(r[0]) + __uint_as_float(r[1]); m = __float_as_uint(v);
    auto q = __builtin_amdgcn_permlane32_swap(m, m, false, false); return __uint_as_float(q[0]) + __uint_as_float(q[1]); }

#define XB_TMO      128
#define XB_XCNT(j)  (256  + 64 * (j))
#define XB_XSUB(j)  (1280 + 64 * (j))
#define XB_XGEN(j)  (2304 + 64 * (j))
#define XB_TOP      3328
#define XB_TOPGEN   3392
#define XCD_BAR_WORDS 3456
#define XB_SPIN_CAP (1u << 18)
__device__ __forceinline__ unsigned xb_ld(unsigned* p)              { return __hip_atomic_load(p, __ATOMIC_RELAXED, __HIP_MEMORY_SCOPE_AGENT); }
__device__ __forceinline__ unsigned xb_add(unsigned* p, unsigned v) { return __hip_atomic_fetch_add(p, v, __ATOMIC_RELAXED, __HIP_MEMORY_SCOPE_AGENT); }
__device__ __forceinline__ unsigned xb_xcc_id() { return (unsigned)__builtin_amdgcn_s_getreg((3 << 11) | 20) & 0xFu; }
#define XB_SPIN(cond, bar) do { unsigned _sp = 0; while (cond) { __builtin_amdgcn_s_sleep(1); \
    if ((++_sp & 255u) == 0u) { if (xb_ld(&(bar)[XB_TMO])) break; if (_sp > XB_SPIN_CAP) { atomicAdd(&(bar)[XB_TMO], 1u); break; } } } } while (0)
struct XcdBarrier { unsigned* bar; unsigned x; volatile LAS unsigned* st; };
__device__ __forceinline__ XcdBarrier xcd_barrier_post(unsigned* bar, volatile LAS unsigned* st) {
    XcdBarrier b; b.bar = bar; b.x = xb_xcc_id(); b.st = st;
    if (threadIdx.x == 0) (void)xb_add(&bar[XB_XCNT(b.x)], 1u);
    return b;
}
__device__ __forceinline__ void xcd_barrier_complete(unsigned* bar, unsigned x, unsigned& nloc, unsigned& nx) {
    const unsigned G = gridDim.x * gridDim.y * gridDim.z;
    unsigned sum, cnt, mine, sp = 0u;
    for (;;) {
        sum = 0u; cnt = 0u; mine = 0u;
#pragma unroll
        for (unsigned j = 0; j < 16; ++j) { const unsigned c = xb_ld(&bar[XB_XCNT(j)]); sum += c; cnt += (c > 0u) ? 1u : 0u; mine = (j == x) ? c : mine; }
        if (sum == G) break;
        __builtin_amdgcn_s_sleep(1);
        if ((++sp & 255u) == 0u) { if (xb_ld(&bar[XB_TMO])) break; if (sp > XB_SPIN_CAP) { atomicAdd(&bar[XB_TMO], 1u); break; } }
    }
    nloc = mine > 0u ? mine : 1u; nx = cnt > 0u ? cnt : 1u;
}
__device__ __forceinline__ void xcd_barrier(const XcdBarrier& b) {
    asm volatile("s_waitcnt vmcnt(0)" ::: "memory");
    __syncthreads();
    if (threadIdx.x == 0) {
        unsigned* bar = b.bar;
        __builtin_amdgcn_s_waitcnt(0);
        unsigned nloc = b.st[0], nx = b.st[1];
        if (nloc == 0u) { xcd_barrier_complete(bar, b.x, nloc, nx); b.st[0] = nloc; b.st[1] = nx; }
        const unsigned old = xb_add(&bar[XB_XSUB(b.x)], 1u);
        const unsigned gen = old / nloc;
        if (old + 1u == (gen + 1u) * nloc) {
            __builtin_amdgcn_fence(__ATOMIC_RELEASE, "agent");
            asm volatile("s_waitcnt vmcnt(0)" ::: "memory");
            const unsigned og = xb_add(&bar[XB_TOP], 1u);
            const unsigned tg = og / nx;
            if (og + 1u == (tg + 1u) * nx) xb_add(&bar[XB_TOPGEN], 1u);
            else XB_SPIN(xb_ld(&bar[XB_TOPGEN]) == tg, bar);
            __builtin_amdgcn_fence(__ATOMIC_ACQUIRE, "agent");
            xb_add(&bar[XB_XGEN(b.x)], 1u);
            asm volatile("s_waitcnt vmcnt(0)" ::: "memory");
        } else {
            XB_SPIN(xb_ld(&bar[XB_XGEN(b.x)]) == gen, bar);
            __builtin_amdgcn_fence(__ATOMIC_ACQUIRE, "agent");
            asm volatile("s_waitcnt vmcnt(0)" ::: "memory");
        }
    }
    __syncthreads();
}

struct EpiStoreBf {
    static constexpr bool PERM = true, AFTER_DRAIN = false;
    bf16_t* O; int ldc;
    __device__ __forceinline__ void operator()(const pg8::f32x4 (&acc)[2][2][4][2], const pg8::Unit& u, int wr, int wc, int fr, int fq) const {
        const int row0 = u.pm * 256 + wr * 64 + fr, col0 = u.pn * 256 + wc * 32 + 8 * fq;
#pragma unroll
        for (int ai = 0; ai < 2; ++ai)
#pragma unroll
            for (int m = 0; m < 4; ++m) { bf16_t* rowp = O + (size_t)(row0 + ai * 128 + m * 16) * ldc + col0;
#pragma unroll
                for (int bj = 0; bj < 2; ++bj) { const pg8::f32x4 v0 = acc[ai][bj][m][0], v1 = acc[ai][bj][m][1];
                    v4u w; w.x = cvtpk(v0[0], v0[1]); w.y = cvtpk(v0[2], v0[3]); w.z = cvtpk(v1[0], v1[1]); w.w = cvtpk(v1[2], v1[3]);
                    *(v4u*)(rowp + bj * 128) = w; } }
    }
};
struct EpiY1 {
    static constexpr bool PERM = true, AFTER_DRAIN = false;
    const float* x; float* y;
    __device__ __forceinline__ void operator()(const pg8::f32x4 (&acc)[2][2][4][2], const pg8::Unit& u, int wr, int wc, int fr, int fq) const {
        const int row0 = u.pm * 256 + wr * 64 + fr, col0 = u.pn * 256 + wc * 32 + 8 * fq;
#pragma unroll
        for (int ai = 0; ai < 2; ++ai)
#pragma unroll
            for (int m = 0; m < 4; ++m) { const size_t off = (size_t)(row0 + ai * 128 + m * 16) * D_MODEL + col0;
#pragma unroll
                for (int bj = 0; bj < 2; ++bj) {
                    const f32x4 x0 = *(const f32x4*)(x + off + bj * 128), x1 = *(const f32x4*)(x + off + bj * 128 + 4);
                    *(f32x4*)(y + off + bj * 128) = x0 * ALPHA + acc[ai][bj][m][0]; *(f32x4*)(y + off + bj * 128 + 4) = x1 * ALPHA + acc[ai][bj][m][1]; } }
    }
};
struct EpiIn {
    static constexpr bool PERM = true, AFTER_DRAIN = false;
    float* POOLV; bf16_t *Q, *K, *V, *QM; const float* rope;
    __device__ __forceinline__ void operator()(const pg8::f32x4 (&acc)[2][2][4][2], const pg8::Unit& u, int wr, int wc, int fr, int fq) const {
        const int row0 = u.pm * 256 + wr * 64 + fr, cl = wc * 32 + 8 * fq, pn = u.pn;
        if (pn < 2) {
#pragma unroll
            for (int ai = 0; ai < 2; ++ai)
#pragma unroll
                for (int m = 0; m < 4; ++m) { float* rp = POOLV + (size_t)(row0 + ai * 128 + m * 16) * POOL_W + pn * 256 + cl;
#pragma unroll
                    for (int bj = 0; bj < 2; ++bj) { *(f32x4*)(rp + bj * 128) = acc[ai][bj][m][0]; *(f32x4*)(rp + bj * 128 + 4) = acc[ai][bj][m][1]; } }
            return;
        }
        bf16_t* base; int ld, c0; bool rot = false;
        if (pn < 6) { base = Q; ld = SWA_W; c0 = (pn - 2) * 256; rot = true; }
        else if (pn == 6) { base = K; ld = KV_W; c0 = 0; rot = true; }
        else if (pn == 7) { base = V; ld = KV_W; c0 = 0; }
        else { base = QM; ld = MEM_W; c0 = (pn - 8) * 256; }
        rot = rot && ((wc & 1) == 0);
#pragma unroll
        for (int ai = 0; ai < 2; ++ai)
#pragma unroll
            for (int m = 0; m < 4; ++m) {
                const int row = row0 + ai * 128 + m * 16;
                f32x4 v[2][2];
#pragma unroll
                for (int bj = 0; bj < 2; ++bj) { v[bj][0] = acc[ai][bj][m][0]; v[bj][1] = acc[ai][bj][m][1]; }
                if (rot) {
                    const f32x4* tp = (const f32x4*)(rope + (size_t)row * 16);
                    f32x4 cs[2][2]; cs[0][0] = tp[0]; cs[0][1] = tp[1]; cs[1][0] = tp[2]; cs[1][1] = tp[3];
#pragma unroll
                    for (int bj = 0; bj < 2; ++bj)
#pragma unroll
                        for (int n = 0; n < 2; ++n)
#pragma unroll
                            for (int i = 0; i < 4; ++i) {
                                const float xv = v[bj][n][i], pv = __shfl_xor(xv, 16);
                                const float c = cs[n][i >> 1][2 * (i & 1)], s = cs[n][i >> 1][2 * (i & 1) + 1];
                                const float o = fq == 0 ? xv * c - pv * s : (fq == 1 ? xv * c + pv * s : xv);
                                v[bj][n][i] = o; }
                }
                bf16_t* rowp = base + (size_t)row * ld + c0 + cl;
#pragma unroll
                for (int bj = 0; bj < 2; ++bj) { v4u w; w.x = cvtpk(v[bj][0][0], v[bj][0][1]); w.y = cvtpk(v[bj][0][2], v[bj][0][3]); w.z = cvtpk(v[bj][1][0], v[bj][1][1]); w.w = cvtpk(v[bj][1][2], v[bj][1][3]);
                    *(v4u*)(rowp + bj * 128) = w; }
            }
    }
};

__device__ __forceinline__ void p0_transpose_item(const float* W, int K, int N, bf16_t* WT, LAS float* scr, int item, int lane) {
    const int nblk = N / 32, kb = item / nblk, nb = item % nblk, k0 = 64 * kb, n0 = 32 * nb;
#pragma unroll 8
    for (int i = 0; i < 32; ++i) { const int kk = 2 * i + (lane >> 5); scr[kk * 33 + (lane & 31)] = W[(size_t)(k0 + kk) * N + n0 + (lane & 31)]; }
    LDS_WAIT(); asm volatile("" ::: "memory");
    const int c = lane & 7;
#pragma unroll
    for (int j = 0; j < 4; ++j) { const int n = (lane >> 3) + 8 * j; const LAS float* s = scr + (8 * c) * 33 + n;
        v4u o; o.x = cvtpk(s[0 * 33], s[1 * 33]); o.y = cvtpk(s[2 * 33], s[3 * 33]); o.z = cvtpk(s[4 * 33], s[5 * 33]); o.w = cvtpk(s[6 * 33], s[7 * 33]);
        *(v4u*)(WT + (size_t)(n0 + n) * K + k0 + 8 * c) = o; }
    LDS_WAIT(); asm volatile("" ::: "memory");
}
template <bool NT>
__device__ __forceinline__ void cvt_stream(const float* in, bf16_t* out, size_t n, int gw, int NGW, int lane) {
#pragma unroll 4
    for (size_t i = (size_t)gw * 512 + lane * 8; i < n; i += (size_t)NGW * 512) {
        f32x4 a, b;
        if (NT) { a = __builtin_nontemporal_load((const f32x4*)(in + i)); b = __builtin_nontemporal_load((const f32x4*)(in + i + 4)); }
        else { a = *(const f32x4*)(in + i); b = *(const f32x4*)(in + i + 4); }
        v4u o; o.x = cvtpk(a.x, a.y); o.y = cvtpk(a.z, a.w); o.z = cvtpk(b.x, b.y); o.w = cvtpk(b.z, b.w);
        *(v4u*)(out + i) = o;
    }
}

constexpr int SWA_KROW = 144, SWA_VROW = 528, SWA_VT_OFF = 256 * SWA_KROW;
__device__ __forceinline__ void swa_item(LAS unsigned char* lds, int item, const bf16_t* __restrict__ Q, const bf16_t* __restrict__ Kb, const bf16_t* __restrict__ Vb, const float* __restrict__ sinks,
                                         bf16_t* CONCAT, int tid, int wave, int lane) {
    const int qb = item & 31, kvh = (item >> 5) & 3, b = item >> 7;
    const int tok0 = b * SEQ + qb * 128;
    LAS unsigned char* Kl = lds; LAS unsigned char* Vt = lds + SWA_VT_OFF;
#pragma unroll
    for (int j = 0; j < 4; ++j) {
        const int c = tid + NTHREADS * j, row = c >> 3, part = c & 7;
        v4u kv = {0u, 0u, 0u, 0u}, vv = {0u, 0u, 0u, 0u};
        if (qb > 0 || row >= 128) { const size_t tk = (size_t)(tok0 - 128 + row); kv = *(const v4u*)(Kb + tk * KV_W + kvh * HD + part * 8); vv = *(const v4u*)(Vb + tk * KV_W + kvh * HD + part * 8); }
        *(LAS v4u*)(Kl + row * SWA_KROW + part * 16) = kv;
        LAS unsigned short* vp = (LAS unsigned short*)(Vt + (part * 8) * SWA_VROW + row * 2);
        vp[0 * (SWA_VROW / 2)] = (unsigned short)(vv.x & 0xffffu); vp[1 * (SWA_VROW / 2)] = (unsigned short)(vv.x >> 16);
        vp[2 * (SWA_VROW / 2)] = (unsigned short)(vv.y & 0xffffu); vp[3 * (SWA_VROW / 2)] = (unsigned short)(vv.y >> 16);
        vp[4 * (SWA_VROW / 2)] = (unsigned short)(vv.z & 0xffffu); vp[5 * (SWA_VROW / 2)] = (unsigned short)(vv.z >> 16);
        vp[6 * (SWA_VROW / 2)] = (unsigned short)(vv.w & 0xffffu); vp[7 * (SWA_VROW / 2)] = (unsigned short)(vv.w >> 16);
    }
    __syncthreads();
    const int g = wave & 3, h = kvh * 4 + g, q15 = lane & 15, qq = lane >> 4;
    const float sink2 = sinks[h] * LOG2E;
    const float SC = 0.125f * LOG2E;
#pragma unroll 1
    for (int cc = 0; cc < 2; ++cc) {
        const int c = 2 * (wave >> 2) + cc, kl0 = 32 * c;
        bf16x8 qf[2][2];
#pragma unroll
        for (int ni = 0; ni < 2; ++ni)
#pragma unroll
            for (int ks = 0; ks < 2; ++ks) qf[ni][ks] = *(const bf16x8*)(Q + (size_t)(tok0 + 32 * c + 16 * ni + q15) * SWA_W + h * HD + 32 * ks + 8 * qq);
        f32x4 s[10][2];
#pragma unroll
        for (int mi = 0; mi < 10; ++mi) { s[mi][0] = (f32x4){0.f, 0.f, 0.f, 0.f}; s[mi][1] = (f32x4){0.f, 0.f, 0.f, 0.f}; }
#pragma unroll
        for (int mi = 0; mi < 10; ++mi)
#pragma unroll
            for (int ks = 0; ks < 2; ++ks) {
                const bf16x8 kf = *(const LAS bf16x8*)(Kl + (kl0 + 16 * mi + q15) * SWA_KROW + (32 * ks + 8 * qq) * 2);
                s[mi][0] = mfma16(kf, qf[0][ks], s[mi][0]); s[mi][1] = mfma16(kf, qf[1][ks], s[mi][1]);
            }
        float rl[2];
#pragma unroll
        for (int ni = 0; ni < 2; ++ni) {
            const int ql = 32 * c + 16 * ni + q15;
            float mx = -INFINITY;
#pragma unroll
            for (int mi = 0; mi < 10; ++mi)
#pragma unroll
                for (int r = 0; r < 4; ++r) {
                    const int kl = kl0 + 16 * mi + 4 * qq + r;
                    const bool valid = (kl > ql) && (kl <= ql + 128) && (qb > 0 || kl >= 128);
                    const float t = valid ? s[mi][ni][r] * SC : -INFINITY;
                    s[mi][ni][r] = t; mx = fmaxf(mx, t);
                }
            mx = fmaxf(xfmax4(mx), sink2);
            float l = 0.f;
#pragma unroll
            for (int mi = 0; mi < 10; ++mi)
#pragma unroll
                for (int r = 0; r < 4; ++r) { const float p = fexp2(s[mi][ni][r] - mx); s[mi][ni][r] = p; l += p; }
            l = xfsum4(l) + fexp2(sink2 - mx);
            rl[ni] = 1.0f / l;
        }
        f32x4 o[4][2];
#pragma unroll
        for (int dt = 0; dt < 4; ++dt) { o[dt][0] = (f32x4){0.f, 0.f, 0.f, 0.f}; o[dt][1] = (f32x4){0.f, 0.f, 0.f, 0.f}; }
#pragma unroll
        for (int kk = 0; kk < 5; ++kk) {
            bf16x8 pf[2];
#pragma unroll
            for (int ni = 0; ni < 2; ++ni) {
                v4u w; w.x = cvtpk(s[2 * kk][ni][0], s[2 * kk][ni][1]); w.y = cvtpk(s[2 * kk][ni][2], s[2 * kk][ni][3]);
                w.z = cvtpk(s[2 * kk + 1][ni][0], s[2 * kk + 1][ni][1]); w.w = cvtpk(s[2 * kk + 1][ni][2], s[2 * kk + 1][ni][3]);
                pf[ni] = __builtin_bit_cast(bf16x8, w);
            }
#pragma unroll
            for (int dt = 0; dt < 4; ++dt) {
                const LAS unsigned char* vb = Vt + (16 * dt + q15) * SWA_VROW + (kl0 + 32 * kk + 4 * qq) * 2;
                const v2u lo = *(const LAS v2u*)vb, hi = *(const LAS v2u*)(vb + 32);
                v4u w; w.x = lo.x; w.y = lo.y; w.z = hi.x; w.w = hi.y;
                const bf16x8 vf = __builtin_bit_cast(bf16x8, w);
                o[dt][0] = mfma16(vf, pf[0], o[dt][0]); o[dt][1] = mfma16(vf, pf[1], o[dt][1]);
            }
        }
#pragma unroll
        for (int ni = 0; ni < 2; ++ni) {
            bf16_t* orow = CONCAT + (size_t)(tok0 + 32 * c + 16 * ni + q15) * D_MODEL + POOL_W + h * HD + 4 * qq;
#pragma unroll
            for (int dt = 0; dt < 4; ++dt) { v2u w; w.x = cvtpk(o[dt][ni][0] * rl[ni], o[dt][ni][1] * rl[ni]); w.y = cvtpk(o[dt][ni][2] * rl[ni], o[dt][ni][3] * rl[ni]); *(v2u*)(orow + 16 * dt) = w; }
        }
    }
    __syncthreads();
}
constexpr int MEM_KROW = 272, MEM_VROW = 528, MEM_VT_OFF = 256 * MEM_KROW;
__device__ __forceinline__ void mem_item(LAS unsigned char* lds, int item, const bf16_t* __restrict__ QM, const bf16_t* __restrict__ KVM, bf16_t* CONCAT, int tid, int wave, int lane) {
    const int qt = item & 31, hm = (item >> 5) & 3, b = item >> 7;
    LAS unsigned char* Kl = lds; LAS unsigned char* Vt = lds + MEM_VT_OFF;
#pragma unroll
    for (int j = 0; j < 8; ++j) {
        const int c = tid + NTHREADS * j, row = c >> 4, part = c & 15;
        const bf16_t* src = KVM + (size_t)(b * MEM_LEN + row) * (2 * MEM_W) + hm * MHD + part * 8;
        const v4u kv = *(const v4u*)src, vv = *(const v4u*)(src + MEM_W);
        *(LAS v4u*)(Kl + row * MEM_KROW + part * 16) = kv;
        LAS unsigned short* vp = (LAS unsigned short*)(Vt + (part * 8) * MEM_VROW + row * 2);
        vp[0 * (MEM_VROW / 2)] = (unsigned short)(vv.x & 0xffffu); vp[1 * (MEM_VROW / 2)] = (unsigned short)(vv.x >> 16);
        vp[2 * (MEM_VROW / 2)] = (unsigned short)(vv.y & 0xffffu); vp[3 * (MEM_VROW / 2)] = (unsigned short)(vv.y >> 16);
        vp[4 * (MEM_VROW / 2)] = (unsigned short)(vv.z & 0xffffu); vp[5 * (MEM_VROW / 2)] = (unsigned short)(vv.z >> 16);
        vp[6 * (MEM_VROW / 2)] = (unsigned short)(vv.w & 0xffffu); vp[7 * (MEM_VROW / 2)] = (unsigned short)(vv.w >> 16);
    }
    __syncthreads();
    const int q15 = lane & 15, qq = lane >> 4;
    const int tok = b * SEQ + qt * 128 + wave * 16 + q15;
    const float SC = 0.08838834764831845f * LOG2E;
    bf16x8 qf[4];
#pragma unroll
    for (int ks = 0; ks < 4; ++ks) qf[ks] = *(const bf16x8*)(QM + (size_t)tok * MEM_W + hm * MHD + 32 * ks + 8 * qq);
    f32x4 s[16];
#pragma unroll
    for (int mi = 0; mi < 16; ++mi) s[mi] = (f32x4){0.f, 0.f, 0.f, 0.f};
#pragma unroll
    for (int mi = 0; mi < 16; ++mi)
#pragma unroll
        for (int ks = 0; ks < 4; ++ks) {
            const bf16x8 kf = *(const LAS bf16x8*)(Kl + (16 * mi + q15) * MEM_KROW + (32 * ks + 8 * qq) * 2);
            s[mi] = mfma16(kf, qf[ks], s[mi]);
        }
    float mx = -INFINITY;
#pragma unroll
    for (int mi = 0; mi < 16; ++mi)
#pragma unroll
        for (int r = 0; r < 4; ++r) { const float t = s[mi][r] * SC; s[mi][r] = t; mx = fmaxf(mx, t); }
    mx = xfmax4(mx);
    float l = 0.f;
#pragma unroll
    for (int mi = 0; mi < 16; ++mi)
#pragma unroll
        for (int r = 0; r < 4; ++r) { const float p = fexp2(s[mi][r] - mx); s[mi][r] = p; l += p; }
    l = xfsum4(l);
    const float rl = 1.0f / l;
    f32x4 o[8];
#pragma unroll
    for (int dt = 0; dt < 8; ++dt) o[dt] = (f32x4){0.f, 0.f, 0.f, 0.f};
#pragma unroll
    for (int kk = 0; kk < 8; ++kk) {
        v4u pw; pw.x = cvtpk(s[2 * kk][0], s[2 * kk][1]); pw.y = cvtpk(s[2 * kk][2], s[2 * kk][3]); pw.z = cvtpk(s[2 * kk + 1][0], s[2 * kk + 1][1]); pw.w = cvtpk(s[2 * kk + 1][2], s[2 * kk + 1][3]);
        const bf16x8 pf = __builtin_bit_cast(bf16x8, pw);
#pragma unroll
        for (int dt = 0; dt < 8; ++dt) {
            const LAS unsigned char* vb = Vt + (16 * dt + q15) * MEM_VROW + (32 * kk + 4 * qq) * 2;
            const v2u lo = *(const LAS v2u*)vb, hi = *(const LAS v2u*)(vb + 32);
            v4u w; w.x = lo.x; w.y = lo.y; w.z = hi.x; w.w = hi.y;
            o[dt] = mfma16(__builtin_bit_cast(bf16x8, w), pf, o[dt]);
        }
    }
    bf16_t* orow = CONCAT + (size_t)tok * D_MODEL + POOL_W + SWA_W + hm * MHD + 4 * qq;
#pragma unroll
    for (int dt = 0; dt < 8; ++dt) { v2u w; w.x = cvtpk(o[dt][0] * rl, o[dt][1] * rl); w.y = cvtpk(o[dt][2] * rl, o[dt][3] * rl); *(v2u*)(orow + 16 * dt) = w; }
    __syncthreads();
}
template <int W>
__device__ __forceinline__ void pool_frags(bf16x8 (&pf)[4], const float* __restrict__ POOLV, int t, int g, int qq) {
    const int sp = t & (SEQ - 1);
    const int cnt = (sp + 1) < W ? (sp + 1) : W;
    const float inv = 1.0f / (float)cnt;
    f32x4 c[4][2], a[4][2];
#pragma unroll
    for (int ks = 0; ks < 4; ++ks) { const float* p0 = POOLV + (size_t)t * POOL_W + g * 128 + 32 * ks + 8 * qq; c[ks][0] = *(const f32x4*)p0; c[ks][1] = *(const f32x4*)(p0 + 4); a[ks][0] = c[ks][0]; a[ks][1] = c[ks][1]; }
#pragma unroll
    for (int i = 1; i < W; ++i) {
        const bool ok = i <= sp; const size_t back = ok ? (size_t)i * POOL_W : 0;
        const float m = ok ? 1.0f : 0.0f;
#pragma unroll
        for (int ks = 0; ks < 4; ++ks) { const float* p0 = POOLV + (size_t)t * POOL_W + g * 128 + 32 * ks + 8 * qq - back; a[ks][0] += *(const f32x4*)p0 * m; a[ks][1] += *(const f32x4*)(p0 + 4) * m; }
    }
#pragma unroll
    for (int ks = 0; ks < 4; ++ks) {
        const f32x4 a0 = a[ks][0] * inv - c[ks][0], a1 = a[ks][1] * inv - c[ks][1];
        v4u pw; pw.x = cvtpk(a0.x, a0.y); pw.y = cvtpk(a0.z, a0.w); pw.z = cvtpk(a1.x, a1.y); pw.w = cvtpk(a1.z, a1.w);
        pf[ks] = __builtin_bit_cast(bf16x8, pw);
    }
}
__device__ __forceinline__ void pool_item(int item, const float* __restrict__ POOLV, const bf16_t* __restrict__ WPT, const float* __restrict__ pool_scale, bf16_t* CONCAT, int lane) {
    const int g = item & 3, t0 = (item >> 2) * 16, q15 = lane & 15, qq = lane >> 4;
    const int t = t0 + q15;
    bf16x8 pf[4];
    if (g == 0) pool_frags<2>(pf, POOLV, t, g, qq); else if (g == 1) pool_frags<4>(pf, POOLV, t, g, qq); else if (g == 2) pool_frags<8>(pf, POOLV, t, g, qq); else pool_frags<16>(pf, POOLV, t, g, qq);
    bf16_t* orow = CONCAT + (size_t)t * D_MODEL + g * 128 + 4 * qq;
#pragma unroll
    for (int mt = 0; mt < 8; ++mt) {
        f32x4 acc = {0.f, 0.f, 0.f, 0.f};
#pragma unroll
        for (int ks = 0; ks < 4; ++ks) { const bf16x8 wf = *(const bf16x8*)(WPT + (size_t)g * 16384 + (16 * mt + q15) * 128 + 32 * ks + 8 * qq); acc = mfma16(wf, pf[ks], acc); }
        const f32x4 sc = *(const f32x4*)(pool_scale + g * 128 + 16 * mt + 4 * qq);
        v2u wv; wv.x = cvtpk(acc[0] * sc[0], acc[1] * sc[1]); wv.y = cvtpk(acc[2] * sc[2], acc[3] * sc[3]);
        *(v2u*)(orow + 16 * mt) = wv;
    }
}

__device__ __forceinline__ void ln1_row(const float* __restrict__ yrow, const float* __restrict__ g, const float* __restrict__ bta, float* xo, bf16_t* xb, int lane) {
    f32x4 v[8]; float s = 0.f;
#pragma unroll
    for (int j = 0; j < 8; ++j) { v[j] = *(const f32x4*)(yrow + 256 * j + 4 * lane); s += (v[j].x + v[j].y) + (v[j].z + v[j].w); }
    const float mean = wave_sum(s) * (1.f / D_MODEL); float q = 0.f;
#pragma unroll
    for (int j = 0; j < 8; ++j) { v[j] = v[j] - mean; q += (v[j].x * v[j].x + v[j].y * v[j].y) + (v[j].z * v[j].z + v[j].w * v[j].w); }
    const float rstd = 1.0f / sqrtf(wave_sum(q) * (1.f / D_MODEL) + LN_EPS);
#pragma unroll
    for (int j = 0; j < 8; ++j) {
        const f32x4 gg = *(const f32x4*)(g + 256 * j + 4 * lane), bb = *(const f32x4*)(bta + 256 * j + 4 * lane);
        const f32x4 y = v[j] * rstd * gg + bb;
        *(f32x4*)(xo + 256 * j + 4 * lane) = y;
        v2u w; w.x = cvtpk(y.x, y.y); w.y = cvtpk(y.z, y.w); *(v2u*)(xb + 256 * j + 4 * lane) = w;
    }
}

__device__ __forceinline__ unsigned f2ord(float f) { const unsigned u = __float_as_uint(f); return u ^ ((unsigned)((int)u >> 31) | 0x80000000u); }
__device__ __forceinline__ float ord2f(unsigned o) { const unsigned u = (o & 0x80000000u) ? (o ^ 0x80000000u) : ~o; return __uint_as_float(u); }
constexpr int TK_KROW = 272, TK_HALF = 128 * TK_KROW;
__device__ __forceinline__ void topk_item(int item, const bf16_t* __restrict__ QP, const LAS unsigned char* Kl, int* EIDX, float* GATE, int lane) {
    const int h = item & 7, t0 = (item >> 3) * 16, q15 = lane & 15, qq = lane >> 4;
    const int t = t0 + q15;
    unsigned top[2][16];
#pragma unroll
    for (int half = 0; half < 2; ++half) {
        bf16x8 qf[4];
#pragma unroll
        for (int ks = 0; ks < 4; ++ks) qf[ks] = *(const bf16x8*)(QP + (size_t)t * D_MODEL + h * 256 + half * 128 + 32 * ks + 8 * qq);
        unsigned key[32];
#pragma unroll
        for (int mi = 0; mi < 8; ++mi) {
            f32x4 acc = {0.f, 0.f, 0.f, 0.f};
#pragma unroll
            for (int ks = 0; ks < 4; ++ks) { const bf16x8 kf = *(const LAS bf16x8*)(Kl + half * TK_HALF + (16 * mi + q15) * TK_KROW + (32 * ks + 8 * qq) * 2); acc = mfma16(kf, qf[ks], acc); }
#pragma unroll
            for (int r = 0; r < 4; ++r) key[mi * 4 + r] = (f2ord(acc[r]) & ~0x7Fu) | (unsigned)(127 - (16 * mi + 4 * qq + r));
        }
#pragma unroll
        for (int r = 0; r < 16; ++r) {
            unsigned t1[11];
#pragma unroll
            for (int i = 0; i < 10; ++i) t1[i] = umax(umax(key[3 * i], key[3 * i + 1]), key[3 * i + 2]);
            t1[10] = umax(key[30], key[31]);
            const unsigned u0 = umax(umax(t1[0], t1[1]), t1[2]), u1 = umax(umax(t1[3], t1[4]), t1[5]), u2 = umax(umax(t1[6], t1[7]), t1[8]), u3 = umax(t1[9], t1[10]);
            const unsigned M = xmax4(umax(umax(umax(u0, u1), u2), u3));
            top[half][r] = M;
#pragma unroll
            for (int i = 0; i < 32; ++i) key[i] = (key[i] == M) ? 0u : key[i];
            __builtin_amdgcn_sched_barrier(0);
        }
        __builtin_amdgcn_sched_barrier(0);
    }
    float v1[16], v2[16]; unsigned e1[16], e2[16];
#pragma unroll
    for (int r = 0; r < 16; ++r) { v1[r] = ord2f(top[0][r] & ~0x7Fu); v2[r] = ord2f(top[1][r] & ~0x7Fu); e1[r] = (127u - (top[0][r] & 0x7Fu)) * 128u; e2[r] = 127u - (top[1][r] & 0x7Fu); }
    unsigned ck[13], ce[13];
#pragma unroll
    for (int i = 0; i < 13; ++i) { ck[i] = 0u; ce[i] = 0u; }
    {
        int n = 0;
#pragma unroll
        for (int a = 0; a < 16; ++a)
#pragma unroll
            for (int bb = 0; bb < 16; ++bb)
                if ((a + 1) * (bb + 1) <= 16) {
                    const unsigned pk = (f2ord(v1[a] + v2[bb]) & ~0xFFu) | (unsigned)(255 - (a * 16 + bb));
                    const unsigned ee = e1[a] + e2[bb];
                    const bool me = (qq == (n & 3));
                    ck[n >> 2] = me ? pk : ck[n >> 2]; ce[n >> 2] = me ? ee : ce[n >> 2];
                    ++n;
                }
    }
    float sc[16];
#pragma unroll
    for (int r = 0; r < 16; ++r) {
        const unsigned c0 = umax(umax(ck[0], ck[1]), ck[2]), c1 = umax(umax(ck[3], ck[4]), ck[5]), c2 = umax(umax(ck[6], ck[7]), ck[8]), c3 = umax(umax(ck[9], ck[10]), ck[11]);
        const unsigned Lm = umax(umax(umax(c0, c1), umax(c2, c3)), ck[12]);
        const unsigned M = xmax4(Lm);
        unsigned we = 0u;
#pragma unroll
        for (int i = 0; i < 13; ++i) { const bool hit = (ck[i] == M); we = hit ? ce[i] : we; ck[i] = hit ? 0u : ck[i]; }
        sc[r] = ord2f(M & ~0xFFu);
        if (Lm == M) EIDX[(size_t)t * EPT + h * TOPK + r] = (int)we;
        __builtin_amdgcn_sched_barrier(0);
    }
    const float smax = sc[0];
    float den = 0.f;
#pragma unroll
    for (int r = 0; r < 16; ++r) { sc[r] = fexp2((sc[r] - smax) * LOG2E); den += sc[r]; }
    const float rden = 1.0f / den;
    if (qq == 0) {
        float* gp = GATE + (size_t)t * EPT + h * TOPK;
#pragma unroll
        for (int r = 0; r < 16; r += 4) *(f32x4*)(gp + r) = (f32x4){sc[r] * rden, sc[r + 1] * rden, sc[r + 2] * rden, sc[r + 3] * rden};
    }
}

__device__ __forceinline__ float reduce16(const float (&p)[16], int lane) {
    const bool b3 = lane & 8, b2 = lane & 4;
    float r8[8], r4[4], r2[2];
#pragma unroll
    for (int k = 0; k < 8; ++k) { auto r = __builtin_amdgcn_permlane32_swap(__float_as_uint(p[k]), __float_as_uint(p[k + 8]), false, false); r8[k] = __uint_as_float(r[0]) + __uint_as_float(r[1]); }
#pragma unroll
    for (int k = 0; k < 4; ++k) { auto r = __builtin_amdgcn_permlane16_swap(__float_as_uint(r8[k]), __float_as_uint(r8[k + 4]), false, false); r4[k] = __uint_as_float(r[0]) + __uint_as_float(r[1]); }
#pragma unroll
    for (int k = 0; k < 2; ++k) { const float keep = b3 ? r4[k + 2] : r4[k], send = b3 ? r4[k] : r4[k + 2]; r2[k] = keep + __shfl_xor(send, 8); }
    const float keep = b2 ? r2[1] : r2[0], send = b2 ? r2[0] : r2[1];
    float r1 = keep + __shfl_xor(send, 4);
    r1 += __shfl_xor(r1, 2); r1 += __shfl_xor(r1, 1);
    return r1;
}
#define G_LANE_OF(e) ((((e) >> 3) & 1) * 32 + (((e) >> 2) & 1) * 16 + (((e) >> 1) & 1) * 8 + ((e) & 1) * 4)
#define G_ISSUE1(slot, TAB, idv, ln) do { const int _id = __builtin_amdgcn_readlane((idv), (ln)); const unsigned char* _rp = (TAB) + (size_t)_id * D_MODEL + 16 * lane; \
        buf[slot][0] = *(const v4u*)_rp; buf[slot][1] = *(const v4u*)(_rp + 1024); } while (0)
#define G_DOT1(slot, pi) do { float _a = 0.f, _b = 0.f; \
        _Pragma("unroll") for (int _i = 0; _i < 2; ++_i) _Pragma("unroll") for (int _j = 0; _j < 4; ++_j) { const unsigned _w = buf[slot][_i][_j]; \
            _a = __builtin_amdgcn_fdot2_f32_bf16(__builtin_amdgcn_cvt_scalef32_pk_bf16_fp8(_w, 1.0f, false), __builtin_bit_cast(bf16x2, xb[_i][2 * _j]), _a, false); \
            _b = __builtin_amdgcn_fdot2_f32_bf16(__builtin_amdgcn_cvt_scalef32_pk_bf16_fp8(_w, 1.0f, true), __builtin_bit_cast(bf16x2, xb[_i][2 * _j + 1]), _b, false); } \
        part[pi] = _a + _b; } while (0)
#define G_FMA1(slot, e) do { const float _a = __int_as_float(__builtin_amdgcn_readlane(__float_as_int(aval), G_LANE_OF(e))); \
        _Pragma("unroll") for (int _i = 0; _i < 2; ++_i) _Pragma("unroll") for (int _j = 0; _j < 4; ++_j) { const unsigned _w = buf[slot][_i][_j]; \
            const f32x2 _lo = __builtin_amdgcn_cvt_pk_f32_fp8(_w, false), _hi = __builtin_amdgcn_cvt_pk_f32_fp8(_w, true); \
            acc[_i][_j] += (f32x4){_lo.x, _lo.y, _hi.x, _hi.y} * _a; } } while (0)
__device__ __forceinline__ void gather_token(int t, const float* __restrict__ X1, const bf16_t* __restrict__ X1B, const int* __restrict__ EIDX, const float* __restrict__ GATE,
                                             const unsigned char* __restrict__ U8, const unsigned char* __restrict__ V8, const float* __restrict__ SU, const float* __restrict__ SV,
                                             const float* __restrict__ g2, const float* __restrict__ b2, float* out, int lane) {
    unsigned xb[2][8];
#pragma unroll
    for (int i = 0; i < 2; ++i) {
        const v4u a = *(const v4u*)(X1B + (size_t)t * D_MODEL + 1024 * i + 16 * lane), b = *(const v4u*)(X1B + (size_t)t * D_MODEL + 1024 * i + 16 * lane + 8);
        xb[i][0] = a.x; xb[i][1] = a.y; xb[i][2] = a.z; xb[i][3] = a.w; xb[i][4] = b.x; xb[i][5] = b.y; xb[i][6] = b.z; xb[i][7] = b.w;
    }
    const int id_lo = EIDX[(size_t)t * EPT + lane], id_hi = EIDX[(size_t)t * EPT + 64 + lane];
    const float g_lo = GATE[(size_t)t * EPT + lane], g_hi = GATE[(size_t)t * EPT + 64 + lane];
    const float su_lo = SU[id_lo], su_hi = SU[id_hi], sv_lo = SV[id_lo], sv_hi = SV[id_hi];
    f32x4 acc[2][4];
#pragma unroll
    for (int i = 0; i < 2; ++i)
#pragma unroll
        for (int j = 0; j < 4; ++j) acc[i][j] = (f32x4){0.f, 0.f, 0.f, 0.f};
    const int e_me = ((lane >> 5) & 1) * 8 + ((lane >> 4) & 1) * 4 + ((lane >> 3) & 1) * 2 + ((lane >> 2) & 1);
    v4u buf[8][2];
#pragma unroll
    for (int e = 0; e < 8; ++e) G_ISSUE1(e, U8, id_lo, e);
#pragma unroll 1
    for (int hh = 0; hh < 8; ++hh) {
        const int idv = hh < 4 ? id_lo : id_hi; const float gv = hh < 4 ? g_lo : g_hi, suv = hh < 4 ? su_lo : su_hi, svv = hh < 4 ? sv_lo : sv_hi;
        const int lb = (hh & 3) * 16;
        const int hn = hh < 7 ? hh + 1 : 7; const int idn = hn < 4 ? id_lo : id_hi; const int lbn = (hn & 3) * 16;
        float part[16];
#pragma unroll
        for (int e = 0; e < 16; ++e) {
            G_DOT1(e & 7, e);
            if (e < 8) G_ISSUE1(e & 7, U8, idv, lb + e + 8); else G_ISSUE1(e & 7, V8, idv, lb + e - 8);
        }
        const float hval = reduce16(part, lane) * __shfl(suv, lb + e_me);
        const float aval = __shfl(gv, lb + e_me) * gelu_erf(hval) * __shfl(svv, lb + e_me);
#pragma unroll
        for (int e = 0; e < 16; ++e) {
            G_FMA1(e & 7, e);
            if (e < 8) G_ISSUE1(e & 7, V8, idv, lb + e + 8); else G_ISSUE1(e & 7, U8, idn, lbn + e - 8);
        }
    }
    float s = 0.f;
#pragma unroll
    for (int i = 0; i < 2; ++i)
#pragma unroll
        for (int j = 0; j < 4; ++j) {
            const f32x4 x0 = *(const f32x4*)(X1 + (size_t)t * D_MODEL + 1024 * i + 16 * lane + 4 * j);
            acc[i][j] = x0 * ALPHA + acc[i][j];
            s += (acc[i][j].x + acc[i][j].y) + (acc[i][j].z + acc[i][j].w);
        }
    const float mean = wave_sum(s) * (1.f / D_MODEL); float q = 0.f;
#pragma unroll
    for (int i = 0; i < 2; ++i)
#pragma unroll
        for (int j = 0; j < 4; ++j) { acc[i][j] = acc[i][j] - mean; q += (acc[i][j].x * acc[i][j].x + acc[i][j].y * acc[i][j].y) + (acc[i][j].z * acc[i][j].z + acc[i][j].w * acc[i][j].w); }
    const float rstd = 1.0f / sqrtf(wave_sum(q) * (1.f / D_MODEL) + LN_EPS);
#pragma unroll
    for (int i = 0; i < 2; ++i)
#pragma unroll
        for (int j = 0; j < 4; ++j) {
            const int c = 1024 * i + 16 * lane + 4 * j;
            const f32x4 gg = *(const f32x4*)(g2 + c), bb = *(const f32x4*)(b2 + c);
            *(f32x4*)(out + (size_t)t * D_MODEL + c) = acc[i][j] * rstd * gg + bb;
        }
}
template <int R>
__device__ __forceinline__ void cvt_rows_fp8(const float* __restrict__ in, unsigned char* out8, float* sc, int row0, int lane) {
    f32x4 v[R][2][4];
#pragma unroll
    for (int r = 0; r < R; ++r)
#pragma unroll
        for (int i = 0; i < 2; ++i)
#pragma unroll
            for (int j = 0; j < 4; ++j) v[r][i][j] = __builtin_nontemporal_load((const f32x4*)(in + (size_t)(row0 + r) * D_MODEL + 16 * lane + 1024 * i + 4 * j));
#pragma unroll
    for (int r = 0; r < R; ++r) {
        float am = 0.f;
#pragma unroll
        for (int i = 0; i < 2; ++i)
#pragma unroll
            for (int j = 0; j < 4; ++j) am = fmaxf(am, fmaxf(fmaxf(fabsf(v[r][i][j].x), fabsf(v[r][i][j].y)), fmaxf(fabsf(v[r][i][j].z), fabsf(v[r][i][j].w))));
#pragma unroll
        for (int o = 1; o < 64; o <<= 1) am = fmaxf(am, __shfl_xor(am, o));
        const float inv = am > 0.f ? 256.0f / am : 1.0f, scale = am > 0.f ? am * (1.0f / 256.0f) : 1.0f;
#pragma unroll
        for (int i = 0; i < 2; ++i) {
            v4u o;
#pragma unroll
            for (int j = 0; j < 4; ++j) { int w = 0; w = __builtin_amdgcn_cvt_pk_fp8_f32(v[r][i][j].x * inv, v[r][i][j].y * inv, w, false); w = __builtin_amdgcn_cvt_pk_fp8_f32(v[r][i][j].z * inv, v[r][i][j].w * inv, w, true); o[j] = (unsigned)w; }
            *(v4u*)(out8 + (size_t)(row0 + r) * D_MODEL + 1024 * i + 16 * lane) = o;
        }
        if (lane == 0) sc[row0 + r] = scale;
    }
}

struct Args { const void* in[18]; float* out; unsigned char* ws; int ph_lo, ph_hi, li, pad; };
constexpr int N_PHASES = 8;

#define P_IN(T, i) ((const T*)args.in[i])
#define P_WS(T, off) ((T*)(ws + (off)))
#define x_in P_IN(float, 0)
#define mem_in P_IN(float, 1)
#define positions P_IN(int, 2)
#define w_in P_IN(float, 3)
#define w_mem_kv P_IN(float, 4)
#define w_pool P_IN(float, 5)
#define pool_scale P_IN(float, 6)
#define sinks P_IN(float, 7)
#define w_out P_IN(float, 8)
#define ln1_g P_IN(float, 9)
#define ln1_b P_IN(float, 10)
#define w_peer_q P_IN(float, 11)
#define sk1 P_IN(float, 12)
#define sk2 P_IN(float, 13)
#define eu P_IN(float, 14)
#define ev P_IN(float, 15)
#define ln2_g P_IN(float, 16)
#define ln2_b P_IN(float, 17)
#define WINT P_WS(bf16_t, WS_WINT)
#define WKVT P_WS(bf16_t, WS_WKVT)
#define WOT P_WS(bf16_t, WS_WOT)
#define WQT P_WS(bf16_t, WS_WQT)
#define WPT P_WS(bf16_t, WS_SMALL)
#define K1B P_WS(bf16_t, WS_SMALL + 131072)
#define K2B P_WS(bf16_t, WS_SMALL + 163840)
#define ROPE P_WS(float, WS_SMALL + 262144)
#define XB P_WS(bf16_t, WS_XB)
#define X1B P_WS(bf16_t, WS_X1B)
#define MEMB P_WS(bf16_t, WS_MEMB)
#define KVM P_WS(bf16_t, WS_KVM)
#define POOLV P_WS(float, WS_POOLV)
#define Q P_WS(bf16_t, WS_Q)
#define Kb P_WS(bf16_t, WS_K)
#define Vb P_WS(bf16_t, WS_V)
#define QM P_WS(bf16_t, WS_QM)
#define CONCAT P_WS(bf16_t, WS_CONCAT)
#define Y1 P_WS(float, WS_Y1)
#define X1 P_WS(float, WS_X1)
#define QP P_WS(bf16_t, WS_QP)
#define EIDX P_WS(int, WS_EIDX)
#define GATE P_WS(float, WS_GATE)
#define U8 P_WS(unsigned char, WS_UB)
#define V8 P_WS(unsigned char, WS_VB)
#define SU P_WS(float, WS_UB + 48 * MiB)
#define SV P_WS(float, WS_VB + 48 * MiB)
__global__ void __launch_bounds__(NTHREADS, 2) mega_fwd(Args args) {
    extern __shared__ __attribute__((aligned(16))) unsigned char lds_raw[];
    LAS unsigned char* lds = (LAS unsigned char*)lds_raw;
    volatile LAS unsigned* MISC = (volatile LAS unsigned*)(lds + MISC_OFF);
    const int tid = threadIdx.x, lane = tid & 63, wave = __builtin_amdgcn_readfirstlane(tid >> 6);
    const int G = gridDim.x, bx = blockIdx.x;
    const int vcu = (G % 8 == 0) ? (bx % 8) * (G / 8) + bx / 8 : bx;
    const int gw = vcu * NWAVES + wave, NGW = G * NWAVES;
    unsigned char* ws = args.ws;
    for (int u = tid; u < (LDS_BYTES - MISC_OFF) / 4; u += NTHREADS) MISC[u] = 0u;
    __syncthreads();
    XcdBarrier bar = xcd_barrier_post((unsigned*)(ws + WS_CTL) + CW_BAR + args.li * XCD_BAR_WORDS, MISC + 8);
    const int lo = args.ph_lo, hi = args.ph_hi;
#ifndef ONLY_PHASES
#define ONLY_PHASES 255
#endif
#define IN(k) (((ONLY_PHASES >> (k)) & 1) && lo <= (k) && (k) < hi)
#ifndef REPEAT_MASK
#define REPEAT_MASK 0
#endif
#define REP(k) for (int _rep = 0; _rep < 1 + ((REPEAT_MASK >> (k)) & 1); ++_rep)
#define SEAM(k) do { if (IN(k) && IN((k) + 1)) xcd_barrier(bar); } while (0)

    if (IN(0)) REP(0) {
        LAS float* scr = (LAS float*)(lds + wave * 16384);
        constexpr int I_IN = (D_MODEL / 64) * (IN_W / 32), I_KV = (D_MODEL / 64) * (2 * MEM_W / 32), I_O = (D_MODEL / 64) * (D_MODEL / 32), I_Q = I_O, I_P = 4 * 2 * 4;
        constexpr int NITEMS = I_IN + I_KV + I_O + I_Q + I_P;
        for (int it = gw; it < NITEMS; it += NGW) {
            int r = it;
            if (r < I_IN) { p0_transpose_item(w_in, D_MODEL, IN_W, WINT, scr, r, lane); continue; } r -= I_IN;
            if (r < I_KV) { p0_transpose_item(w_mem_kv, D_MODEL, 2 * MEM_W, WKVT, scr, r, lane); continue; } r -= I_KV;
            if (r < I_O) { p0_transpose_item(w_out, D_MODEL, D_MODEL, WOT, scr, r, lane); continue; } r -= I_O;
            if (r < I_Q) { p0_transpose_item(w_peer_q, D_MODEL, D_MODEL, WQT, scr, r, lane); continue; } r -= I_Q;
            { const int gpl = r >> 3; p0_transpose_item(w_pool + (size_t)gpl * 16384, 128, 128, WPT + (size_t)gpl * 16384, scr, r & 7, lane); }
        }
        cvt_stream<false>(x_in, XB, (size_t)MTOK * D_MODEL, gw, NGW, lane);
        cvt_stream<false>(mem_in, MEMB, (size_t)MMEM * D_MODEL, gw, NGW, lane);
        cvt_stream<false>(sk1, K1B, (size_t)NKEYS * 128, gw, NGW, lane);
        cvt_stream<false>(sk2, K2B, (size_t)NKEYS * 128, gw, NGW, lane);
        for (int i = gw * 64 + lane; i < MTOK * 8; i += NGW * 64) { float c, s; rope_cs(positions[i >> 3], i & 7, c, s); *(f32x2*)(ROPE + 2 * (size_t)i) = (f32x2){c, s}; }
    }
    SEAM(0);
    if (IN(1)) REP(1) {
        { pg8::Gemm g{XB, WINT, MTOK, IN_W, D_MODEL}; pg8::StaticOrder S; S.init(MTOK, IN_W, G, bx);
          EpiIn E{POOLV, Q, Kb, Vb, QM, ROPE};
          pg8::gemm_phase<EpiIn, pg8::StaticOrder, true, true>(lds, g, S, E); }
        { pg8::Gemm g{MEMB, WKVT, MMEM, 2 * MEM_W, D_MODEL}; pg8::StaticOrder S; S.init(MMEM, 2 * MEM_W, G, (bx + G - 64) % G);
          EpiStoreBf E{KVM, 2 * MEM_W};
          pg8::gemm_phase<EpiStoreBf, pg8::StaticOrder, true, true>(lds, g, S, E); }
        { const int f0 = (G == 256) ? 72 : 0;
          if (bx >= f0) { const int fw = (bx - f0) * NWAVES + wave, NFW = (G - f0) * NWAVES;
            for (int r = fw * 4; r < 2 * NEXP; r += NFW * 4) { if (r < NEXP) cvt_rows_fp8<4>(eu, U8, SU, r, lane); else cvt_rows_fp8<4>(ev, V8, SV, r - NEXP, lane); } } }
    }
    SEAM(1);
    if (IN(2)) REP(2) {
        for (int it = vcu; it < 512; it += G) {
            if (it < 256) swa_item(lds, it, Q, Kb, Vb, sinks, CONCAT, tid, wave, lane);
            else mem_item(lds, it - 256, QM, KVM, CONCAT, tid, wave, lane);
        }
        for (int it = gw; it < (MTOK / 16) * 4; it += NGW) pool_item(it, POOLV, WPT, pool_scale, CONCAT, lane);
    }
    SEAM(2);
    if (IN(3)) REP(3) {
        pg8::Gemm g{CONCAT, WOT, MTOK, D_MODEL, D_MODEL}; pg8::StaticOrder S; S.init(MTOK, D_MODEL, G, bx);
        EpiY1 E{x_in, Y1};
        pg8::gemm_phase<EpiY1, pg8::StaticOrder, true, true>(lds, g, S, E);
    }
    SEAM(3);
    if (IN(4)) REP(4) { for (int r = gw; r < MTOK; r += NGW) ln1_row(Y1 + (size_t)r * D_MODEL, ln1_g, ln1_b, X1 + (size_t)r * D_MODEL, X1B + (size_t)r * D_MODEL, lane); }
    SEAM(4);
    if (IN(5)) REP(5) {
        pg8::Gemm g{X1B, WQT, MTOK, D_MODEL, D_MODEL}; pg8::StaticOrder S; S.init(MTOK, D_MODEL, G, bx);
        EpiStoreBf E{QP, D_MODEL};
        pg8::gemm_phase<EpiStoreBf, pg8::StaticOrder, true, true>(lds, g, S, E);
    }
    SEAM(5);
    if (IN(6)) REP(6) {
#pragma unroll
        for (int j = 0; j < 8; ++j) { const int c = tid + NTHREADS * j, half = c >> 11, row = (c >> 4) & 127, part = c & 15;
            *(LAS v4u*)(lds + half * TK_HALF + row * TK_KROW + part * 16) = *(const v4u*)((half ? K2B : K1B) + row * 128 + part * 8); }
        __syncthreads();
        for (int it = gw; it < (MTOK / 16) * PHEADS; it += NGW) topk_item(it, QP, lds, EIDX, GATE, lane);
        __syncthreads();
    }
    SEAM(6);
    if (IN(7)) REP(7) { for (int t = gw; t < MTOK; t += NGW) gather_token(t, X1, X1B, EIDX, GATE, U8, V8, SU, SV, ln2_g, ln2_b, args.out, lane); }
#undef IN
#undef SEAM
}
#undef P_IN(T,
#undef P_WS(T,
#undef x_in
#undef mem_in
#undef positions
#undef w_in
#undef w_mem_kv
#undef w_pool
#undef pool_scale
#undef sinks
#undef w_out
#undef ln1_g
#undef ln1_b
#undef w_peer_q
#undef sk1
#undef sk2
#undef eu
#undef ev
#undef ln2_g
#undef ln2_b
#undef WINT
#undef WKVT
#undef WOT
#undef WQT
#undef WPT
#undef K1B
#undef K2B
#undef ROPE
#undef XB
#undef X1B
#undef MEMB
#undef KVM
#undef POOLV
#undef Q
#undef Kb
#undef Vb
#undef QM
#undef CONCAT
#undef Y1
#undef X1
#undef QP
#undef EIDX
#undef GATE
#undef U8
#undef V8
#undef SU
#undef SV

#if NAIVE_MASK != 0
__device__ __forceinline__ float toF(float v) { return v; }
__device__ __forceinline__ float toF(bf16_t v) { return bf2f(v); }

struct NvEpiF32 { float* C; int ldc, pad; __device__ void operator()(int r, int c, float v) const { C[(size_t)r * ldc + c] = v; } };
struct NvEpiBf { bf16_t* C; int ldc, pad; __device__ void operator()(int r, int c, float v) const { C[(size_t)r * ldc + c] = f2bf(v); } };
struct NvEpiY1 { const float* x; float* y; __device__ void operator()(int r, int c, float v) const { y[(size_t)r * D_MODEL + c] = ALPHA * x[(size_t)r * D_MODEL + c] + v; } };

template <class TA, class Epi>
__global__ void __launch_bounds__(256) nv_gemm(const TA* __restrict__ A, const float* __restrict__ B, int M, int N, int K, Epi epi) {
    __shared__ float As[16][65];
    __shared__ float Bs[16][64];
    const int tx = threadIdx.x & 15, ty = threadIdx.x >> 4;
    const int m0 = blockIdx.y * 64, n0 = blockIdx.x * 64;
    float acc[4][4];
#pragma unroll
    for (int i = 0; i < 4; ++i)
#pragma unroll
        for (int j = 0; j < 4; ++j) acc[i][j] = 0.f;
    for (int k0 = 0; k0 < K; k0 += 16) {
        for (int i = threadIdx.x; i < 1024; i += 256) { const int r = i >> 4, c = i & 15; As[c][r] = toF(A[(size_t)(m0 + r) * K + k0 + c]); }
        for (int i = threadIdx.x; i < 1024; i += 256) { const int r = i >> 6, c = i & 63; Bs[r][c] = B[(size_t)(k0 + r) * N + n0 + c]; }
        __syncthreads();
#pragma unroll
        for (int kk = 0; kk < 16; ++kk) {
            float a[4], b[4];
#pragma unroll
            for (int i = 0; i < 4; ++i) { a[i] = As[kk][ty * 4 + i]; b[i] = Bs[kk][tx * 4 + i]; }
#pragma unroll
            for (int i = 0; i < 4; ++i)
#pragma unroll
                for (int j = 0; j < 4; ++j) acc[i][j] += a[i] * b[j];
        }
        __syncthreads();
    }
#pragma unroll
    for (int i = 0; i < 4; ++i)
#pragma unroll
        for (int j = 0; j < 4; ++j) epi(m0 + ty * 4 + i, n0 + tx * 4 + j, acc[i][j]);
}

__global__ void nv_post1(const float* __restrict__ H, const int* __restrict__ positions, float* POOLV, bf16_t* Q, bf16_t* Kb, bf16_t* Vb, bf16_t* QM) {
    const size_t gid = (size_t)blockIdx.x * blockDim.x + threadIdx.x;
    if (gid >= (size_t)MTOK * IN_W) return;
    const int t = (int)(gid / IN_W), col = (int)(gid % IN_W);
    const float* hr = H + (size_t)t * IN_W;
    const float v = hr[col];
    if (col < POOL_W) { POOLV[(size_t)t * POOL_W + col] = v; return; }
    if (col < POOL_W + SWA_W + KV_W) {
        const bool isq = col < POOL_W + SWA_W;
        const int c = isq ? col - POOL_W : col - POOL_W - SWA_W;
        const int d = c & 63;
        float o = v;
        if (d < 16) {
            const int j = d & 7; float cs, sn; rope_cs(positions[t], j, cs, sn);
            if (d < 8) o = v * cs - hr[col + 8] * sn; else o = v * cs + hr[col - 8] * sn;
        }
        if (isq) Q[(size_t)t * SWA_W + c] = f2bf(o); else Kb[(size_t)t * KV_W + c] = f2bf(o);
        return;
    }
    if (col < POOL_W + SWA_W + 2 * KV_W) { Vb[(size_t)t * KV_W + (col - POOL_W - SWA_W - KV_W)] = f2bf(v); return; }
    QM[(size_t)t * MEM_W + (col - POOL_W - SWA_W - 2 * KV_W)] = f2bf(v);
}
__global__ void nv_cvt_bf16(const float* __restrict__ in, bf16_t* out, size_t n) {
    const size_t gid = (size_t)blockIdx.x * blockDim.x + threadIdx.x;
    if (gid < n) out[gid] = f2bf(in[gid]);
}
__global__ void nv_pool1(const float* __restrict__ POOLV, float* PS) {
    const size_t gid = (size_t)blockIdx.x * blockDim.x + threadIdx.x;
    if (gid >= (size_t)MTOK * POOL_W) return;
    const int t = (int)(gid / POOL_W), ch = (int)(gid % POOL_W);
    const int g = ch >> 7, w = 2 << g, s = t & (SEQ - 1);
    const int cnt = (s + 1) < w ? (s + 1) : w;
    float sum = 0.f;
    for (int i = 0; i < cnt; ++i) sum += POOLV[(size_t)(t - i) * POOL_W + ch];
    PS[gid] = sum / (float)cnt - POOLV[gid];
}
__global__ void nv_pool2(const float* __restrict__ PS, const float* __restrict__ w_pool, const float* __restrict__ pool_scale, bf16_t* CONCAT) {
    const size_t gid = (size_t)blockIdx.x * blockDim.x + threadIdx.x;
    if (gid >= (size_t)MTOK * POOL_W) return;
    const int t = (int)(gid / POOL_W), ch = (int)(gid % POOL_W);
    const int g = ch >> 7, d = ch & 127;
    const float* p = PS + (size_t)t * POOL_W + g * 128;
    const float* w = w_pool + (size_t)g * 128 * 128 + d;
    float y = 0.f;
    for (int c = 0; c < 128; ++c) y += p[c] * w[(size_t)c * 128];
    CONCAT[(size_t)t * D_MODEL + ch] = f2bf(y * pool_scale[ch]);
}
__global__ void __launch_bounds__(256) nv_swa(const bf16_t* __restrict__ Q, const bf16_t* __restrict__ Kb, const bf16_t* __restrict__ Vb, const float* __restrict__ sinks, bf16_t* CONCAT) {
    const int wv = (int)((blockIdx.x * 256 + threadIdx.x) >> 6), lane = threadIdx.x & 63;
    if (wv >= MTOK * NHEAD) return;
    const int t = wv / NHEAD, h = wv % NHEAD, kvh = h >> 2, s = t & (SEQ - 1), tb = t - s;
    const float q = bf2f(Q[(size_t)t * SWA_W + h * HD + lane]);
    float m = sinks[h], l = 1.0f, o = 0.f;
    const int k0 = s - (WINDOW - 1) < 0 ? 0 : s - (WINDOW - 1);
    for (int kk = k0; kk <= s; ++kk) {
        const size_t kt = (size_t)(tb + kk);
        const float sc = wave_sum(q * bf2f(Kb[kt * KV_W + kvh * HD + lane])) * 0.125f;
        const float mn = fmaxf(m, sc), r = expf(m - mn), p = expf(sc - mn);
        l = l * r + p; o = o * r + p * bf2f(Vb[kt * KV_W + kvh * HD + lane]); m = mn;
    }
    CONCAT[(size_t)t * D_MODEL + POOL_W + h * HD + lane] = f2bf(o / l);
}
__global__ void __launch_bounds__(256) nv_mem(const bf16_t* __restrict__ QM, const bf16_t* __restrict__ KVM, bf16_t* CONCAT) {
    const int wv = (int)((blockIdx.x * 256 + threadIdx.x) >> 6), lane = threadIdx.x & 63;
    if (wv >= MTOK * MHEADS) return;
    const int t = wv / MHEADS, hm = wv % MHEADS, b = t / SEQ;
    const float q0 = bf2f(QM[(size_t)t * MEM_W + hm * MHD + lane]), q1 = bf2f(QM[(size_t)t * MEM_W + hm * MHD + 64 + lane]);
    float m = -1e30f, l = 0.f, o0 = 0.f, o1 = 0.f;
    const float scale = 0.08838834764831845f;
    for (int j = 0; j < MEM_LEN; ++j) {
        const bf16_t* kr = KVM + (size_t)(b * MEM_LEN + j) * (2 * MEM_W) + hm * MHD;
        const bf16_t* vr = kr + MEM_W;
        const float sc = wave_sum(q0 * bf2f(kr[lane]) + q1 * bf2f(kr[64 + lane])) * scale;
        const float mn = fmaxf(m, sc), r = expf(m - mn), p = expf(sc - mn);
        l = l * r + p; o0 = o0 * r + p * bf2f(vr[lane]); o1 = o1 * r + p * bf2f(vr[64 + lane]); m = mn;
    }
    bf16_t* orow = CONCAT + (size_t)t * D_MODEL + POOL_W + SWA_W + hm * MHD;
    orow[lane] = f2bf(o0 / l); orow[64 + lane] = f2bf(o1 / l);
}
__global__ void __launch_bounds__(256) nv_ln(const float* __restrict__ in, const float* __restrict__ g, const float* __restrict__ bta, float* outf, bf16_t* outb) {
    const int row = (int)((blockIdx.x * 256 + threadIdx.x) >> 6), lane = threadIdx.x & 63;
    if (row >= MTOK) return;
    const float* r = in + (size_t)row * D_MODEL;
    float v[32]; float s = 0.f;
#pragma unroll
    for (int i = 0; i < 32; ++i) { v[i] = r[lane + 64 * i]; s += v[i]; }
    const float mean = wave_sum(s) * (1.f / D_MODEL); float q = 0.f;
#pragma unroll
    for (int i = 0; i < 32; ++i) { v[i] -= mean; q += v[i] * v[i]; }
    const float rstd = 1.0f / sqrtf(wave_sum(q) * (1.f / D_MODEL) + LN_EPS);
#pragma unroll
    for (int i = 0; i < 32; ++i) {
        const int c = lane + 64 * i; const float y = v[i] * rstd * g[c] + bta[c];
        if (outf) outf[(size_t)row * D_MODEL + c] = y;
        if (outb) outb[(size_t)row * D_MODEL + c] = f2bf(y);
    }
}
__global__ void __launch_bounds__(32) nv_topk(const bf16_t* __restrict__ QP, const float* __restrict__ K1, const float* __restrict__ K2, int* EIDX, float* GATE) {
    __shared__ float sc[256][32];
    __shared__ float lv[32][32];
    __shared__ int li[32][32];
    const int tid = threadIdx.x, gid = blockIdx.x * 32 + tid;
    const int t = gid / PHEADS, h = gid % PHEADS;
    const bf16_t* q = QP + (size_t)t * D_MODEL + h * 256;
    for (int half = 0; half < 2; ++half) {
        const float* Kk = half ? K2 : K1;
        for (int k = 0; k < NKEYS; ++k) {
            float a = 0.f;
            for (int c = 0; c < 128; ++c) a += bf2f(q[half * 128 + c]) * Kk[k * 128 + c];
            sc[half * 128 + k][tid] = a;
        }
        for (int r = 0; r < TOPK; ++r) {
            float best = -INFINITY; int bi = 0;
            for (int k = 0; k < NKEYS; ++k) { const float v = sc[half * 128 + k][tid]; if (v > best) { best = v; bi = k; } }
            lv[half * 16 + r][tid] = best; li[half * 16 + r][tid] = bi; sc[half * 128 + bi][tid] = -INFINITY;
        }
    }
    for (int a = 0; a < 16; ++a) for (int b = 0; b < 16; ++b) sc[a * 16 + b][tid] = lv[a][tid] + lv[16 + b][tid];
    float mx = 0.f, den = 0.f;
    float tv[16]; int ti[16];
#pragma unroll
    for (int r = 0; r < TOPK; ++r) {
        float best = -INFINITY; int bi = 0;
        for (int k = 0; k < 256; ++k) { const float v = sc[k][tid]; if (v > best) { best = v; bi = k; } }
        sc[bi][tid] = -INFINITY;
        if (r == 0) mx = best;
        tv[r] = expf(best - mx); den += tv[r]; ti[r] = li[bi >> 4][tid] * NKEYS + li[16 + (bi & 15)][tid];
    }
#pragma unroll
    for (int r = 0; r < TOPK; ++r) { EIDX[(size_t)t * EPT + h * TOPK + r] = ti[r]; GATE[(size_t)t * EPT + h * TOPK + r] = tv[r] / den; }
}
__global__ void __launch_bounds__(256) nv_gather(const float* __restrict__ X1, const int* __restrict__ EIDX, const float* __restrict__ GATE, const float* __restrict__ EU, const float* __restrict__ EV,
                                                  const float* __restrict__ g, const float* __restrict__ bta, float* out) {
    const int t = (int)((blockIdx.x * 256 + threadIdx.x) >> 6), lane = threadIdx.x & 63;
    if (t >= MTOK) return;
    float x[32], acc[32];
#pragma unroll
    for (int i = 0; i < 32; ++i) { x[i] = X1[(size_t)t * D_MODEL + lane + 64 * i]; acc[i] = 0.f; }
    for (int e = 0; e < EPT; ++e) {
        const int id = EIDX[(size_t)t * EPT + e]; const float gt = GATE[(size_t)t * EPT + e];
        const float* u = EU + (size_t)id * D_MODEL; const float* vv = EV + (size_t)id * D_MODEL;
        float p = 0.f;
#pragma unroll
        for (int i = 0; i < 32; ++i) p += x[i] * u[lane + 64 * i];
        const float a = gt * gelu_erf(wave_sum(p));
#pragma unroll
        for (int i = 0; i < 32; ++i) acc[i] += a * vv[lane + 64 * i];
    }
    float s = 0.f;
#pragma unroll
    for (int i = 0; i < 32; ++i) { acc[i] = ALPHA * x[i] + acc[i]; s += acc[i]; }
    const float mean = wave_sum(s) * (1.f / D_MODEL); float q = 0.f;
#pragma unroll
    for (int i = 0; i < 32; ++i) { acc[i] -= mean; q += acc[i] * acc[i]; }
    const float rstd = 1.0f / sqrtf(wave_sum(q) * (1.f / D_MODEL) + LN_EPS);
#pragma unroll
    for (int i = 0; i < 32; ++i) { const int c = lane + 64 * i; out[(size_t)t * D_MODEL + c] = acc[i] * rstd * g[c] + bta[c]; }
}

#endif
extern "C" void kernel_launch(void* const* d_in, const int* in_sizes, int n_in, void* d_out, int out_size, void* d_ws, size_t ws_size, hipStream_t stream) {
    static int grid = 0;
    if (grid == 0) {
        if (n_in != 18 || in_sizes[0] != MTOK * D_MODEL || out_size != MTOK * D_MODEL || ws_size < WS_END) {
            fprintf(stderr, "kernel_launch: unexpected shapes (n_in %d, in0 %d, out %d, ws %zu)\n", n_in, n_in > 0 ? in_sizes[0] : -1, out_size, ws_size); grid = -1; return; }
        int dev = 0, cus = 0, per_cu = 0;
        if (hipGetDevice(&dev) != hipSuccess || hipDeviceGetAttribute(&cus, hipDeviceAttributeMultiprocessorCount, dev) != hipSuccess) { fprintf(stderr, "kernel_launch: device query failed\n"); grid = -1; return; }
        if (hipFuncSetAttribute((const void*)mega_fwd, hipFuncAttributeMaxDynamicSharedMemorySize, LDS_BYTES) != hipSuccess) { fprintf(stderr, "kernel_launch: hipFuncSetAttribute failed\n"); grid = -1; return; }
        if (hipOccupancyMaxActiveBlocksPerMultiprocessor(&per_cu, (const void*)mega_fwd, NTHREADS, LDS_BYTES) != hipSuccess || per_cu < 1) {
            fprintf(stderr, "kernel_launch: occupancy query reports %d workgroups per CU\n", per_cu); (void)hipGetLastError(); grid = -1; return; }
        grid = cus;
    }
    if (grid < 0) return;
    unsigned char* ws = (unsigned char*)d_ws;
    (void)hipMemsetAsync(ws + WS_CTL, 0, 1 * MiB, stream);
    Args a{};
    for (int i = 0; i < 18; ++i) a.in[i] = d_in[i];
    a.out = (float*)d_out; a.ws = ws;
#if NAIVE_MASK != 0
    const float* x = (const float*)d_in[0]; const float* mem = (const float*)d_in[1]; const int* positions = (const int*)d_in[2];
    const float* w_in = (const float*)d_in[3]; const float* w_mem_kv = (const float*)d_in[4]; const float* w_pool = (const float*)d_in[5];
    const float* pool_scale = (const float*)d_in[6]; const float* sinks = (const float*)d_in[7]; const float* w_out = (const float*)d_in[8];
    const float* ln1_g = (const float*)d_in[9]; const float* ln1_b = (const float*)d_in[10]; const float* w_peer_q = (const float*)d_in[11];
    const float* sk1 = (const float*)d_in[12]; const float* sk2 = (const float*)d_in[13]; const float* eu = (const float*)d_in[14]; const float* ev = (const float*)d_in[15];
    const float* ln2_g = (const float*)d_in[16]; const float* ln2_b = (const float*)d_in[17];
    float* out = (float*)d_out;
    float* POOLV = (float*)(ws + WS_POOLV); bf16_t* Q = (bf16_t*)(ws + WS_Q); bf16_t* Kb = (bf16_t*)(ws + WS_K); bf16_t* Vb = (bf16_t*)(ws + WS_V); bf16_t* QM = (bf16_t*)(ws + WS_QM);
    bf16_t* KVM = (bf16_t*)(ws + WS_KVM); bf16_t* CONCAT = (bf16_t*)(ws + WS_CONCAT); float* Y1 = (float*)(ws + WS_Y1); float* X1 = (float*)(ws + WS_X1); bf16_t* X1B = (bf16_t*)(ws + WS_X1B);
    bf16_t* QP = (bf16_t*)(ws + WS_QP); int* EIDX = (int*)(ws + WS_EIDX); float* GATE = (float*)(ws + WS_GATE);
    float* NVH = (float*)(ws + WS_NV_H); float* NVPS = (float*)(ws + WS_NV_PS); float* NVKVM = (float*)(ws + WS_NV_KVM);
#endif
    int li = 0;
    for (int p = 0; p < N_PHASES;) {
#if NAIVE_MASK != 0
        if ((NAIVE_MASK >> p) & 1) {
            switch (p) {
            case 1:
                nv_gemm<float, NvEpiF32><<<dim3(IN_W / 64, MTOK / 64), 256, 0, stream>>>(x, w_in, MTOK, IN_W, D_MODEL, NvEpiF32{NVH, IN_W, 0});
                nv_gemm<float, NvEpiF32><<<dim3(2 * MEM_W / 64, MMEM / 64), 256, 0, stream>>>(mem, w_mem_kv, MMEM, 2 * MEM_W, D_MODEL, NvEpiF32{NVKVM, 2 * MEM_W, 0});
                nv_post1<<<(unsigned)(((size_t)MTOK * IN_W + 255) / 256), 256, 0, stream>>>(NVH, positions, POOLV, Q, Kb, Vb, QM);
                nv_cvt_bf16<<<(MMEM * 2 * MEM_W + 255) / 256, 256, 0, stream>>>(NVKVM, KVM, (size_t)MMEM * 2 * MEM_W);
                break;
            case 2:
                nv_pool1<<<MTOK * POOL_W / 256, 256, 0, stream>>>(POOLV, NVPS);
                nv_pool2<<<MTOK * POOL_W / 256, 256, 0, stream>>>(NVPS, w_pool, pool_scale, CONCAT);
                nv_swa<<<MTOK * NHEAD / 4, 256, 0, stream>>>(Q, Kb, Vb, sinks, CONCAT);
                nv_mem<<<MTOK * MHEADS / 4, 256, 0, stream>>>(QM, KVM, CONCAT);
                break;
            case 3: nv_gemm<bf16_t, NvEpiY1><<<dim3(D_MODEL / 64, MTOK / 64), 256, 0, stream>>>(CONCAT, w_out, MTOK, D_MODEL, D_MODEL, NvEpiY1{x, Y1}); break;
            case 4: nv_ln<<<MTOK / 4, 256, 0, stream>>>(Y1, ln1_g, ln1_b, X1, X1B); break;
            case 5: nv_gemm<float, NvEpiBf><<<dim3(D_MODEL / 64, MTOK / 64), 256, 0, stream>>>(X1, w_peer_q, MTOK, D_MODEL, D_MODEL, NvEpiBf{QP, D_MODEL, 0}); break;
            case 6: nv_topk<<<MTOK * PHEADS / 32, 32, 0, stream>>>(QP, sk1, sk2, EIDX, GATE); break;
            case 7: nv_gather<<<MTOK / 4, 256, 0, stream>>>(X1, EIDX, GATE, eu, ev, ln2_g, ln2_b, out); break;
            default: break;
            }
            ++p; continue;
        }
#endif
        int q = p;
        while (q < N_PHASES && !((NAIVE_MASK >> q) & 1)) ++q;
        a.ph_lo = p; a.ph_hi = q; a.li = li++;
        hipLaunchKernelGGL(mega_fwd, dim3(grid), dim3(NTHREADS), LDS_BYTES, stream, a);
        const hipError_t le = hipPeekAtLastError();
        if (le != hipSuccess) { fprintf(stderr, "kernel_launch: launch failed: %s\n", hipGetErrorName(le)); break; }
        p = q;
    }
#ifdef PROBE_EXTRA_LO
    a.ph_lo = PROBE_EXTRA_LO; a.ph_hi = PROBE_EXTRA_HI; a.li = li++;
    hipLaunchKernelGGL(mega_fwd, dim3(grid), dim3(NTHREADS), LDS_BYTES, stream, a);
#endif
}
```

```cpp
#include <hip/hip_runtime.h>
#include <cstdint>
#include <cstdio>
#ifndef NAIVE_MASK
#define NAIVE_MASK 0
#endif

constexpr int D_MODEL = 2048, BATCH = 2, SEQ = 4096, MTOK = BATCH * SEQ, MEM_LEN = 256, MMEM = BATCH * MEM_LEN;
constexpr int POOL_W = 512, SWA_W = 1024, KV_W = 256, MEM_W = 512, IN_W = 2560;
constexpr int NHEAD = 16, NKV = 4, HD = 64, WINDOW = 128, MHEADS = 4, MHD = 128;
constexpr int PHEADS = 8, NKEYS = 128, TOPK = 16, NEXP = NKEYS * NKEYS, EPT = PHEADS * TOPK;
constexpr float ALPHA = 1.18920711500272106672f;
constexpr float LN_EPS = 1e-5f;

typedef unsigned short bf16_t;
__device__ __forceinline__ float bf2f(bf16_t v) { return __uint_as_float((unsigned)v << 16); }
__device__ __forceinline__ bf16_t f2bf(float f) { unsigned u = __float_as_uint(f); return (bf16_t)((u + 0x7fffu + ((u >> 16) & 1u)) >> 16); }

constexpr size_t MiB = 1u << 20;
constexpr size_t WS_CTL = 0, WS_WINT = 1 * MiB, WS_WKVT = 11 * MiB, WS_WOT = 15 * MiB, WS_WQT = 23 * MiB, WS_SMALL = 31 * MiB;
constexpr size_t WS_XB = 32 * MiB, WS_X1B = 32 * MiB  , WS_MEMB = 64 * MiB, WS_KVM = 66 * MiB;
constexpr size_t WS_POOLV = 68 * MiB, WS_Q = 84 * MiB, WS_K = 100 * MiB, WS_V = 104 * MiB, WS_QM = 108 * MiB, WS_CONCAT = 116 * MiB;
constexpr size_t WS_Y1 = 148 * MiB, WS_X1 = 212 * MiB, WS_QP = 276 * MiB, WS_EIDX = 308 * MiB, WS_GATE = 312 * MiB, WS_UB = 316 * MiB, WS_VB = 380 * MiB, WS_END = 444 * MiB;
constexpr size_t WS_NV_H = 148 * MiB  , WS_NV_PS = 232 * MiB, WS_NV_KVM = 248 * MiB;

__device__ __forceinline__ void rope_cs(int pos, int j, float& c, float& s) {
    const double invf[8] = {1.0, 0.19392274474868576, 0.03760603093086393, 0.007292664737217109, 0.001414213562373095, 0.0002742481756762073, 5.318295896944988e-05, 1.031338537721246e-05};
    double f = j == 0 ? invf[0] : j == 1 ? invf[1] : j == 2 ? invf[2] : j == 3 ? invf[3] : j == 4 ? invf[4] : j == 5 ? invf[5] : j == 6 ? invf[6] : invf[7];
    double rev = (double)pos * f * 0.15915494309189533577;
    rev -= floor(rev);
    float fr = (float)rev;
    s = __builtin_amdgcn_sinf(fr); c = __builtin_amdgcn_cosf(fr);
}
__device__ __forceinline__ float gelu_erf(float h) { return 0.5f * h * (1.0f + erff(h * 0.70710678118654752440f)); }
__device__ __forceinline__ float wave_sum(float v) {
#pragma unroll
    for (int o = 1; o < 64; o <<= 1) v += __shfl_xor(v, o);
    return v;
}

namespace pg8 {
#define PG8_LAS __attribute__((address_space(3)))
typedef unsigned short bf16_t;
typedef short bf16x8 __attribute__((ext_vector_type(8)));
typedef float f32x4 __attribute__((ext_vector_type(4)));
typedef unsigned u32x4 __attribute__((ext_vector_type(4)));
constexpr int BM = 256, BK = 64, HALF = 128, HTB = HALF * BK * 2  , STAGE_BYTES = 8 * HTB, NXCD = 8, WGM = 8;

__host__ __device__ __forceinline__ int lds_byte(int r, int c) { const int st = (r >> 4) * 2 + (c >> 5), rr = r & 15, cc = c & 31, ob = rr * 64 + cc * 2; return st * 1024 + (ob ^ (((ob >> 9) & 1) << 5)); }
__host__ __device__ __forceinline__ void stage_rc(int b, int& R, int& C) { const int st = b / 1024, sb = b % 1024, swz = sb ^ (((sb >> 9) & 1) << 5); R = (st >> 1) * 16 + swz / 64; C = (st & 1) * 32 + (swz % 64) / 2; }
__host__ __device__ __forceinline__ int perm32(int rho) { const int n = rho >> 4, i = rho & 15; return 8 * (i >> 2) + 4 * n + (i & 3); }

struct Unit { int pm, pn; };
struct Gemm { const bf16_t* A; const bf16_t* Bt; int M, N, K; };

struct StaticOrder {
    int nM, nN, nwg, G, c;
    __host__ __device__ void init(int M, int N, int G_, int c_) { nM = M / BM; nN = N / BM; nwg = nM * nN; G = G_; c = c_; }
    __host__ __device__ bool next(int i, Unit& u) const {
        const long L = (long)i * G + c; if (L >= nwg) return false;
        int wgid = (int)L; { const int q = nwg / NXCD, r = nwg % NXCD, xcd = wgid % NXCD, off = wgid / NXCD; wgid = (xcd < r ? xcd * (q + 1) : r * (q + 1) + (xcd - r) * q) + off; }
        const int nig = WGM * nN, gid = wgid / nig, fm = gid * WGM, gsz = (nM - fm) < WGM ? (nM - fm) : WGM;
        u.pm = fm + ((wgid % nig) % gsz); u.pn = (wgid % nig) / gsz; return true;
    }
    __device__ __forceinline__ void a_ready(const Unit&) const {}
    __device__ __forceinline__ void done(const Unit&) const {}
};

__device__ __forceinline__ unsigned cvt_pk_bf16(float lo, float hi) { unsigned r; asm volatile("v_cvt_pk_bf16_f32 %0, %1, %2" : "=v"(r) : "v"(lo), "v"(hi)); return r; }
template <class Epi, class Sched, bool ALIGN_EPI = false, bool SP2 = false>
__device__ __forceinline__ void gemm_phase(PG8_LAS unsigned char* lds, const Gemm g, const Sched& S, const Epi& E) {
    const int tid = threadIdx.x, wid = __builtin_amdgcn_readfirstlane(tid >> 6), lane = tid & 63, wr = wid >> 2, wc = wid & 3, fr = lane & 15, fq = lane >> 4;
    const int K = g.K, nt = K / BK;
    unsigned voffA[2], voffB[2];
#pragma unroll
    for (int i = 0; i < 2; ++i) { int R, C; stage_rc(tid * 16 + i * 8192, R, C); const int Rb = Epi::PERM ? ((R & ~31) + perm32(R & 31)) : R;
        voffA[i] = (unsigned)(R * K + C) * 2u; voffB[i] = (unsigned)(Rb * K + C) * 2u; }
    const size_t kstep = (size_t)(BK * 2);
    const size_t hstep = (size_t)HALF * K * 2;
    const size_t tstep = 2 * hstep;
    const unsigned ldsw = (unsigned)wid * 1024u;
    const int aoff = lds_byte(wr * 64 + fr, fq * 8), boff = lds_byte(wc * 32 + fr, fq * 8);
#define PG8_SA(b, h) (((b) * 2 + (h)) * HTB)
#define PG8_SB(b, h) ((4 + (b) * 2 + (h)) * HTB)
#define PG8_STAGE(bufoff, gbase, voff) do { _Pragma("unroll") for (int _i = 0; _i < 2; ++_i) \
        __builtin_amdgcn_global_load_lds((const unsigned*)((const char*)(gbase) + (voff)[_i]), (PG8_LAS unsigned*)(lds + (bufoff) + ldsw + _i * 8192), 16, 0, 0); } while (0)
#define PG8_LDA(dst, b, h) do { _Pragma("unroll") for (int m = 0; m < 4; ++m) _Pragma("unroll") for (int k = 0; k < 2; ++k) dst[m][k] = *(const PG8_LAS bf16x8*)(lds + PG8_SA(b, h) + aoff + m * 2048 + k * 1024); } while (0)
#define PG8_LDB(dst, b, h) do { _Pragma("unroll") for (int n = 0; n < 2; ++n) _Pragma("unroll") for (int k = 0; k < 2; ++k) dst[n][k] = *(const PG8_LAS bf16x8*)(lds + PG8_SB(b, h) + boff + n * 2048 + k * 1024); } while (0)
#define PG8_MMA(ai, bj, At, Bt) do { __builtin_amdgcn_s_setprio(1); _Pragma("unroll") for (int m = 0; m < 4; ++m) _Pragma("unroll") for (int n = 0; n < 2; ++n) _Pragma("unroll") for (int k = 0; k < 2; ++k) \
        acc[ai][bj][m][n] = __builtin_amdgcn_mfma_f32_16x16x32_bf16(Bt[n][k], At[m][k], acc[ai][bj][m][n], 0, 0, 0); __builtin_amdgcn_s_setprio(0); } while (0)
#define PG8_WAIT_V(n) asm volatile("s_waitcnt vmcnt(" #n ")" ::: "memory")
#define PG8_WAIT_L(n) asm volatile("s_waitcnt lgkmcnt(" #n ")" ::: "memory")
#define PG8_BAR __builtin_amdgcn_s_barrier()
#define PG8_SCHED __builtin_amdgcn_sched_barrier(0)
    Unit cur, nxt; int ui = 0;
    if (!S.next(0, cur)) return;
    f32x4 acc[2][2][4][2];
#pragma unroll
    for (int a = 0; a < 2; ++a)
#pragma unroll
        for (int b = 0; b < 2; ++b)
#pragma unroll
            for (int m = 0; m < 4; ++m)
#pragma unroll
                for (int n = 0; n < 2; ++n) acc[a][b][m][n] = (f32x4){0.f, 0.f, 0.f, 0.f};
    bf16x8 At[4][2], B0[2][2], B1[2][2];
    const char* cA = (const char*)g.A + (size_t)cur.pm * tstep; const char* cB = (const char*)g.Bt + (size_t)cur.pn * tstep;
    S.a_ready(cur);
    if constexpr (SP2) {
        PG8_STAGE(PG8_SB(0, 0), cB, voffB); PG8_STAGE(PG8_SB(0, 1), cB + hstep, voffB); PG8_STAGE(PG8_SA(0, 0), cA, voffA); PG8_STAGE(PG8_SA(0, 1), cA + hstep, voffA);
        if (wr == 1) PG8_BAR;
        PG8_WAIT_V(2); PG8_BAR;
        PG8_STAGE(PG8_SB(1, 0), cB + kstep, voffB); PG8_STAGE(PG8_SA(1, 0), cA + kstep, voffA); PG8_STAGE(PG8_SB(1, 1), cB + hstep + kstep, voffB);
        PG8_WAIT_V(6); PG8_BAR;
    } else {
        PG8_STAGE(PG8_SB(0, 0), cB, voffB); PG8_STAGE(PG8_SA(0, 0), cA, voffA); PG8_STAGE(PG8_SB(0, 1), cB + hstep, voffB); PG8_STAGE(PG8_SA(0, 1), cA + hstep, voffA);
        if (wr == 1) PG8_BAR;
        PG8_WAIT_V(4); PG8_BAR;
        PG8_STAGE(PG8_SB(1, 0), cB + kstep, voffB); PG8_STAGE(PG8_SA(1, 0), cA + kstep, voffA); PG8_STAGE(PG8_SB(1, 1), cB + hstep + kstep, voffB);
        PG8_WAIT_V(6); PG8_BAR;
    }
    for (;;) {
        const bool has_next = S.next(ui + 1, nxt);
        const char* nA = has_next ? (const char*)g.A + (size_t)nxt.pm * tstep : cA; const char* nB = has_next ? (const char*)g.Bt + (size_t)nxt.pn * tstep : cB;
        for (int t = 0; t < nt; t += 2) {
            const bool last = (t == nt - 2);
            const char* a1 = cA + (size_t)(t + 1) * kstep;
            const char* a2 = last ? nA : cA + (size_t)(t + 2) * kstep; const char* b2 = last ? nB : cB + (size_t)(t + 2) * kstep;
            const char* a3 = a2 + kstep; const char* b3 = b2 + kstep;
            if (last && has_next) S.a_ready(nxt);
            if constexpr (SP2) {
            PG8_LDB(B0, 0, 0); PG8_LDB(B1, 0, 1); PG8_SCHED; PG8_LDA(At, 0, 0); PG8_STAGE(PG8_SA(1, 1), a1 + hstep, voffA);
            PG8_WAIT_V(8); PG8_WAIT_L(0); PG8_BAR; PG8_MMA(0, 0, At, B0); PG8_MMA(0, 1, At, B1); PG8_BAR; PG8_SCHED;
            PG8_LDA(At, 0, 1); PG8_STAGE(PG8_SB(0, 0), b2, voffB); PG8_STAGE(PG8_SB(0, 1), b2 + hstep, voffB); PG8_STAGE(PG8_SA(0, 0), a2, voffA);
            PG8_WAIT_V(8); PG8_WAIT_L(0); PG8_BAR; PG8_MMA(1, 0, At, B0); PG8_MMA(1, 1, At, B1); PG8_BAR; PG8_SCHED;
            PG8_LDB(B0, 1, 0); PG8_LDB(B1, 1, 1); PG8_SCHED; PG8_LDA(At, 1, 0); PG8_STAGE(PG8_SA(0, 1), a2 + hstep, voffA);
            PG8_WAIT_V(8); PG8_WAIT_L(0); PG8_BAR; PG8_MMA(0, 0, At, B0); PG8_MMA(0, 1, At, B1); PG8_BAR; PG8_SCHED;
            PG8_LDA(At, 1, 1); PG8_STAGE(PG8_SB(1, 0), b3, voffB); PG8_STAGE(PG8_SB(1, 1), b3 + hstep, voffB); PG8_STAGE(PG8_SA(1, 0), a3, voffA);
            PG8_WAIT_V(8); PG8_WAIT_L(0); PG8_BAR; PG8_MMA(1, 0, At, B0); PG8_MMA(1, 1, At, B1); PG8_BAR; PG8_SCHED;
            } else {
            PG8_LDB(B0, 0, 0); PG8_SCHED; PG8_LDA(At, 0, 0); PG8_STAGE(PG8_SA(1, 1), a1 + hstep, voffA);
            PG8_WAIT_L(8); PG8_BAR; PG8_WAIT_L(0); PG8_MMA(0, 0, At, B0); PG8_BAR; PG8_SCHED;
            PG8_LDB(B1, 0, 1); PG8_STAGE(PG8_SB(0, 0), b2, voffB);
            PG8_BAR; PG8_WAIT_L(0); PG8_MMA(0, 1, At, B1); PG8_BAR;
            PG8_LDA(At, 0, 1); PG8_STAGE(PG8_SA(0, 0), a2, voffA);
            PG8_BAR; PG8_WAIT_L(0); PG8_MMA(1, 0, At, B0); PG8_BAR; PG8_SCHED;
            PG8_STAGE(PG8_SB(0, 1), b2 + hstep, voffB);
            PG8_WAIT_V(6); PG8_BAR; PG8_MMA(1, 1, At, B1); PG8_BAR;
            PG8_LDB(B0, 1, 0); PG8_SCHED; PG8_LDA(At, 1, 0); PG8_STAGE(PG8_SA(0, 1), a2 + hstep, voffA);
            PG8_WAIT_L(8); PG8_BAR; PG8_WAIT_L(0); PG8_MMA(0, 0, At, B0); PG8_BAR; PG8_SCHED;
            PG8_LDB(B1, 1, 1); PG8_STAGE(PG8_SB(1, 0), b3, voffB);
            PG8_BAR; PG8_WAIT_L(0); PG8_MMA(0, 1, At, B1); PG8_BAR;
            PG8_LDA(At, 1, 1); PG8_STAGE(PG8_SA(1, 0), a3, voffA);
            PG8_BAR; PG8_WAIT_L(0); PG8_MMA(1, 0, At, B0); PG8_BAR; PG8_SCHED;
            PG8_STAGE(PG8_SB(1, 1), b3 + hstep, voffB);
            PG8_WAIT_V(6); PG8_BAR; PG8_MMA(1, 1, At, B1); PG8_BAR;
            }
        }
        if constexpr (ALIGN_EPI) { if (wr == 0) PG8_BAR; }
        if constexpr (!Epi::AFTER_DRAIN) { E(acc, cur, wr, wc, fr, fq); S.done(cur); }
        if (!has_next) break;
#pragma unroll
        for (int a = 0; a < 2; ++a)
#pragma unroll
            for (int b = 0; b < 2; ++b)
#pragma unroll
                for (int m = 0; m < 4; ++m)
#pragma unroll
                    for (int n = 0; n < 2; ++n) acc[a][b][m][n] = (f32x4){0.f, 0.f, 0.f, 0.f};
        cur = nxt; cA = nA; cB = nB; ++ui;
        if constexpr (ALIGN_EPI) { if (wr == 1) PG8_BAR; }
    }
    PG8_WAIT_V(0);
    if constexpr (!ALIGN_EPI) { if (wr == 0) PG8_BAR; }
    PG8_BAR;
    if constexpr (Epi::AFTER_DRAIN) { E.fused(acc, cur, wr, wc, fr, fq, lds, wid, lane); S.done(cur); }
#undef PG8_SA
#undef PG8_SB
#undef PG8_STAGE
#undef PG8_LDA
#undef PG8_LDB
#undef PG8_MMA
#undef PG8_WAIT_V
#undef PG8_WAIT_L
#undef PG8_BAR
#undef PG8_SCHED
}
}
#define GAS __attribute__((address_space(1)))
#define LAS __attribute__((address_space(3)))
typedef unsigned v4u __attribute__((ext_vector_type(4)));
typedef unsigned v2u __attribute__((ext_vector_type(2)));
typedef float f32x4 __attribute__((ext_vector_type(4)));
typedef float f32x2 __attribute__((ext_vector_type(2)));
typedef short bf16x8 __attribute__((ext_vector_type(8)));
typedef __bf16 bf16x2 __attribute__((ext_vector_type(2)));
constexpr int NWAVES = 8, NTHREADS = NWAVES * 64;
constexpr int LDS_BYTES = 147456, MISC_OFF = LDS_BYTES - 512;
constexpr int CW_BAR = 4096;
constexpr float LOG2E = 1.44269504088896340736f;

__device__ __forceinline__ unsigned cvtpk(float lo, float hi) { f32x2 v = {lo, hi}; bf16x2 b = __builtin_convertvector(v, bf16x2); return __builtin_bit_cast(unsigned, b); }
__device__ __forceinline__ f32x4 mfma16(bf16x8 a, bf16x8 b, f32x4 c) { return __builtin_amdgcn_mfma_f32_16x16x32_bf16(a, b, c, 0, 0, 0); }
__device__ __forceinline__ float dot2bf(unsigned w, unsigned x, float acc) { return __builtin_amdgcn_fdot2_f32_bf16(__builtin_bit_cast(bf16x2, w), __builtin_bit_cast(bf16x2, x), acc, false); }
__device__ __forceinline__ float fexp2(float x) { return __builtin_amdgcn_exp2f(x); }
#define LDS_WAIT() asm volatile("s_waitcnt lgkmcnt(0)" ::: "memory")
__device__ __forceinline__ unsigned umax(unsigned a, unsigned b) { return a > b ? a : b; }
__device__ __forceinline__ unsigned xmax4(unsigned m) { auto r = __builtin_amdgcn_permlane16_swap(m, m, false, false); m = umax(r[0], r[1]); auto q = __builtin_amdgcn_permlane32_swap(m, m, false, false); return umax(q[0], q[1]); }
__device__ __forceinline__ float xfmax4(float v) { unsigned m = __float_as_uint(v); auto r = __builtin_amdgcn_permlane16_swap(m, m, false, false); v = fmaxf(__uint_as_float(r[0]), __uint_as_float(r[1])); m = __float_as_uint(v);
    auto q = __builtin_amdgcn_permlane32_swap(m, m, false, false); return fmaxf(__uint_as_float(q[0]), __uint_as_float(q[1])); }
__device__ __forceinline__ float xfsum4(float v) { unsigned m = __float_as_uint(v); auto r = __builtin_amdgcn_permlane16_swap(m, m, false, false); v = __uint_as_float(r[0]) + __uint_as_float(r[1]); m = __float_as_uint(v);
    auto q = __builtin_amdgcn_permlane32_swap(m, m, false, false); return __uint_as_float(q[0]) + __uint_as_float(q[1]); }

#define XB_TMO      128
#define XB_XCNT(j)  (256  + 64 * (j))
#define XB_XSUB(j)  (1280 + 64 * (j))
#define XB_XGEN(j)  (2304 + 64 * (j))
#define XB_TOP      3328
#define XB_TOPGEN   3392
#define XCD_BAR_WORDS 3456
#define XB_SPIN_CAP (1u << 18)
__device__ __forceinline__ unsigned xb_ld(unsigned* p)              { return __hip_atomic_load(p, __ATOMIC_RELAXED, __HIP_MEMORY_SCOPE_AGENT); }
__device__ __forceinline__ unsigned xb_add(unsigned* p, unsigned v) { return __hip_atomic_fetch_add(p, v, __ATOMIC_RELAXED, __HIP_MEMORY_SCOPE_AGENT); }
__device__ __forceinline__ unsigned xb_xcc_id() { return (unsigned)__builtin_amdgcn_s_getreg((3 << 11) | 20) & 0xFu; }
#define XB_SPIN(cond, bar) do { unsigned _sp = 0; while (cond) { __builtin_amdgcn_s_sleep(1); \
    if ((++_sp & 255u) == 0u) { if (xb_ld(&(bar)[XB_TMO])) break; if (_sp > XB_SPIN_CAP) { atomicAdd(&(bar)[XB_TMO], 1u); break; } } } } while (0)
struct XcdBarrier { unsigned* bar; unsigned x; volatile LAS unsigned* st; };
__device__ __forceinline__ XcdBarrier xcd_barrier_post(unsigned* bar, volatile LAS unsigned* st) {
    XcdBarrier b; b.bar = bar; b.x = xb_xcc_id(); b.st = st;
    if (threadIdx.x == 0) (void)xb_add(&bar[XB_XCNT(b.x)], 1u);
    return b;
}
__device__ __forceinline__ void xcd_barrier_complete(unsigned* bar, unsigned x, unsigned& nloc, unsigned& nx) {
    const unsigned G = gridDim.x * gridDim.y * gridDim.z;
    unsigned sum, cnt, mine, sp = 0u;
    for (;;) {
        sum = 0u; cnt = 0u; mine = 0u;
#pragma unroll
        for (unsigned j = 0; j < 16; ++j) { const unsigned c = xb_ld(&bar[XB_XCNT(j)]); sum += c; cnt += (c > 0u) ? 1u : 0u; mine = (j == x) ? c : mine; }
        if (sum == G) break;
        __builtin_amdgcn_s_sleep(1);
        if ((++sp & 255u) == 0u) { if (xb_ld(&bar[XB_TMO])) break; if (sp > XB_SPIN_CAP) { atomicAdd(&bar[XB_TMO], 1u); break; } }
    }
    nloc = mine > 0u ? mine : 1u; nx = cnt > 0u ? cnt : 1u;
}
__device__ __forceinline__ void xcd_barrier(const XcdBarrier& b) {
    asm volatile("s_waitcnt vmcnt(0)" ::: "memory");
    __syncthreads();
    if (threadIdx.x == 0) {
        unsigned* bar = b.bar;
        __builtin_amdgcn_s_waitcnt(0);
        unsigned nloc = b.st[0], nx = b.st[1];
        if (nloc == 0u) { xcd_barrier_complete(bar, b.x, nloc, nx); b.st[0] = nloc; b.st[1] = nx; }
        const unsigned old = xb_add(&bar[XB_XSUB(b.x)], 1u);
        const unsigned gen = old / nloc;
        if (old + 1u == (gen + 1u) * nloc) {
            __builtin_amdgcn_fence(__ATOMIC_RELEASE, "agent");
            asm volatile("s_waitcnt vmcnt(0)" ::: "memory");
            const unsigned og = xb_add(&bar[XB_TOP], 1u);
            const unsigned tg = og / nx;
            if (og + 1u == (tg + 1u) * nx) xb_add(&bar[XB_TOPGEN], 1u);
            else XB_SPIN(xb_ld(&bar[XB_TOPGEN]) == tg, bar);
            __builtin_amdgcn_fence(__ATOMIC_ACQUIRE, "agent");
            xb_add(&bar[XB_XGEN(b.x)], 1u);
            asm volatile("s_waitcnt vmcnt(0)" ::: "memory");
        } else {
            XB_SPIN(xb_ld(&bar[XB_XGEN(b.x)]) == gen, bar);
            __builtin_amdgcn_fence(__ATOMIC_ACQUIRE, "agent");
            asm volatile("s_waitcnt vmcnt(0)" ::: "memory");
        }
    }
    __syncthreads();
}

struct EpiStoreBf {
    static constexpr bool PERM = true, AFTER_DRAIN = false;
    bf16_t* O; int ldc;
    __device__ __forceinline__ void operator()(const pg8::f32x4 (&acc)[2][2][4][2], const pg8::Unit& u, int wr, int wc, int fr, int fq) const {
        const int row0 = u.pm * 256 + wr * 64 + fr, col0 = u.pn * 256 + wc * 32 + 8 * fq;
#pragma unroll
        for (int ai = 0; ai < 2; ++ai)
#pragma unroll
            for (int m = 0; m < 4; ++m) { bf16_t* rowp = O + (size_t)(row0 + ai * 128 + m * 16) * ldc + col0;
#pragma unroll
                for (int bj = 0; bj < 2; ++bj) { const pg8::f32x4 v0 = acc[ai][bj][m][0], v1 = acc[ai][bj][m][1];
                    v4u w; w.x = cvtpk(v0[0], v0[1]); w.y = cvtpk(v0[2], v0[3]); w.z = cvtpk(v1[0], v1[1]); w.w = cvtpk(v1[2], v1[3]);
                    *(v4u*)(rowp + bj * 128) = w; } }
    }
};
struct EpiY1 {
    static constexpr bool PERM = true, AFTER_DRAIN = false;
    const float* x; float* y;
    __device__ __forceinline__ void operator()(const pg8::f32x4 (&acc)[2][2][4][2], const pg8::Unit& u, int wr, int wc, int fr, int fq) const {
        const int row0 = u.pm * 256 + wr * 64 + fr, col0 = u.pn * 256 + wc * 32 + 8 * fq;
#pragma unroll
        for (int ai = 0; ai < 2; ++ai)
#pragma unroll
            for (int m = 0; m < 4; ++m) { const size_t off = (size_t)(row0 + ai * 128 + m * 16) * D_MODEL + col0;
#pragma unroll
                for (int bj = 0; bj < 2; ++bj) {
                    const f32x4 x0 = *(const f32x4*)(x + off + bj * 128), x1 = *(const f32x4*)(x + off + bj * 128 + 4);
                    *(f32x4*)(y + off + bj * 128) = x0 * ALPHA + acc[ai][bj][m][0]; *(f32x4*)(y + off + bj * 128 + 4) = x1 * ALPHA + acc[ai][bj][m][1]; } }
    }
};
struct EpiIn {
    static constexpr bool PERM = true, AFTER_DRAIN = false;
    float* POOLV; bf16_t *Q, *K, *V, *QM; const float* rope;
    __device__ __forceinline__ void operator()(const pg8::f32x4 (&acc)[2][2][4][2], const pg8::Unit& u, int wr, int wc, int fr, int fq) const {
        const int row0 = u.pm * 256 + wr * 64 + fr, cl = wc * 32 + 8 * fq, pn = u.pn;
        if (pn < 2) {
#pragma unroll
            for (int ai = 0; ai < 2; ++ai)
#pragma unroll
                for (int m = 0; m < 4; ++m) { float* rp = POOLV + (size_t)(row0 + ai * 128 + m * 16) * POOL_W + pn * 256 + cl;
#pragma unroll
                    for (int bj = 0; bj < 2; ++bj) { *(f32x4*)(rp + bj * 128) = acc[ai][bj][m][0]; *(f32x4*)(rp + bj * 128 + 4) = acc[ai][bj][m][1]; } }
            return;
        }
        bf16_t* base; int ld, c0; bool rot = false;
        if (pn < 6) { base = Q; ld = SWA_W; c0 = (pn - 2) * 256; rot = true; }
        else if (pn == 6) { base = K; ld = KV_W; c0 = 0; rot = true; }
        else if (pn == 7) { base = V; ld = KV_W; c0 = 0; }
        else { base = QM; ld = MEM_W; c0 = (pn - 8) * 256; }
        rot = rot && ((wc & 1) == 0);
#pragma unroll
        for (int ai = 0; ai < 2; ++ai)
#pragma unroll
            for (int m = 0; m < 4; ++m) {
                const int row = row0 + ai * 128 + m * 16;
                f32x4 v[2][2];
#pragma unroll
                for (int bj = 0; bj < 2; ++bj) { v[bj][0] = acc[ai][bj][m][0]; v[bj][1] = acc[ai][bj][m][1]; }
                if (rot) {
                    const f32x4* tp = (const f32x4*)(rope + (size_t)row * 16);
                    f32x4 cs[2][2]; cs[0][0] = tp[0]; cs[0][1] = tp[1]; cs[1][0] = tp[2]; cs[1][1] = tp[3];
#pragma unroll
                    for (int bj = 0; bj < 2; ++bj)
#pragma unroll
                        for (int n = 0; n < 2; ++n)
#pragma unroll
                            for (int i = 0; i < 4; ++i) {
                                const float xv = v[bj][n][i], pv = __shfl_xor(xv, 16);
                                const float c = cs[n][i >> 1][2 * (i & 1)], s = cs[n][i >> 1][2 * (i & 1) + 1];
                                const float o = fq == 0 ? xv * c - pv * s : (fq == 1 ? xv * c + pv * s : xv);
                                v[bj][n][i] = o; }
                }
                bf16_t* rowp = base + (size_t)row * ld + c0 + cl;
#pragma unroll
                for (int bj = 0; bj < 2; ++bj) { v4u w; w.x = cvtpk(v[bj][0][0], v[bj][0][1]); w.y = cvtpk(v[bj][0][2], v[bj][0][3]); w.z = cvtpk(v[bj][1][0], v[bj][1][1]); w.w = cvtpk(v[bj][1][2], v[bj][1][3]);
                    *(v4u*)(rowp + bj * 128) = w; }
            }
    }
};

__device__ __forceinline__ void p0_transpose_item(const float* W, int K, int N, bf16_t* WT, LAS float* scr, int item, int lane) {
    const int nblk = N / 32, kb = item / nblk, nb = item % nblk, k0 = 64 * kb, n0 = 32 * nb;
#pragma unroll 8
    for (int i = 0; i < 32; ++i) { const int kk = 2 * i + (lane >> 5); scr[kk * 33 + (lane & 31)] = W[(size_t)(k0 + kk) * N + n0 + (lane & 31)]; }
    LDS_WAIT(); asm volatile("" ::: "memory");
    const int c = lane & 7;
#pragma unroll
    for (int j = 0; j < 4; ++j) { const int n = (lane >> 3) + 8 * j; const LAS float* s = scr + (8 * c) * 33 + n;
        v4u o; o.x = cvtpk(s[0 * 33], s[1 * 33]); o.y = cvtpk(s[2 * 33], s[3 * 33]); o.z = cvtpk(s[4 * 33], s[5 * 33]); o.w = cvtpk(s[6 * 33], s[7 * 33]);
        *(v4u*)(WT + (size_t)(n0 + n) * K + k0 + 8 * c) = o; }
    LDS_WAIT(); asm volatile("" ::: "memory");
}
template <bool NT>
__device__ __forceinline__ void cvt_stream(const float* in, bf16_t* out, size_t n, int gw, int NGW, int lane) {
#pragma unroll 4
    for (size_t i = (size_t)gw * 512 + lane * 4; i < n; i += (size_t)NGW * 512) {
        f32x4 a, b;
        if (NT) { a = __builtin_nontemporal_load((const f32x4*)(in + i)); b = __builtin_nontemporal_load((const f32x4*)(in + i + 256)); }
        else { a = *(const f32x4*)(in + i); b = *(const f32x4*)(in + i + 256); }
        v2u o0, o1; o0.x = cvtpk(a.x, a.y); o0.y = cvtpk(a.z, a.w); o1.x = cvtpk(b.x, b.y); o1.y = cvtpk(b.z, b.w);
        *(v2u*)(out + i) = o0; *(v2u*)(out + i + 256) = o1;
    }
}

constexpr int SWA_KROW = 144, SWA_VROW = 528, SWA_VT_OFF = 256 * SWA_KROW;
__device__ __forceinline__ void swa_item(LAS unsigned char* lds, int item, const bf16_t* __restrict__ Q, const bf16_t* __restrict__ Kb, const bf16_t* __restrict__ Vb, const float* __restrict__ sinks,
                                         bf16_t* CONCAT, int tid, int wave, int lane) {
    const int qb = item & 31, kvh = (item >> 5) & 3, b = item >> 7;
    const int tok0 = b * SEQ + qb * 128;
    LAS unsigned char* Kl = lds; LAS unsigned char* Vt = lds + SWA_VT_OFF;
#pragma unroll
    for (int j = 0; j < 4; ++j) {
        const int c = tid + NTHREADS * j, row = c >> 3, part = c & 7;
        v4u kv = {0u, 0u, 0u, 0u}, vv = {0u, 0u, 0u, 0u};
        if (qb > 0 || row >= 128) { const size_t tk = (size_t)(tok0 - 128 + row); kv = *(const v4u*)(Kb + tk * KV_W + kvh * HD + part * 8); vv = *(const v4u*)(Vb + tk * KV_W + kvh * HD + part * 8); }
        *(LAS v4u*)(Kl + row * SWA_KROW + part * 16) = kv;
        LAS unsigned short* vp = (LAS unsigned short*)(Vt + (part * 8) * SWA_VROW + row * 2);
        vp[0 * (SWA_VROW / 2)] = (unsigned short)(vv.x & 0xffffu); vp[1 * (SWA_VROW / 2)] = (unsigned short)(vv.x >> 16);
        vp[2 * (SWA_VROW / 2)] = (unsigned short)(vv.y & 0xffffu); vp[3 * (SWA_VROW / 2)] = (unsigned short)(vv.y >> 16);
        vp[4 * (SWA_VROW / 2)] = (unsigned short)(vv.z & 0xffffu); vp[5 * (SWA_VROW / 2)] = (unsigned short)(vv.z >> 16);
        vp[6 * (SWA_VROW / 2)] = (unsigned short)(vv.w & 0xffffu); vp[7 * (SWA_VROW / 2)] = (unsigned short)(vv.w >> 16);
    }
    __syncthreads();
    const int g = wave & 3, h = kvh * 4 + g, q15 = lane & 15, qq = lane >> 4;
    const float sink2 = sinks[h] * LOG2E;
    const float SC = 0.125f * LOG2E;
#pragma unroll 1
    for (int cc = 0; cc < 2; ++cc) {
        const int c = 2 * (wave >> 2) + cc, kl0 = 32 * c;
        bf16x8 qf[2][2];
#pragma unroll
        for (int ni = 0; ni < 2; ++ni)
#pragma unroll
            for (int ks = 0; ks < 2; ++ks) qf[ni][ks] = *(const bf16x8*)(Q + (size_t)(tok0 + 32 * c + 16 * ni + q15) * SWA_W + h * HD + 32 * ks + 8 * qq);
        f32x4 s[10][2];
#pragma unroll
        for (int mi = 0; mi < 10; ++mi) { s[mi][0] = (f32x4){0.f, 0.f, 0.f, 0.f}; s[mi][1] = (f32x4){0.f, 0.f, 0.f, 0.f}; }
#pragma unroll
        for (int mi = 0; mi < 10; ++mi)
#pragma unroll
            for (int ks = 0; ks < 2; ++ks) {
                const bf16x8 kf = *(const LAS bf16x8*)(Kl + (kl0 + 16 * mi + q15) * SWA_KROW + (32 * ks + 8 * qq) * 2);
                s[mi][0] = mfma16(kf, qf[0][ks], s[mi][0]); s[mi][1] = mfma16(kf, qf[1][ks], s[mi][1]);
            }
        float rl[2];
#pragma unroll
        for (int ni = 0; ni < 2; ++ni) {
            const int ql = 32 * c + 16 * ni + q15;
            float mx = -INFINITY;
#pragma unroll
            for (int mi = 0; mi < 10; ++mi)
#pragma unroll
                for (int r = 0; r < 4; ++r) {
                    const int kl = kl0 + 16 * mi + 4 * qq + r;
                    const bool valid = (kl > ql) && (kl <= ql + 128) && (qb > 0 || kl >= 128);
                    const float t = valid ? s[mi][ni][r] * SC : -INFINITY;
                    s[mi][ni][r] = t; mx = fmaxf(mx, t);
                }
            mx = fmaxf(xfmax4(mx), sink2);
            float l = 0.f;
#pragma unroll
            for (int mi = 0; mi < 10; ++mi)
#pragma unroll
                for (int r = 0; r < 4; ++r) { const float p = fexp2(s[mi][ni][r] - mx); s[mi][ni][r] = p; l += p; }
            l = xfsum4(l) + fexp2(sink2 - mx);
            rl[ni] = 1.0f / l;
        }
        f32x4 o[4][2];
#pragma unroll
        for (int dt = 0; dt < 4; ++dt) { o[dt][0] = (f32x4){0.f, 0.f, 0.f, 0.f}; o[dt][1] = (f32x4){0.f, 0.f, 0.f, 0.f}; }
#pragma unroll
        for (int kk = 0; kk < 5; ++kk) {
            bf16x8 pf[2];
#pragma unroll
            for (int ni = 0; ni < 2; ++ni) {
                v4u w; w.x = cvtpk(s[2 * kk][ni][0], s[2 * kk][ni][1]); w.y = cvtpk(s[2 * kk][ni][2], s[2 * kk][ni][3]);
                w.z = cvtpk(s[2 * kk + 1][ni][0], s[2 * kk + 1][ni][1]); w.w = cvtpk(s[2 * kk + 1][ni][2], s[2 * kk + 1][ni][3]);
                pf[ni] = __builtin_bit_cast(bf16x8, w);
            }
#pragma unroll
            for (int dt = 0; dt < 4; ++dt) {
                const LAS unsigned char* vb = Vt + (16 * dt + q15) * SWA_VROW + (kl0 + 32 * kk + 4 * qq) * 2;
                const v2u lo = *(const LAS v2u*)vb, hi = *(const LAS v2u*)(vb + 32);
                v4u w; w.x = lo.x; w.y = lo.y; w.z = hi.x; w.w = hi.y;
                const bf16x8 vf = __builtin_bit_cast(bf16x8, w);
                o[dt][0] = mfma16(vf, pf[0], o[dt][0]); o[dt][1] = mfma16(vf, pf[1], o[dt][1]);
            }
        }
#pragma unroll
        for (int ni = 0; ni < 2; ++ni) {
            bf16_t* orow = CONCAT + (size_t)(tok0 + 32 * c + 16 * ni + q15) * D_MODEL + POOL_W + h * HD + 4 * qq;
#pragma unroll
            for (int dt = 0; dt < 4; ++dt) { v2u w; w.x = cvtpk(o[dt][ni][0] * rl[ni], o[dt][ni][1] * rl[ni]); w.y = cvtpk(o[dt][ni][2] * rl[ni], o[dt][ni][3] * rl[ni]); *(v2u*)(orow + 16 * dt) = w; }
        }
    }
    __syncthreads();
}
constexpr int MEM_KROW = 272, MEM_VROW = 528, MEM_VT_OFF = 256 * MEM_KROW;
__device__ __forceinline__ void mem_item(LAS unsigned char* lds, int item, const bf16_t* __restrict__ QM, const bf16_t* __restrict__ KVM, bf16_t* CONCAT, int tid, int wave, int lane) {
    const int qt = item & 31, hm = (item >> 5) & 3, b = item >> 7;
    LAS unsigned char* Kl = lds; LAS unsigned char* Vt = lds + MEM_VT_OFF;
#pragma unroll
    for (int j = 0; j < 8; ++j) {
        const int c = tid + NTHREADS * j, row = c >> 4, part = c & 15;
        const bf16_t* src = KVM + (size_t)(b * MEM_LEN + row) * (2 * MEM_W) + hm * MHD + part * 8;
        const v4u kv = *(const v4u*)src, vv = *(const v4u*)(src + MEM_W);
        *(LAS v4u*)(Kl + row * MEM_KROW + part * 16) = kv;
        LAS unsigned short* vp = (LAS unsigned short*)(Vt + (part * 8) * MEM_VROW + row * 2);
        vp[0 * (MEM_VROW / 2)] = (unsigned short)(vv.x & 0xffffu); vp[1 * (MEM_VROW / 2)] = (unsigned short)(vv.x >> 16);
        vp[2 * (MEM_VROW / 2)] = (unsigned short)(vv.y & 0xffffu); vp[3 * (MEM_VROW / 2)] = (unsigned short)(vv.y >> 16);
        vp[4 * (MEM_VROW / 2)] = (unsigned short)(vv.z & 0xffffu); vp[5 * (MEM_VROW / 2)] = (unsigned short)(vv.z >> 16);
        vp[6 * (MEM_VROW / 2)] = (unsigned short)(vv.w & 0xffffu); vp[7 * (MEM_VROW / 2)] = (unsigned short)(vv.w >> 16);
    }
    __syncthreads();
    const int q15 = lane & 15, qq = lane >> 4;
    const int tok = b * SEQ + qt * 128 + wave * 16 + q15;
    const float SC = 0.08838834764831845f * LOG2E;
    bf16x8 qf[4];
#pragma unroll
    for (int ks = 0; ks < 4; ++ks) qf[ks] = *(const bf16x8*)(QM + (size_t)tok * MEM_W + hm * MHD + 32 * ks + 8 * qq);
    f32x4 s[16];
#pragma unroll
    for (int mi = 0; mi < 16; ++mi) s[mi] = (f32x4){0.f, 0.f, 0.f, 0.f};
#pragma unroll
    for (int mi = 0; mi < 16; ++mi)
#pragma unroll
        for (int ks = 0; ks < 4; ++ks) {
            const bf16x8 kf = *(const LAS bf16x8*)(Kl + (16 * mi + q15) * MEM_KROW + (32 * ks + 8 * qq) * 2);
            s[mi] = mfma16(kf, qf[ks], s[mi]);
        }
    float mx = -INFINITY;
#pragma unroll
    for (int mi = 0; mi < 16; ++mi)
#pragma unroll
        for (int r = 0; r < 4; ++r) { const float t = s[mi][r] * SC; s[mi][r] = t; mx = fmaxf(mx, t); }
    mx = xfmax4(mx);
    float l = 0.f;
#pragma unroll
    for (int mi = 0; mi < 16; ++mi)
#pragma unroll
        for (int r = 0; r < 4; ++r) { const float p = fexp2(s[mi][r] - mx); s[mi][r] = p; l += p; }
    l = xfsum4(l);
    const float rl = 1.0f / l;
    f32x4 o[8];
#pragma unroll
    for (int dt = 0; dt < 8; ++dt) o[dt] = (f32x4){0.f, 0.f, 0.f, 0.f};
#pragma unroll
    for (int kk = 0; kk < 8; ++kk) {
        v4u pw; pw.x = cvtpk(s[2 * kk][0], s[2 * kk][1]); pw.y = cvtpk(s[2 * kk][2], s[2 * kk][3]); pw.z = cvtpk(s[2 * kk + 1][0], s[2 * kk + 1][1]); pw.w = cvtpk(s[2 * kk + 1][2], s[2 * kk + 1][3]);
        const bf16x8 pf = __builtin_bit_cast(bf16x8, pw);
#pragma unroll
        for (int dt = 0; dt < 8; ++dt) {
            const LAS unsigned char* vb = Vt + (16 * dt + q15) * MEM_VROW + (32 * kk + 4 * qq) * 2;
            const v2u lo = *(const LAS v2u*)vb, hi = *(const LAS v2u*)(vb + 32);
            v4u w; w.x = lo.x; w.y = lo.y; w.z = hi.x; w.w = hi.y;
            o[dt] = mfma16(__builtin_bit_cast(bf16x8, w), pf, o[dt]);
        }
    }
    bf16_t* orow = CONCAT + (size_t)tok * D_MODEL + POOL_W + SWA_W + hm * MHD + 4 * qq;
#pragma unroll
    for (int dt = 0; dt < 8; ++dt) { v2u w; w.x = cvtpk(o[dt][0] * rl, o[dt][1] * rl); w.y = cvtpk(o[dt][2] * rl, o[dt][3] * rl); *(v2u*)(orow + 16 * dt) = w; }
    __syncthreads();
}
template <int W>
__device__ __forceinline__ void pool_frags(bf16x8 (&pf)[4], const float* __restrict__ POOLV, int t, int g, int qq) {
    const int sp = t & (SEQ - 1);
    const int cnt = (sp + 1) < W ? (sp + 1) : W;
    const float inv = 1.0f / (float)cnt;
    f32x4 c[4][2], a[4][2];
#pragma unroll
    for (int ks = 0; ks < 4; ++ks) { const float* p0 = POOLV + (size_t)t * POOL_W + g * 128 + 32 * ks + 8 * qq; c[ks][0] = *(const f32x4*)p0; c[ks][1] = *(const f32x4*)(p0 + 4); a[ks][0] = c[ks][0]; a[ks][1] = c[ks][1]; }
#pragma unroll
    for (int i = 1; i < W; ++i) {
        const bool ok = i <= sp; const size_t back = ok ? (size_t)i * POOL_W : 0;
        const float m = ok ? 1.0f : 0.0f;
#pragma unroll
        for (int ks = 0; ks < 4; ++ks) { const float* p0 = POOLV + (size_t)t * POOL_W + g * 128 + 32 * ks + 8 * qq - back; a[ks][0] += *(const f32x4*)p0 * m; a[ks][1] += *(const f32x4*)(p0 + 4) * m; }
    }
#pragma unroll
    for (int ks = 0; ks < 4; ++ks) {
        const f32x4 a0 = a[ks][0] * inv - c[ks][0], a1 = a[ks][1] * inv - c[ks][1];
        v4u pw; pw.x = cvtpk(a0.x, a0.y); pw.y = cvtpk(a0.z, a0.w); pw.z = cvtpk(a1.x, a1.y); pw.w = cvtpk(a1.z, a1.w);
        pf[ks] = __builtin_bit_cast(bf16x8, pw);
    }
}
__device__ __forceinline__ void pool_item(int item, const float* __restrict__ POOLV, const bf16_t* __restrict__ WPT, const float* __restrict__ pool_scale, bf16_t* CONCAT, int lane) {
    const int g = item & 3, t0 = (item >> 2) * 16, q15 = lane & 15, qq = lane >> 4;
    const int t = t0 + q15;
    bf16x8 pf[4];
    if (g == 0) pool_frags<2>(pf, POOLV, t, g, qq); else if (g == 1) pool_frags<4>(pf, POOLV, t, g, qq); else if (g == 2) pool_frags<8>(pf, POOLV, t, g, qq); else pool_frags<16>(pf, POOLV, t, g, qq);
    bf16_t* orow = CONCAT + (size_t)t * D_MODEL + g * 128 + 4 * qq;
#pragma unroll
    for (int mt = 0; mt < 8; ++mt) {
        f32x4 acc = {0.f, 0.f, 0.f, 0.f};
#pragma unroll
        for (int ks = 0; ks < 4; ++ks) { const bf16x8 wf = *(const bf16x8*)(WPT + (size_t)g * 16384 + (16 * mt + q15) * 128 + 32 * ks + 8 * qq); acc = mfma16(wf, pf[ks], acc); }
        const f32x4 sc = *(const f32x4*)(pool_scale + g * 128 + 16 * mt + 4 * qq);
        v2u wv; wv.x = cvtpk(acc[0] * sc[0], acc[1] * sc[1]); wv.y = cvtpk(acc[2] * sc[2], acc[3] * sc[3]);
        *(v2u*)(orow + 16 * mt) = wv;
    }
}

__device__ __forceinline__ void ln1_row(const float* __restrict__ yrow, const float* __restrict__ g, const float* __restrict__ bta, float* xo, bf16_t* xb, int lane) {
    f32x4 v[8]; float s = 0.f;
#pragma unroll
    for (int j = 0; j < 8; ++j) { v[j] = *(const f32x4*)(yrow + 256 * j + 4 * lane); s += (v[j].x + v[j].y) + (v[j].z + v[j].w); }
    const float mean = wave_sum(s) * (1.f / D_MODEL); float q = 0.f;
#pragma unroll
    for (int j = 0; j < 8; ++j) { v[j] = v[j] - mean; q += (v[j].x * v[j].x + v[j].y * v[j].y) + (v[j].z * v[j].z + v[j].w * v[j].w); }
    const float rstd = 1.0f / sqrtf(wave_sum(q) * (1.f / D_MODEL) + LN_EPS);
#pragma unroll
    for (int j = 0; j < 8; ++j) {
        const f32x4 gg = *(const f32x4*)(g + 256 * j + 4 * lane), bb = *(const f32x4*)(bta + 256 * j + 4 * lane);
        const f32x4 y = v[j] * rstd * gg + bb;
        *(f32x4*)(xo + 256 * j + 4 * lane) = y;
        v2u w; w.x = cvtpk(y.x, y.y); w.y = cvtpk(y.z, y.w); *(v2u*)(xb + 256 * j + 4 * lane) = w;
    }
}

__device__ __forceinline__ unsigned f2ord(float f) { const unsigned u = __float_as_uint(f); return u ^ ((unsigned)((int)u >> 31) | 0x80000000u); }
__device__ __forceinline__ float ord2f(unsigned o) { const unsigned u = (o & 0x80000000u) ? (o ^ 0x80000000u) : ~o; return __uint_as_float(u); }
constexpr int TK_KROW = 272, TK_HALF = 128 * TK_KROW;
__device__ __forceinline__ void topk_item(int item, const bf16_t* __restrict__ QP, const LAS unsigned char* Kl, int* EIDX, float* GATE, int lane) {
    const int h = item & 7, t0 = (item >> 3) * 16, q15 = lane & 15, qq = lane >> 4;
    const int t = t0 + q15;
    unsigned top[2][16];
#pragma unroll
    for (int half = 0; half < 2; ++half) {
        bf16x8 qf[4];
#pragma unroll
        for (int ks = 0; ks < 4; ++ks) qf[ks] = *(const bf16x8*)(QP + (size_t)t * D_MODEL + h * 256 + half * 128 + 32 * ks + 8 * qq);
        unsigned key[32];
#pragma unroll
        for (int mi = 0; mi < 8; ++mi) {
            f32x4 acc = {0.f, 0.f, 0.f, 0.f};
#pragma unroll
            for (int ks = 0; ks < 4; ++ks) { const bf16x8 kf = *(const LAS bf16x8*)(Kl + half * TK_HALF + (16 * mi + q15) * TK_KROW + (32 * ks + 8 * qq) * 2); acc = mfma16(kf, qf[ks], acc); }
#pragma unroll
            for (int r = 0; r < 4; ++r) key[mi * 4 + r] = (f2ord(acc[r]) & ~0x7Fu) | (unsigned)(127 - (16 * mi + 4 * qq + r));
        }
#pragma unroll
        for (int r = 0; r < 16; ++r) {
            unsigned t1[11];
#pragma unroll
            for (int i = 0; i < 10; ++i) t1[i] = umax(umax(key[3 * i], key[3 * i + 1]), key[3 * i + 2]);
            t1[10] = umax(key[30], key[31]);
            const unsigned u0 = umax(umax(t1[0], t1[1]), t1[2]), u1 = umax(umax(t1[3], t1[4]), t1[5]), u2 = umax(umax(t1[6], t1[7]), t1[8]), u3 = umax(t1[9], t1[10]);
            const unsigned M = xmax4(umax(umax(umax(u0, u1), u2), u3));
            top[half][r] = M;
#pragma unroll
            for (int i = 0; i < 32; ++i) key[i] = (key[i] == M) ? 0u : key[i];
            __builtin_amdgcn_sched_barrier(0);
        }
        __builtin_amdgcn_sched_barrier(0);
    }
    float v1[16], v2[16]; unsigned e1[16], e2[16];
#pragma unroll
    for (int r = 0; r < 16; ++r) { v1[r] = ord2f(top[0][r] & ~0x7Fu); v2[r] = ord2f(top[1][r] & ~0x7Fu); e1[r] = (127u - (top[0][r] & 0x7Fu)) * 128u; e2[r] = 127u - (top[1][r] & 0x7Fu); }
    unsigned ck[13], ce[13];
#pragma unroll
    for (int i = 0; i < 13; ++i) { ck[i] = 0u; ce[i] = 0u; }
    {
        int n = 0;
#pragma unroll
        for (int a = 0; a < 16; ++a)
#pragma unroll
            for (int bb = 0; bb < 16; ++bb)
                if ((a + 1) * (bb + 1) <= 16) {
                    const unsigned pk = (f2ord(v1[a] + v2[bb]) & ~0xFFu) | (unsigned)(255 - (a * 16 + bb));
                    const unsigned ee = e1[a] + e2[bb];
                    const bool me = (qq == (n & 3));
                    ck[n >> 2] = me ? pk : ck[n >> 2]; ce[n >> 2] = me ? ee : ce[n >> 2];
                    ++n;
                }
    }
    float sc[16];
#pragma unroll
    for (int r = 0; r < 16; ++r) {
        const unsigned c0 = umax(umax(ck[0], ck[1]), ck[2]), c1 = umax(umax(ck[3], ck[4]), ck[5]), c2 = umax(umax(ck[6], ck[7]), ck[8]), c3 = umax(umax(ck[9], ck[10]), ck[11]);
        const unsigned Lm = umax(umax(umax(c0, c1), umax(c2, c3)), ck[12]);
        const unsigned M = xmax4(Lm);
        unsigned we = 0u;
#pragma unroll
        for (int i = 0; i < 13; ++i) { const bool hit = (ck[i] == M); we = hit ? ce[i] : we; ck[i] = hit ? 0u : ck[i]; }
        sc[r] = ord2f(M & ~0xFFu);
        if (Lm == M) EIDX[(size_t)t * EPT + h * TOPK + r] = (int)we;
        __builtin_amdgcn_sched_barrier(0);
    }
    const float smax = sc[0];
    float den = 0.f;
#pragma unroll
    for (int r = 0; r < 16; ++r) { sc[r] = fexp2((sc[r] - smax) * LOG2E); den += sc[r]; }
    const float rden = 1.0f / den;
    if (qq == 0) {
        float* gp = GATE + (size_t)t * EPT + h * TOPK;
#pragma unroll
        for (int r = 0; r < 16; r += 4) *(f32x4*)(gp + r) = (f32x4){sc[r] * rden, sc[r + 1] * rden, sc[r + 2] * rden, sc[r + 3] * rden};
    }
}

__device__ __forceinline__ float reduce16(const float (&p)[16], int lane) {
    const bool b3 = lane & 8, b2 = lane & 4;
    float r8[8], r4[4], r2[2];
#pragma unroll
    for (int k = 0; k < 8; ++k) { auto r = __builtin_amdgcn_permlane32_swap(__float_as_uint(p[k]), __float_as_uint(p[k + 8]), false, false); r8[k] = __uint_as_float(r[0]) + __uint_as_float(r[1]); }
#pragma unroll
    for (int k = 0; k < 4; ++k) { auto r = __builtin_amdgcn_permlane16_swap(__float_as_uint(r8[k]), __float_as_uint(r8[k + 4]), false, false); r4[k] = __uint_as_float(r[0]) + __uint_as_float(r[1]); }
#pragma unroll
    for (int k = 0; k < 2; ++k) { const float keep = b3 ? r4[k + 2] : r4[k], send = b3 ? r4[k] : r4[k + 2]; r2[k] = keep + __shfl_xor(send, 8); }
    const float keep = b2 ? r2[1] : r2[0], send = b2 ? r2[0] : r2[1];
    float r1 = keep + __shfl_xor(send, 4);
    r1 += __shfl_xor(r1, 2); r1 += __shfl_xor(r1, 1);
    return r1;
}
#define G_LANE_OF(e) ((((e) >> 3) & 1) * 32 + (((e) >> 2) & 1) * 16 + (((e) >> 1) & 1) * 8 + ((e) & 1) * 4)
#define G_ISSUE1(slot, TAB, idv, ln) do { const int _id = __builtin_amdgcn_readlane((idv), (ln)); const unsigned char* _rp = (TAB) + (size_t)_id * D_MODEL + 16 * lane; \
        buf[slot][0] = *(const v4u*)_rp; buf[slot][1] = *(const v4u*)(_rp + 1024); } while (0)
#define G_DOT1(slot, pi) do { float _a = 0.f, _b = 0.f; \
        _Pragma("unroll") for (int _i = 0; _i < 2; ++_i) _Pragma("unroll") for (int _j = 0; _j < 4; ++_j) { const unsigned _w = buf[slot][_i][_j]; \
            _a = __builtin_amdgcn_fdot2_f32_bf16(__builtin_amdgcn_cvt_scalef32_pk_bf16_fp8(_w, 1.0f, false), __builtin_bit_cast(bf16x2, xb[_i][2 * _j]), _a, false); \
            _b = __builtin_amdgcn_fdot2_f32_bf16(__builtin_amdgcn_cvt_scalef32_pk_bf16_fp8(_w, 1.0f, true), __builtin_bit_cast(bf16x2, xb[_i][2 * _j + 1]), _b, false); } \
        part[pi] = _a + _b; } while (0)
#define G_FMA1(slot, e) do { const float _a = __int_as_float(__builtin_amdgcn_readlane(__float_as_int(aval), G_LANE_OF(e))); \
        _Pragma("unroll") for (int _i = 0; _i < 2; ++_i) _Pragma("unroll") for (int _j = 0; _j < 4; ++_j) { const unsigned _w = buf[slot][_i][_j]; \
            const f32x2 _lo = __builtin_amdgcn_cvt_pk_f32_fp8(_w, false), _hi = __builtin_amdgcn_cvt_pk_f32_fp8(_w, true); \
            acc[_i][_j] += (f32x4){_lo.x, _lo.y, _hi.x, _hi.y} * _a; } } while (0)
__device__ __forceinline__ void gather_token(int t, const float* __restrict__ X1, const bf16_t* __restrict__ X1B, const int* __restrict__ EIDX, const float* __restrict__ GATE,
                                             const unsigned char* __restrict__ U8, const unsigned char* __restrict__ V8, const float* __restrict__ SU, const float* __restrict__ SV,
                                             const float* __restrict__ g2, const float* __restrict__ b2, float* out, int lane) {
    unsigned xb[2][8];
#pragma unroll
    for (int i = 0; i < 2; ++i)
#pragma unroll
        for (int j = 0; j < 4; ++j) { const v2u a = *(const v2u*)(X1B + (size_t)t * D_MODEL + 1024 * i + 256 * j + 4 * lane); xb[i][2 * j] = a.x; xb[i][2 * j + 1] = a.y; }
    const int id_lo = EIDX[(size_t)t * EPT + lane], id_hi = EIDX[(size_t)t * EPT + 64 + lane];
    const float g_lo = GATE[(size_t)t * EPT + lane], g_hi = GATE[(size_t)t * EPT + 64 + lane];
    const float su_lo = SU[id_lo], su_hi = SU[id_hi], sv_lo = SV[id_lo], sv_hi = SV[id_hi];
    f32x4 acc[2][4];
#pragma unroll
    for (int i = 0; i < 2; ++i)
#pragma unroll
        for (int j = 0; j < 4; ++j) acc[i][j] = (f32x4){0.f, 0.f, 0.f, 0.f};
    const int e_me = ((lane >> 5) & 1) * 8 + ((lane >> 4) & 1) * 4 + ((lane >> 3) & 1) * 2 + ((lane >> 2) & 1);
    v4u buf[8][2];
#pragma unroll
    for (int e = 0; e < 8; ++e) G_ISSUE1(e, U8, id_lo, e);
#pragma unroll 1
    for (int hh = 0; hh < 8; ++hh) {
        const int idv = hh < 4 ? id_lo : id_hi; const float gv = hh < 4 ? g_lo : g_hi, suv = hh < 4 ? su_lo : su_hi, svv = hh < 4 ? sv_lo : sv_hi;
        const int lb = (hh & 3) * 16;
        const int hn = hh < 7 ? hh + 1 : 7; const int idn = hn < 4 ? id_lo : id_hi; const int lbn = (hn & 3) * 16;
        float part[16];
#pragma unroll
        for (int e = 0; e < 16; ++e) {
            G_DOT1(e & 7, e);
            if (e < 8) G_ISSUE1(e & 7, U8, idv, lb + e + 8); else G_ISSUE1(e & 7, V8, idv, lb + e - 8);
        }
        const float hval = reduce16(part, lane) * __shfl(suv, lb + e_me);
        const float aval = __shfl(gv, lb + e_me) * gelu_erf(hval) * __shfl(svv, lb + e_me);
#pragma unroll
        for (int e = 0; e < 16; ++e) {
            G_FMA1(e & 7, e);
            if (e < 8) G_ISSUE1(e & 7, V8, idv, lb + e + 8); else G_ISSUE1(e & 7, U8, idn, lbn + e - 8);
        }
    }
    float s = 0.f;
#pragma unroll
    for (int i = 0; i < 2; ++i)
#pragma unroll
        for (int j = 0; j < 4; ++j) {
            const f32x4 x0 = *(const f32x4*)(X1 + (size_t)t * D_MODEL + 1024 * i + 256 * j + 4 * lane);
            acc[i][j] = x0 * ALPHA + acc[i][j];
            s += (acc[i][j].x + acc[i][j].y) + (acc[i][j].z + acc[i][j].w);
        }
    const float mean = wave_sum(s) * (1.f / D_MODEL); float q = 0.f;
#pragma unroll
    for (int i = 0; i < 2; ++i)
#pragma unroll
        for (int j = 0; j < 4; ++j) { acc[i][j] = acc[i][j] - mean; q += (acc[i][j].x * acc[i][j].x + acc[i][j].y * acc[i][j].y) + (acc[i][j].z * acc[i][j].z + acc[i][j].w * acc[i][j].w); }
    const float rstd = 1.0f / sqrtf(wave_sum(q) * (1.f / D_MODEL) + LN_EPS);
#pragma unroll
    for (int i = 0; i < 2; ++i)
#pragma unroll
        for (int j = 0; j < 4; ++j) {
            const int c = 1024 * i + 256 * j + 4 * lane;
            const f32x4 gg = *(const f32x4*)(g2 + c), bb = *(const f32x4*)(b2 + c);
            *(f32x4*)(out + (size_t)t * D_MODEL + c) = acc[i][j] * rstd * gg + bb;
        }
}
template <int R>
__device__ __forceinline__ void cvt_rows_fp8(const float* __restrict__ in, unsigned char* out8, float* sc, int row0, int lane) {
    f32x4 v[R][2][4];
#pragma unroll
    for (int r = 0; r < R; ++r)
#pragma unroll
        for (int i = 0; i < 2; ++i)
#pragma unroll
            for (int j = 0; j < 4; ++j) v[r][i][j] = __builtin_nontemporal_load((const f32x4*)(in + (size_t)(row0 + r) * D_MODEL + 1024 * i + 256 * j + 4 * lane));
#pragma unroll
    for (int r = 0; r < R; ++r) {
        float am = 0.f;
#pragma unroll
        for (int i = 0; i < 2; ++i)
#pragma unroll
            for (int j = 0; j < 4; ++j) am = fmaxf(am, fmaxf(fmaxf(fabsf(v[r][i][j].x), fabsf(v[r][i][j].y)), fmaxf(fabsf(v[r][i][j].z), fabsf(v[r][i][j].w))));
#pragma unroll
        for (int o = 1; o < 64; o <<= 1) am = fmaxf(am, __shfl_xor(am, o));
        const float inv = am > 0.f ? 256.0f / am : 1.0f, scale = am > 0.f ? am * (1.0f / 256.0f) : 1.0f;
#pragma unroll
        for (int i = 0; i < 2; ++i) {
            v4u o;
#pragma unroll
            for (int j = 0; j < 4; ++j) { int w = 0; w = __builtin_amdgcn_cvt_pk_fp8_f32(v[r][i][j].x * inv, v[r][i][j].y * inv, w, false); w = __builtin_amdgcn_cvt_pk_fp8_f32(v[r][i][j].z * inv, v[r][i][j].w * inv, w, true); o[j] = (unsigned)w; }
            *(v4u*)(out8 + (size_t)(row0 + r) * D_MODEL + 1024 * i + 16 * lane) = o;
        }
        if (lane == 0) sc[row0 + r] = scale;
    }
}

struct Args { const void* in[18]; float* out; unsigned char* ws; int ph_lo, ph_hi, li, pad; };
constexpr int N_PHASES = 8;

#define P_IN(T, i) ((const T*)args.in[i])
#define P_WS(T, off) ((T*)(ws + (off)))
#define x_in P_IN(float, 0)
#define mem_in P_IN(float, 1)
#define positions P_IN(int, 2)
#define w_in P_IN(float, 3)
#define w_mem_kv P_IN(float, 4)
#define w_pool P_IN(float, 5)
#define pool_scale P_IN(float, 6)
#define sinks P_IN(float, 7)
#define w_out P_IN(float, 8)
#define ln1_g P_IN(float, 9)
#define ln1_b P_IN(float, 10)
#define w_peer_q P_IN(float, 11)
#define sk1 P_IN(float, 12)
#define sk2 P_IN(float, 13)
#define eu P_IN(float, 14)
#define ev P_IN(float, 15)
#define ln2_g P_IN(float, 16)
#define ln2_b P_IN(float, 17)
#define WINT P_WS(bf16_t, WS_WINT)
#define WKVT P_WS(bf16_t, WS_WKVT)
#define WOT P_WS(bf16_t, WS_WOT)
#define WQT P_WS(bf16_t, WS_WQT)
#define WPT P_WS(bf16_t, WS_SMALL)
#define K1B P_WS(bf16_t, WS_SMALL + 131072)
#define K2B P_WS(bf16_t, WS_SMALL + 163840)
#define ROPE P_WS(float, WS_SMALL + 262144)
#define XB P_WS(bf16_t, WS_XB)
#define X1B P_WS(bf16_t, WS_X1B)
#define MEMB P_WS(bf16_t, WS_MEMB)
#define KVM P_WS(bf16_t, WS_KVM)
#define POOLV P_WS(float, WS_POOLV)
#define Q P_WS(bf16_t, WS_Q)
#define Kb P_WS(bf16_t, WS_K)
#define Vb P_WS(bf16_t, WS_V)
#define QM P_WS(bf16_t, WS_QM)
#define CONCAT P_WS(bf16_t, WS_CONCAT)
#define Y1 P_WS(float, WS_Y1)
#define X1 P_WS(float, WS_X1)
#define QP P_WS(bf16_t, WS_QP)
#define EIDX P_WS(int, WS_EIDX)
#define GATE P_WS(float, WS_GATE)
#define U8 P_WS(unsigned char, WS_UB)
#define V8 P_WS(unsigned char, WS_VB)
#define SU P_WS(float, WS_UB + 48 * MiB)
#define SV P_WS(float, WS_VB + 48 * MiB)
__global__ void __launch_bounds__(NTHREADS, 2) mega_fwd(Args args) {
    extern __shared__ __attribute__((aligned(16))) unsigned char lds_raw[];
    LAS unsigned char* lds = (LAS unsigned char*)lds_raw;
    volatile LAS unsigned* MISC = (volatile LAS unsigned*)(lds + MISC_OFF);
    const int tid = threadIdx.x, lane = tid & 63, wave = __builtin_amdgcn_readfirstlane(tid >> 6);
    const int G = gridDim.x, bx = blockIdx.x;
    const int vcu = (G % 8 == 0) ? (bx % 8) * (G / 8) + bx / 8 : bx;
    const int gw = vcu * NWAVES + wave, NGW = G * NWAVES;
    unsigned char* ws = args.ws;
    for (int u = tid; u < (LDS_BYTES - MISC_OFF) / 4; u += NTHREADS) MISC[u] = 0u;
    __syncthreads();
    XcdBarrier bar = xcd_barrier_post((unsigned*)(ws + WS_CTL) + CW_BAR + args.li * XCD_BAR_WORDS, MISC + 8);
    const int lo = args.ph_lo, hi = args.ph_hi;
#ifndef ONLY_PHASES
#define ONLY_PHASES 255
#endif
#define IN(k) (((ONLY_PHASES >> (k)) & 1) && lo <= (k) && (k) < hi)
#ifndef REPEAT_MASK
#define REPEAT_MASK 0
#endif
#define REP(k) for (int _rep = 0; _rep < 1 + ((REPEAT_MASK >> (k)) & 1); ++_rep)
#define SEAM(k) do { if (IN(k) && IN((k) + 1)) xcd_barrier(bar); } while (0)

    if (IN(0)) REP(0) {
        LAS float* scr = (LAS float*)(lds + wave * 16384);
        constexpr int I_IN = (D_MODEL / 64) * (IN_W / 32), I_KV = (D_MODEL / 64) * (2 * MEM_W / 32), I_O = (D_MODEL / 64) * (D_MODEL / 32), I_Q = I_O, I_P = 4 * 2 * 4;
        constexpr int NITEMS = I_IN + I_KV + I_O + I_Q + I_P;
        for (int it = gw; it < NITEMS; it += NGW) {
            int r = it;
            if (r < I_IN) { p0_transpose_item(w_in, D_MODEL, IN_W, WINT, scr, r, lane); continue; } r -= I_IN;
            if (r < I_KV) { p0_transpose_item(w_mem_kv, D_MODEL, 2 * MEM_W, WKVT, scr, r, lane); continue; } r -= I_KV;
            if (r < I_O) { p0_transpose_item(w_out, D_MODEL, D_MODEL, WOT, scr, r, lane); continue; } r -= I_O;
            if (r < I_Q) { p0_transpose_item(w_peer_q, D_MODEL, D_MODEL, WQT, scr, r, lane); continue; } r -= I_Q;
            { const int gpl = r >> 3; p0_transpose_item(w_pool + (size_t)gpl * 16384, 128, 128, WPT + (size_t)gpl * 16384, scr, r & 7, lane); }
        }
        cvt_stream<false>(x_in, XB, (size_t)MTOK * D_MODEL, gw, NGW, lane);
        cvt_stream<false>(mem_in, MEMB, (size_t)MMEM * D_MODEL, gw, NGW, lane);
        cvt_stream<false>(sk1, K1B, (size_t)NKEYS * 128, gw, NGW, lane);
        cvt_stream<false>(sk2, K2B, (size_t)NKEYS * 128, gw, NGW, lane);
        for (int i = gw * 64 + lane; i < MTOK * 8; i += NGW * 64) { float c, s; rope_cs(positions[i >> 3], i & 7, c, s); *(f32x2*)(ROPE + 2 * (size_t)i) = (f32x2){c, s}; }
    }
    SEAM(0);
    if (IN(1)) REP(1) {
        { pg8::Gemm g{XB, WINT, MTOK, IN_W, D_MODEL}; pg8::StaticOrder S; S.init(MTOK, IN_W, G, bx);
          EpiIn E{POOLV, Q, Kb, Vb, QM, ROPE};
          pg8::gemm_phase<EpiIn, pg8::StaticOrder, true, true>(lds, g, S, E); }
        { pg8::Gemm g{MEMB, WKVT, MMEM, 2 * MEM_W, D_MODEL}; pg8::StaticOrder S; S.init(MMEM, 2 * MEM_W, G, (bx + G - 64) % G);
          EpiStoreBf E{KVM, 2 * MEM_W};
          pg8::gemm_phase<EpiStoreBf, pg8::StaticOrder, true, true>(lds, g, S, E); }
        { const int f0 = (G == 256) ? 72 : 0;
          if (bx >= f0) { const int fw = (bx - f0) * NWAVES + wave, NFW = (G - f0) * NWAVES;
            for (int r = fw * 4; r < 2 * NEXP; r += NFW * 4) { if (r < NEXP) cvt_rows_fp8<4>(eu, U8, SU, r, lane); else cvt_rows_fp8<4>(ev, V8, SV, r - NEXP, lane); } } }
    }
    SEAM(1);
    if (IN(2)) REP(2) {
        for (int it = vcu; it < 512; it += G) {
            if (it < 256) swa_item(lds, it, Q, Kb, Vb, sinks, CONCAT, tid, wave, lane);
            else mem_item(lds, it - 256, QM, KVM, CONCAT, tid, wave, lane);
        }
        for (int it = gw; it < (MTOK / 16) * 4; it += NGW) pool_item(it, POOLV, WPT, pool_scale, CONCAT, lane);
    }
    SEAM(2);
    if (IN(3)) REP(3) {
        pg8::Gemm g{CONCAT, WOT, MTOK, D_MODEL, D_MODEL}; pg8::StaticOrder S; S.init(MTOK, D_MODEL, G, bx);
        EpiY1 E{x_in, Y1};
        pg8::gemm_phase<EpiY1, pg8::StaticOrder, true, true>(lds, g, S, E);
    }
    SEAM(3);
    if (IN(4)) REP(4) { for (int r = gw; r < MTOK; r += NGW) ln1_row(Y1 + (size_t)r * D_MODEL, ln1_g, ln1_b, X1 + (size_t)r * D_MODEL, X1B + (size_t)r * D_MODEL, lane); }
    SEAM(4);
    if (IN(5)) REP(5) {
        pg8::Gemm g{X1B, WQT, MTOK, D_MODEL, D_MODEL}; pg8::StaticOrder S; S.init(MTOK, D_MODEL, G, bx);
        EpiStoreBf E{QP, D_MODEL};
        pg8::gemm_phase<EpiStoreBf, pg8::StaticOrder, true, true>(lds, g, S, E);
    }
    SEAM(5);
    if (IN(6)) REP(6) {
#pragma unroll
        for (int j = 0; j < 8; ++j) { const int c = tid + NTHREADS * j, half = c >> 11, row = (c >> 4) & 127, part = c & 15;
            *(LAS v4u*)(lds + half * TK_HALF + row * TK_KROW + part * 16) = *(const v4u*)((half ? K2B : K1B) + row * 128 + part * 8); }
        __syncthreads();
        for (int it = gw; it < (MTOK / 16) * PHEADS; it += NGW) topk_item(it, QP, lds, EIDX, GATE, lane);
        __syncthreads();
    }
    SEAM(6);
    if (IN(7)) REP(7) { for (int t = gw; t < MTOK; t += NGW) gather_token(t, X1, X1B, EIDX, GATE, U8, V8, SU, SV, ln2_g, ln2_b, args.out, lane); }
#undef IN
#undef SEAM
}
#undef P_IN(T,
#undef P_WS(T,
#undef x_in
#undef mem_in
#undef positions
#undef w_in
#undef w_mem_kv
#undef w_pool
#undef pool_scale
#undef sinks
#undef w_out
#undef ln1_g
#undef ln1_b
#undef w_peer_q
#undef sk1
#undef sk2
#undef eu
#undef ev
#undef ln2_g
#undef ln2_b
#undef WINT
#undef WKVT
#undef WOT
#undef WQT
#undef WPT
#undef K1B
#undef K2B
#undef ROPE
#undef XB
#undef X1B
#undef MEMB
#undef KVM
#undef POOLV
#undef Q
#undef Kb
#undef Vb
#undef QM
#undef CONCAT
#undef Y1
#undef X1
#undef QP
#undef EIDX
#undef GATE
#undef U8
#undef V8
#undef SU
#undef SV

#if NAIVE_MASK != 0
__device__ __forceinline__ float toF(float v) { return v; }
__device__ __forceinline__ float toF(bf16_t v) { return bf2f(v); }

struct NvEpiF32 { float* C; int ldc, pad; __device__ void operator()(int r, int c, float v) const { C[(size_t)r * ldc + c] = v; } };
struct NvEpiBf { bf16_t* C; int ldc, pad; __device__ void operator()(int r, int c, float v) const { C[(size_t)r * ldc + c] = f2bf(v); } };
struct NvEpiY1 { const float* x; float* y; __device__ void operator()(int r, int c, float v) const { y[(size_t)r * D_MODEL + c] = ALPHA * x[(size_t)r * D_MODEL + c] + v; } };

template <class TA, class Epi>
__global__ void __launch_bounds__(256) nv_gemm(const TA* __restrict__ A, const float* __restrict__ B, int M, int N, int K, Epi epi) {
    __shared__ float As[16][65];
    __shared__ float Bs[16][64];
    const int tx = threadIdx.x & 15, ty = threadIdx.x >> 4;
    const int m0 = blockIdx.y * 64, n0 = blockIdx.x * 64;
    float acc[4][4];
#pragma unroll
    for (int i = 0; i < 4; ++i)
#pragma unroll
        for (int j = 0; j < 4; ++j) acc[i][j] = 0.f;
    for (int k0 = 0; k0 < K; k0 += 16) {
        for (int i = threadIdx.x; i < 1024; i += 256) { const int r = i >> 4, c = i & 15; As[c][r] = toF(A[(size_t)(m0 + r) * K + k0 + c]); }
        for (int i = threadIdx.x; i < 1024; i += 256) { const int r = i >> 6, c = i & 63; Bs[r][c] = B[(size_t)(k0 + r) * N + n0 + c]; }
        __syncthreads();
#pragma unroll
        for (int kk = 0; kk < 16; ++kk) {
            float a[4], b[4];
#pragma unroll
            for (int i = 0; i < 4; ++i) { a[i] = As[kk][ty * 4 + i]; b[i] = Bs[kk][tx * 4 + i]; }
#pragma unroll
            for (int i = 0; i < 4; ++i)
#pragma unroll
                for (int j = 0; j < 4; ++j) acc[i][j] += a[i] * b[j];
        }
        __syncthreads();
    }
#pragma unroll
    for (int i = 0; i < 4; ++i)
#pragma unroll
        for (int j = 0; j < 4; ++j) epi(m0 + ty * 4 + i, n0 + tx * 4 + j, acc[i][j]);
}

__global__ void nv_post1(const float* __restrict__ H, const int* __restrict__ positions, float* POOLV, bf16_t* Q, bf16_t* Kb, bf16_t* Vb, bf16_t* QM) {
    const size_t gid = (size_t)blockIdx.x * blockDim.x + threadIdx.x;
    if (gid >= (size_t)MTOK * IN_W) return;
    const int t = (int)(gid / IN_W), col = (int)(gid % IN_W);
    const float* hr = H + (size_t)t * IN_W;
    const float v = hr[col];
    if (col < POOL_W) { POOLV[(size_t)t * POOL_W + col] = v; return; }
    if (col < POOL_W + SWA_W + KV_W) {
        const bool isq = col < POOL_W + SWA_W;
        const int c = isq ? col - POOL_W : col - POOL_W - SWA_W;
        const int d = c & 63;
        float o = v;
        if (d < 16) {
            const int j = d & 7; float cs, sn; rope_cs(positions[t], j, cs, sn);
            if (d < 8) o = v * cs - hr[col + 8] * sn; else o = v * cs + hr[col - 8] * sn;
        }
        if (isq) Q[(size_t)t * SWA_W + c] = f2bf(o); else Kb[(size_t)t * KV_W + c] = f2bf(o);
        return;
    }
    if (col < POOL_W + SWA_W + 2 * KV_W) { Vb[(size_t)t * KV_W + (col - POOL_W - SWA_W - KV_W)] = f2bf(v); return; }
    QM[(size_t)t * MEM_W + (col - POOL_W - SWA_W - 2 * KV_W)] = f2bf(v);
}
__global__ void nv_cvt_bf16(const float* __restrict__ in, bf16_t* out, size_t n) {
    const size_t gid = (size_t)blockIdx.x * blockDim.x + threadIdx.x;
    if (gid < n) out[gid] = f2bf(in[gid]);
}
__global__ void nv_pool1(const float* __restrict__ POOLV, float* PS) {
    const size_t gid = (size_t)blockIdx.x * blockDim.x + threadIdx.x;
    if (gid >= (size_t)MTOK * POOL_W) return;
    const int t = (int)(gid / POOL_W), ch = (int)(gid % POOL_W);
    const int g = ch >> 7, w = 2 << g, s = t & (SEQ - 1);
    const int cnt = (s + 1) < w ? (s + 1) : w;
    float sum = 0.f;
    for (int i = 0; i < cnt; ++i) sum += POOLV[(size_t)(t - i) * POOL_W + ch];
    PS[gid] = sum / (float)cnt - POOLV[gid];
}
__global__ void nv_pool2(const float* __restrict__ PS, const float* __restrict__ w_pool, const float* __restrict__ pool_scale, bf16_t* CONCAT) {
    const size_t gid = (size_t)blockIdx.x * blockDim.x + threadIdx.x;
    if (gid >= (size_t)MTOK * POOL_W) return;
    const int t = (int)(gid / POOL_W), ch = (int)(gid % POOL_W);
    const int g = ch >> 7, d = ch & 127;
    const float* p = PS + (size_t)t * POOL_W + g * 128;
    const float* w = w_pool + (size_t)g * 128 * 128 + d;
    float y = 0.f;
    for (int c = 0; c < 128; ++c) y += p[c] * w[(size_t)c * 128];
    CONCAT[(size_t)t * D_MODEL + ch] = f2bf(y * pool_scale[ch]);
}
__global__ void __launch_bounds__(256) nv_swa(const bf16_t* __restrict__ Q, const bf16_t* __restrict__ Kb, const bf16_t* __restrict__ Vb, const float* __restrict__ sinks, bf16_t* CONCAT) {
    const int wv = (int)((blockIdx.x * 256 + threadIdx.x) >> 6), lane = threadIdx.x & 63;
    if (wv >= MTOK * NHEAD) return;
    const int t = wv / NHEAD, h = wv % NHEAD, kvh = h >> 2, s = t & (SEQ - 1), tb = t - s;
    const float q = bf2f(Q[(size_t)t * SWA_W + h * HD + lane]);
    float m = sinks[h], l = 1.0f, o = 0.f;
    const int k0 = s - (WINDOW - 1) < 0 ? 0 : s - (WINDOW - 1);
    for (int kk = k0; kk <= s; ++kk) {
        const size_t kt = (size_t)(tb + kk);
        const float sc = wave_sum(q * bf2f(Kb[kt * KV_W + kvh * HD + lane])) * 0.125f;
        const float mn = fmaxf(m, sc), r = expf(m - mn), p = expf(sc - mn);
        l = l * r + p; o = o * r + p * bf2f(Vb[kt * KV_W + kvh * HD + lane]); m = mn;
    }
    CONCAT[(size_t)t * D_MODEL + POOL_W + h * HD + lane] = f2bf(o / l);
}
__global__ void __launch_bounds__(256) nv_mem(const bf16_t* __restrict__ QM, const bf16_t* __restrict__ KVM, bf16_t* CONCAT) {
    const int wv = (int)((blockIdx.x * 256 + threadIdx.x) >> 6), lane = threadIdx.x & 63;
    if (wv >= MTOK * MHEADS) return;
    const int t = wv / MHEADS, hm = wv % MHEADS, b = t / SEQ;
    const float q0 = bf2f(QM[(size_t)t * MEM_W + hm * MHD + lane]), q1 = bf2f(QM[(size_t)t * MEM_W + hm * MHD + 64 + lane]);
    float m = -1e30f, l = 0.f, o0 = 0.f, o1 = 0.f;
    const float scale = 0.08838834764831845f;
    for (int j = 0; j < MEM_LEN; ++j) {
        const bf16_t* kr = KVM + (size_t)(b * MEM_LEN + j) * (2 * MEM_W) + hm * MHD;
        const bf16_t* vr = kr + MEM_W;
        const float sc = wave_sum(q0 * bf2f(kr[lane]) + q1 * bf2f(kr[64 + lane])) * scale;
        const float mn = fmaxf(m, sc), r = expf(m - mn), p = expf(sc - mn);
        l = l * r + p; o0 = o0 * r + p * bf2f(vr[lane]); o1 = o1 * r + p * bf2f(vr[64 + lane]); m = mn;
    }
    bf16_t* orow = CONCAT + (size_t)t * D_MODEL + POOL_W + SWA_W + hm * MHD;
    orow[lane] = f2bf(o0 / l); orow[64 + lane] = f2bf(o1 / l);
}
__global__ void __launch_bounds__(256) nv_ln(const float* __restrict__ in, const float* __restrict__ g, const float* __restrict__ bta, float* outf, bf16_t* outb) {
    const int row = (int)((blockIdx.x * 256 + threadIdx.x) >> 6), lane = threadIdx.x & 63;
    if (row >= MTOK) return;
    const float* r = in + (size_t)row * D_MODEL;
    float v[32]; float s = 0.f;
#pragma unroll
    for (int i = 0; i < 32; ++i) { v[i] = r[lane + 64 * i]; s += v[i]; }
    const float mean = wave_sum(s) * (1.f / D_MODEL); float q = 0.f;
#pragma unroll
    for (int i = 0; i < 32; ++i) { v[i] -= mean; q += v[i] * v[i]; }
    const float rstd = 1.0f / sqrtf(wave_sum(q) * (1.f / D_MODEL) + LN_EPS);
#pragma unroll
    for (int i = 0; i < 32; ++i) {
        const int c = lane + 64 * i; const float y = v[i] * rstd * g[c] + bta[c];
        if (outf) outf[(size_t)row * D_MODEL + c] = y;
        if (outb) outb[(size_t)row * D_MODEL + c] = f2bf(y);
    }
}
__global__ void __launch_bounds__(32) nv_topk(const bf16_t* __restrict__ QP, const float* __restrict__ K1, const float* __restrict__ K2, int* EIDX, float* GATE) {
    __shared__ float sc[256][32];
    __shared__ float lv[32][32];
    __shared__ int li[32][32];
    const int tid = threadIdx.x, gid = blockIdx.x * 32 + tid;
    const int t = gid / PHEADS, h = gid % PHEADS;
    const bf16_t* q = QP + (size_t)t * D_MODEL + h * 256;
    for (int half = 0; half < 2; ++half) {
        const float* Kk = half ? K2 : K1;
        for (int k = 0; k < NKEYS; ++k) {
            float a = 0.f;
            for (int c = 0; c < 128; ++c) a += bf2f(q[half * 128 + c]) * Kk[k * 128 + c];
            sc[half * 128 + k][tid] = a;
        }
        for (int r = 0; r < TOPK; ++r) {
            float best = -INFINITY; int bi = 0;
            for (int k = 0; k < NKEYS; ++k) { const float v = sc[half * 128 + k][tid]; if (v > best) { best = v; bi = k; } }
            lv[half * 16 + r][tid] = best; li[half * 16 + r][tid] = bi; sc[half * 128 + bi][tid] = -INFINITY;
        }
    }
    for (int a = 0; a < 16; ++a) for (int b = 0; b < 16; ++b) sc[a * 16 + b][tid] = lv[a][tid] + lv[16 + b][tid];
    float mx = 0.f, den = 0.f;
    float tv[16]; int ti[16];
#pragma unroll
    for (int r = 0; r < TOPK; ++r) {
        float best = -INFINITY; int bi = 0;
        for (int k = 0; k < 256; ++k) { const float v = sc[k][tid]; if (v > best) { best = v; bi = k; } }
        sc[bi][tid] = -INFINITY;
        if (r == 0) mx = best;
        tv[r] = expf(best - mx); den += tv[r]; ti[r] = li[bi >> 4][tid] * NKEYS + li[16 + (bi & 15)][tid];
    }
#pragma unroll
    for (int r = 0; r < TOPK; ++r) { EIDX[(size_t)t * EPT + h * TOPK + r] = ti[r]; GATE[(size_t)t * EPT + h * TOPK + r] = tv[r] / den; }
}
__global__ void __launch_bounds__(256) nv_gather(const float* __restrict__ X1, const int* __restrict__ EIDX, const float* __restrict__ GATE, const float* __restrict__ EU, const float* __restrict__ EV,
                                                  const float* __restrict__ g, const float* __restrict__ bta, float* out) {
    const int t = (int)((blockIdx.x * 256 + threadIdx.x) >> 6), lane = threadIdx.x & 63;
    if (t >= MTOK) return;
    float x[32], acc[32];
#pragma unroll
    for (int i = 0; i < 32; ++i) { x[i] = X1[(size_t)t * D_MODEL + lane + 64 * i]; acc[i] = 0.f; }
    for (int e = 0; e < EPT; ++e) {
        const int id = EIDX[(size_t)t * EPT + e]; const float gt = GATE[(size_t)t * EPT + e];
        const float* u = EU + (size_t)id * D_MODEL; const float* vv = EV + (size_t)id * D_MODEL;
        float p = 0.f;
#pragma unroll
        for (int i = 0; i < 32; ++i) p += x[i] * u[lane + 64 * i];
        const float a = gt * gelu_erf(wave_sum(p));
#pragma unroll
        for (int i = 0; i < 32; ++i) acc[i] += a * vv[lane + 64 * i];
    }
    float s = 0.f;
#pragma unroll
    for (int i = 0; i < 32; ++i) { acc[i] = ALPHA * x[i] + acc[i]; s += acc[i]; }
    const float mean = wave_sum(s) * (1.f / D_MODEL); float q = 0.f;
#pragma unroll
    for (int i = 0; i < 32; ++i) { acc[i] -= mean; q += acc[i] * acc[i]; }
    const float rstd = 1.0f / sqrtf(wave_sum(q) * (1.f / D_MODEL) + LN_EPS);
#pragma unroll
    for (int i = 0; i < 32; ++i) { const int c = lane + 64 * i; out[(size_t)t * D_MODEL + c] = acc[i] * rstd * g[c] + bta[c]; }
}

#endif
extern "C" void kernel_launch(void* const* d_in, const int* in_sizes, int n_in, void* d_out, int out_size, void* d_ws, size_t ws_size, hipStream_t stream) {
    static int grid = 0;
    if (grid == 0) {
        if (n_in != 18 || in_sizes[0] != MTOK * D_MODEL || out_size != MTOK * D_MODEL || ws_size < WS_END) {
            fprintf(stderr, "kernel_launch: unexpected shapes (n_in %d, in0 %d, out %d, ws %zu)\n", n_in, n_in > 0 ? in_sizes[0] : -1, out_size, ws_size); grid = -1; return; }
        int dev = 0, cus = 0, per_cu = 0;
        if (hipGetDevice(&dev) != hipSuccess || hipDeviceGetAttribute(&cus, hipDeviceAttributeMultiprocessorCount, dev) != hipSuccess) { fprintf(stderr, "kernel_launch: device query failed\n"); grid = -1; return; }
        if (hipFuncSetAttribute((const void*)mega_fwd, hipFuncAttributeMaxDynamicSharedMemorySize, LDS_BYTES) != hipSuccess) { fprintf(stderr, "kernel_launch: hipFuncSetAttribute failed\n"); grid = -1; return; }
        if (hipOccupancyMaxActiveBlocksPerMultiprocessor(&per_cu, (const void*)mega_fwd, NTHREADS, LDS_BYTES) != hipSuccess || per_cu < 1) {
            fprintf(stderr, "kernel_launch: occupancy query reports %d workgroups per CU\n", per_cu); (void)hipGetLastError(); grid = -1; return; }
        grid = cus;
    }
    if (grid < 0) return;
    unsigned char* ws = (unsigned char*)d_ws;
    (void)hipMemsetAsync(ws + WS_CTL, 0, 1 * MiB, stream);
    Args a{};
    for (int i = 0; i < 18; ++i) a.in[i] = d_in[i];
    a.out = (float*)d_out; a.ws = ws;
#if NAIVE_MASK != 0
    const float* x = (const float*)d_in[0]; const float* mem = (const float*)d_in[1]; const int* positions = (const int*)d_in[2];
    const float* w_in = (const float*)d_in[3]; const float* w_mem_kv = (const float*)d_in[4]; const float* w_pool = (const float*)d_in[5];
    const float* pool_scale = (const float*)d_in[6]; const float* sinks = (const float*)d_in[7]; const float* w_out = (const float*)d_in[8];
    const float* ln1_g = (const float*)d_in[9]; const float* ln1_b = (const float*)d_in[10]; const float* w_peer_q = (const float*)d_in[11];
    const float* sk1 = (const float*)d_in[12]; const float* sk2 = (const float*)d_in[13]; const float* eu = (const float*)d_in[14]; const float* ev = (const float*)d_in[15];
    const float* ln2_g = (const float*)d_in[16]; const float* ln2_b = (const float*)d_in[17];
    float* out = (float*)d_out;
    float* POOLV = (float*)(ws + WS_POOLV); bf16_t* Q = (bf16_t*)(ws + WS_Q); bf16_t* Kb = (bf16_t*)(ws + WS_K); bf16_t* Vb = (bf16_t*)(ws + WS_V); bf16_t* QM = (bf16_t*)(ws + WS_QM);
    bf16_t* KVM = (bf16_t*)(ws + WS_KVM); bf16_t* CONCAT = (bf16_t*)(ws + WS_CONCAT); float* Y1 = (float*)(ws + WS_Y1); float* X1 = (float*)(ws + WS_X1); bf16_t* X1B = (bf16_t*)(ws + WS_X1B);
    bf16_t* QP = (bf16_t*)(ws + WS_QP); int* EIDX = (int*)(ws + WS_EIDX); float* GATE = (float*)(ws + WS_GATE);
    float* NVH = (float*)(ws + WS_NV_H); float* NVPS = (float*)(ws + WS_NV_PS); float* NVKVM = (float*)(ws + WS_NV_KVM);
#endif
    int li = 0;
    for (int p = 0; p < N_PHASES;) {
#if NAIVE_MASK != 0
        if ((NAIVE_MASK >> p) & 1) {
            switch (p) {
            case 1:
                nv_gemm<float, NvEpiF32><<<dim3(IN_W / 64, MTOK / 64), 256, 0, stream>>>(x, w_in, MTOK, IN_W, D_MODEL, NvEpiF32{NVH, IN_W, 0});
                nv_gemm<float, NvEpiF32><<<dim3(2 * MEM_W / 64, MMEM / 64), 256, 0, stream>>>(mem, w_mem_kv, MMEM, 2 * MEM_W, D_MODEL, NvEpiF32{NVKVM, 2 * MEM_W, 0});
                nv_post1<<<(unsigned)(((size_t)MTOK * IN_W + 255) / 256), 256, 0, stream>>>(NVH, positions, POOLV, Q, Kb, Vb, QM);
                nv_cvt_bf16<<<(MMEM * 2 * MEM_W + 255) / 256, 256, 0, stream>>>(NVKVM, KVM, (size_t)MMEM * 2 * MEM_W);
                break;
            case 2:
                nv_pool1<<<MTOK * POOL_W / 256, 256, 0, stream>>>(POOLV, NVPS);
                nv_pool2<<<MTOK * POOL_W / 256, 256, 0, stream>>>(NVPS, w_pool, pool_scale, CONCAT);
                nv_swa<<<MTOK * NHEAD / 4, 256, 0, stream>>>(Q, Kb, Vb, sinks, CONCAT);
                nv_mem<<<MTOK * MHEADS / 4, 256, 0, stream>>>(QM, KVM, CONCAT);
                break;
            case 3: nv_gemm<bf16_t, NvEpiY1><<<dim3(D_MODEL / 64, MTOK / 64), 256, 0, stream>>>(CONCAT, w_out, MTOK, D_MODEL, D_MODEL, NvEpiY1{x, Y1}); break;
            case 4: nv_ln<<<MTOK / 4, 256, 0, stream>>>(Y1, ln1_g, ln1_b, X1, X1B); break;
            case 5: nv_gemm<float, NvEpiBf><<<dim3(D_MODEL / 64, MTOK / 64), 256, 0, stream>>>(X1, w_peer_q, MTOK, D_MODEL, D_MODEL, NvEpiBf{QP, D_MODEL, 0}); break;
            case 6: nv_topk<<<MTOK * PHEADS / 32, 32, 0, stream>>>(QP, sk1, sk2, EIDX, GATE); break;
            case 7: nv_gather<<<MTOK / 4, 256, 0, stream>>>(X1, EIDX, GATE, eu, ev, ln2_g, ln2_b, out); break;
            default: break;
            }
            ++p; continue;
        }
#endif
        int q = p;
        while (q < N_PHASES && !((NAIVE_MASK >> q) & 1)) ++q;
        a.ph_lo = p; a.ph_hi = q; a.li = li++;
        hipLaunchKernelGGL(mega_fwd, dim3(grid), dim3(NTHREADS), LDS_BYTES, stream, a);
        const hipError_t le = hipPeekAtLastError();
        if (le != hipSuccess) { fprintf(stderr, "kernel_launch: launch failed: %s\n", hipGetErrorName(le)); break; }
        p = q;
    }
#ifdef PROBE_EXTRA_LO
    a.ph_lo = PROBE_EXTRA_LO; a.ph_hi = PROBE_EXTRA_HI; a.li = li++;
    hipLaunchKernelGGL(mega_fwd, dim3(grid), dim3(NTHREADS), LDS_BYTES, stream, a);
#endif
}
```

```cpp
#include <hip/hip_runtime.h>
#include <cstdint>
#include <cstdio>
#ifndef NAIVE_MASK
#define NAIVE_MASK 0
#endif

constexpr int D_MODEL = 2048, BATCH = 2, SEQ = 4096, MTOK = BATCH * SEQ, MEM_LEN = 256, MMEM = BATCH * MEM_LEN;
constexpr int POOL_W = 512, SWA_W = 1024, KV_W = 256, MEM_W = 512, IN_W = 2560;
constexpr int NHEAD = 16, NKV = 4, HD = 64, WINDOW = 128, MHEADS = 4, MHD = 128;
constexpr int PHEADS = 8, NKEYS = 128, TOPK = 16, NEXP = NKEYS * NKEYS, EPT = PHEADS * TOPK;
constexpr float ALPHA = 1.18920711500272106672f;
constexpr float LN_EPS = 1e-5f;

typedef unsigned short bf16_t;
__device__ __forceinline__ float bf2f(bf16_t v) { return __uint_as_float((unsigned)v << 16); }
__device__ __forceinline__ bf16_t f2bf(float f) { unsigned u = __float_as_uint(f); return (bf16_t)((u + 0x7fffu + ((u >> 16) & 1u)) >> 16); }

constexpr size_t MiB = 1u << 20;
constexpr size_t WS_CTL = 0, WS_WINT = 1 * MiB, WS_WKVT = 11 * MiB, WS_WOT = 15 * MiB, WS_WQT = 23 * MiB, WS_SMALL = 31 * MiB;
constexpr size_t WS_XB = 32 * MiB, WS_X1B = 32 * MiB  , WS_MEMB = 64 * MiB, WS_KVM = 66 * MiB;
constexpr size_t WS_POOLV = 68 * MiB, WS_Q = 84 * MiB, WS_K = 100 * MiB, WS_V = 104 * MiB, WS_QM = 108 * MiB, WS_CONCAT = 116 * MiB;
constexpr size_t WS_Y1 = 148 * MiB, WS_X1 = 212 * MiB, WS_QP = 276 * MiB, WS_EIDX = 308 * MiB, WS_GATE = 312 * MiB, WS_UB = 316 * MiB, WS_VB = 380 * MiB, WS_END = 444 * MiB;
constexpr size_t WS_NV_H = 148 * MiB  , WS_NV_PS = 232 * MiB, WS_NV_KVM = 248 * MiB;

__device__ __forceinline__ void rope_cs(int pos, int j, float& c, float& s) {
    const double invf[8] = {1.0, 0.19392274474868576, 0.03760603093086393, 0.007292664737217109, 0.001414213562373095, 0.0002742481756762073, 5.318295896944988e-05, 1.031338537721246e-05};
    double f = j == 0 ? invf[0] : j == 1 ? invf[1] : j == 2 ? invf[2] : j == 3 ? invf[3] : j == 4 ? invf[4] : j == 5 ? invf[5] : j == 6 ? invf[6] : invf[7];
    double rev = (double)pos * f * 0.15915494309189533577;
    rev -= floor(rev);
    float fr = (float)rev;
    s = __builtin_amdgcn_sinf(fr); c = __builtin_amdgcn_cosf(fr);
}
__device__ __forceinline__ float gelu_erf(float h) { return 0.5f * h * (1.0f + erff(h * 0.70710678118654752440f)); }
__device__ __forceinline__ float wave_sum(float v) {
#pragma unroll
    for (int o = 1; o < 64; o <<= 1) v += __shfl_xor(v, o);
    return v;
}

namespace pg8 {
#define PG8_LAS __attribute__((address_space(3)))
typedef unsigned short bf16_t;
typedef short bf16x8 __attribute__((ext_vector_type(8)));
typedef float f32x4 __attribute__((ext_vector_type(4)));
typedef unsigned u32x4 __attribute__((ext_vector_type(4)));
constexpr int BM = 256, BK = 64, HALF = 128, HTB = HALF * BK * 2  , STAGE_BYTES = 8 * HTB, NXCD = 8, WGM = 8;

__host__ __device__ __forceinline__ int lds_byte(int r, int c) { const int st = (r >> 4) * 2 + (c >> 5), rr = r & 15, cc = c & 31, ob = rr * 64 + cc * 2; return st * 1024 + (ob ^ (((ob >> 9) & 1) << 5)); }
__host__ __device__ __forceinline__ void stage_rc(int b, int& R, int& C) { const int st = b / 1024, sb = b % 1024, swz = sb ^ (((sb >> 9) & 1) << 5); R = (st >> 1) * 16 + swz / 64; C = (st & 1) * 32 + (swz % 64) / 2; }
__host__ __device__ __forceinline__ int perm32(int rho) { const int n = rho >> 4, i = rho & 15; return 8 * (i >> 2) + 4 * n + (i & 3); }

struct Unit { int pm, pn; };
struct Gemm { const bf16_t* A; const bf16_t* Bt; int M, N, K; };

struct StaticOrder {
    int nM, nN, nwg, G, c;
    __host__ __device__ void init(int M, int N, int G_, int c_) { nM = M / BM; nN = N / BM; nwg = nM * nN; G = G_; c = c_; }
    __host__ __device__ bool next(int i, Unit& u) const {
        const long L = (long)i * G + c; if (L >= nwg) return false;
        int wgid = (int)L; { const int q = nwg / NXCD, r = nwg % NXCD, xcd = wgid % NXCD, off = wgid / NXCD; wgid = (xcd < r ? xcd * (q + 1) : r * (q + 1) + (xcd - r) * q) + off; }
        const int nig = WGM * nN, gid = wgid / nig, fm = gid * WGM, gsz = (nM - fm) < WGM ? (nM - fm) : WGM;
        u.pm = fm + ((wgid % nig) % gsz); u.pn = (wgid % nig) / gsz; return true;
    }
    __device__ __forceinline__ void a_ready(const Unit&) const {}
    __device__ __forceinline__ void done(const Unit&) const {}
};

__device__ __forceinline__ unsigned cvt_pk_bf16(float lo, float hi) { unsigned r; asm volatile("v_cvt_pk_bf16_f32 %0, %1, %2" : "=v"(r) : "v"(lo), "v"(hi)); return r; }
template <class Epi, class Sched, bool ALIGN_EPI = false, bool SP2 = false>
__device__ __forceinline__ void gemm_phase(PG8_LAS unsigned char* lds, const Gemm g, const Sched& S, const Epi& E) {
    const int tid = threadIdx.x, wid = __builtin_amdgcn_readfirstlane(tid >> 6), lane = tid & 63, wr = wid >> 2, wc = wid & 3, fr = lane & 15, fq = lane >> 4;
    const int K = g.K, nt = K / BK;
    unsigned voffA[2], voffB[2];
#pragma unroll
    for (int i = 0; i < 2; ++i) { int R, C; stage_rc(tid * 16 + i * 8192, R, C); const int Rb = Epi::PERM ? ((R & ~31) + perm32(R & 31)) : R;
        voffA[i] = (unsigned)(R * K + C) * 2u; voffB[i] = (unsigned)(Rb * K + C) * 2u; }
    const size_t kstep = (size_t)(BK * 2);
    const size_t hstep = (size_t)HALF * K * 2;
    const size_t tstep = 2 * hstep;
    const unsigned ldsw = (unsigned)wid * 1024u;
    const int aoff = lds_byte(wr * 64 + fr, fq * 8), boff = lds_byte(wc * 32 + fr, fq * 8);
#define PG8_SA(b, h) (((b) * 2 + (h)) * HTB)
#define PG8_SB(b, h) ((4 + (b) * 2 + (h)) * HTB)
#define PG8_STAGE(bufoff, gbase, voff) do { _Pragma("unroll") for (int _i = 0; _i < 2; ++_i) \
        __builtin_amdgcn_global_load_lds((const unsigned*)((const char*)(gbase) + (voff)[_i]), (PG8_LAS unsigned*)(lds + (bufoff) + ldsw + _i * 8192), 16, 0, 0); } while (0)
#define PG8_LDA(dst, b, h) do { _Pragma("unroll") for (int m = 0; m < 4; ++m) _Pragma("unroll") for (int k = 0; k < 2; ++k) dst[m][k] = *(const PG8_LAS bf16x8*)(lds + PG8_SA(b, h) + aoff + m * 2048 + k * 1024); } while (0)
#define PG8_LDB(dst, b, h) do { _Pragma("unroll") for (int n = 0; n < 2; ++n) _Pragma("unroll") for (int k = 0; k < 2; ++k) dst[n][k] = *(const PG8_LAS bf16x8*)(lds + PG8_SB(b, h) + boff + n * 2048 + k * 1024); } while (0)
#define PG8_MMA(ai, bj, At, Bt) do { __builtin_amdgcn_s_setprio(1); _Pragma("unroll") for (int m = 0; m < 4; ++m) _Pragma("unroll") for (int n = 0; n < 2; ++n) _Pragma("unroll") for (int k = 0; k < 2; ++k) \
        acc[ai][bj][m][n] = __builtin_amdgcn_mfma_f32_16x16x32_bf16(Bt[n][k], At[m][k], acc[ai][bj][m][n], 0, 0, 0); __builtin_amdgcn_s_setprio(0); } while (0)
#define PG8_WAIT_V(n) asm volatile("s_waitcnt vmcnt(" #n ")" ::: "memory")
#define PG8_WAIT_L(n) asm volatile("s_waitcnt lgkmcnt(" #n ")" ::: "memory")
#define PG8_BAR __builtin_amdgcn_s_barrier()
#define PG8_SCHED __builtin_amdgcn_sched_barrier(0)
    Unit cur, nxt; int ui = 0;
    if (!S.next(0, cur)) return;
    f32x4 acc[2][2][4][2];
#pragma unroll
    for (int a = 0; a < 2; ++a)
#pragma unroll
        for (int b = 0; b < 2; ++b)
#pragma unroll
            for (int m = 0; m < 4; ++m)
#pragma unroll
                for (int n = 0; n < 2; ++n) acc[a][b][m][n] = (f32x4){0.f, 0.f, 0.f, 0.f};
    bf16x8 At[4][2], B0[2][2], B1[2][2];
    const char* cA = (const char*)g.A + (size_t)cur.pm * tstep; const char* cB = (const char*)g.Bt + (size_t)cur.pn * tstep;
    S.a_ready(cur);
    if constexpr (SP2) {
        PG8_STAGE(PG8_SB(0, 0), cB, voffB); PG8_STAGE(PG8_SB(0, 1), cB + hstep, voffB); PG8_STAGE(PG8_SA(0, 0), cA, voffA); PG8_STAGE(PG8_SA(0, 1), cA + hstep, voffA);
        if (wr == 1) PG8_BAR;
        PG8_WAIT_V(2); PG8_BAR;
        PG8_STAGE(PG8_SB(1, 0), cB + kstep, voffB); PG8_STAGE(PG8_SA(1, 0), cA + kstep, voffA); PG8_STAGE(PG8_SB(1, 1), cB + hstep + kstep, voffB);
        PG8_WAIT_V(6); PG8_BAR;
    } else {
        PG8_STAGE(PG8_SB(0, 0), cB, voffB); PG8_STAGE(PG8_SA(0, 0), cA, voffA); PG8_STAGE(PG8_SB(0, 1), cB + hstep, voffB); PG8_STAGE(PG8_SA(0, 1), cA + hstep, voffA);
        if (wr == 1) PG8_BAR;
        PG8_WAIT_V(4); PG8_BAR;
        PG8_STAGE(PG8_SB(1, 0), cB + kstep, voffB); PG8_STAGE(PG8_SA(1, 0), cA + kstep, voffA); PG8_STAGE(PG8_SB(1, 1), cB + hstep + kstep, voffB);
        PG8_WAIT_V(6); PG8_BAR;
    }
    for (;;) {
        const bool has_next = S.next(ui + 1, nxt);
        const char* nA = has_next ? (const char*)g.A + (size_t)nxt.pm * tstep : cA; const char* nB = has_next ? (const char*)g.Bt + (size_t)nxt.pn * tstep : cB;
        for (int t = 0; t < nt; t += 2) {
            const bool last = (t == nt - 2);
            const char* a1 = cA + (size_t)(t + 1) * kstep;
            const char* a2 = last ? nA : cA + (size_t)(t + 2) * kstep; const char* b2 = last ? nB : cB + (size_t)(t + 2) * kstep;
            const char* a3 = a2 + kstep; const char* b3 = b2 + kstep;
            if (last && has_next) S.a_ready(nxt);
            if constexpr (SP2) {
            PG8_LDB(B0, 0, 0); PG8_LDB(B1, 0, 1); PG8_SCHED; PG8_LDA(At, 0, 0); PG8_STAGE(PG8_SA(1, 1), a1 + hstep, voffA);
            PG8_WAIT_V(8); PG8_WAIT_L(0); PG8_BAR; PG8_MMA(0, 0, At, B0); PG8_MMA(0, 1, At, B1); PG8_BAR; PG8_SCHED;
            PG8_LDA(At, 0, 1); PG8_STAGE(PG8_SB(0, 0), b2, voffB); PG8_STAGE(PG8_SB(0, 1), b2 + hstep, voffB); PG8_STAGE(PG8_SA(0, 0), a2, voffA);
            PG8_WAIT_V(8); PG8_WAIT_L(0); PG8_BAR; PG8_MMA(1, 0, At, B0); PG8_MMA(1, 1, At, B1); PG8_BAR; PG8_SCHED;
            PG8_LDB(B0, 1, 0); PG8_LDB(B1, 1, 1); PG8_SCHED; PG8_LDA(At, 1, 0); PG8_STAGE(PG8_SA(0, 1), a2 + hstep, voffA);
            PG8_WAIT_V(8); PG8_WAIT_L(0); PG8_BAR; PG8_MMA(0, 0, At, B0); PG8_MMA(0, 1, At, B1); PG8_BAR; PG8_SCHED;
            PG8_LDA(At, 1, 1); PG8_STAGE(PG8_SB(1, 0), b3, voffB); PG8_STAGE(PG8_SB(1, 1), b3 + hstep, voffB); PG8_STAGE(PG8_SA(1, 0), a3, voffA);
            PG8_WAIT_V(8); PG8_WAIT_L(0); PG8_BAR; PG8_MMA(1, 0, At, B0); PG8_MMA(1, 1, At, B1); PG8_BAR; PG8_SCHED;
            } else {
            PG8_LDB(B0, 0, 0); PG8_SCHED; PG8_LDA(At, 0, 0); PG8_STAGE(PG8_SA(1, 1), a1 + hstep, voffA);
            PG8_WAIT_L(8); PG8_BAR; PG8_WAIT_L(0); PG8_MMA(0, 0, At, B0); PG8_BAR; PG8_SCHED;
            PG8_LDB(B1, 0, 1); PG8_STAGE(PG8_SB(0, 0), b2, voffB);
            PG8_BAR; PG8_WAIT_L(0); PG8_MMA(0, 1, At, B1); PG8_BAR;
            PG8_LDA(At, 0, 1); PG8_STAGE(PG8_SA(0, 0), a2, voffA);
            PG8_BAR; PG8_WAIT_L(0); PG8_MMA(1, 0, At, B0); PG8_BAR; PG8_SCHED;
            PG8_STAGE(PG8_SB(0, 1), b2 + hstep, voffB);
            PG8_WAIT_V(6); PG8_BAR; PG8_MMA(1, 1, At, B1); PG8_BAR;
            PG8_LDB(B0, 1, 0); PG8_SCHED; PG8_LDA(At, 1, 0); PG8_STAGE(PG8_SA(0, 1), a2 + hstep, voffA);
            PG8_WAIT_L(8); PG8_BAR; PG8_WAIT_L(0); PG8_MMA(0, 0, At, B0); PG8_BAR; PG8_SCHED;
            PG8_LDB(B1, 1, 1); PG8_STAGE(PG8_SB(1, 0), b3, voffB);
            PG8_BAR; PG8_WAIT_L(0); PG8_MMA(0, 1, At, B1); PG8_BAR;
            PG8_LDA(At, 1, 1); PG8_STAGE(PG8_SA(1, 0), a3, voffA);
            PG8_BAR; PG8_WAIT_L(0); PG8_MMA(1, 0, At, B0); PG8_BAR; PG8_SCHED;
            PG8_STAGE(PG8_SB(1, 1), b3 + hstep, voffB);
            PG8_WAIT_V(6); PG8_BAR; PG8_MMA(1, 1, At, B1); PG8_BAR;
            }
        }
        if constexpr (ALIGN_EPI) { if (wr == 0) PG8_BAR; }
        if constexpr (!Epi::AFTER_DRAIN) { E(acc, cur, wr, wc, fr, fq); S.done(cur); }
        if (!has_next) break;
#pragma unroll
        for (int a = 0; a < 2; ++a)
#pragma unroll
            for (int b = 0; b < 2; ++b)
#pragma unroll
                for (int m = 0; m < 4; ++m)
#pragma unroll
                    for (int n = 0; n < 2; ++n) acc[a][b][m][n] = (f32x4){0.f, 0.f, 0.f, 0.f};
        cur = nxt; cA = nA; cB = nB; ++ui;
        if constexpr (ALIGN_EPI) { if (wr == 1) PG8_BAR; }
    }
    PG8_WAIT_V(0);
    if constexpr (!ALIGN_EPI) { if (wr == 0) PG8_BAR; }
    PG8_BAR;
    if constexpr (Epi::AFTER_DRAIN) { E.fused(acc, cur, wr, wc, fr, fq, lds, wid, lane); S.done(cur); }
#undef PG8_SA
#undef PG8_SB
#undef PG8_STAGE
#undef PG8_LDA
#undef PG8_LDB
#undef PG8_MMA
#undef PG8_WAIT_V
#undef PG8_WAIT_L
#undef PG8_BAR
#undef PG8_SCHED
}
}
#define GAS __attribute__((address_space(1)))
#define LAS __attribute__((address_space(3)))
typedef unsigned v4u __attribute__((ext_vector_type(4)));
typedef unsigned v2u __attribute__((ext_vector_type(2)));
typedef float f32x4 __attribute__((ext_vector_type(4)));
typedef float f32x2 __attribute__((ext_vector_type(2)));
typedef short bf16x8 __attribute__((ext_vector_type(8)));
typedef __bf16 bf16x2 __attribute__((ext_vector_type(2)));
constexpr int NWAVES = 8, NTHREADS = NWAVES * 64;
constexpr int LDS_BYTES = 147456, MISC_OFF = LDS_BYTES - 512;
constexpr int CW_BAR = 4096;
constexpr float LOG2E = 1.44269504088896340736f;

__device__ __forceinline__ unsigned cvtpk(float lo, float hi) { f32x2 v = {lo, hi}; bf16x2 b = __builtin_convertvector(v, bf16x2); return __builtin_bit_cast(unsigned, b); }
__device__ __forceinline__ f32x4 mfma16(bf16x8 a, bf16x8 b, f32x4 c) { return __builtin_amdgcn_mfma_f32_16x16x32_bf16(a, b, c, 0, 0, 0); }
__device__ __forceinline__ float dot2bf(unsigned w, unsigned x, float acc) { return __builtin_amdgcn_fdot2_f32_bf16(__builtin_bit_cast(bf16x2, w), __builtin_bit_cast(bf16x2, x), acc, false); }
__device__ __forceinline__ float fexp2(float x) { return __builtin_amdgcn_exp2f(x); }
#define LDS_WAIT() asm volatile("s_waitcnt lgkmcnt(0)" ::: "memory")
__device__ __forceinline__ unsigned umax(unsigned a, unsigned b) { return a > b ? a : b; }
__device__ __forceinline__ unsigned xmax4(unsigned m) { auto r = __builtin_amdgcn_permlane16_swap(m, m, false, false); m = umax(r[0], r[1]); auto q = __builtin_amdgcn_permlane32_swap(m, m, false, false); return umax(q[0], q[1]); }
__device__ __forceinline__ float xfmax4(float v) { unsigned m = __float_as_uint(v); auto r = __builtin_amdgcn_permlane16_swap(m, m, false, false); v = fmaxf(__uint_as_float(r[0]), __uint_as_float(r[1])); m = __float_as_uint(v);
    auto q = __builtin_amdgcn_permlane32_swap(m, m, false, false); return fmaxf(__uint_as_float(q[0]), __uint_as_float(q[1])); }
__device__ __forceinline__ float xfsum4(float v) { unsigned m = __float_as_uint(v); auto r = __builtin_amdgcn_permlane16_swap(m, m, false, false); v = __uint_as_float(r[0]) + __uint_as_float(r[1]); m = __float_as_uint(v);
    auto q = __builtin_amdgcn_permlane32_swap(m, m, false, false); return __uint_as_float(q[0]) + __uint_as_float(q[1]); }

#define XB_TMO      128
#define XB_XCNT(j)  (256  + 64 * (j))
#define XB_XSUB(j)  (1280 + 64 * (j))
#define XB_XGEN(j)  (2304 + 64 * (j))
#define XB_TOP      3328
#define XB_TOPGEN   3392
#define XCD_BAR_WORDS 3456
#define XB_SPIN_CAP (1u << 18)
__device__ __forceinline__ unsigned xb_ld(unsigned* p)              { return __hip_atomic_load(p, __ATOMIC_RELAXED, __HIP_MEMORY_SCOPE_AGENT); }
__device__ __forceinline__ unsigned xb_add(unsigned* p, unsigned v) { return __hip_atomic_fetch_add(p, v, __ATOMIC_RELAXED, __HIP_MEMORY_SCOPE_AGENT); }
__device__ __forceinline__ unsigned xb_xcc_id() { return (unsigned)__builtin_amdgcn_s_getreg((3 << 11) | 20) & 0xFu; }
#define XB_SPIN(cond, bar) do { unsigned _sp = 0; while (cond) { __builtin_amdgcn_s_sleep(1); \
    if ((++_sp & 255u) == 0u) { if (xb_ld(&(bar)[XB_TMO])) break; if (_sp > XB_SPIN_CAP) { atomicAdd(&(bar)[XB_TMO], 1u); break; } } } } while (0)
struct XcdBarrier { unsigned* bar; unsigned x; volatile LAS unsigned* st; };
__device__ __forceinline__ XcdBarrier xcd_barrier_post(unsigned* bar, volatile LAS unsigned* st) {
    XcdBarrier b; b.bar = bar; b.x = xb_xcc_id(); b.st = st;
    if (threadIdx.x == 0) (void)xb_add(&bar[XB_XCNT(b.x)], 1u);
    return b;
}
__device__ __forceinline__ void xcd_barrier_complete(unsigned* bar, unsigned x, unsigned& nloc, unsigned& nx) {
    const unsigned G = gridDim.x * gridDim.y * gridDim.z;
    unsigned sum, cnt, mine, sp = 0u;
    for (;;) {
        sum = 0u; cnt = 0u; mine = 0u;
#pragma unroll
        for (unsigned j = 0; j < 16; ++j) { const unsigned c = xb_ld(&bar[XB_XCNT(j)]); sum += c; cnt += (c > 0u) ? 1u : 0u; mine = (j == x) ? c : mine; }
        if (sum == G) break;
        __builtin_amdgcn_s_sleep(1);
        if ((++sp & 255u) == 0u) { if (xb_ld(&bar[XB_TMO])) break; if (sp > XB_SPIN_CAP) { atomicAdd(&bar[XB_TMO], 1u); break; } }
    }
    nloc = mine > 0u ? mine : 1u; nx = cnt > 0u ? cnt : 1u;
}
__device__ __forceinline__ void xcd_barrier(const XcdBarrier& b) {
    asm volatile("s_waitcnt vmcnt(0)" ::: "memory");
    __syncthreads();
    if (threadIdx.x == 0) {
        unsigned* bar = b.bar;
        __builtin_amdgcn_s_waitcnt(0);
        unsigned nloc = b.st[0], nx = b.st[1];
        if (nloc == 0u) { xcd_barrier_complete(bar, b.x, nloc, nx); b.st[0] = nloc; b.st[1] = nx; }
        const unsigned old = xb_add(&bar[XB_XSUB(b.x)], 1u);
        const unsigned gen = old / nloc;
        if (old + 1u == (gen + 1u) * nloc) {
            __builtin_amdgcn_fence(__ATOMIC_RELEASE, "agent");
            asm volatile("s_waitcnt vmcnt(0)" ::: "memory");
            const unsigned og = xb_add(&bar[XB_TOP], 1u);
            const unsigned tg = og / nx;
            if (og + 1u == (tg + 1u) * nx) xb_add(&bar[XB_TOPGEN], 1u);
            else XB_SPIN(xb_ld(&bar[XB_TOPGEN]) == tg, bar);
            __builtin_amdgcn_fence(__ATOMIC_ACQUIRE, "agent");
            xb_add(&bar[XB_XGEN(b.x)], 1u);
            asm volatile("s_waitcnt vmcnt(0)" ::: "memory");
        } else {
            XB_SPIN(xb_ld(&bar[XB_XGEN(b.x)]) == gen, bar);
            __builtin_amdgcn_fence(__ATOMIC_ACQUIRE, "agent");
            asm volatile("s_waitcnt vmcnt(0)" ::: "memory");
        }
    }
    __syncthreads();
}

struct EpiStoreBf {
    static constexpr bool PERM = true, AFTER_DRAIN = false;
    bf16_t* O; int ldc;
    __device__ __forceinline__ void operator()(const pg8::f32x4 (&acc)[2][2][4][2], const pg8::Unit& u, int wr, int wc, int fr, int fq) const {
        const int row0 = u.pm * 256 + wr * 64 + fr, col0 = u.pn * 256 + wc * 32 + 8 * fq;
#pragma unroll
        for (int ai = 0; ai < 2; ++ai)
#pragma unroll
            for (int m = 0; m < 4; ++m) { bf16_t* rowp = O + (size_t)(row0 + ai * 128 + m * 16) * ldc + col0;
#pragma unroll
                for (int bj = 0; bj < 2; ++bj) { const pg8::f32x4 v0 = acc[ai][bj][m][0], v1 = acc[ai][bj][m][1];
                    v4u w; w.x = cvtpk(v0[0], v0[1]); w.y = cvtpk(v0[2], v0[3]); w.z = cvtpk(v1[0], v1[1]); w.w = cvtpk(v1[2], v1[3]);
                    *(v4u*)(rowp + bj * 128) = w; } }
    }
};
struct EpiY1 {
    static constexpr bool PERM = true, AFTER_DRAIN = false;
    const float* x; float* y;
    __device__ __forceinline__ void operator()(const pg8::f32x4 (&acc)[2][2][4][2], const pg8::Unit& u, int wr, int wc, int fr, int fq) const {
        const int row0 = u.pm * 256 + wr * 64 + fr, col0 = u.pn * 256 + wc * 32 + 8 * fq;
#pragma unroll
        for (int ai = 0; ai < 2; ++ai)
#pragma unroll
            for (int m = 0; m < 4; ++m) { const size_t off = (size_t)(row0 + ai * 128 + m * 16) * D_MODEL + col0;
#pragma unroll
                for (int bj = 0; bj < 2; ++bj) {
                    const f32x4 x0 = *(const f32x4*)(x + off + bj * 128), x1 = *(const f32x4*)(x + off + bj * 128 + 4);
                    *(f32x4*)(y + off + bj * 128) = x0 * ALPHA + acc[ai][bj][m][0]; *(f32x4*)(y + off + bj * 128 + 4) = x1 * ALPHA + acc[ai][bj][m][1]; } }
    }
};
struct EpiIn {
    static constexpr bool PERM = true, AFTER_DRAIN = false;
    float* POOLV; bf16_t *Q, *K, *V, *QM; const float* rope;
    __device__ __forceinline__ void operator()(const pg8::f32x4 (&acc)[2][2][4][2], const pg8::Unit& u, int wr, int wc, int fr, int fq) const {
        const int row0 = u.pm * 256 + wr * 64 + fr, cl = wc * 32 + 8 * fq, pn = u.pn;
        if (pn < 2) {
#pragma unroll
            for (int ai = 0; ai < 2; ++ai)
#pragma unroll
                for (int m = 0; m < 4; ++m) { float* rp = POOLV + (size_t)(row0 + ai * 128 + m * 16) * POOL_W + pn * 256 + cl;
#pragma unroll
                    for (int bj = 0; bj < 2; ++bj) { *(f32x4*)(rp + bj * 128) = acc[ai][bj][m][0]; *(f32x4*)(rp + bj * 128 + 4) = acc[ai][bj][m][1]; } }
            return;
        }
        bf16_t* base; int ld, c0; bool rot = false;
        if (pn < 6) { base = Q; ld = SWA_W; c0 = (pn - 2) * 256; rot = true; }
        else if (pn == 6) { base = K; ld = KV_W; c0 = 0; rot = true; }
        else if (pn == 7) { base = V; ld = KV_W; c0 = 0; }
        else { base = QM; ld = MEM_W; c0 = (pn - 8) * 256; }
        rot = rot && ((wc & 1) == 0);
#pragma unroll
        for (int ai = 0; ai < 2; ++ai)
#pragma unroll
            for (int m = 0; m < 4; ++m) {
                const int row = row0 + ai * 128 + m * 16;
                f32x4 v[2][2];
#pragma unroll
                for (int bj = 0; bj < 2; ++bj) { v[bj][0] = acc[ai][bj][m][0]; v[bj][1] = acc[ai][bj][m][1]; }
                if (rot) {
                    const f32x4* tp = (const f32x4*)(rope + (size_t)row * 16);
                    f32x4 cs[2][2]; cs[0][0] = tp[0]; cs[0][1] = tp[1]; cs[1][0] = tp[2]; cs[1][1] = tp[3];
#pragma unroll
                    for (int bj = 0; bj < 2; ++bj)
#pragma unroll
                        for (int n = 0; n < 2; ++n)
#pragma unroll
                            for (int i = 0; i < 4; ++i) {
                                const float xv = v[bj][n][i], pv = __shfl_xor(xv, 16);
                                const float c = cs[n][i >> 1][2 * (i & 1)], s = cs[n][i >> 1][2 * (i & 1) + 1];
                                const float o = fq == 0 ? xv * c - pv * s : (fq == 1 ? xv * c + pv * s : xv);
                                v[bj][n][i] = o; }
                }
                bf16_t* rowp = base + (size_t)row * ld + c0 + cl;
#pragma unroll
                for (int bj = 0; bj < 2; ++bj) { v4u w; w.x = cvtpk(v[bj][0][0], v[bj][0][1]); w.y = cvtpk(v[bj][0][2], v[bj][0][3]); w.z = cvtpk(v[bj][1][0], v[bj][1][1]); w.w = cvtpk(v[bj][1][2], v[bj][1][3]);
                    *(v4u*)(rowp + bj * 128) = w; }
            }
    }
};

__device__ __forceinline__ void p0_transpose_item(const float* W, int K, int N, bf16_t* WT, LAS float* scr, int item, int lane) {
    const int nblk = N / 32, kb = item / nblk, nb = item % nblk, k0 = 64 * kb, n0 = 32 * nb;
#pragma unroll 8
    for (int i = 0; i < 32; ++i) { const int kk = 2 * i + (lane >> 5); scr[kk * 33 + (lane & 31)] = W[(size_t)(k0 + kk) * N + n0 + (lane & 31)]; }
    LDS_WAIT(); asm volatile("" ::: "memory");
    const int c = lane & 7;
#pragma unroll
    for (int j = 0; j < 4; ++j) { const int n = (lane >> 3) + 8 * j; const LAS float* s = scr + (8 * c) * 33 + n;
        v4u o; o.x = cvtpk(s[0 * 33], s[1 * 33]); o.y = cvtpk(s[2 * 33], s[3 * 33]); o.z = cvtpk(s[4 * 33], s[5 * 33]); o.w = cvtpk(s[6 * 33], s[7 * 33]);
        *(v4u*)(WT + (size_t)(n0 + n) * K + k0 + 8 * c) = o; }
    LDS_WAIT(); asm volatile("" ::: "memory");
}
template <bool NT>
__device__ __forceinline__ void cvt_stream(const float* in, bf16_t* out, size_t n, int gw, int NGW, int lane) {
#pragma unroll 4
    for (size_t i = (size_t)gw * 512 + lane * 4; i < n; i += (size_t)NGW * 512) {
        f32x4 a, b;
        if (NT) { a = __builtin_nontemporal_load((const f32x4*)(in + i)); b = __builtin_nontemporal_load((const f32x4*)(in + i + 256)); }
        else { a = *(const f32x4*)(in + i); b = *(const f32x4*)(in + i + 256); }
        v2u o0, o1; o0.x = cvtpk(a.x, a.y); o0.y = cvtpk(a.z, a.w); o1.x = cvtpk(b.x, b.y); o1.y = cvtpk(b.z, b.w);
        *(v2u*)(out + i) = o0; *(v2u*)(out + i + 256) = o1;
    }
}

constexpr int SWA_KROW = 144, SWA_VROW = 528, SWA_VT_OFF = 256 * SWA_KROW;
__device__ __forceinline__ void swa_item(LAS unsigned char* lds, int item, const bf16_t* __restrict__ Q, const bf16_t* __restrict__ Kb, const bf16_t* __restrict__ Vb, const float* __restrict__ sinks,
                                         bf16_t* CONCAT, int tid, int wave, int lane) {
    const int qb = item & 31, kvh = (item >> 5) & 3, b = item >> 7;
    const int tok0 = b * SEQ + qb * 128;
    LAS unsigned char* Kl = lds; LAS unsigned char* Vt = lds + SWA_VT_OFF;
#pragma unroll
    for (int j = 0; j < 4; ++j) {
        const int c = tid + NTHREADS * j, row = c >> 3, part = c & 7;
        v4u kv = {0u, 0u, 0u, 0u}, vv = {0u, 0u, 0u, 0u};
        if (qb > 0 || row >= 128) { const size_t tk = (size_t)(tok0 - 128 + row); kv = *(const v4u*)(Kb + tk * KV_W + kvh * HD + part * 8); vv = *(const v4u*)(Vb + tk * KV_W + kvh * HD + part * 8); }
        *(LAS v4u*)(Kl + row * SWA_KROW + part * 16) = kv;
        LAS unsigned short* vp = (LAS unsigned short*)(Vt + (part * 8) * SWA_VROW + row * 2);
        vp[0 * (SWA_VROW / 2)] = (unsigned short)(vv.x & 0xffffu); vp[1 * (SWA_VROW / 2)] = (unsigned short)(vv.x >> 16);
        vp[2 * (SWA_VROW / 2)] = (unsigned short)(vv.y & 0xffffu); vp[3 * (SWA_VROW / 2)] = (unsigned short)(vv.y >> 16);
        vp[4 * (SWA_VROW / 2)] = (unsigned short)(vv.z & 0xffffu); vp[5 * (SWA_VROW / 2)] = (unsigned short)(vv.z >> 16);
        vp[6 * (SWA_VROW / 2)] = (unsigned short)(vv.w & 0xffffu); vp[7 * (SWA_VROW / 2)] = (unsigned short)(vv.w >> 16);
    }
    __syncthreads();
    const int g = wave & 3, h = kvh * 4 + g, q15 = lane & 15, qq = lane >> 4;
    const float sink2 = sinks[h] * LOG2E;
    const float SC = 0.125f * LOG2E;
#pragma unroll 1
    for (int cc = 0; cc < 2; ++cc) {
        const int c = 2 * (wave >> 2) + cc, kl0 = 32 * c;
        bf16x8 qf[2][2];
#pragma unroll
        for (int ni = 0; ni < 2; ++ni)
#pragma unroll
            for (int ks = 0; ks < 2; ++ks) qf[ni][ks] = *(const bf16x8*)(Q + (size_t)(tok0 + 32 * c + 16 * ni + q15) * SWA_W + h * HD + 32 * ks + 8 * qq);
        f32x4 s[10][2];
#pragma unroll
        for (int mi = 0; mi < 10; ++mi) { s[mi][0] = (f32x4){0.f, 0.f, 0.f, 0.f}; s[mi][1] = (f32x4){0.f, 0.f, 0.f, 0.f}; }
#pragma unroll
        for (int mi = 0; mi < 10; ++mi)
#pragma unroll
            for (int ks = 0; ks < 2; ++ks) {
                const bf16x8 kf = *(const LAS bf16x8*)(Kl + (kl0 + 16 * mi + q15) * SWA_KROW + (32 * ks + 8 * qq) * 2);
                s[mi][0] = mfma16(kf, qf[0][ks], s[mi][0]); s[mi][1] = mfma16(kf, qf[1][ks], s[mi][1]);
            }
        float rl[2];
#pragma unroll
        for (int ni = 0; ni < 2; ++ni) {
            const int ql = 32 * c + 16 * ni + q15;
            float mx = -INFINITY;
#pragma unroll
            for (int mi = 0; mi < 10; ++mi)
#pragma unroll
                for (int r = 0; r < 4; ++r) {
                    const int kl = kl0 + 16 * mi + 4 * qq + r;
                    const bool valid = (kl > ql) && (kl <= ql + 128) && (qb > 0 || kl >= 128);
                    const float t = valid ? s[mi][ni][r] * SC : -INFINITY;
                    s[mi][ni][r] = t; mx = fmaxf(mx, t);
                }
            mx = fmaxf(xfmax4(mx), sink2);
            float l = 0.f;
#pragma unroll
            for (int mi = 0; mi < 10; ++mi)
#pragma unroll
                for (int r = 0; r < 4; ++r) { const float p = fexp2(s[mi][ni][r] - mx); s[mi][ni][r] = p; l += p; }
            l = xfsum4(l) + fexp2(sink2 - mx);
            rl[ni] = 1.0f / l;
        }
        f32x4 o[4][2];
#pragma unroll
        for (int dt = 0; dt < 4; ++dt) { o[dt][0] = (f32x4){0.f, 0.f, 0.f, 0.f}; o[dt][1] = (f32x4){0.f, 0.f, 0.f, 0.f}; }
#pragma unroll
        for (int kk = 0; kk < 5; ++kk) {
            bf16x8 pf[2];
#pragma unroll
            for (int ni = 0; ni < 2; ++ni) {
                v4u w; w.x = cvtpk(s[2 * kk][ni][0], s[2 * kk][ni][1]); w.y = cvtpk(s[2 * kk][ni][2], s[2 * kk][ni][3]);
                w.z = cvtpk(s[2 * kk + 1][ni][0], s[2 * kk + 1][ni][1]); w.w = cvtpk(s[2 * kk + 1][ni][2], s[2 * kk + 1][ni][3]);
                pf[ni] = __builtin_bit_cast(bf16x8, w);
            }
#pragma unroll
            for (int dt = 0; dt < 4; ++dt) {
                const LAS unsigned char* vb = Vt + (16 * dt + q15) * SWA_VROW + (kl0 + 32 * kk + 4 * qq) * 2;
                const v2u lo = *(const LAS v2u*)vb, hi = *(const LAS v2u*)(vb + 32);
                v4u w; w.x = lo.x; w.y = lo.y; w.z = hi.x; w.w = hi.y;
                const bf16x8 vf = __builtin_bit_cast(bf16x8, w);
                o[dt][0] = mfma16(vf, pf[0], o[dt][0]); o[dt][1] = mfma16(vf, pf[1], o[dt][1]);
            }
        }
#pragma unroll
        for (int ni = 0; ni < 2; ++ni) {
            bf16_t* orow = CONCAT + (size_t)(tok0 + 32 * c + 16 * ni + q15) * D_MODEL + POOL_W + h * HD + 4 * qq;
#pragma unroll
            for (int dt = 0; dt < 4; ++dt) { v2u w; w.x = cvtpk(o[dt][ni][0] * rl[ni], o[dt][ni][1] * rl[ni]); w.y = cvtpk(o[dt][ni][2] * rl[ni], o[dt][ni][3] * rl[ni]); *(v2u*)(orow + 16 * dt) = w; }
        }
    }
    __syncthreads();
}
constexpr int MEM_KROW = 272, MEM_VROW = 528, MEM_VT_OFF = 256 * MEM_KROW;
__device__ __forceinline__ void mem_item(LAS unsigned char* lds, int item, const bf16_t* __restrict__ QM, const bf16_t* __restrict__ KVM, bf16_t* CONCAT, int tid, int wave, int lane) {
    const int qt = item & 31, hm = (item >> 5) & 3, b = item >> 7;
    LAS unsigned char* Kl = lds; LAS unsigned char* Vt = lds + MEM_VT_OFF;
#pragma unroll
    for (int j = 0; j < 8; ++j) {
        const int c = tid + NTHREADS * j, row = c >> 4, part = c & 15;
        const bf16_t* src = KVM + (size_t)(b * MEM_LEN + row) * (2 * MEM_W) + hm * MHD + part * 8;
        const v4u kv = *(const v4u*)src, vv = *(const v4u*)(src + MEM_W);
        *(LAS v4u*)(Kl + row * MEM_KROW + part * 16) = kv;
        LAS unsigned short* vp = (LAS unsigned short*)(Vt + (part * 8) * MEM_VROW + row * 2);
        vp[0 * (MEM_VROW / 2)] = (unsigned short)(vv.x & 0xffffu); vp[1 * (MEM_VROW / 2)] = (unsigned short)(vv.x >> 16);
        vp[2 * (MEM_VROW / 2)] = (unsigned short)(vv.y & 0xffffu); vp[3 * (MEM_VROW / 2)] = (unsigned short)(vv.y >> 16);
        vp[4 * (MEM_VROW / 2)] = (unsigned short)(vv.z & 0xffffu); vp[5 * (MEM_VROW / 2)] = (unsigned short)(vv.z >> 16);
        vp[6 * (MEM_VROW / 2)] = (unsigned short)(vv.w & 0xffffu); vp[7 * (MEM_VROW / 2)] = (unsigned short)(vv.w >> 16);
    }
    __syncthreads();
    const int q15 = lane & 15, qq = lane >> 4;
    const int tok = b * SEQ + qt * 128 + wave * 16 + q15;
    const float SC = 0.08838834764831845f * LOG2E;
    bf16x8 qf[4];
#pragma unroll
    for (int ks = 0; ks < 4; ++ks) qf[ks] = *(const bf16x8*)(QM + (size_t)tok * MEM_W + hm * MHD + 32 * ks + 8 * qq);
    f32x4 s[16];
#pragma unroll
    for (int mi = 0; mi < 16; ++mi) s[mi] = (f32x4){0.f, 0.f, 0.f, 0.f};
#pragma unroll
    for (int mi = 0; mi < 16; ++mi)
#pragma unroll
        for (int ks = 0; ks < 4; ++ks) {
            const bf16x8 kf = *(const LAS bf16x8*)(Kl + (16 * mi + q15) * MEM_KROW + (32 * ks + 8 * qq) * 2);
            s[mi] = mfma16(kf, qf[ks], s[mi]);
        }
    float mx = -INFINITY;
#pragma unroll
    for (int mi = 0; mi < 16; ++mi)
#pragma unroll
        for (int r = 0; r < 4; ++r) { const float t = s[mi][r] * SC; s[mi][r] = t; mx = fmaxf(mx, t); }
    mx = xfmax4(mx);
    float l = 0.f;
#pragma unroll
    for (int mi = 0; mi < 16; ++mi)
#pragma unroll
        for (int r = 0; r < 4; ++r) { const float p = fexp2(s[mi][r] - mx); s[mi][r] = p; l += p; }
    l = xfsum4(l);
    const float rl = 1.0f / l;
    f32x4 o[8];
#pragma unroll
    for (int dt = 0; dt < 8; ++dt) o[dt] = (f32x4){0.f, 0.f, 0.f, 0.f};
#pragma unroll
    for (int kk = 0; kk < 8; ++kk) {
        v4u pw; pw.x = cvtpk(s[2 * kk][0], s[2 * kk][1]); pw.y = cvtpk(s[2 * kk][2], s[2 * kk][3]); pw.z = cvtpk(s[2 * kk + 1][0], s[2 * kk + 1][1]); pw.w = cvtpk(s[2 * kk + 1][2], s[2 * kk + 1][3]);
        const bf16x8 pf = __builtin_bit_cast(bf16x8, pw);
#pragma unroll
        for (int dt = 0; dt < 8; ++dt) {
            const LAS unsigned char* vb = Vt + (16 * dt + q15) * MEM_VROW + (32 * kk + 4 * qq) * 2;
            const v2u lo = *(const LAS v2u*)vb, hi = *(const LAS v2u*)(vb + 32);
            v4u w; w.x = lo.x; w.y = lo.y; w.z = hi.x; w.w = hi.y;
            o[dt] = mfma16(__builtin_bit_cast(bf16x8, w), pf, o[dt]);
        }
    }
    bf16_t* orow = CONCAT + (size_t)tok * D_MODEL + POOL_W + SWA_W + hm * MHD + 4 * qq;
#pragma unroll
    for (int dt = 0; dt < 8; ++dt) { v2u w; w.x = cvtpk(o[dt][0] * rl, o[dt][1] * rl); w.y = cvtpk(o[dt][2] * rl, o[dt][3] * rl); *(v2u*)(orow + 16 * dt) = w; }
    __syncthreads();
}
template <int W>
__device__ __forceinline__ void pool_frags(bf16x8 (&pf)[4], const float* __restrict__ POOLV, int t, int g, int qq) {
    const int sp = t & (SEQ - 1);
    const int cnt = (sp + 1) < W ? (sp + 1) : W;
    const float inv = 1.0f / (float)cnt;
    f32x4 c[4][2], a[4][2];
#pragma unroll
    for (int ks = 0; ks < 4; ++ks) { const float* p0 = POOLV + (size_t)t * POOL_W + g * 128 + 32 * ks + 8 * qq; c[ks][0] = *(const f32x4*)p0; c[ks][1] = *(const f32x4*)(p0 + 4); a[ks][0] = c[ks][0]; a[ks][1] = c[ks][1]; }
#pragma unroll
    for (int i = 1; i < W; ++i) {
        const bool ok = i <= sp; const size_t back = ok ? (size_t)i * POOL_W : 0;
        const float m = ok ? 1.0f : 0.0f;
#pragma unroll
        for (int ks = 0; ks < 4; ++ks) { const float* p0 = POOLV + (size_t)t * POOL_W + g * 128 + 32 * ks + 8 * qq - back; a[ks][0] += *(const f32x4*)p0 * m; a[ks][1] += *(const f32x4*)(p0 + 4) * m; }
    }
#pragma unroll
    for (int ks = 0; ks < 4; ++ks) {
        const f32x4 a0 = a[ks][0] * inv - c[ks][0], a1 = a[ks][1] * inv - c[ks][1];
        v4u pw; pw.x = cvtpk(a0.x, a0.y); pw.y = cvtpk(a0.z, a0.w); pw.z = cvtpk(a1.x, a1.y); pw.w = cvtpk(a1.z, a1.w);
        pf[ks] = __builtin_bit_cast(bf16x8, pw);
    }
}
__device__ __forceinline__ void pool_item(int item, const float* __restrict__ POOLV, const bf16_t* __restrict__ WPT, const float* __restrict__ pool_scale, bf16_t* CONCAT, int lane) {
    const int g = item & 3, t0 = (item >> 2) * 16, q15 = lane & 15, qq = lane >> 4;
    const int t = t0 + q15;
    bf16x8 pf[4];
    if (g == 0) pool_frags<2>(pf, POOLV, t, g, qq); else if (g == 1) pool_frags<4>(pf, POOLV, t, g, qq); else if (g == 2) pool_frags<8>(pf, POOLV, t, g, qq); else pool_frags<16>(pf, POOLV, t, g, qq);
    bf16_t* orow = CONCAT + (size_t)t * D_MODEL + g * 128 + 4 * qq;
#pragma unroll
    for (int mt = 0; mt < 8; ++mt) {
        f32x4 acc = {0.f, 0.f, 0.f, 0.f};
#pragma unroll
        for (int ks = 0; ks < 4; ++ks) { const bf16x8 wf = *(const bf16x8*)(WPT + (size_t)g * 16384 + (16 * mt + q15) * 128 + 32 * ks + 8 * qq); acc = mfma16(wf, pf[ks], acc); }
        const f32x4 sc = *(const f32x4*)(pool_scale + g * 128 + 16 * mt + 4 * qq);
        v2u wv; wv.x = cvtpk(acc[0] * sc[0], acc[1] * sc[1]); wv.y = cvtpk(acc[2] * sc[2], acc[3] * sc[3]);
        *(v2u*)(orow + 16 * mt) = wv;
    }
}

__device__ __forceinline__ void ln1_row(const float* __restrict__ yrow, const float* __restrict__ g, const float* __restrict__ bta, float* xo, bf16_t* xb, int lane) {
    f32x4 v[8]; float s = 0.f;
#pragma unroll
    for (int j = 0; j < 8; ++j) { v[j] = *(const f32x4*)(yrow + 256 * j + 4 * lane); s += (v[j].x + v[j].y) + (v[j].z + v[j].w); }
    const float mean = wave_sum(s) * (1.f / D_MODEL); float q = 0.f;
#pragma unroll
    for (int j = 0; j < 8; ++j) { v[j] = v[j] - mean; q += (v[j].x * v[j].x + v[j].y * v[j].y) + (v[j].z * v[j].z + v[j].w * v[j].w); }
    const float rstd = 1.0f / sqrtf(wave_sum(q) * (1.f / D_MODEL) + LN_EPS);
#pragma unroll
    for (int j = 0; j < 8; ++j) {
        const f32x4 gg = *(const f32x4*)(g + 256 * j + 4 * lane), bb = *(const f32x4*)(bta + 256 * j + 4 * lane);
        const f32x4 y = v[j] * rstd * gg + bb;
        *(f32x4*)(xo + 256 * j + 4 * lane) = y;
        v2u w; w.x = cvtpk(y.x, y.y); w.y = cvtpk(y.z, y.w); *(v2u*)(xb + 256 * j + 4 * lane) = w;
    }
}

__device__ __forceinline__ unsigned f2ord(float f) { const unsigned u = __float_as_uint(f); return u ^ ((unsigned)((int)u >> 31) | 0x80000000u); }
__device__ __forceinline__ float ord2f(unsigned o) { const unsigned u = (o & 0x80000000u) ? (o ^ 0x80000000u) : ~o; return __uint_as_float(u); }
constexpr int TK_KROW = 272, TK_HALF = 128 * TK_KROW;
__device__ __forceinline__ void topk_item(int item, const bf16_t* __restrict__ QP, const LAS unsigned char* Kl, int* EIDX, float* GATE, int lane) {
    const int h = item & 7, t0 = (item >> 3) * 16, q15 = lane & 15, qq = lane >> 4;
    const int t = t0 + q15;
    unsigned top[2][16];
#pragma unroll
    for (int half = 0; half < 2; ++half) {
        bf16x8 qf[4];
#pragma unroll
        for (int ks = 0; ks < 4; ++ks) qf[ks] = *(const bf16x8*)(QP + (size_t)t * D_MODEL + h * 256 + half * 128 + 32 * ks + 8 * qq);
        unsigned key[32];
#pragma unroll
        for (int mi = 0; mi < 8; ++mi) {
            f32x4 acc = {0.f, 0.f, 0.f, 0.f};
#pragma unroll
            for (int ks = 0; ks < 4; ++ks) { const bf16x8 kf = *(const LAS bf16x8*)(Kl + half * TK_HALF + (16 * mi + q15) * TK_KROW + (32 * ks + 8 * qq) * 2); acc = mfma16(kf, qf[ks], acc); }
#pragma unroll
            for (int r = 0; r < 4; ++r) key[mi * 4 + r] = (f2ord(acc[r]) & ~0x7Fu) | (unsigned)(127 - (16 * mi + 4 * qq + r));
        }
#pragma unroll
        for (int r = 0; r < 16; ++r) {
            unsigned t1[11];
#pragma unroll
            for (int i = 0; i < 10; ++i) t1[i] = umax(umax(key[3 * i], key[3 * i + 1]), key[3 * i + 2]);
            t1[10] = umax(key[30], key[31]);
            const unsigned u0 = umax(umax(t1[0], t1[1]), t1[2]), u1 = umax(umax(t1[3], t1[4]), t1[5]), u2 = umax(umax(t1[6], t1[7]), t1[8]), u3 = umax(t1[9], t1[10]);
            const unsigned M = xmax4(umax(umax(umax(u0, u1), u2), u3));
            top[half][r] = M;
#pragma unroll
            for (int i = 0; i < 32; ++i) key[i] = (key[i] == M) ? 0u : key[i];
            __builtin_amdgcn_sched_barrier(0);
        }
        __builtin_amdgcn_sched_barrier(0);
    }
    float v1[16], v2[16]; unsigned e1[16], e2[16];
#pragma unroll
    for (int r = 0; r < 16; ++r) { v1[r] = ord2f(top[0][r] & ~0x7Fu); v2[r] = ord2f(top[1][r] & ~0x7Fu); e1[r] = (127u - (top[0][r] & 0x7Fu)) * 128u; e2[r] = 127u - (top[1][r] & 0x7Fu); }
    unsigned ck[13], ce[13];
#pragma unroll
    for (int i = 0; i < 13; ++i) { ck[i] = 0u; ce[i] = 0u; }
    {
        int n = 0;
#pragma unroll
        for (int a = 0; a < 16; ++a)
#pragma unroll
            for (int bb = 0; bb < 16; ++bb)
                if ((a + 1) * (bb + 1) <= 16) {
                    const unsigned pk = (f2ord(v1[a] + v2[bb]) & ~0xFFu) | (unsigned)(255 - (a * 16 + bb));
                    const unsigned ee = e1[a] + e2[bb];
                    const bool me = (qq == (n & 3));
                    ck[n >> 2] = me ? pk : ck[n >> 2]; ce[n >> 2] = me ? ee : ce[n >> 2];
                    ++n;
                }
    }
    float sc[16];
#pragma unroll
    for (int r = 0; r < 16; ++r) {
        const unsigned c0 = umax(umax(ck[0], ck[1]), ck[2]), c1 = umax(umax(ck[3], ck[4]), ck[5]), c2 = umax(umax(ck[6], ck[7]), ck[8]), c3 = umax(umax(ck[9], ck[10]), ck[11]);
        const unsigned Lm = umax(umax(umax(c0, c1), umax(c2, c3)), ck[12]);
        const unsigned M = xmax4(Lm);
        unsigned we = 0u;
#pragma unroll
        for (int i = 0; i < 13; ++i) { const bool hit = (ck[i] == M); we = hit ? ce[i] : we; ck[i] = hit ? 0u : ck[i]; }
        sc[r] = ord2f(M & ~0xFFu);
        if (Lm == M) EIDX[(size_t)t * EPT + h * TOPK + r] = (int)we;
        __builtin_amdgcn_sched_barrier(0);
    }
    const float smax = sc[0];
    float den = 0.f;
#pragma unroll
    for (int r = 0; r < 16; ++r) { sc[r] = fexp2((sc[r] - smax) * LOG2E); den += sc[r]; }
    const float rden = 1.0f / den;
    if (qq == 0) {
        float* gp = GATE + (size_t)t * EPT + h * TOPK;
#pragma unroll
        for (int r = 0; r < 16; r += 4) *(f32x4*)(gp + r) = (f32x4){sc[r] * rden, sc[r + 1] * rden, sc[r + 2] * rden, sc[r + 3] * rden};
    }
}

struct SliceMeta { int idx[16]; };
__device__ __forceinline__ void slice_meta(SliceMeta& m, const int* __restrict__ EIDX, int t, int g) {
#pragma unroll
    for (int k4 = 0; k4 < 4; ++k4) { const v4u iv = *(const v4u*)(EIDX + (size_t)t * EPT + 16 * g + 4 * k4); m.idx[4 * k4] = (int)iv.x; m.idx[4 * k4 + 1] = (int)iv.y; m.idx[4 * k4 + 2] = (int)iv.z; m.idx[4 * k4 + 3] = (int)iv.w; }
}
__device__ __forceinline__ void pu_sweep(int s, int tfirst, int tstep, const bf16_t* __restrict__ X1B, const int* __restrict__ EIDX, const unsigned char* __restrict__ U8S, float* HP, int lane) {
    const int g = lane >> 3, c = lane & 7;
    const unsigned char* base = U8S + (size_t)s * NEXP * 128 + 16 * c;
    const bool b4 = c & 4, b2 = c & 2, b1 = c & 1;
    const int k0 = (b4 ? 8 : 0) + (b2 ? 4 : 0) + (b1 ? 2 : 0);
    SliceMeta cur; v4u xa, xc;
    slice_meta(cur, EIDX, tfirst, g);
    xa = *(const v4u*)(X1B + (size_t)tfirst * D_MODEL + 128 * s + 16 * c); xc = *(const v4u*)(X1B + (size_t)tfirst * D_MODEL + 128 * s + 16 * c + 8);
#pragma unroll 1
    for (int t = tfirst; t < MTOK; t += tstep) {
        v4u w[16];
#pragma unroll
        for (int k = 0; k < 16; ++k) w[k] = *(const v4u*)(base + (size_t)cur.idx[k] * 128);
        const int tn = (t + tstep < MTOK) ? t + tstep : t;
        SliceMeta nxt; slice_meta(nxt, EIDX, tn, g);
        const v4u xan = *(const v4u*)(X1B + (size_t)tn * D_MODEL + 128 * s + 16 * c), xcn = *(const v4u*)(X1B + (size_t)tn * D_MODEL + 128 * s + 16 * c + 8);
        const unsigned xb[8] = {xa.x, xa.y, xa.z, xa.w, xc.x, xc.y, xc.z, xc.w};
        float p[16];
#pragma unroll
        for (int k = 0; k < 16; ++k) { float a = 0.f, b = 0.f;
#pragma unroll
            for (int j = 0; j < 4; ++j) { const unsigned wv = w[k][j];
                a = __builtin_amdgcn_fdot2_f32_bf16(__builtin_amdgcn_cvt_scalef32_pk_bf16_fp8(wv, 1.0f, false), __builtin_bit_cast(bf16x2, xb[2 * j]), a, false);
                b = __builtin_amdgcn_fdot2_f32_bf16(__builtin_amdgcn_cvt_scalef32_pk_bf16_fp8(wv, 1.0f, true), __builtin_bit_cast(bf16x2, xb[2 * j + 1]), b, false); }
            p[k] = a + b; }
        float r8[8], r4[4], r2[2];
#pragma unroll
        for (int m = 0; m < 8; ++m) { const float keep = b4 ? p[m + 8] : p[m], send = b4 ? p[m] : p[m + 8]; r8[m] = keep + __shfl_xor(send, 4); }
#pragma unroll
        for (int m = 0; m < 4; ++m) { const float keep = b2 ? r8[m + 4] : r8[m], send = b2 ? r8[m] : r8[m + 4]; r4[m] = keep + __shfl_xor(send, 2); }
#pragma unroll
        for (int m = 0; m < 2; ++m) { const float keep = b1 ? r4[m + 2] : r4[m], send = b1 ? r4[m] : r4[m + 2]; r2[m] = keep + __shfl_xor(send, 1); }
        *(f32x2*)(HP + ((size_t)s * MTOK + t) * EPT + 16 * g + k0) = (f32x2){r2[0], r2[1]};
        cur = nxt; xa = xan; xc = xcn;
    }
}
__device__ __forceinline__ void pv_sweep(int s, int tfirst, int tstep, const float* __restrict__ X1, const int* __restrict__ EIDX, const float* __restrict__ A, const unsigned char* __restrict__ V8S,
                                         float* Y2, float* STAT, int lane) {
    const int g = lane >> 3, c = lane & 7;
    const unsigned char* base = V8S + (size_t)s * NEXP * 128 + 16 * c;
    const bool b3 = lane & 8;
    const int col = 16 * c + ((lane & 32) ? 8 : 0) + ((lane & 16) ? 4 : 0) + (b3 ? 2 : 0);
    SliceMeta cur; f32x4 av[4];
    slice_meta(cur, EIDX, tfirst, g);
#pragma unroll
    for (int k4 = 0; k4 < 4; ++k4) av[k4] = *(const f32x4*)(A + (size_t)tfirst * EPT + 16 * g + 4 * k4);
#pragma unroll 1
    for (int t = tfirst; t < MTOK; t += tstep) {
        v4u w[16];
#pragma unroll
        for (int k = 0; k < 16; ++k) w[k] = *(const v4u*)(base + (size_t)cur.idx[k] * 128);
        const int tn = (t + tstep < MTOK) ? t + tstep : t;
        SliceMeta nxt; slice_meta(nxt, EIDX, tn, g);
        f32x4 avn[4];
#pragma unroll
        for (int k4 = 0; k4 < 4; ++k4) avn[k4] = *(const f32x4*)(A + (size_t)tn * EPT + 16 * g + 4 * k4);
        const f32x2 xr = *(const f32x2*)(X1 + (size_t)t * D_MODEL + 128 * s + col);
        f32x4 acc[4];
#pragma unroll
        for (int j = 0; j < 4; ++j) acc[j] = (f32x4){0.f, 0.f, 0.f, 0.f};
#pragma unroll
        for (int k = 0; k < 16; ++k) { const float a = av[k >> 2][k & 3];
#pragma unroll
            for (int j = 0; j < 4; ++j) { const unsigned wv = w[k][j]; const f32x2 lo = __builtin_amdgcn_cvt_pk_f32_fp8(wv, false), hi = __builtin_amdgcn_cvt_pk_f32_fp8(wv, true);
                acc[j] += (f32x4){lo.x, lo.y, hi.x, hi.y} * a; } }
        float r8[8], r4[4], r2[2];
#pragma unroll
        for (int m = 0; m < 8; ++m) { auto r = __builtin_amdgcn_permlane32_swap(__float_as_uint(acc[m >> 2][m & 3]), __float_as_uint(acc[(m + 8) >> 2][m & 3]), false, false); r8[m] = __uint_as_float(r[0]) + __uint_as_float(r[1]); }
#pragma unroll
        for (int m = 0; m < 4; ++m) { auto r = __builtin_amdgcn_permlane16_swap(__float_as_uint(r8[m]), __float_as_uint(r8[m + 4]), false, false); r4[m] = __uint_as_float(r[0]) + __uint_as_float(r[1]); }
#pragma unroll
        for (int m = 0; m < 2; ++m) { const float keep = b3 ? r4[m + 2] : r4[m], send = b3 ? r4[m] : r4[m + 2]; r2[m] = keep + __shfl_xor(send, 8); }
        const float y0 = xr.x * ALPHA + r2[0], y1 = xr.y * ALPHA + r2[1];
        *(f32x2*)(Y2 + (size_t)t * D_MODEL + 128 * s + col) = (f32x2){y0, y1};
        const float s1 = wave_sum(y0 + y1), s2 = wave_sum(y0 * y0 + y1 * y1);
        if (lane == 0) *(f32x2*)(STAT + ((size_t)t * 16 + s) * 2) = (f32x2){s1, s2};
        cur = nxt;
#pragma unroll
        for (int k4 = 0; k4 < 4; ++k4) av[k4] = avn[k4];
    }
}
__device__ __forceinline__ void ln2_row(int t, const float* __restrict__ Y2, const float* __restrict__ STAT, const float* __restrict__ g2, const float* __restrict__ b2, float* out, int lane) {
    f32x2 st = {0.f, 0.f};
    if (lane < 16) st = *(const f32x2*)(STAT + ((size_t)t * 16 + lane) * 2);
    const float mean = wave_sum(st.x) * (1.f / D_MODEL), ex2 = wave_sum(st.y) * (1.f / D_MODEL);
    const float rstd = 1.0f / sqrtf(fmaxf(ex2 - mean * mean, 0.f) + LN_EPS);
#pragma unroll
    for (int j = 0; j < 8; ++j) {
        const int c = 256 * j + 4 * lane;
        const f32x4 y = *(const f32x4*)(Y2 + (size_t)t * D_MODEL + c), gg = *(const f32x4*)(g2 + c), bb = *(const f32x4*)(b2 + c);
        *(f32x4*)(out + (size_t)t * D_MODEL + c) = (y - mean) * rstd * gg + bb;
    }
}
template <int R>
__device__ __forceinline__ void cvt_rows_fp8(const float* __restrict__ in, unsigned char* outs, float* sc, int row0, int lane) {
    f32x4 v[R][8];
#pragma unroll
    for (int r = 0; r < R; ++r)
#pragma unroll
        for (int j = 0; j < 8; ++j) v[r][j] = __builtin_nontemporal_load((const f32x4*)(in + (size_t)(row0 + r) * D_MODEL + 256 * j + 4 * lane));
#pragma unroll
    for (int r = 0; r < R; ++r) {
        float am = 0.f;
#pragma unroll
        for (int j = 0; j < 8; ++j) am = fmaxf(am, fmaxf(fmaxf(fabsf(v[r][j].x), fabsf(v[r][j].y)), fmaxf(fabsf(v[r][j].z), fabsf(v[r][j].w))));
#pragma unroll
        for (int o = 1; o < 64; o <<= 1) am = fmaxf(am, __shfl_xor(am, o));
        const float inv = am > 0.f ? 256.0f / am : 1.0f, scale = am > 0.f ? am * (1.0f / 256.0f) : 1.0f;
#pragma unroll
        for (int j = 0; j < 8; ++j) {
            int w = 0; w = __builtin_amdgcn_cvt_pk_fp8_f32(v[r][j].x * inv, v[r][j].y * inv, w, false); w = __builtin_amdgcn_cvt_pk_fp8_f32(v[r][j].z * inv, v[r][j].w * inv, w, true);
            *(unsigned*)(outs + ((size_t)(2 * j + (lane >> 5)) * NEXP + (row0 + r)) * 128 + 4 * (lane & 31)) = (unsigned)w;
        }
        if (lane == 0) sc[row0 + r] = scale;
    }
}

struct Args { const void* in[18]; float* out; unsigned char* ws; int ph_lo, ph_hi, li, pad; };
constexpr int N_PHASES = 11;

#define P_IN(T, i) ((const T*)args.in[i])
#define P_WS(T, off) ((T*)(ws + (off)))
#define x_in P_IN(float, 0)
#define mem_in P_IN(float, 1)
#define positions P_IN(int, 2)
#define w_in P_IN(float, 3)
#define w_mem_kv P_IN(float, 4)
#define w_pool P_IN(float, 5)
#define pool_scale P_IN(float, 6)
#define sinks P_IN(float, 7)
#define w_out P_IN(float, 8)
#define ln1_g P_IN(float, 9)
#define ln1_b P_IN(float, 10)
#define w_peer_q P_IN(float, 11)
#define sk1 P_IN(float, 12)
#define sk2 P_IN(float, 13)
#define eu P_IN(float, 14)
#define ev P_IN(float, 15)
#define ln2_g P_IN(float, 16)
#define ln2_b P_IN(float, 17)
#define WINT P_WS(bf16_t, WS_WINT)
#define WKVT P_WS(bf16_t, WS_WKVT)
#define WOT P_WS(bf16_t, WS_WOT)
#define WQT P_WS(bf16_t, WS_WQT)
#define WPT P_WS(bf16_t, WS_SMALL)
#define K1B P_WS(bf16_t, WS_SMALL + 131072)
#define K2B P_WS(bf16_t, WS_SMALL + 163840)
#define ROPE P_WS(float, WS_SMALL + 262144)
#define XB P_WS(bf16_t, WS_XB)
#define X1B P_WS(bf16_t, WS_X1B)
#define MEMB P_WS(bf16_t, WS_MEMB)
#define KVM P_WS(bf16_t, WS_KVM)
#define POOLV P_WS(float, WS_POOLV)
#define Q P_WS(bf16_t, WS_Q)
#define Kb P_WS(bf16_t, WS_K)
#define Vb P_WS(bf16_t, WS_V)
#define QM P_WS(bf16_t, WS_QM)
#define CONCAT P_WS(bf16_t, WS_CONCAT)
#define Y1 P_WS(float, WS_Y1)
#define X1 P_WS(float, WS_X1)
#define QP P_WS(bf16_t, WS_QP)
#define EIDX P_WS(int, WS_EIDX)
#define GATE P_WS(float, WS_GATE)
#define U8 P_WS(unsigned char, WS_UB)
#define V8 P_WS(unsigned char, WS_VB)
#define SU P_WS(float, WS_UB + 48 * MiB)
#define SV P_WS(float, WS_VB + 48 * MiB)
#define HP P_WS(float, WS_POOLV)
#define AV P_WS(float, WS_POOLV + 64 * MiB)
#define STAT P_WS(float, WS_POOLV + 68 * MiB)
#define Y2 P_WS(float, WS_Y1)
__global__ void __launch_bounds__(NTHREADS, 2) mega_fwd(Args args) {
    extern __shared__ __attribute__((aligned(16))) unsigned char lds_raw[];
    LAS unsigned char* lds = (LAS unsigned char*)lds_raw;
    volatile LAS unsigned* MISC = (volatile LAS unsigned*)(lds + MISC_OFF);
    const int tid = threadIdx.x, lane = tid & 63, wave = __builtin_amdgcn_readfirstlane(tid >> 6);
    const int G = gridDim.x, bx = blockIdx.x;
    const int vcu = (G % 8 == 0) ? (bx % 8) * (G / 8) + bx / 8 : bx;
    const int gw = vcu * NWAVES + wave, NGW = G * NWAVES;
    unsigned char* ws = args.ws;
    for (int u = tid; u < (LDS_BYTES - MISC_OFF) / 4; u += NTHREADS) MISC[u] = 0u;
    __syncthreads();
    XcdBarrier bar = xcd_barrier_post((unsigned*)(ws + WS_CTL) + CW_BAR + args.li * XCD_BAR_WORDS, MISC + 8);
    const int lo = args.ph_lo, hi = args.ph_hi;
#ifndef ONLY_PHASES
#define ONLY_PHASES 2047
#endif
#define IN(k) (((ONLY_PHASES >> (k)) & 1) && lo <= (k) && (k) < hi)
#ifndef REPEAT_MASK
#define REPEAT_MASK 0
#endif
#define REP(k) for (int _rep = 0; _rep < 1 + ((REPEAT_MASK >> (k)) & 1); ++_rep)
#define SEAM(k) do { if (IN(k) && IN((k) + 1)) xcd_barrier(bar); } while (0)

    if (IN(0)) REP(0) {
        LAS float* scr = (LAS float*)(lds + wave * 16384);
        constexpr int I_IN = (D_MODEL / 64) * (IN_W / 32), I_KV = (D_MODEL / 64) * (2 * MEM_W / 32), I_O = (D_MODEL / 64) * (D_MODEL / 32), I_Q = I_O, I_P = 4 * 2 * 4;
        constexpr int NITEMS = I_IN + I_KV + I_O + I_Q + I_P;
        for (int it = gw; it < NITEMS; it += NGW) {
            int r = it;
            if (r < I_IN) { p0_transpose_item(w_in, D_MODEL, IN_W, WINT, scr, r, lane); continue; } r -= I_IN;
            if (r < I_KV) { p0_transpose_item(w_mem_kv, D_MODEL, 2 * MEM_W, WKVT, scr, r, lane); continue; } r -= I_KV;
            if (r < I_O) { p0_transpose_item(w_out, D_MODEL, D_MODEL, WOT, scr, r, lane); continue; } r -= I_O;
            if (r < I_Q) { p0_transpose_item(w_peer_q, D_MODEL, D_MODEL, WQT, scr, r, lane); continue; } r -= I_Q;
            { const int gpl = r >> 3; p0_transpose_item(w_pool + (size_t)gpl * 16384, 128, 128, WPT + (size_t)gpl * 16384, scr, r & 7, lane); }
        }
        cvt_stream<false>(x_in, XB, (size_t)MTOK * D_MODEL, gw, NGW, lane);
        cvt_stream<false>(mem_in, MEMB, (size_t)MMEM * D_MODEL, gw, NGW, lane);
        cvt_stream<false>(sk1, K1B, (size_t)NKEYS * 128, gw, NGW, lane);
        cvt_stream<false>(sk2, K2B, (size_t)NKEYS * 128, gw, NGW, lane);
        for (int i = gw * 64 + lane; i < MTOK * 8; i += NGW * 64) { float c, s; rope_cs(positions[i >> 3], i & 7, c, s); *(f32x2*)(ROPE + 2 * (size_t)i) = (f32x2){c, s}; }
    }
    SEAM(0);
    if (IN(1)) REP(1) {
        { pg8::Gemm g{XB, WINT, MTOK, IN_W, D_MODEL}; pg8::StaticOrder S; S.init(MTOK, IN_W, G, bx);
          EpiIn E{POOLV, Q, Kb, Vb, QM, ROPE};
          pg8::gemm_phase<EpiIn, pg8::StaticOrder, true, true>(lds, g, S, E); }
        { pg8::Gemm g{MEMB, WKVT, MMEM, 2 * MEM_W, D_MODEL}; pg8::StaticOrder S; S.init(MMEM, 2 * MEM_W, G, (bx + G - 64) % G);
          EpiStoreBf E{KVM, 2 * MEM_W};
          pg8::gemm_phase<EpiStoreBf, pg8::StaticOrder, true, true>(lds, g, S, E); }
        { const int f0 = (G == 256) ? 72 : 0;
          if (bx >= f0) { const int fw = (bx - f0) * NWAVES + wave, NFW = (G - f0) * NWAVES;
            for (int r = fw * 4; r < 2 * NEXP; r += NFW * 4) { if (r < NEXP) cvt_rows_fp8<4>(eu, U8, SU, r, lane); else cvt_rows_fp8<4>(ev, V8, SV, r - NEXP, lane); } } }
    }
    SEAM(1);
    if (IN(2)) REP(2) {
        for (int it = vcu; it < 512; it += G) {
            if (it < 256) swa_item(lds, it, Q, Kb, Vb, sinks, CONCAT, tid, wave, lane);
            else mem_item(lds, it - 256, QM, KVM, CONCAT, tid, wave, lane);
        }
        for (int it = gw; it < (MTOK / 16) * 4; it += NGW) pool_item(it, POOLV, WPT, pool_scale, CONCAT, lane);
    }
    SEAM(2);
    if (IN(3)) REP(3) {
        pg8::Gemm g{CONCAT, WOT, MTOK, D_MODEL, D_MODEL}; pg8::StaticOrder S; S.init(MTOK, D_MODEL, G, bx);
        EpiY1 E{x_in, Y1};
        pg8::gemm_phase<EpiY1, pg8::StaticOrder, true, true>(lds, g, S, E);
    }
    SEAM(3);
    if (IN(4)) REP(4) { for (int r = gw; r < MTOK; r += NGW) ln1_row(Y1 + (size_t)r * D_MODEL, ln1_g, ln1_b, X1 + (size_t)r * D_MODEL, X1B + (size_t)r * D_MODEL, lane); }
    SEAM(4);
    if (IN(5)) REP(5) {
        pg8::Gemm g{X1B, WQT, MTOK, D_MODEL, D_MODEL}; pg8::StaticOrder S; S.init(MTOK, D_MODEL, G, bx);
        EpiStoreBf E{QP, D_MODEL};
        pg8::gemm_phase<EpiStoreBf, pg8::StaticOrder, true, true>(lds, g, S, E);
    }
    SEAM(5);
    if (IN(6)) REP(6) {
#pragma unroll
        for (int j = 0; j < 8; ++j) { const int c = tid + NTHREADS * j, half = c >> 11, row = (c >> 4) & 127, part = c & 15;
            *(LAS v4u*)(lds + half * TK_HALF + row * TK_KROW + part * 16) = *(const v4u*)((half ? K2B : K1B) + row * 128 + part * 8); }
        __syncthreads();
        for (int it = gw; it < (MTOK / 16) * PHEADS; it += NGW) topk_item(it, QP, lds, EIDX, GATE, lane);
        __syncthreads();
    }
    SEAM(6);
    if (IN(7)) REP(7) { const int cls = bx & 7, rk = bx >> 3;
        for (int sub = 0; sub < 2; ++sub) pu_sweep(2 * cls + sub, rk * NWAVES + wave, (G >> 3) * NWAVES, X1B, EIDX, U8, HP, lane); }
    SEAM(7);
    if (IN(8)) REP(8) {
        for (int e = gw * 64 + lane; e < MTOK * EPT; e += NGW * 64) {
            float h = 0.f;
#pragma unroll
            for (int sl = 0; sl < 16; ++sl) h += HP[(size_t)sl * MTOK * EPT + e];
            const int id = EIDX[e];
            AV[e] = GATE[e] * gelu_erf(h * SU[id]) * SV[id];
        } }
    SEAM(8);
    if (IN(9)) REP(9) { const int cls = bx & 7, rk = bx >> 3;
        for (int sub = 0; sub < 2; ++sub) pv_sweep(2 * cls + sub, rk * NWAVES + wave, (G >> 3) * NWAVES, X1, EIDX, AV, V8, Y2, STAT, lane); }
    SEAM(9);
    if (IN(10)) REP(10) { for (int t = gw; t < MTOK; t += NGW) ln2_row(t, Y2, STAT, ln2_g, ln2_b, args.out, lane); }
#undef IN
#undef SEAM
}
#undef P_IN(T,
#undef P_WS(T,
#undef x_in
#undef mem_in
#undef positions
#undef w_in
#undef w_mem_kv
#undef w_pool
#undef pool_scale
#undef sinks
#undef w_out
#undef ln1_g
#undef ln1_b
#undef w_peer_q
#undef sk1
#undef sk2
#undef eu
#undef ev
#undef ln2_g
#undef ln2_b
#undef WINT
#undef WKVT
#undef WOT
#undef WQT
#undef WPT
#undef K1B
#undef K2B
#undef ROPE
#undef XB
#undef X1B
#undef MEMB
#undef KVM
#undef POOLV
#undef Q
#undef Kb
#undef Vb
#undef QM
#undef CONCAT
#undef Y1
#undef X1
#undef QP
#undef EIDX
#undef GATE
#undef U8
#undef V8
#undef SU
#undef SV
#undef HP
#undef AV
#undef STAT
#undef Y2

#if NAIVE_MASK != 0
__device__ __forceinline__ float toF(float v) { return v; }
__device__ __forceinline__ float toF(bf16_t v) { return bf2f(v); }

struct NvEpiF32 { float* C; int ldc, pad; __device__ void operator()(int r, int c, float v) const { C[(size_t)r * ldc + c] = v; } };
struct NvEpiBf { bf16_t* C; int ldc, pad; __device__ void operator()(int r, int c, float v) const { C[(size_t)r * ldc + c] = f2bf(v); } };
struct NvEpiY1 { const float* x; float* y; __device__ void operator()(int r, int c, float v) const { y[(size_t)r * D_MODEL + c] = ALPHA * x[(size_t)r * D_MODEL + c] + v; } };

template <class TA, class Epi>
__global__ void __launch_bounds__(256) nv_gemm(const TA* __restrict__ A, const float* __restrict__ B, int M, int N, int K, Epi epi) {
    __shared__ float As[16][65];
    __shared__ float Bs[16][64];
    const int tx = threadIdx.x & 15, ty = threadIdx.x >> 4;
    const int m0 = blockIdx.y * 64, n0 = blockIdx.x * 64;
    float acc[4][4];
#pragma unroll
    for (int i = 0; i < 4; ++i)
#pragma unroll
        for (int j = 0; j < 4; ++j) acc[i][j] = 0.f;
    for (int k0 = 0; k0 < K; k0 += 16) {
        for (int i = threadIdx.x; i < 1024; i += 256) { const int r = i >> 4, c = i & 15; As[c][r] = toF(A[(size_t)(m0 + r) * K + k0 + c]); }
        for (int i = threadIdx.x; i < 1024; i += 256) { const int r = i >> 6, c = i & 63; Bs[r][c] = B[(size_t)(k0 + r) * N + n0 + c]; }
        __syncthreads();
#pragma unroll
        for (int kk = 0; kk < 16; ++kk) {
            float a[4], b[4];
#pragma unroll
            for (int i = 0; i < 4; ++i) { a[i] = As[kk][ty * 4 + i]; b[i] = Bs[kk][tx * 4 + i]; }
#pragma unroll
            for (int i = 0; i < 4; ++i)
#pragma unroll
                for (int j = 0; j < 4; ++j) acc[i][j] += a[i] * b[j];
        }
        __syncthreads();
    }
#pragma unroll
    for (int i = 0; i < 4; ++i)
#pragma unroll
        for (int j = 0; j < 4; ++j) epi(m0 + ty * 4 + i, n0 + tx * 4 + j, acc[i][j]);
}

__global__ void nv_post1(const float* __restrict__ H, const int* __restrict__ positions, float* POOLV, bf16_t* Q, bf16_t* Kb, bf16_t* Vb, bf16_t* QM) {
    const size_t gid = (size_t)blockIdx.x * blockDim.x + threadIdx.x;
    if (gid >= (size_t)MTOK * IN_W) return;
    const int t = (int)(gid / IN_W), col = (int)(gid % IN_W);
    const float* hr = H + (size_t)t * IN_W;
    const float v = hr[col];
    if (col < POOL_W) { POOLV[(size_t)t * POOL_W + col] = v; return; }
    if (col < POOL_W + SWA_W + KV_W) {
        const bool isq = col < POOL_W + SWA_W;
        const int c = isq ? col - POOL_W : col - POOL_W - SWA_W;
        const int d = c & 63;
        float o = v;
        if (d < 16) {
            const int j = d & 7; float cs, sn; rope_cs(positions[t], j, cs, sn);
            if (d < 8) o = v * cs - hr[col + 8] * sn; else o = v * cs + hr[col - 8] * sn;
        }
        if (isq) Q[(size_t)t * SWA_W + c] = f2bf(o); else Kb[(size_t)t * KV_W + c] = f2bf(o);
        return;
    }
    if (col < POOL_W + SWA_W + 2 * KV_W) { Vb[(size_t)t * KV_W + (col - POOL_W - SWA_W - KV_W)] = f2bf(v); return; }
    QM[(size_t)t * MEM_W + (col - POOL_W - SWA_W - 2 * KV_W)] = f2bf(v);
}
__global__ void nv_cvt_bf16(const float* __restrict__ in, bf16_t* out, size_t n) {
    const size_t gid = (size_t)blockIdx.x * blockDim.x + threadIdx.x;
    if (gid < n) out[gid] = f2bf(in[gid]);
}
__global__ void nv_pool1(const float* __restrict__ POOLV, float* PS) {
    const size_t gid = (size_t)blockIdx.x * blockDim.x + threadIdx.x;
    if (gid >= (size_t)MTOK * POOL_W) return;
    const int t = (int)(gid / POOL_W), ch = (int)(gid % POOL_W);
    const int g = ch >> 7, w = 2 << g, s = t & (SEQ - 1);
    const int cnt = (s + 1) < w ? (s + 1) : w;
    float sum = 0.f;
    for (int i = 0; i < cnt; ++i) sum += POOLV[(size_t)(t - i) * POOL_W + ch];
    PS[gid] = sum / (float)cnt - POOLV[gid];
}
__global__ void nv_pool2(const float* __restrict__ PS, const float* __restrict__ w_pool, const float* __restrict__ pool_scale, bf16_t* CONCAT) {
    const size_t gid = (size_t)blockIdx.x * blockDim.x + threadIdx.x;
    if (gid >= (size_t)MTOK * POOL_W) return;
    const int t = (int)(gid / POOL_W), ch = (int)(gid % POOL_W);
    const int g = ch >> 7, d = ch & 127;
    const float* p = PS + (size_t)t * POOL_W + g * 128;
    const float* w = w_pool + (size_t)g * 128 * 128 + d;
    float y = 0.f;
    for (int c = 0; c < 128; ++c) y += p[c] * w[(size_t)c * 128];
    CONCAT[(size_t)t * D_MODEL + ch] = f2bf(y * pool_scale[ch]);
}
__global__ void __launch_bounds__(256) nv_swa(const bf16_t* __restrict__ Q, const bf16_t* __restrict__ Kb, const bf16_t* __restrict__ Vb, const float* __restrict__ sinks, bf16_t* CONCAT) {
    const int wv = (int)((blockIdx.x * 256 + threadIdx.x) >> 6), lane = threadIdx.x & 63;
    if (wv >= MTOK * NHEAD) return;
    const int t = wv / NHEAD, h = wv % NHEAD, kvh = h >> 2, s = t & (SEQ - 1), tb = t - s;
    const float q = bf2f(Q[(size_t)t * SWA_W + h * HD + lane]);
    float m = sinks[h], l = 1.0f, o = 0.f;
    const int k0 = s - (WINDOW - 1) < 0 ? 0 : s - (WINDOW - 1);
    for (int kk = k0; kk <= s; ++kk) {
        const size_t kt = (size_t)(tb + kk);
        const float sc = wave_sum(q * bf2f(Kb[kt * KV_W + kvh * HD + lane])) * 0.125f;
        const float mn = fmaxf(m, sc), r = expf(m - mn), p = expf(sc - mn);
        l = l * r + p; o = o * r + p * bf2f(Vb[kt * KV_W + kvh * HD + lane]); m = mn;
    }
    CONCAT[(size_t)t * D_MODEL + POOL_W + h * HD + lane] = f2bf(o / l);
}
__global__ void __launch_bounds__(256) nv_mem(const bf16_t* __restrict__ QM, const bf16_t* __restrict__ KVM, bf16_t* CONCAT) {
    const int wv = (int)((blockIdx.x * 256 + threadIdx.x) >> 6), lane = threadIdx.x & 63;
    if (wv >= MTOK * MHEADS) return;
    const int t = wv / MHEADS, hm = wv % MHEADS, b = t / SEQ;
    const float q0 = bf2f(QM[(size_t)t * MEM_W + hm * MHD + lane]), q1 = bf2f(QM[(size_t)t * MEM_W + hm * MHD + 64 + lane]);
    float m = -1e30f, l = 0.f, o0 = 0.f, o1 = 0.f;
    const float scale = 0.08838834764831845f;
    for (int j = 0; j < MEM_LEN; ++j) {
        const bf16_t* kr = KVM + (size_t)(b * MEM_LEN + j) * (2 * MEM_W) + hm * MHD;
        const bf16_t* vr = kr + MEM_W;
        const float sc = wave_sum(q0 * bf2f(kr[lane]) + q1 * bf2f(kr[64 + lane])) * scale;
        const float mn = fmaxf(m, sc), r = expf(m - mn), p = expf(sc - mn);
        l = l * r + p; o0 = o0 * r + p * bf2f(vr[lane]); o1 = o1 * r + p * bf2f(vr[64 + lane]); m = mn;
    }
    bf16_t* orow = CONCAT + (size_t)t * D_MODEL + POOL_W + SWA_W + hm * MHD;
    orow[lane] = f2bf(o0 / l); orow[64 + lane] = f2bf(o1 / l);
}
__global__ void __launch_bounds__(256) nv_ln(const float* __restrict__ in, const float* __restrict__ g, const float* __restrict__ bta, float* outf, bf16_t* outb) {
    const int row = (int)((blockIdx.x * 256 + threadIdx.x) >> 6), lane = threadIdx.x & 63;
    if (row >= MTOK) return;
    const float* r = in + (size_t)row * D_MODEL;
    float v[32]; float s = 0.f;
#pragma unroll
    for (int i = 0; i < 32; ++i) { v[i] = r[lane + 64 * i]; s += v[i]; }
    const float mean = wave_sum(s) * (1.f / D_MODEL); float q = 0.f;
#pragma unroll
    for (int i = 0; i < 32; ++i) { v[i] -= mean; q += v[i] * v[i]; }
    const float rstd = 1.0f / sqrtf(wave_sum(q) * (1.f / D_MODEL) + LN_EPS);
#pragma unroll
    for (int i = 0; i < 32; ++i) {
        const int c = lane + 64 * i; const float y = v[i] * rstd * g[c] + bta[c];
        if (outf) outf[(size_t)row * D_MODEL + c] = y;
        if (outb) outb[(size_t)row * D_MODEL + c] = f2bf(y);
    }
}
__global__ void __launch_bounds__(32) nv_topk(const bf16_t* __restrict__ QP, const float* __restrict__ K1, const float* __restrict__ K2, int* EIDX, float* GATE) {
    __shared__ float sc[256][32];
    __shared__ float lv[32][32];
    __shared__ int li[32][32];
    const int tid = threadIdx.x, gid = blockIdx.x * 32 + tid;
    const int t = gid / PHEADS, h = gid % PHEADS;
    const bf16_t* q = QP + (size_t)t * D_MODEL + h * 256;
    for (int half = 0; half < 2; ++half) {
        const float* Kk = half ? K2 : K1;
        for (int k = 0; k < NKEYS; ++k) {
            float a = 0.f;
            for (int c = 0; c < 128; ++c) a += bf2f(q[half * 128 + c]) * Kk[k * 128 + c];
            sc[half * 128 + k][tid] = a;
        }
        for (int r = 0; r < TOPK; ++r) {
            float best = -INFINITY; int bi = 0;
            for (int k = 0; k < NKEYS; ++k) { const float v = sc[half * 128 + k][tid]; if (v > best) { best = v; bi = k; } }
            lv[half * 16 + r][tid] = best; li[half * 16 + r][tid] = bi; sc[half * 128 + bi][tid] = -INFINITY;
        }
    }
    for (int a = 0; a < 16; ++a) for (int b = 0; b < 16; ++b) sc[a * 16 + b][tid] = lv[a][tid] + lv[16 + b][tid];
    float mx = 0.f, den = 0.f;
    float tv[16]; int ti[16];
#pragma unroll
    for (int r = 0; r < TOPK; ++r) {
        float best = -INFINITY; int bi = 0;
        for (int k = 0; k < 256; ++k) { const float v = sc[k][tid]; if (v > best) { best = v; bi = k; } }
        sc[bi][tid] = -INFINITY;
        if (r == 0) mx = best;
        tv[r] = expf(best - mx); den += tv[r]; ti[r] = li[bi >> 4][tid] * NKEYS + li[16 + (bi & 15)][tid];
    }
#pragma unroll
    for (int r = 0; r < TOPK; ++r) { EIDX[(size_t)t * EPT + h * TOPK + r] = ti[r]; GATE[(size_t)t * EPT + h * TOPK + r] = tv[r] / den; }
}
__global__ void __launch_bounds__(256) nv_gather(const float* __restrict__ X1, const int* __restrict__ EIDX, const float* __restrict__ GATE, const float* __restrict__ EU, const float* __restrict__ EV,
                                                  const float* __restrict__ g, const float* __restrict__ bta, float* out) {
    const int t = (int)((blockIdx.x * 256 + threadIdx.x) >> 6), lane = threadIdx.x & 63;
    if (t >= MTOK) return;
    float x[32], acc[32];
#pragma unroll
    for (int i = 0; i < 32; ++i) { x[i] = X1[(size_t)t * D_MODEL + lane + 64 * i]; acc[i] = 0.f; }
    for (int e = 0; e < EPT; ++e) {
        const int id = EIDX[(size_t)t * EPT + e]; const float gt = GATE[(size_t)t * EPT + e];
        const float* u = EU + (size_t)id * D_MODEL; const float* vv = EV + (size_t)id * D_MODEL;
        float p = 0.f;
#pragma unroll
        for (int i = 0; i < 32; ++i) p += x[i] * u[lane + 64 * i];
        const float a = gt * gelu_erf(wave_sum(p));
#pragma unroll
        for (int i = 0; i < 32; ++i) acc[i] += a * vv[lane + 64 * i];
    }
    float s = 0.f;
#pragma unroll
    for (int i = 0; i < 32; ++i) { acc[i] = ALPHA * x[i] + acc[i]; s += acc[i]; }
    const float mean = wave_sum(s) * (1.f / D_MODEL); float q = 0.f;
#pragma unroll
    for (int i = 0; i < 32; ++i) { acc[i] -= mean; q += acc[i] * acc[i]; }
    const float rstd = 1.0f / sqrtf(wave_sum(q) * (1.f / D_MODEL) + LN_EPS);
#pragma unroll
    for (int i = 0; i < 32; ++i) { const int c = lane + 64 * i; out[(size_t)t * D_MODEL + c] = acc[i] * rstd * g[c] + bta[c]; }
}

#endif
extern "C" void kernel_launch(void* const* d_in, const int* in_sizes, int n_in, void* d_out, int out_size, void* d_ws, size_t ws_size, hipStream_t stream) {
    static int grid = 0;
    if (grid == 0) {
        if (n_in != 18 || in_sizes[0] != MTOK * D_MODEL || out_size != MTOK * D_MODEL || ws_size < WS_END) {
            fprintf(stderr, "kernel_launch: unexpected shapes (n_in %d, in0 %d, out %d, ws %zu)\n", n_in, n_in > 0 ? in_sizes[0] : -1, out_size, ws_size); grid = -1; return; }
        int dev = 0, cus = 0, per_cu = 0;
        if (hipGetDevice(&dev) != hipSuccess || hipDeviceGetAttribute(&cus, hipDeviceAttributeMultiprocessorCount, dev) != hipSuccess) { fprintf(stderr, "kernel_launch: device query failed\n"); grid = -1; return; }
        if (hipFuncSetAttribute((const void*)mega_fwd, hipFuncAttributeMaxDynamicSharedMemorySize, LDS_BYTES) != hipSuccess) { fprintf(stderr, "kernel_launch: hipFuncSetAttribute failed\n"); grid = -1; return; }
        if (hipOccupancyMaxActiveBlocksPerMultiprocessor(&per_cu, (const void*)mega_fwd, NTHREADS, LDS_BYTES) != hipSuccess || per_cu < 1) {
            fprintf(stderr, "kernel_launch: occupancy query reports %d workgroups per CU\n", per_cu); (void)hipGetLastError(); grid = -1; return; }
        grid = cus;
    }
    if (grid < 0) return;
    unsigned char* ws = (unsigned char*)d_ws;
    (void)hipMemsetAsync(ws + WS_CTL, 0, 1 * MiB, stream);
    Args a{};
    for (int i = 0; i < 18; ++i) a.in[i] = d_in[i];
    a.out = (float*)d_out; a.ws = ws;
#if NAIVE_MASK != 0
    const float* x = (const float*)d_in[0]; const float* mem = (const float*)d_in[1]; const int* positions = (const int*)d_in[2];
    const float* w_in = (const float*)d_in[3]; const float* w_mem_kv = (const float*)d_in[4]; const float* w_pool = (const float*)d_in[5];
    const float* pool_scale = (const float*)d_in[6]; const float* sinks = (const float*)d_in[7]; const float* w_out = (const float*)d_in[8];
    const float* ln1_g = (const float*)d_in[9]; const float* ln1_b = (const float*)d_in[10]; const float* w_peer_q = (const float*)d_in[11];
    const float* sk1 = (const float*)d_in[12]; const float* sk2 = (const float*)d_in[13]; const float* eu = (const float*)d_in[14]; const float* ev = (const float*)d_in[15];
    const float* ln2_g = (const float*)d_in[16]; const float* ln2_b = (const float*)d_in[17];
    float* out = (float*)d_out;
    float* POOLV = (float*)(ws + WS_POOLV); bf16_t* Q = (bf16_t*)(ws + WS_Q); bf16_t* Kb = (bf16_t*)(ws + WS_K); bf16_t* Vb = (bf16_t*)(ws + WS_V); bf16_t* QM = (bf16_t*)(ws + WS_QM);
    bf16_t* KVM = (bf16_t*)(ws + WS_KVM); bf16_t* CONCAT = (bf16_t*)(ws + WS_CONCAT); float* Y1 = (float*)(ws + WS_Y1); float* X1 = (float*)(ws + WS_X1); bf16_t* X1B = (bf16_t*)(ws + WS_X1B);
    bf16_t* QP = (bf16_t*)(ws + WS_QP); int* EIDX = (int*)(ws + WS_EIDX); float* GATE = (float*)(ws + WS_GATE);
    float* NVH = (float*)(ws + WS_NV_H); float* NVPS = (float*)(ws + WS_NV_PS); float* NVKVM = (float*)(ws + WS_NV_KVM);
#endif
    int li = 0;
    for (int p = 0; p < N_PHASES;) {
#if NAIVE_MASK != 0
        if ((NAIVE_MASK >> p) & 1) {
            switch (p) {
            case 1:
                nv_gemm<float, NvEpiF32><<<dim3(IN_W / 64, MTOK / 64), 256, 0, stream>>>(x, w_in, MTOK, IN_W, D_MODEL, NvEpiF32{NVH, IN_W, 0});
                nv_gemm<float, NvEpiF32><<<dim3(2 * MEM_W / 64, MMEM / 64), 256, 0, stream>>>(mem, w_mem_kv, MMEM, 2 * MEM_W, D_MODEL, NvEpiF32{NVKVM, 2 * MEM_W, 0});
                nv_post1<<<(unsigned)(((size_t)MTOK * IN_W + 255) / 256), 256, 0, stream>>>(NVH, positions, POOLV, Q, Kb, Vb, QM);
                nv_cvt_bf16<<<(MMEM * 2 * MEM_W + 255) / 256, 256, 0, stream>>>(NVKVM, KVM, (size_t)MMEM * 2 * MEM_W);
                break;
            case 2:
                nv_pool1<<<MTOK * POOL_W / 256, 256, 0, stream>>>(POOLV, NVPS);
                nv_pool2<<<MTOK * POOL_W / 256, 256, 0, stream>>>(NVPS, w_pool, pool_scale, CONCAT);
                nv_swa<<<MTOK * NHEAD / 4, 256, 0, stream>>>(Q, Kb, Vb, sinks, CONCAT);
                nv_mem<<<MTOK * MHEADS / 4, 256, 0, stream>>>(QM, KVM, CONCAT);
                break;
            case 3: nv_gemm<bf16_t, NvEpiY1><<<dim3(D_MODEL / 64, MTOK / 64), 256, 0, stream>>>(CONCAT, w_out, MTOK, D_MODEL, D_MODEL, NvEpiY1{x, Y1}); break;
            case 4: nv_ln<<<MTOK / 4, 256, 0, stream>>>(Y1, ln1_g, ln1_b, X1, X1B); break;
            case 5: nv_gemm<float, NvEpiBf><<<dim3(D_MODEL / 64, MTOK / 64), 256, 0, stream>>>(X1, w_peer_q, MTOK, D_MODEL, D_MODEL, NvEpiBf{QP, D_MODEL, 0}); break;
            case 6: nv_topk<<<MTOK * PHEADS / 32, 32, 0, stream>>>(QP, sk1, sk2, EIDX, GATE); break;
            case 7: nv_gather<<<MTOK / 4, 256, 0, stream>>>(X1, EIDX, GATE, eu, ev, ln2_g, ln2_b, out); p = N_PHASES - 1; break;
            default: break;
            }
            ++p; continue;
        }
#endif
        int q = p;
        while (q < N_PHASES && !((NAIVE_MASK >> q) & 1)) ++q;
        a.ph_lo = p; a.ph_hi = q; a.li = li++;
        hipLaunchKernelGGL(mega_fwd, dim3(grid), dim3(NTHREADS), LDS_BYTES, stream, a);
        const hipError_t le = hipPeekAtLastError();
        if (le != hipSuccess) { fprintf(stderr, "kernel_launch: launch failed: %s\n", hipGetErrorName(le)); break; }
        p = q;
    }
#ifdef PROBE_EXTRA_LO
    a.ph_lo = PROBE_EXTRA_LO; a.ph_hi = PROBE_EXTRA_HI; a.li = li++;
    hipLaunchKernelGGL(mega_fwd, dim3(grid), dim3(NTHREADS), LDS_BYTES, stream, a);
#endif
}
```

```cpp
#include <hip/hip_runtime.h>
#include <cstdint>
#include <cstdio>
#ifndef NAIVE_MASK
#define NAIVE_MASK 0
#endif

constexpr int D_MODEL = 2048, BATCH = 2, SEQ = 4096, MTOK = BATCH * SEQ, MEM_LEN = 256, MMEM = BATCH * MEM_LEN;
constexpr int POOL_W = 512, SWA_W = 1024, KV_W = 256, MEM_W = 512, IN_W = 2560;
constexpr int NHEAD = 16, NKV = 4, HD = 64, WINDOW = 128, MHEADS = 4, MHD = 128;
constexpr int PHEADS = 8, NKEYS = 128, TOPK = 16, NEXP = NKEYS * NKEYS, EPT = PHEADS * TOPK;
constexpr float ALPHA = 1.18920711500272106672f;
constexpr float LN_EPS = 1e-5f;

typedef unsigned short bf16_t;
__device__ __forceinline__ float bf2f(bf16_t v) { return __uint_as_float((unsigned)v << 16); }
__device__ __forceinline__ bf16_t f2bf(float f) { unsigned u = __float_as_uint(f); return (bf16_t)((u + 0x7fffu + ((u >> 16) & 1u)) >> 16); }

constexpr size_t MiB = 1u << 20;
constexpr size_t WS_CTL = 0, WS_WINT = 1 * MiB, WS_WKVT = 11 * MiB, WS_WOT = 15 * MiB, WS_WQT = 23 * MiB, WS_SMALL = 31 * MiB;
constexpr size_t WS_XB = 32 * MiB, WS_X1B = 32 * MiB  , WS_MEMB = 64 * MiB, WS_KVM = 66 * MiB;
constexpr size_t WS_POOLV = 68 * MiB, WS_Q = 84 * MiB, WS_K = 100 * MiB, WS_V = 104 * MiB, WS_QM = 108 * MiB, WS_CONCAT = 116 * MiB;
constexpr size_t WS_Y1 = 148 * MiB, WS_X1 = 212 * MiB, WS_QP = 276 * MiB, WS_EIDX = 308 * MiB, WS_GATE = 312 * MiB, WS_UB = 316 * MiB, WS_VB = 380 * MiB, WS_END = 444 * MiB;
constexpr size_t WS_NV_H = 148 * MiB  , WS_NV_PS = 232 * MiB, WS_NV_KVM = 248 * MiB;

__device__ __forceinline__ void rope_cs(int pos, int j, float& c, float& s) {
    const double invf[8] = {1.0, 0.19392274474868576, 0.03760603093086393, 0.007292664737217109, 0.001414213562373095, 0.0002742481756762073, 5.318295896944988e-05, 1.031338537721246e-05};
    double f = j == 0 ? invf[0] : j == 1 ? invf[1] : j == 2 ? invf[2] : j == 3 ? invf[3] : j == 4 ? invf[4] : j == 5 ? invf[5] : j == 6 ? invf[6] : invf[7];
    double rev = (double)pos * f * 0.15915494309189533577;
    rev -= floor(rev);
    float fr = (float)rev;
    s = __builtin_amdgcn_sinf(fr); c = __builtin_amdgcn_cosf(fr);
}
__device__ __forceinline__ float gelu_erf(float h) { return 0.5f * h * (1.0f + erff(h * 0.70710678118654752440f)); }
__device__ __forceinline__ float wave_sum(float v) {
#pragma unroll
    for (int o = 1; o < 64; o <<= 1) v += __shfl_xor(v, o);
    return v;
}

namespace pg8 {
#define PG8_LAS __attribute__((address_space(3)))
typedef unsigned short bf16_t;
typedef short bf16x8 __attribute__((ext_vector_type(8)));
typedef float f32x4 __attribute__((ext_vector_type(4)));
typedef unsigned u32x4 __attribute__((ext_vector_type(4)));
constexpr int BM = 256, BK = 64, HALF = 128, HTB = HALF * BK * 2  , STAGE_BYTES = 8 * HTB, NXCD = 8, WGM = 8;

__host__ __device__ __forceinline__ int lds_byte(int r, int c) { const int st = (r >> 4) * 2 + (c >> 5), rr = r & 15, cc = c & 31, ob = rr * 64 + cc * 2; return st * 1024 + (ob ^ (((ob >> 9) & 1) << 5)); }
__host__ __device__ __forceinline__ void stage_rc(int b, int& R, int& C) { const int st = b / 1024, sb = b % 1024, swz = sb ^ (((sb >> 9) & 1) << 5); R = (st >> 1) * 16 + swz / 64; C = (st & 1) * 32 + (swz % 64) / 2; }
__host__ __device__ __forceinline__ int perm32(int rho) { const int n = rho >> 4, i = rho & 15; return 8 * (i >> 2) + 4 * n + (i & 3); }

struct Unit { int pm, pn; };
struct Gemm { const bf16_t* A; const bf16_t* Bt; int M, N, K; };

struct StaticOrder {
    int nM, nN, nwg, G, c;
    __host__ __device__ void init(int M, int N, int G_, int c_) { nM = M / BM; nN = N / BM; nwg = nM * nN; G = G_; c = c_; }
    __host__ __device__ bool next(int i, Unit& u) const {
        const long L = (long)i * G + c; if (L >= nwg) return false;
        int wgid = (int)L; { const int q = nwg / NXCD, r = nwg % NXCD, xcd = wgid % NXCD, off = wgid / NXCD; wgid = (xcd < r ? xcd * (q + 1) : r * (q + 1) + (xcd - r) * q) + off; }
        const int nig = WGM * nN, gid = wgid / nig, fm = gid * WGM, gsz = (nM - fm) < WGM ? (nM - fm) : WGM;
        u.pm = fm + ((wgid % nig) % gsz); u.pn = (wgid % nig) / gsz; return true;
    }
    __device__ __forceinline__ void a_ready(const Unit&) const {}
    __device__ __forceinline__ void done(const Unit&) const {}
};

__device__ __forceinline__ unsigned cvt_pk_bf16(float lo, float hi) { unsigned r; asm volatile("v_cvt_pk_bf16_f32 %0, %1, %2" : "=v"(r) : "v"(lo), "v"(hi)); return r; }
template <class Epi, class Sched, bool ALIGN_EPI = false, bool SP2 = false>
__device__ __forceinline__ void gemm_phase(PG8_LAS unsigned char* lds, const Gemm g, const Sched& S, const Epi& E) {
    const int tid = threadIdx.x, wid = __builtin_amdgcn_readfirstlane(tid >> 6), lane = tid & 63, wr = wid >> 2, wc = wid & 3, fr = lane & 15, fq = lane >> 4;
    const int K = g.K, nt = K / BK;
    unsigned voffA[2], voffB[2];
#pragma unroll
    for (int i = 0; i < 2; ++i) { int R, C; stage_rc(tid * 16 + i * 8192, R, C); const int Rb = Epi::PERM ? ((R & ~31) + perm32(R & 31)) : R;
        voffA[i] = (unsigned)(R * K + C) * 2u; voffB[i] = (unsigned)(Rb * K + C) * 2u; }
    const size_t kstep = (size_t)(BK * 2);
    const size_t hstep = (size_t)HALF * K * 2;
    const size_t tstep = 2 * hstep;
    const unsigned ldsw = (unsigned)wid * 1024u;
    const int aoff = lds_byte(wr * 64 + fr, fq * 8), boff = lds_byte(wc * 32 + fr, fq * 8);
#define PG8_SA(b, h) (((b) * 2 + (h)) * HTB)
#define PG8_SB(b, h) ((4 + (b) * 2 + (h)) * HTB)
#define PG8_STAGE(bufoff, gbase, voff) do { _Pragma("unroll") for (int _i = 0; _i < 2; ++_i) \
        __builtin_amdgcn_global_load_lds((const unsigned*)((const char*)(gbase) + (voff)[_i]), (PG8_LAS unsigned*)(lds + (bufoff) + ldsw + _i * 8192), 16, 0, 0); } while (0)
#define PG8_LDA(dst, b, h) do { _Pragma("unroll") for (int m = 0; m < 4; ++m) _Pragma("unroll") for (int k = 0; k < 2; ++k) dst[m][k] = *(const PG8_LAS bf16x8*)(lds + PG8_SA(b, h) + aoff + m * 2048 + k * 1024); } while (0)
#define PG8_LDB(dst, b, h) do { _Pragma("unroll") for (int n = 0; n < 2; ++n) _Pragma("unroll") for (int k = 0; k < 2; ++k) dst[n][k] = *(const PG8_LAS bf16x8*)(lds + PG8_SB(b, h) + boff + n * 2048 + k * 1024); } while (0)
#define PG8_MMA(ai, bj, At, Bt) do { __builtin_amdgcn_s_setprio(1); _Pragma("unroll") for (int m = 0; m < 4; ++m) _Pragma("unroll") for (int n = 0; n < 2; ++n) _Pragma("unroll") for (int k = 0; k < 2; ++k) \
        acc[ai][bj][m][n] = __builtin_amdgcn_mfma_f32_16x16x32_bf16(Bt[n][k], At[m][k], acc[ai][bj][m][n], 0, 0, 0); __builtin_amdgcn_s_setprio(0); } while (0)
#define PG8_WAIT_V(n) asm volatile("s_waitcnt vmcnt(" #n ")" ::: "memory")
#define PG8_WAIT_L(n) asm volatile("s_waitcnt lgkmcnt(" #n ")" ::: "memory")
#define PG8_BAR __builtin_amdgcn_s_barrier()
#define PG8_SCHED __builtin_amdgcn_sched_barrier(0)
    Unit cur, nxt; int ui = 0;
    if (!S.next(0, cur)) return;
    f32x4 acc[2][2][4][2];
#pragma unroll
    for (int a = 0; a < 2; ++a)
#pragma unroll
        for (int b = 0; b < 2; ++b)
#pragma unroll
            for (int m = 0; m < 4; ++m)
#pragma unroll
                for (int n = 0; n < 2; ++n) acc[a][b][m][n] = (f32x4){0.f, 0.f, 0.f, 0.f};
    bf16x8 At[4][2], B0[2][2], B1[2][2];
    const char* cA = (const char*)g.A + (size_t)cur.pm * tstep; const char* cB = (const char*)g.Bt + (size_t)cur.pn * tstep;
    S.a_ready(cur);
    if constexpr (SP2) {
        PG8_STAGE(PG8_SB(0, 0), cB, voffB); PG8_STAGE(PG8_SB(0, 1), cB + hstep, voffB); PG8_STAGE(PG8_SA(0, 0), cA, voffA); PG8_STAGE(PG8_SA(0, 1), cA + hstep, voffA);
        if (wr == 1) PG8_BAR;
        PG8_WAIT_V(2); PG8_BAR;
        PG8_STAGE(PG8_SB(1, 0), cB + kstep, voffB); PG8_STAGE(PG8_SA(1, 0), cA + kstep, voffA); PG8_STAGE(PG8_SB(1, 1), cB + hstep + kstep, voffB);
        PG8_WAIT_V(6); PG8_BAR;
    } else {
        PG8_STAGE(PG8_SB(0, 0), cB, voffB); PG8_STAGE(PG8_SA(0, 0), cA, voffA); PG8_STAGE(PG8_SB(0, 1), cB + hstep, voffB); PG8_STAGE(PG8_SA(0, 1), cA + hstep, voffA);
        if (wr == 1) PG8_BAR;
        PG8_WAIT_V(4); PG8_BAR;
        PG8_STAGE(PG8_SB(1, 0), cB + kstep, voffB); PG8_STAGE(PG8_SA(1, 0), cA + kstep, voffA); PG8_STAGE(PG8_SB(1, 1), cB + hstep + kstep, voffB);
        PG8_WAIT_V(6); PG8_BAR;
    }
    for (;;) {
        const bool has_next = S.next(ui + 1, nxt);
        const char* nA = has_next ? (const char*)g.A + (size_t)nxt.pm * tstep : cA; const char* nB = has_next ? (const char*)g.Bt + (size_t)nxt.pn * tstep : cB;
        for (int t = 0; t < nt; t += 2) {
            const bool last = (t == nt - 2);
            const char* a1 = cA + (size_t)(t + 1) * kstep;
            const char* a2 = last ? nA : cA + (size_t)(t + 2) * kstep; const char* b2 = last ? nB : cB + (size_t)(t + 2) * kstep;
            const char* a3 = a2 + kstep; const char* b3 = b2 + kstep;
            if (last && has_next) S.a_ready(nxt);
            if constexpr (SP2) {
            PG8_LDB(B0, 0, 0); PG8_LDB(B1, 0, 1); PG8_SCHED; PG8_LDA(At, 0, 0); PG8_STAGE(PG8_SA(1, 1), a1 + hstep, voffA);
            PG8_WAIT_V(8); PG8_WAIT_L(0); PG8_BAR; PG8_MMA(0, 0, At, B0); PG8_MMA(0, 1, At, B1); PG8_BAR; PG8_SCHED;
            PG8_LDA(At, 0, 1); PG8_STAGE(PG8_SB(0, 0), b2, voffB); PG8_STAGE(PG8_SB(0, 1), b2 + hstep, voffB); PG8_STAGE(PG8_SA(0, 0), a2, voffA);
            PG8_WAIT_V(8); PG8_WAIT_L(0); PG8_BAR; PG8_MMA(1, 0, At, B0); PG8_MMA(1, 1, At, B1); PG8_BAR; PG8_SCHED;
            PG8_LDB(B0, 1, 0); PG8_LDB(B1, 1, 1); PG8_SCHED; PG8_LDA(At, 1, 0); PG8_STAGE(PG8_SA(0, 1), a2 + hstep, voffA);
            PG8_WAIT_V(8); PG8_WAIT_L(0); PG8_BAR; PG8_MMA(0, 0, At, B0); PG8_MMA(0, 1, At, B1); PG8_BAR; PG8_SCHED;
            PG8_LDA(At, 1, 1); PG8_STAGE(PG8_SB(1, 0), b3, voffB); PG8_STAGE(PG8_SB(1, 1), b3 + hstep, voffB); PG8_STAGE(PG8_SA(1, 0), a3, voffA);
            PG8_WAIT_V(8); PG8_WAIT_L(0); PG8_BAR; PG8_MMA(1, 0, At, B0); PG8_MMA(1, 1, At, B1); PG8_BAR; PG8_SCHED;
            } else {
            PG8_LDB(B0, 0, 0); PG8_SCHED; PG8_LDA(At, 0, 0); PG8_STAGE(PG8_SA(1, 1), a1 + hstep, voffA);
            PG8_WAIT_L(8); PG8_BAR; PG8_WAIT_L(0); PG8_MMA(0, 0, At, B0); PG8_BAR; PG8_SCHED;
            PG8_LDB(B1, 0, 1); PG8_STAGE(PG8_SB(0, 0), b2, voffB);
            PG8_BAR; PG8_WAIT_L(0); PG8_MMA(0, 1, At, B1); PG8_BAR;
            PG8_LDA(At, 0, 1); PG8_STAGE(PG8_SA(0, 0), a2, voffA);
            PG8_BAR; PG8_WAIT_L(0); PG8_MMA(1, 0, At, B0); PG8_BAR; PG8_SCHED;
            PG8_STAGE(PG8_SB(0, 1), b2 + hstep, voffB);
            PG8_WAIT_V(6); PG8_BAR; PG8_MMA(1, 1, At, B1); PG8_BAR;
            PG8_LDB(B0, 1, 0); PG8_SCHED; PG8_LDA(At, 1, 0); PG8_STAGE(PG8_SA(0, 1), a2 + hstep, voffA);
            PG8_WAIT_L(8); PG8_BAR; PG8_WAIT_L(0); PG8_MMA(0, 0, At, B0); PG8_BAR; PG8_SCHED;
            PG8_LDB(B1, 1, 1); PG8_STAGE(PG8_SB(1, 0), b3, voffB);
            PG8_BAR; PG8_WAIT_L(0); PG8_MMA(0, 1, At, B1); PG8_BAR;
            PG8_LDA(At, 1, 1); PG8_STAGE(PG8_SA(1, 0), a3, voffA);
            PG8_BAR; PG8_WAIT_L(0); PG8_MMA(1, 0, At, B0); PG8_BAR; PG8_SCHED;
            PG8_STAGE(PG8_SB(1, 1), b3 + hstep, voffB);
            PG8_WAIT_V(6); PG8_BAR; PG8_MMA(1, 1, At, B1); PG8_BAR;
            }
        }
        if constexpr (ALIGN_EPI) { if (wr == 0) PG8_BAR; }
        if constexpr (!Epi::AFTER_DRAIN) { E(acc, cur, wr, wc, fr, fq); S.done(cur); }
        if (!has_next) break;
#pragma unroll
        for (int a = 0; a < 2; ++a)
#pragma unroll
            for (int b = 0; b < 2; ++b)
#pragma unroll
                for (int m = 0; m < 4; ++m)
#pragma unroll
                    for (int n = 0; n < 2; ++n) acc[a][b][m][n] = (f32x4){0.f, 0.f, 0.f, 0.f};
        cur = nxt; cA = nA; cB = nB; ++ui;
        if constexpr (ALIGN_EPI) { if (wr == 1) PG8_BAR; }
    }
    PG8_WAIT_V(0);
    if constexpr (!ALIGN_EPI) { if (wr == 0) PG8_BAR; }
    PG8_BAR;
    if constexpr (Epi::AFTER_DRAIN) { E.fused(acc, cur, wr, wc, fr, fq, lds, wid, lane); S.done(cur); }
#undef PG8_SA
#undef PG8_SB
#undef PG8_STAGE
#undef PG8_LDA
#undef PG8_LDB
#undef PG8_MMA
#undef PG8_WAIT_V
#undef PG8_WAIT_L
#undef PG8_BAR
#undef PG8_SCHED
}
}
#define GAS __attribute__((address_space(1)))
#define LAS __attribute__((address_space(3)))
typedef unsigned v4u __attribute__((ext_vector_type(4)));
typedef unsigned v2u __attribute__((ext_vector_type(2)));
typedef float f32x4 __attribute__((ext_vector_type(4)));
typedef float f32x2 __attribute__((ext_vector_type(2)));
typedef short bf16x8 __attribute__((ext_vector_type(8)));
typedef __bf16 bf16x2 __attribute__((ext_vector_type(2)));
constexpr int NWAVES = 8, NTHREADS = NWAVES * 64;
constexpr int LDS_BYTES = 147456, MISC_OFF = LDS_BYTES - 512;
constexpr int CW_BAR = 4096;
constexpr float LOG2E = 1.44269504088896340736f;

__device__ __forceinline__ unsigned cvtpk(float lo, float hi) { f32x2 v = {lo, hi}; bf16x2 b = __builtin_convertvector(v, bf16x2); return __builtin_bit_cast(unsigned, b); }
__device__ __forceinline__ f32x4 mfma16(bf16x8 a, bf16x8 b, f32x4 c) { return __builtin_amdgcn_mfma_f32_16x16x32_bf16(a, b, c, 0, 0, 0); }
__device__ __forceinline__ float dot2bf(unsigned w, unsigned x, float acc) { return __builtin_amdgcn_fdot2_f32_bf16(__builtin_bit_cast(bf16x2, w), __builtin_bit_cast(bf16x2, x), acc, false); }
__device__ __forceinline__ float fexp2(float x) { return __builtin_amdgcn_exp2f(x); }
#define LDS_WAIT() asm volatile("s_waitcnt lgkmcnt(0)" ::: "memory")
__device__ __forceinline__ unsigned umax(unsigned a, unsigned b) { return a > b ? a : b; }
__device__ __forceinline__ unsigned xmax4(unsigned m) { auto r = __builtin_amdgcn_permlane16_swap(m, m, false, false); m = umax(r[0], r[1]); auto q = __builtin_amdgcn_permlane32_swap(m, m, false, false); return umax(q[0], q[1]); }
__device__ __forceinline__ float xfmax4(float v) { unsigned m = __float_as_uint(v); auto r = __builtin_amdgcn_permlane16_swap(m, m, false, false); v = fmaxf(__uint_as_float(r[0]), __uint_as_float(r[1])); m = __float_as_uint(v);
    auto q = __builtin_amdgcn_permlane32_swap(m, m, false, false); return fmaxf(__uint_as_float(q[0]), __uint_as_float(q[1])); }
__device__ __forceinline__ float xfsum4(float v) { unsigned m = __float_as_uint(v); auto r = __builtin_amdgcn_permlane16_swap(m, m, false, false); v = __uint_as_float(r[0]) + __uint_as_float(r[1]); m = __float_as_uint(v);
    auto q = __builtin_amdgcn_permlane32_swap(m, m, false, false); return __uint_as_float(q[0]) + __uint_as_float(q[1]); }

#define XB_TMO      128
#define XB_XCNT(j)  (256  + 64 * (j))
#define XB_XSUB(j)  (1280 + 64 * (j))
#define XB_XGEN(j)  (2304 + 64 * (j))
#define XB_TOP      3328
#define XB_TOPGEN   3392
#define XCD_BAR_WORDS 3456
#define XB_SPIN_CAP (1u << 18)
__device__ __forceinline__ unsigned xb_ld(unsigned* p)              { return __hip_atomic_load(p, __ATOMIC_RELAXED, __HIP_MEMORY_SCOPE_AGENT); }
__device__ __forceinline__ unsigned xb_add(unsigned* p, unsigned v) { return __hip_atomic_fetch_add(p, v, __ATOMIC_RELAXED, __HIP_MEMORY_SCOPE_AGENT); }
__device__ __forceinline__ unsigned xb_xcc_id() { return (unsigned)__builtin_amdgcn_s_getreg((3 << 11) | 20) & 0xFu; }
#define XB_SPIN(cond, bar) do { unsigned _sp = 0; while (cond) { __builtin_amdgcn_s_sleep(1); \
    if ((++_sp & 255u) == 0u) { if (xb_ld(&(bar)[XB_TMO])) break; if (_sp > XB_SPIN_CAP) { atomicAdd(&(bar)[XB_TMO], 1u); break; } } } } while (0)
struct XcdBarrier { unsigned* bar; unsigned x; volatile LAS unsigned* st; };
__device__ __forceinline__ XcdBarrier xcd_barrier_post(unsigned* bar, volatile LAS unsigned* st) {
    XcdBarrier b; b.bar = bar; b.x = xb_xcc_id(); b.st = st;
    if (threadIdx.x == 0) (void)xb_add(&bar[XB_XCNT(b.x)], 1u);
    return b;
}
__device__ __forceinline__ void xcd_barrier_complete(unsigned* bar, unsigned x, unsigned& nloc, unsigned& nx) {
    const unsigned G = gridDim.x * gridDim.y * gridDim.z;
    unsigned sum, cnt, mine, sp = 0u;
    for (;;) {
        sum = 0u; cnt = 0u; mine = 0u;
#pragma unroll
        for (unsigned j = 0; j < 16; ++j) { const unsigned c = xb_ld(&bar[XB_XCNT(j)]); sum += c; cnt += (c > 0u) ? 1u : 0u; mine = (j == x) ? c : mine; }
        if (sum == G) break;
        __builtin_amdgcn_s_sleep(1);
        if ((++sp & 255u) == 0u) { if (xb_ld(&bar[XB_TMO])) break; if (sp > XB_SPIN_CAP) { atomicAdd(&bar[XB_TMO], 1u); break; } }
    }
    nloc = mine > 0u ? mine : 1u; nx = cnt > 0u ? cnt : 1u;
}
__device__ __forceinline__ void xcd_barrier(const XcdBarrier& b) {
    asm volatile("s_waitcnt vmcnt(0)" ::: "memory");
    __syncthreads();
    if (threadIdx.x == 0) {
        unsigned* bar = b.bar;
        __builtin_amdgcn_s_waitcnt(0);
        unsigned nloc = b.st[0], nx = b.st[1];
        if (nloc == 0u) { xcd_barrier_complete(bar, b.x, nloc, nx); b.st[0] = nloc; b.st[1] = nx; }
        const unsigned old = xb_add(&bar[XB_XSUB(b.x)], 1u);
        const unsigned gen = old / nloc;
        if (old + 1u == (gen + 1u) * nloc) {
            __builtin_amdgcn_fence(__ATOMIC_RELEASE, "agent");
            asm volatile("s_waitcnt vmcnt(0)" ::: "memory");
            const unsigned og = xb_add(&bar[XB_TOP], 1u);
            const unsigned tg = og / nx;
            if (og + 1u == (tg + 1u) * nx) xb_add(&bar[XB_TOPGEN], 1u);
            else XB_SPIN(xb_ld(&bar[XB_TOPGEN]) == tg, bar);
            __builtin_amdgcn_fence(__ATOMIC_ACQUIRE, "agent");
            xb_add(&bar[XB_XGEN(b.x)], 1u);
            asm volatile("s_waitcnt vmcnt(0)" ::: "memory");
        } else {
            XB_SPIN(xb_ld(&bar[XB_XGEN(b.x)]) == gen, bar);
            __builtin_amdgcn_fence(__ATOMIC_ACQUIRE, "agent");
            asm volatile("s_waitcnt vmcnt(0)" ::: "memory");
        }
    }
    __syncthreads();
}

struct EpiStoreBf {
    static constexpr bool PERM = true, AFTER_DRAIN = false;
    bf16_t* O; int ldc;
    __device__ __forceinline__ void operator()(const pg8::f32x4 (&acc)[2][2][4][2], const pg8::Unit& u, int wr, int wc, int fr, int fq) const {
        const int row0 = u.pm * 256 + wr * 64 + fr, col0 = u.pn * 256 + wc * 32 + 8 * fq;
#pragma unroll
        for (int ai = 0; ai < 2; ++ai)
#pragma unroll
            for (int m = 0; m < 4; ++m) { bf16_t* rowp = O + (size_t)(row0 + ai * 128 + m * 16) * ldc + col0;
#pragma unroll
                for (int bj = 0; bj < 2; ++bj) { const pg8::f32x4 v0 = acc[ai][bj][m][0], v1 = acc[ai][bj][m][1];
                    v4u w; w.x = cvtpk(v0[0], v0[1]); w.y = cvtpk(v0[2], v0[3]); w.z = cvtpk(v1[0], v1[1]); w.w = cvtpk(v1[2], v1[3]);
                    *(v4u*)(rowp + bj * 128) = w; } }
    }
};
struct EpiY1 {
    static constexpr bool PERM = true, AFTER_DRAIN = false;
    const float* x; float* y;
    __device__ __forceinline__ void operator()(const pg8::f32x4 (&acc)[2][2][4][2], const pg8::Unit& u, int wr, int wc, int fr, int fq) const {
        const int row0 = u.pm * 256 + wr * 64 + fr, col0 = u.pn * 256 + wc * 32 + 8 * fq;
#pragma unroll
        for (int ai = 0; ai < 2; ++ai)
#pragma unroll
            for (int m = 0; m < 4; ++m) { const size_t off = (size_t)(row0 + ai * 128 + m * 16) * D_MODEL + col0;
#pragma unroll
                for (int bj = 0; bj < 2; ++bj) {
                    const f32x4 x0 = *(const f32x4*)(x + off + bj * 128), x1 = *(const f32x4*)(x + off + bj * 128 + 4);
                    *(f32x4*)(y + off + bj * 128) = x0 * ALPHA + acc[ai][bj][m][0]; *(f32x4*)(y + off + bj * 128 + 4) = x1 * ALPHA + acc[ai][bj][m][1]; } }
    }
};
struct EpiIn {
    static constexpr bool PERM = true, AFTER_DRAIN = false;
    float* POOLV; bf16_t *Q, *K, *V, *QM; const float* rope;
    __device__ __forceinline__ void operator()(const pg8::f32x4 (&acc)[2][2][4][2], const pg8::Unit& u, int wr, int wc, int fr, int fq) const {
        const int row0 = u.pm * 256 + wr * 64 + fr, cl = wc * 32 + 8 * fq, pn = u.pn;
        if (pn < 2) {
#pragma unroll
            for (int ai = 0; ai < 2; ++ai)
#pragma unroll
                for (int m = 0; m < 4; ++m) { float* rp = POOLV + (size_t)(row0 + ai * 128 + m * 16) * POOL_W + pn * 256 + cl;
#pragma unroll
                    for (int bj = 0; bj < 2; ++bj) { *(f32x4*)(rp + bj * 128) = acc[ai][bj][m][0]; *(f32x4*)(rp + bj * 128 + 4) = acc[ai][bj][m][1]; } }
            return;
        }
        bf16_t* base; int ld, c0; bool rot = false;
        if (pn < 6) { base = Q; ld = SWA_W; c0 = (pn - 2) * 256; rot = true; }
        else if (pn == 6) { base = K; ld = KV_W; c0 = 0; rot = true; }
        else if (pn == 7) { base = V; ld = KV_W; c0 = 0; }
        else { base = QM; ld = MEM_W; c0 = (pn - 8) * 256; }
        rot = rot && ((wc & 1) == 0);
#pragma unroll
        for (int ai = 0; ai < 2; ++ai)
#pragma unroll
            for (int m = 0; m < 4; ++m) {
                const int row = row0 + ai * 128 + m * 16;
                f32x4 v[2][2];
#pragma unroll
                for (int bj = 0; bj < 2; ++bj) { v[bj][0] = acc[ai][bj][m][0]; v[bj][1] = acc[ai][bj][m][1]; }
                if (rot) {
                    const f32x4* tp = (const f32x4*)(rope + (size_t)row * 16);
                    f32x4 cs[2][2]; cs[0][0] = tp[0]; cs[0][1] = tp[1]; cs[1][0] = tp[2]; cs[1][1] = tp[3];
#pragma unroll
                    for (int bj = 0; bj < 2; ++bj)
#pragma unroll
                        for (int n = 0; n < 2; ++n)
#pragma unroll
                            for (int i = 0; i < 4; ++i) {
                                const float xv = v[bj][n][i], pv = __shfl_xor(xv, 16);
                                const float c = cs[n][i >> 1][2 * (i & 1)], s = cs[n][i >> 1][2 * (i & 1) + 1];
                                const float o = fq == 0 ? xv * c - pv * s : (fq == 1 ? xv * c + pv * s : xv);
                                v[bj][n][i] = o; }
                }
                bf16_t* rowp = base + (size_t)row * ld + c0 + cl;
#pragma unroll
                for (int bj = 0; bj < 2; ++bj) { v4u w; w.x = cvtpk(v[bj][0][0], v[bj][0][1]); w.y = cvtpk(v[bj][0][2], v[bj][0][3]); w.z = cvtpk(v[bj][1][0], v[bj][1][1]); w.w = cvtpk(v[bj][1][2], v[bj][1][3]);
                    *(v4u*)(rowp + bj * 128) = w; }
            }
    }
};

__device__ __forceinline__ void p0_transpose_item(const float* W, int K, int N, bf16_t* WT, LAS float* scr, int item, int lane) {
    const int nblk = N / 32, kb = item / nblk, nb = item % nblk, k0 = 64 * kb, n0 = 32 * nb;
#pragma unroll 8
    for (int i = 0; i < 32; ++i) { const int kk = 2 * i + (lane >> 5); scr[kk * 33 + (lane & 31)] = W[(size_t)(k0 + kk) * N + n0 + (lane & 31)]; }
    LDS_WAIT(); asm volatile("" ::: "memory");
    const int c = lane & 7;
#pragma unroll
    for (int j = 0; j < 4; ++j) { const int n = (lane >> 3) + 8 * j; const LAS float* s = scr + (8 * c) * 33 + n;
        v4u o; o.x = cvtpk(s[0 * 33], s[1 * 33]); o.y = cvtpk(s[2 * 33], s[3 * 33]); o.z = cvtpk(s[4 * 33], s[5 * 33]); o.w = cvtpk(s[6 * 33], s[7 * 33]);
        *(v4u*)(WT + (size_t)(n0 + n) * K + k0 + 8 * c) = o; }
    LDS_WAIT(); asm volatile("" ::: "memory");
}
template <bool NT>
__device__ __forceinline__ void cvt_stream(const float* in, bf16_t* out, size_t n, int gw, int NGW, int lane) {
#pragma unroll 4
    for (size_t i = (size_t)gw * 512 + lane * 4; i < n; i += (size_t)NGW * 512) {
        f32x4 a, b;
        if (NT) { a = __builtin_nontemporal_load((const f32x4*)(in + i)); b = __builtin_nontemporal_load((const f32x4*)(in + i + 256)); }
        else { a = *(const f32x4*)(in + i); b = *(const f32x4*)(in + i + 256); }
        v2u o0, o1; o0.x = cvtpk(a.x, a.y); o0.y = cvtpk(a.z, a.w); o1.x = cvtpk(b.x, b.y); o1.y = cvtpk(b.z, b.w);
        *(v2u*)(out + i) = o0; *(v2u*)(out + i + 256) = o1;
    }
}

constexpr int SWA_KROW = 144, SWA_VROW = 528, SWA_VT_OFF = 256 * SWA_KROW;
__device__ __forceinline__ void swa_item(LAS unsigned char* lds, int item, const bf16_t* __restrict__ Q, const bf16_t* __restrict__ Kb, const bf16_t* __restrict__ Vb, const float* __restrict__ sinks,
                                         bf16_t* CONCAT, int tid, int wave, int lane) {
    const int qb = item & 31, kvh = (item >> 5) & 3, b = item >> 7;
    const int tok0 = b * SEQ + qb * 128;
    LAS unsigned char* Kl = lds; LAS unsigned char* Vt = lds + SWA_VT_OFF;
#pragma unroll
    for (int j = 0; j < 4; ++j) {
        const int c = tid + NTHREADS * j, row = c >> 3, part = c & 7;
        v4u kv = {0u, 0u, 0u, 0u}, vv = {0u, 0u, 0u, 0u};
        if (qb > 0 || row >= 128) { const size_t tk = (size_t)(tok0 - 128 + row); kv = *(const v4u*)(Kb + tk * KV_W + kvh * HD + part * 8); vv = *(const v4u*)(Vb + tk * KV_W + kvh * HD + part * 8); }
        *(LAS v4u*)(Kl + row * SWA_KROW + part * 16) = kv;
        LAS unsigned short* vp = (LAS unsigned short*)(Vt + (part * 8) * SWA_VROW + row * 2);
        vp[0 * (SWA_VROW / 2)] = (unsigned short)(vv.x & 0xffffu); vp[1 * (SWA_VROW / 2)] = (unsigned short)(vv.x >> 16);
        vp[2 * (SWA_VROW / 2)] = (unsigned short)(vv.y & 0xffffu); vp[3 * (SWA_VROW / 2)] = (unsigned short)(vv.y >> 16);
        vp[4 * (SWA_VROW / 2)] = (unsigned short)(vv.z & 0xffffu); vp[5 * (SWA_VROW / 2)] = (unsigned short)(vv.z >> 16);
        vp[6 * (SWA_VROW / 2)] = (unsigned short)(vv.w & 0xffffu); vp[7 * (SWA_VROW / 2)] = (unsigned short)(vv.w >> 16);
    }
    __syncthreads();
    const int g = wave & 3, h = kvh * 4 + g, q15 = lane & 15, qq = lane >> 4;
    const float sink2 = sinks[h] * LOG2E;
    const float SC = 0.125f * LOG2E;
#pragma unroll 1
    for (int cc = 0; cc < 2; ++cc) {
        const int c = 2 * (wave >> 2) + cc, kl0 = 32 * c;
        bf16x8 qf[2][2];
#pragma unroll
        for (int ni = 0; ni < 2; ++ni)
#pragma unroll
            for (int ks = 0; ks < 2; ++ks) qf[ni][ks] = *(const bf16x8*)(Q + (size_t)(tok0 + 32 * c + 16 * ni + q15) * SWA_W + h * HD + 32 * ks + 8 * qq);
        f32x4 s[10][2];
#pragma unroll
        for (int mi = 0; mi < 10; ++mi) { s[mi][0] = (f32x4){0.f, 0.f, 0.f, 0.f}; s[mi][1] = (f32x4){0.f, 0.f, 0.f, 0.f}; }
#pragma unroll
        for (int mi = 0; mi < 10; ++mi)
#pragma unroll
            for (int ks = 0; ks < 2; ++ks) {
                const bf16x8 kf = *(const LAS bf16x8*)(Kl + (kl0 + 16 * mi + q15) * SWA_KROW + (32 * ks + 8 * qq) * 2);
                s[mi][0] = mfma16(kf, qf[0][ks], s[mi][0]); s[mi][1] = mfma16(kf, qf[1][ks], s[mi][1]);
            }
        float rl[2];
#pragma unroll
        for (int ni = 0; ni < 2; ++ni) {
            const int ql = 32 * c + 16 * ni + q15;
            float mx = -INFINITY;
#pragma unroll
            for (int mi = 0; mi < 10; ++mi)
#pragma unroll
                for (int r = 0; r < 4; ++r) {
                    const int kl = kl0 + 16 * mi + 4 * qq + r;
                    const bool valid = (kl > ql) && (kl <= ql + 128) && (qb > 0 || kl >= 128);
                    const float t = valid ? s[mi][ni][r] * SC : -INFINITY;
                    s[mi][ni][r] = t; mx = fmaxf(mx, t);
                }
            mx = fmaxf(xfmax4(mx), sink2);
            float l = 0.f;
#pragma unroll
            for (int mi = 0; mi < 10; ++mi)
#pragma unroll
                for (int r = 0; r < 4; ++r) { const float p = fexp2(s[mi][ni][r] - mx); s[mi][ni][r] = p; l += p; }
            l = xfsum4(l) + fexp2(sink2 - mx);
            rl[ni] = 1.0f / l;
        }
        f32x4 o[4][2];
#pragma unroll
        for (int dt = 0; dt < 4; ++dt) { o[dt][0] = (f32x4){0.f, 0.f, 0.f, 0.f}; o[dt][1] = (f32x4){0.f, 0.f, 0.f, 0.f}; }
#pragma unroll
        for (int kk = 0; kk < 5; ++kk) {
            bf16x8 pf[2];
#pragma unroll
            for (int ni = 0; ni < 2; ++ni) {
                v4u w; w.x = cvtpk(s[2 * kk][ni][0], s[2 * kk][ni][1]); w.y = cvtpk(s[2 * kk][ni][2], s[2 * kk][ni][3]);
                w.z = cvtpk(s[2 * kk + 1][ni][0], s[2 * kk + 1][ni][1]); w.w = cvtpk(s[2 * kk + 1][ni][2], s[2 * kk + 1][ni][3]);
                pf[ni] = __builtin_bit_cast(bf16x8, w);
            }
#pragma unroll
            for (int dt = 0; dt < 4; ++dt) {
                const LAS unsigned char* vb = Vt + (16 * dt + q15) * SWA_VROW + (kl0 + 32 * kk + 4 * qq) * 2;
                const v2u lo = *(const LAS v2u*)vb, hi = *(const LAS v2u*)(vb + 32);
                v4u w; w.x = lo.x; w.y = lo.y; w.z = hi.x; w.w = hi.y;
                const bf16x8 vf = __builtin_bit_cast(bf16x8, w);
                o[dt][0] = mfma16(vf, pf[0], o[dt][0]); o[dt][1] = mfma16(vf, pf[1], o[dt][1]);
            }
        }
#pragma unroll
        for (int ni = 0; ni < 2; ++ni) {
            bf16_t* orow = CONCAT + (size_t)(tok0 + 32 * c + 16 * ni + q15) * D_MODEL + POOL_W + h * HD + 4 * qq;
#pragma unroll
            for (int dt = 0; dt < 4; ++dt) { v2u w; w.x = cvtpk(o[dt][ni][0] * rl[ni], o[dt][ni][1] * rl[ni]); w.y = cvtpk(o[dt][ni][2] * rl[ni], o[dt][ni][3] * rl[ni]); *(v2u*)(orow + 16 * dt) = w; }
        }
    }
    __syncthreads();
}
constexpr int MEM_KROW = 272, MEM_VROW = 528, MEM_VT_OFF = 256 * MEM_KROW;
__device__ __forceinline__ void mem_item(LAS unsigned char* lds, int item, const bf16_t* __restrict__ QM, const bf16_t* __restrict__ KVM, bf16_t* CONCAT, int tid, int wave, int lane) {
    const int qt = item & 31, hm = (item >> 5) & 3, b = item >> 7;
    LAS unsigned char* Kl = lds; LAS unsigned char* Vt = lds + MEM_VT_OFF;
#pragma unroll
    for (int j = 0; j < 8; ++j) {
        const int c = tid + NTHREADS * j, row = c >> 4, part = c & 15;
        const bf16_t* src = KVM + (size_t)(b * MEM_LEN + row) * (2 * MEM_W) + hm * MHD + part * 8;
        const v4u kv = *(const v4u*)src, vv = *(const v4u*)(src + MEM_W);
        *(LAS v4u*)(Kl + row * MEM_KROW + part * 16) = kv;
        LAS unsigned short* vp = (LAS unsigned short*)(Vt + (part * 8) * MEM_VROW + row * 2);
        vp[0 * (MEM_VROW / 2)] = (unsigned short)(vv.x & 0xffffu); vp[1 * (MEM_VROW / 2)] = (unsigned short)(vv.x >> 16);
        vp[2 * (MEM_VROW / 2)] = (unsigned short)(vv.y & 0xffffu); vp[3 * (MEM_VROW / 2)] = (unsigned short)(vv.y >> 16);
        vp[4 * (MEM_VROW / 2)] = (unsigned short)(vv.z & 0xffffu); vp[5 * (MEM_VROW / 2)] = (unsigned short)(vv.z >> 16);
        vp[6 * (MEM_VROW / 2)] = (unsigned short)(vv.w & 0xffffu); vp[7 * (MEM_VROW / 2)] = (unsigned short)(vv.w >> 16);
    }
    __syncthreads();
    const int q15 = lane & 15, qq = lane >> 4;
    const int tok = b * SEQ + qt * 128 + wave * 16 + q15;
    const float SC = 0.08838834764831845f * LOG2E;
    bf16x8 qf[4];
#pragma unroll
    for (int ks = 0; ks < 4; ++ks) qf[ks] = *(const bf16x8*)(QM + (size_t)tok * MEM_W + hm * MHD + 32 * ks + 8 * qq);
    f32x4 s[16];
#pragma unroll
    for (int mi = 0; mi < 16; ++mi) s[mi] = (f32x4){0.f, 0.f, 0.f, 0.f};
#pragma unroll
    for (int mi = 0; mi < 16; ++mi)
#pragma unroll
        for (int ks = 0; ks < 4; ++ks) {
            const bf16x8 kf = *(const LAS bf16x8*)(Kl + (16 * mi + q15) * MEM_KROW + (32 * ks + 8 * qq) * 2);
            s[mi] = mfma16(kf, qf[ks], s[mi]);
        }
    float mx = -INFINITY;
#pragma unroll
    for (int mi = 0; mi < 16; ++mi)
#pragma unroll
        for (int r = 0; r < 4; ++r) { const float t = s[mi][r] * SC; s[mi][r] = t; mx = fmaxf(mx, t); }
    mx = xfmax4(mx);
    float l = 0.f;
#pragma unroll
    for (int mi = 0; mi < 16; ++mi)
#pragma unroll
        for (int r = 0; r < 4; ++r) { const float p = fexp2(s[mi][r] - mx); s[mi][r] = p; l += p; }
    l = xfsum4(l);
    const float rl = 1.0f / l;
    f32x4 o[8];
#pragma unroll
    for (int dt = 0; dt < 8; ++dt) o[dt] = (f32x4){0.f, 0.f, 0.f, 0.f};
#pragma unroll
    for (int kk = 0; kk < 8; ++kk) {
        v4u pw; pw.x = cvtpk(s[2 * kk][0], s[2 * kk][1]); pw.y = cvtpk(s[2 * kk][2], s[2 * kk][3]); pw.z = cvtpk(s[2 * kk + 1][0], s[2 * kk + 1][1]); pw.w = cvtpk(s[2 * kk + 1][2], s[2 * kk + 1][3]);
        const bf16x8 pf = __builtin_bit_cast(bf16x8, pw);
#pragma unroll
        for (int dt = 0; dt < 8; ++dt) {
            const LAS unsigned char* vb = Vt + (16 * dt + q15) * MEM_VROW + (32 * kk + 4 * qq) * 2;
            const v2u lo = *(const LAS v2u*)vb, hi = *(const LAS v2u*)(vb + 32);
            v4u w; w.x = lo.x; w.y = lo.y; w.z = hi.x; w.w = hi.y;
            o[dt] = mfma16(__builtin_bit_cast(bf16x8, w), pf, o[dt]);
        }
    }
    bf16_t* orow = CONCAT + (size_t)tok * D_MODEL + POOL_W + SWA_W + hm * MHD + 4 * qq;
#pragma unroll
    for (int dt = 0; dt < 8; ++dt) { v2u w; w.x = cvtpk(o[dt][0] * rl, o[dt][1] * rl); w.y = cvtpk(o[dt][2] * rl, o[dt][3] * rl); *(v2u*)(orow + 16 * dt) = w; }
    __syncthreads();
}
constexpr int POOL_LROW = 272, POOL_LDS_PER_WAVE = 16 * POOL_LROW;
template <int W>
__device__ __forceinline__ void pool_window(LAS unsigned char* wl, const float* __restrict__ pv, int sp0, int lane) {
    f32x2 cur[16];
#pragma unroll
    for (int tt = 0; tt < 16; ++tt) cur[tt] = *(const f32x2*)(pv + (size_t)tt * POOL_W);
    f32x2 prev[W - 1];
#pragma unroll
    for (int i = 1; i < W; ++i) { const bool ok = (i <= sp0); const size_t back = ok ? (size_t)i * POOL_W : 0; const f32x2 v = *(const f32x2*)(pv - back); prev[i - 1] = ok ? v : (f32x2){0.f, 0.f}; }
    f32x2 S = {0.f, 0.f};
#pragma unroll
    for (int i = 1; i < W; ++i) S += prev[i - 1];
#pragma unroll
    for (int tt = 0; tt < 16; ++tt) {
        S += cur[tt];
        const int sp = sp0 + tt; const int cnt = (sp + 1) < W ? (sp + 1) : W;
        const f32x2 pooled = S * (1.0f / (float)cnt) - cur[tt];
        *(LAS unsigned*)(wl + tt * POOL_LROW + 4 * lane) = cvtpk(pooled.x, pooled.y);
        if (tt - W + 1 >= 0) S -= cur[tt - W + 1 >= 0 ? tt - W + 1 : 0]; else S -= prev[(W - 1 - tt) - 1 >= 0 ? (W - 1 - tt) - 1 : 0];
    }
}
__device__ __forceinline__ void pool_item(LAS unsigned char* wl, int item, const float* __restrict__ POOLV, const bf16_t* __restrict__ WPT, const float* __restrict__ pool_scale, bf16_t* CONCAT, int lane) {
    const int g = item & 3, t0 = (item >> 2) * 16, q15 = lane & 15, qq = lane >> 4;
    const int sp0 = t0 & (SEQ - 1);
    const float* pv = POOLV + (size_t)t0 * POOL_W + g * 128 + 2 * lane;
    if (g == 0) pool_window<2>(wl, pv, sp0, lane); else if (g == 1) pool_window<4>(wl, pv, sp0, lane); else if (g == 2) pool_window<8>(wl, pv, sp0, lane); else pool_window<16>(wl, pv, sp0, lane);
    LDS_WAIT(); asm volatile("" ::: "memory");
    bf16x8 pf[4];
#pragma unroll
    for (int ks = 0; ks < 4; ++ks) pf[ks] = *(const LAS bf16x8*)(wl + q15 * POOL_LROW + (32 * ks + 8 * qq) * 2);
    const int t = t0 + q15;
    bf16_t* orow = CONCAT + (size_t)t * D_MODEL + g * 128 + 4 * qq;
#pragma unroll
    for (int mt = 0; mt < 8; ++mt) {
        f32x4 acc = {0.f, 0.f, 0.f, 0.f};
#pragma unroll
        for (int ks = 0; ks < 4; ++ks) { const bf16x8 wf = *(const bf16x8*)(WPT + (size_t)g * 16384 + (16 * mt + q15) * 128 + 32 * ks + 8 * qq); acc = mfma16(wf, pf[ks], acc); }
        const f32x4 sc = *(const f32x4*)(pool_scale + g * 128 + 16 * mt + 4 * qq);
        v2u wv; wv.x = cvtpk(acc[0] * sc[0], acc[1] * sc[1]); wv.y = cvtpk(acc[2] * sc[2], acc[3] * sc[3]);
        *(v2u*)(orow + 16 * mt) = wv;
    }
    LDS_WAIT(); asm volatile("" ::: "memory");
}

__device__ __forceinline__ void ln1_row(const float* __restrict__ yrow, const float* __restrict__ g, const float* __restrict__ bta, float* xo, bf16_t* xb, int lane) {
    f32x4 v[8]; float s = 0.f;
#pragma unroll
    for (int j = 0; j < 8; ++j) { v[j] = *(const f32x4*)(yrow + 256 * j + 4 * lane); s += (v[j].x + v[j].y) + (v[j].z + v[j].w); }
    const float mean = wave_sum(s) * (1.f / D_MODEL); float q = 0.f;
#pragma unroll
    for (int j = 0; j < 8; ++j) { v[j] = v[j] - mean; q += (v[j].x * v[j].x + v[j].y * v[j].y) + (v[j].z * v[j].z + v[j].w * v[j].w); }
    const float rstd = 1.0f / sqrtf(wave_sum(q) * (1.f / D_MODEL) + LN_EPS);
#pragma unroll
    for (int j = 0; j < 8; ++j) {
        const f32x4 gg = *(const f32x4*)(g + 256 * j + 4 * lane), bb = *(const f32x4*)(bta + 256 * j + 4 * lane);
        const f32x4 y = v[j] * rstd * gg + bb;
        *(f32x4*)(xo + 256 * j + 4 * lane) = y;
        v2u w; w.x = cvtpk(y.x, y.y); w.y = cvtpk(y.z, y.w); *(v2u*)(xb + 256 * j + 4 * lane) = w;
    }
}

__device__ __forceinline__ unsigned f2ord(float f) { const unsigned u = __float_as_uint(f); return u ^ ((unsigned)((int)u >> 31) | 0x80000000u); }
__device__ __forceinline__ float ord2f(unsigned o) { const unsigned u = (o & 0x80000000u) ? (o ^ 0x80000000u) : ~o; return __uint_as_float(u); }
constexpr int TK_KROW = 272, TK_HALF = 128 * TK_KROW;
__device__ __forceinline__ void topk_item(int item, const bf16_t* __restrict__ QP, const LAS unsigned char* Kl, int* EIDX, float* GATE, int lane) {
    const int h = item & 7, t0 = (item >> 3) * 16, q15 = lane & 15, qq = lane >> 4;
    const int t = t0 + q15;
    unsigned top[2][16];
#pragma unroll
    for (int half = 0; half < 2; ++half) {
        bf16x8 qf[4];
#pragma unroll
        for (int ks = 0; ks < 4; ++ks) qf[ks] = *(const bf16x8*)(QP + (size_t)t * D_MODEL + h * 256 + half * 128 + 32 * ks + 8 * qq);
        unsigned key[32];
#pragma unroll
        for (int mi = 0; mi < 8; ++mi) {
            f32x4 acc = {0.f, 0.f, 0.f, 0.f};
#pragma unroll
            for (int ks = 0; ks < 4; ++ks) { const bf16x8 kf = *(const LAS bf16x8*)(Kl + half * TK_HALF + (16 * mi + q15) * TK_KROW + (32 * ks + 8 * qq) * 2); acc = mfma16(kf, qf[ks], acc); }
#pragma unroll
            for (int r = 0; r < 4; ++r) key[mi * 4 + r] = (f2ord(acc[r]) & ~0x7Fu) | (unsigned)(127 - (16 * mi + 4 * qq + r));
        }
#pragma unroll
        for (int r = 0; r < 16; ++r) {
            unsigned t1[11];
#pragma unroll
            for (int i = 0; i < 10; ++i) t1[i] = umax(umax(key[3 * i], key[3 * i + 1]), key[3 * i + 2]);
            t1[10] = umax(key[30], key[31]);
            const unsigned u0 = umax(umax(t1[0], t1[1]), t1[2]), u1 = umax(umax(t1[3], t1[4]), t1[5]), u2 = umax(umax(t1[6], t1[7]), t1[8]), u3 = umax(t1[9], t1[10]);
            const unsigned M = xmax4(umax(umax(umax(u0, u1), u2), u3));
            top[half][r] = M;
#pragma unroll
            for (int i = 0; i < 32; ++i) key[i] = (key[i] == M) ? 0u : key[i];
            __builtin_amdgcn_sched_barrier(0);
        }
        __builtin_amdgcn_sched_barrier(0);
    }
    float v1[16], v2[16]; unsigned e1[16], e2[16];
#pragma unroll
    for (int r = 0; r < 16; ++r) { v1[r] = ord2f(top[0][r] & ~0x7Fu); v2[r] = ord2f(top[1][r] & ~0x7Fu); e1[r] = (127u - (top[0][r] & 0x7Fu)) * 128u; e2[r] = 127u - (top[1][r] & 0x7Fu); }
    unsigned ck[13], ce[13];
#pragma unroll
    for (int i = 0; i < 13; ++i) { ck[i] = 0u; ce[i] = 0u; }
    {
        int n = 0;
#pragma unroll
        for (int a = 0; a < 16; ++a)
#pragma unroll
            for (int bb = 0; bb < 16; ++bb)
                if ((a + 1) * (bb + 1) <= 16) {
                    const unsigned pk = (f2ord(v1[a] + v2[bb]) & ~0xFFu) | (unsigned)(255 - (a * 16 + bb));
                    const unsigned ee = e1[a] + e2[bb];
                    const bool me = (qq == (n & 3));
                    ck[n >> 2] = me ? pk : ck[n >> 2]; ce[n >> 2] = me ? ee : ce[n >> 2];
                    ++n;
                }
    }
    float sc[16];
#pragma unroll
    for (int r = 0; r < 16; ++r) {
        const unsigned c0 = umax(umax(ck[0], ck[1]), ck[2]), c1 = umax(umax(ck[3], ck[4]), ck[5]), c2 = umax(umax(ck[6], ck[7]), ck[8]), c3 = umax(umax(ck[9], ck[10]), ck[11]);
        const unsigned Lm = umax(umax(umax(c0, c1), umax(c2, c3)), ck[12]);
        const unsigned M = xmax4(Lm);
        unsigned we = 0u;
#pragma unroll
        for (int i = 0; i < 13; ++i) { const bool hit = (ck[i] == M); we = hit ? ce[i] : we; ck[i] = hit ? 0u : ck[i]; }
        sc[r] = ord2f(M & ~0xFFu);
        if (Lm == M) EIDX[(size_t)t * EPT + h * TOPK + r] = (int)we;
        __builtin_amdgcn_sched_barrier(0);
    }
    const float smax = sc[0];
    float den = 0.f;
#pragma unroll
    for (int r = 0; r < 16; ++r) { sc[r] = fexp2((sc[r] - smax) * LOG2E); den += sc[r]; }
    const float rden = 1.0f / den;
    if (qq == 0) {
        float* gp = GATE + (size_t)t * EPT + h * TOPK;
#pragma unroll
        for (int r = 0; r < 16; r += 4) *(f32x4*)(gp + r) = (f32x4){sc[r] * rden, sc[r + 1] * rden, sc[r + 2] * rden, sc[r + 3] * rden};
    }
}

struct SliceMeta { int idx[16]; };
__device__ __forceinline__ void slice_meta(SliceMeta& m, const int* __restrict__ EIDX, int t, int g) {
#pragma unroll
    for (int k4 = 0; k4 < 4; ++k4) { const v4u iv = *(const v4u*)(EIDX + (size_t)t * EPT + 16 * g + 4 * k4); m.idx[4 * k4] = (int)iv.x; m.idx[4 * k4 + 1] = (int)iv.y; m.idx[4 * k4 + 2] = (int)iv.z; m.idx[4 * k4 + 3] = (int)iv.w; }
}
#define PU_GATHER(W, IDX) do { _Pragma("unroll") for (int _k = 0; _k < 16; ++_k) W[_k] = *(const v4u*)(base + (size_t)(IDX).idx[_k] * 128); } while (0)
#define PU_META(M, XA, XC, T) do { slice_meta(M, EIDX, (T), g); XA = *(const v4u*)(X1B + (size_t)(T) * D_MODEL + 128 * s + 16 * c); XC = *(const v4u*)(X1B + (size_t)(T) * D_MODEL + 128 * s + 16 * c + 8); } while (0)
#define PU_COMPUTE(W, XA, XC, T) do { const unsigned xb[8] = {XA.x, XA.y, XA.z, XA.w, XC.x, XC.y, XC.z, XC.w}; float p[16]; \
        if (VARIANT == 1) { _Pragma("unroll") for (int k = 0; k < 16; ++k) p[k] = __uint_as_float((W[k][0] ^ W[k][1]) ^ (W[k][2] ^ W[k][3]) ^ xb[k & 7]); } else \
        _Pragma("unroll") for (int k = 0; k < 16; ++k) { float a = 0.f, b = 0.f; \
            _Pragma("unroll") for (int j = 0; j < 4; ++j) { const unsigned wv = W[k][j]; \
                a = __builtin_amdgcn_fdot2_f32_bf16(__builtin_amdgcn_cvt_scalef32_pk_bf16_fp8(wv, 1.0f, false), __builtin_bit_cast(bf16x2, xb[2 * j]), a, false); \
                b = __builtin_amdgcn_fdot2_f32_bf16(__builtin_amdgcn_cvt_scalef32_pk_bf16_fp8(wv, 1.0f, true), __builtin_bit_cast(bf16x2, xb[2 * j + 1]), b, false); } \
            p[k] = a + b; } \
        float r8[8], r4[4], r2[2]; \
        _Pragma("unroll") for (int m = 0; m < 8; ++m) { const float keep = b4 ? p[m + 8] : p[m], send = b4 ? p[m] : p[m + 8]; r8[m] = keep + __shfl_xor(send, 4); } \
        _Pragma("unroll") for (int m = 0; m < 4; ++m) { const float keep = b2 ? r8[m + 4] : r8[m], send = b2 ? r8[m] : r8[m + 4]; r4[m] = keep + __shfl_xor(send, 2); } \
        _Pragma("unroll") for (int m = 0; m < 2; ++m) { const float keep = b1 ? r4[m + 2] : r4[m], send = b1 ? r4[m] : r4[m + 2]; r2[m] = keep + __shfl_xor(send, 1); } \
        *(f32x2*)(HP + ((size_t)s * MTOK + (T)) * EPT + 16 * g + k0) = (f32x2){r2[0], r2[1]}; } while (0)
template <int VARIANT>
__device__ __forceinline__ void pu_sweep(int s, int tfirst, int tstep, const bf16_t* __restrict__ X1B, const int* __restrict__ EIDX, const unsigned char* __restrict__ U8S, float* HP, int lane) {
    const int g = lane >> 3, c = lane & 7;
    const unsigned char* base = U8S + (size_t)s * NEXP * 128 + 16 * c;
    const bool b4 = c & 4, b2 = c & 2, b1 = c & 1;
    const int k0 = (b4 ? 8 : 0) + (b2 ? 4 : 0) + (b1 ? 2 : 0);
    const int n = (MTOK - tfirst + tstep - 1) / tstep;
    const int tlast = tfirst + (n - 1) * tstep;
    SliceMeta mA, mB; v4u xaA, xcA, xaB, xcB; v4u wA[16], wB[16];
    PU_META(mA, xaA, xcA, tfirst);
    PU_META(mB, xaB, xcB, (tfirst + tstep <= tlast ? tfirst + tstep : tlast));
    PU_GATHER(wA, mA);
#pragma unroll 1
    for (int t = tfirst; t <= tlast; t += 2 * tstep) {
        const int t1 = t + tstep <= tlast ? t + tstep : tlast, t2 = t + 2 * tstep <= tlast ? t + 2 * tstep : tlast, t3 = t + 3 * tstep <= tlast ? t + 3 * tstep : tlast;
        PU_GATHER(wB, mB);
        SliceMeta mN; v4u xaN, xcN; PU_META(mN, xaN, xcN, t2);
        PU_COMPUTE(wA, xaA, xcA, t);
        mA = mN; xaA = xaN; xcA = xcN;
        PU_GATHER(wA, mA);
        PU_META(mN, xaN, xcN, t3);
        if (t + tstep <= tlast) PU_COMPUTE(wB, xaB, xcB, t1);
        mB = mN; xaB = xaN; xcB = xcN;
    }
}
__device__ __forceinline__ void pv_sweep(int s, int tfirst, int tstep, const float* __restrict__ X1, const int* __restrict__ EIDX, const float* __restrict__ A, const unsigned char* __restrict__ V8S,
                                         float* Y2, float* STAT, int lane) {
    const int g = lane >> 3, c = lane & 7;
    const unsigned char* base = V8S + (size_t)s * NEXP * 128 + 16 * c;
    const bool b3 = lane & 8;
    const int col = 16 * c + ((lane & 32) ? 8 : 0) + ((lane & 16) ? 4 : 0) + (b3 ? 2 : 0);
    SliceMeta cur; f32x4 av[4];
    slice_meta(cur, EIDX, tfirst, g);
#pragma unroll
    for (int k4 = 0; k4 < 4; ++k4) av[k4] = *(const f32x4*)(A + (size_t)tfirst * EPT + 16 * g + 4 * k4);
#pragma unroll 1
    for (int t = tfirst; t < MTOK; t += tstep) {
        v4u w[16];
#pragma unroll
        for (int k = 0; k < 16; ++k) w[k] = *(const v4u*)(base + (size_t)cur.idx[k] * 128);
        const int tn = (t + tstep < MTOK) ? t + tstep : t;
        SliceMeta nxt; slice_meta(nxt, EIDX, tn, g);
        f32x4 avn[4];
#pragma unroll
        for (int k4 = 0; k4 < 4; ++k4) avn[k4] = *(const f32x4*)(A + (size_t)tn * EPT + 16 * g + 4 * k4);
        const f32x2 xr = *(const f32x2*)(X1 + (size_t)t * D_MODEL + 128 * s + col);
        f32x4 acc[4];
#pragma unroll
        for (int j = 0; j < 4; ++j) acc[j] = (f32x4){0.f, 0.f, 0.f, 0.f};
#pragma unroll
        for (int k = 0; k < 16; ++k) { const float a = av[k >> 2][k & 3];
#pragma unroll
            for (int j = 0; j < 4; ++j) { const unsigned wv = w[k][j]; const f32x2 lo = __builtin_amdgcn_cvt_pk_f32_fp8(wv, false), hi = __builtin_amdgcn_cvt_pk_f32_fp8(wv, true);
                acc[j] += (f32x4){lo.x, lo.y, hi.x, hi.y} * a; } }
        float r8[8], r4[4], r2[2];
#pragma unroll
        for (int m = 0; m < 8; ++m) { auto r = __builtin_amdgcn_permlane32_swap(__float_as_uint(acc[m >> 2][m & 3]), __float_as_uint(acc[(m + 8) >> 2][m & 3]), false, false); r8[m] = __uint_as_float(r[0]) + __uint_as_float(r[1]); }
#pragma unroll
        for (int m = 0; m < 4; ++m) { auto r = __builtin_amdgcn_permlane16_swap(__float_as_uint(r8[m]), __float_as_uint(r8[m + 4]), false, false); r4[m] = __uint_as_float(r[0]) + __uint_as_float(r[1]); }
#pragma unroll
        for (int m = 0; m < 2; ++m) { const float keep = b3 ? r4[m + 2] : r4[m], send = b3 ? r4[m] : r4[m + 2]; r2[m] = keep + __shfl_xor(send, 8); }
        const float y0 = xr.x * ALPHA + r2[0], y1 = xr.y * ALPHA + r2[1];
        *(f32x2*)(Y2 + (size_t)t * D_MODEL + 128 * s + col) = (f32x2){y0, y1};
        const float s1 = wave_sum(y0 + y1), s2 = wave_sum(y0 * y0 + y1 * y1);
        if (lane == 0) *(f32x2*)(STAT + ((size_t)t * 16 + s) * 2) = (f32x2){s1, s2};
        cur = nxt;
#pragma unroll
        for (int k4 = 0; k4 < 4; ++k4) av[k4] = avn[k4];
    }
}
__device__ __forceinline__ void ln2_row(int t, const float* __restrict__ Y2, const float* __restrict__ STAT, const float* __restrict__ g2, const float* __restrict__ b2, float* out, int lane) {
    f32x2 st = {0.f, 0.f};
    if (lane < 16) st = *(const f32x2*)(STAT + ((size_t)t * 16 + lane) * 2);
    const float mean = wave_sum(st.x) * (1.f / D_MODEL), ex2 = wave_sum(st.y) * (1.f / D_MODEL);
    const float rstd = 1.0f / sqrtf(fmaxf(ex2 - mean * mean, 0.f) + LN_EPS);
#pragma unroll
    for (int j = 0; j < 8; ++j) {
        const int c = 256 * j + 4 * lane;
        const f32x4 y = *(const f32x4*)(Y2 + (size_t)t * D_MODEL + c), gg = *(const f32x4*)(g2 + c), bb = *(const f32x4*)(b2 + c);
        *(f32x4*)(out + (size_t)t * D_MODEL + c) = (y - mean) * rstd * gg + bb;
    }
}
template <int R>
__device__ __forceinline__ void cvt_rows_fp8(const float* __restrict__ in, unsigned char* outs, float* sc, int row0, int lane) {
    f32x4 v[R][8];
#pragma unroll
    for (int r = 0; r < R; ++r)
#pragma unroll
        for (int j = 0; j < 8; ++j) v[r][j] = __builtin_nontemporal_load((const f32x4*)(in + (size_t)(row0 + r) * D_MODEL + 256 * j + 4 * lane));
#pragma unroll
    for (int r = 0; r < R; ++r) {
        float am = 0.f;
#pragma unroll
        for (int j = 0; j < 8; ++j) am = fmaxf(am, fmaxf(fmaxf(fabsf(v[r][j].x), fabsf(v[r][j].y)), fmaxf(fabsf(v[r][j].z), fabsf(v[r][j].w))));
#pragma unroll
        for (int o = 1; o < 64; o <<= 1) am = fmaxf(am, __shfl_xor(am, o));
        const float inv = am > 0.f ? 256.0f / am : 1.0f, scale = am > 0.f ? am * (1.0f / 256.0f) : 1.0f;
#pragma unroll
        for (int j = 0; j < 8; ++j) {
            int w = 0; w = __builtin_amdgcn_cvt_pk_fp8_f32(v[r][j].x * inv, v[r][j].y * inv, w, false); w = __builtin_amdgcn_cvt_pk_fp8_f32(v[r][j].z * inv, v[r][j].w * inv, w, true);
            *(unsigned*)(outs + ((size_t)(2 * j + (lane >> 5)) * NEXP + (row0 + r)) * 128 + 4 * (lane & 31)) = (unsigned)w;
        }
        if (lane == 0) sc[row0 + r] = scale;
    }
}

struct Args { const void* in[18]; float* out; unsigned char* ws; int ph_lo, ph_hi, li, pad; };
constexpr int N_PHASES = 11;

#define P_IN(T, i) ((const T*)args.in[i])
#define P_WS(T, off) ((T*)(ws + (off)))
#define x_in P_IN(float, 0)
#define mem_in P_IN(float, 1)
#define positions P_IN(int, 2)
#define w_in P_IN(float, 3)
#define w_mem_kv P_IN(float, 4)
#define w_pool P_IN(float, 5)
#define pool_scale P_IN(float, 6)
#define sinks P_IN(float, 7)
#define w_out P_IN(float, 8)
#define ln1_g P_IN(float, 9)
#define ln1_b P_IN(float, 10)
#define w_peer_q P_IN(float, 11)
#define sk1 P_IN(float, 12)
#define sk2 P_IN(float, 13)
#define eu P_IN(float, 14)
#define ev P_IN(float, 15)
#define ln2_g P_IN(float, 16)
#define ln2_b P_IN(float, 17)
#define WINT P_WS(bf16_t, WS_WINT)
#define WKVT P_WS(bf16_t, WS_WKVT)
#define WOT P_WS(bf16_t, WS_WOT)
#define WQT P_WS(bf16_t, WS_WQT)
#define WPT P_WS(bf16_t, WS_SMALL)
#define K1B P_WS(bf16_t, WS_SMALL + 131072)
#define K2B P_WS(bf16_t, WS_SMALL + 163840)
#define ROPE P_WS(float, WS_SMALL + 262144)
#define XB P_WS(bf16_t, WS_XB)
#define X1B P_WS(bf16_t, WS_X1B)
#define MEMB P_WS(bf16_t, WS_MEMB)
#define KVM P_WS(bf16_t, WS_KVM)
#define POOLV P_WS(float, WS_POOLV)
#define Q P_WS(bf16_t, WS_Q)
#define Kb P_WS(bf16_t, WS_K)
#define Vb P_WS(bf16_t, WS_V)
#define QM P_WS(bf16_t, WS_QM)
#define CONCAT P_WS(bf16_t, WS_CONCAT)
#define Y1 P_WS(float, WS_Y1)
#define X1 P_WS(float, WS_X1)
#define QP P_WS(bf16_t, WS_QP)
#define EIDX P_WS(int, WS_EIDX)
#define GATE P_WS(float, WS_GATE)
#define U8 P_WS(unsigned char, WS_UB)
#define V8 P_WS(unsigned char, WS_VB)
#define SU P_WS(float, WS_UB + 48 * MiB)
#define SV P_WS(float, WS_VB + 48 * MiB)
#define HP P_WS(float, WS_POOLV)
#define AV P_WS(float, WS_POOLV + 64 * MiB)
#define STAT P_WS(float, WS_POOLV + 68 * MiB)
#define Y2 P_WS(float, WS_Y1)
__global__ void __launch_bounds__(NTHREADS, 2) mega_fwd(Args args) {
    extern __shared__ __attribute__((aligned(16))) unsigned char lds_raw[];
    LAS unsigned char* lds = (LAS unsigned char*)lds_raw;
    volatile LAS unsigned* MISC = (volatile LAS unsigned*)(lds + MISC_OFF);
    const int tid = threadIdx.x, lane = tid & 63, wave = __builtin_amdgcn_readfirstlane(tid >> 6);
    const int G = gridDim.x, bx = blockIdx.x;
    const int vcu = (G % 8 == 0) ? (bx % 8) * (G / 8) + bx / 8 : bx;
    const int gw = vcu * NWAVES + wave, NGW = G * NWAVES;
    unsigned char* ws = args.ws;
    for (int u = tid; u < (LDS_BYTES - MISC_OFF) / 4; u += NTHREADS) MISC[u] = 0u;
    __syncthreads();
    XcdBarrier bar = xcd_barrier_post((unsigned*)(ws + WS_CTL) + CW_BAR + args.li * XCD_BAR_WORDS, MISC + 8);
    const int lo = args.ph_lo, hi = args.ph_hi;
#ifndef ONLY_PHASES
#define ONLY_PHASES 2047
#endif
#define IN(k) (((ONLY_PHASES >> (k)) & 1) && lo <= (k) && (k) < hi)
#ifndef REPEAT_MASK
#define REPEAT_MASK 0
#endif
#define REP(k) for (int _rep = 0; _rep < 1 + ((REPEAT_MASK >> (k)) & 1); ++_rep)
#define SEAM(k) do { if (IN(k) && IN((k) + 1)) xcd_barrier(bar); } while (0)

    if (IN(0)) REP(0) {
        LAS float* scr = (LAS float*)(lds + wave * 16384);
        constexpr int I_IN = (D_MODEL / 64) * (IN_W / 32), I_KV = (D_MODEL / 64) * (2 * MEM_W / 32), I_O = (D_MODEL / 64) * (D_MODEL / 32), I_Q = I_O, I_P = 4 * 2 * 4;
        constexpr int NITEMS = I_IN + I_KV + I_O + I_Q + I_P;
        for (int it = gw; it < NITEMS; it += NGW) {
            int r = it;
            if (r < I_IN) { p0_transpose_item(w_in, D_MODEL, IN_W, WINT, scr, r, lane); continue; } r -= I_IN;
            if (r < I_KV) { p0_transpose_item(w_mem_kv, D_MODEL, 2 * MEM_W, WKVT, scr, r, lane); continue; } r -= I_KV;
            if (r < I_O) { p0_transpose_item(w_out, D_MODEL, D_MODEL, WOT, scr, r, lane); continue; } r -= I_O;
            if (r < I_Q) { p0_transpose_item(w_peer_q, D_MODEL, D_MODEL, WQT, scr, r, lane); continue; } r -= I_Q;
            { const int gpl = r >> 3; p0_transpose_item(w_pool + (size_t)gpl * 16384, 128, 128, WPT + (size_t)gpl * 16384, scr, r & 7, lane); }
        }
        cvt_stream<false>(x_in, XB, (size_t)MTOK * D_MODEL, gw, NGW, lane);
        cvt_stream<false>(mem_in, MEMB, (size_t)MMEM * D_MODEL, gw, NGW, lane);
        cvt_stream<false>(sk1, K1B, (size_t)NKEYS * 128, gw, NGW, lane);
        cvt_stream<false>(sk2, K2B, (size_t)NKEYS * 128, gw, NGW, lane);
        for (int i = gw * 64 + lane; i < MTOK * 8; i += NGW * 64) { float c, s; rope_cs(positions[i >> 3], i & 7, c, s); *(f32x2*)(ROPE + 2 * (size_t)i) = (f32x2){c, s}; }
    }
    SEAM(0);
    if (IN(1)) REP(1) {
        { pg8::Gemm g{XB, WINT, MTOK, IN_W, D_MODEL}; pg8::StaticOrder S; S.init(MTOK, IN_W, G, bx);
          EpiIn E{POOLV, Q, Kb, Vb, QM, ROPE};
          pg8::gemm_phase<EpiIn, pg8::StaticOrder, true, true>(lds, g, S, E); }
        { pg8::Gemm g{MEMB, WKVT, MMEM, 2 * MEM_W, D_MODEL}; pg8::StaticOrder S; S.init(MMEM, 2 * MEM_W, G, (bx + G - 64) % G);
          EpiStoreBf E{KVM, 2 * MEM_W};
          pg8::gemm_phase<EpiStoreBf, pg8::StaticOrder, true, true>(lds, g, S, E); }
        { const int f0 = (G == 256) ? 72 : 0;
          if (bx >= f0) { const int fw = (bx - f0) * NWAVES + wave, NFW = (G - f0) * NWAVES;
            for (int r = fw * 4; r < 2 * NEXP; r += NFW * 4) { if (r < NEXP) cvt_rows_fp8<4>(eu, U8, SU, r, lane); else cvt_rows_fp8<4>(ev, V8, SV, r - NEXP, lane); } } }
    }
    SEAM(1);
    if (IN(2)) REP(2) {
        for (int it = vcu; it < 512; it += G) {
            if (it < 256) swa_item(lds, it, Q, Kb, Vb, sinks, CONCAT, tid, wave, lane);
            else mem_item(lds, it - 256, QM, KVM, CONCAT, tid, wave, lane);
        }
        for (int it = gw; it < (MTOK / 16) * 4; it += NGW) pool_item(lds + wave * POOL_LDS_PER_WAVE, it, POOLV, WPT, pool_scale, CONCAT, lane);
    }
    SEAM(2);
    if (IN(3)) REP(3) {
        pg8::Gemm g{CONCAT, WOT, MTOK, D_MODEL, D_MODEL}; pg8::StaticOrder S; S.init(MTOK, D_MODEL, G, bx);
        EpiY1 E{x_in, Y1};
        pg8::gemm_phase<EpiY1, pg8::StaticOrder, true, true>(lds, g, S, E);
    }
    SEAM(3);
    if (IN(4)) REP(4) { for (int r = gw; r < MTOK; r += NGW) ln1_row(Y1 + (size_t)r * D_MODEL, ln1_g, ln1_b, X1 + (size_t)r * D_MODEL, X1B + (size_t)r * D_MODEL, lane); }
    SEAM(4);
    if (IN(5)) REP(5) {
        pg8::Gemm g{X1B, WQT, MTOK, D_MODEL, D_MODEL}; pg8::StaticOrder S; S.init(MTOK, D_MODEL, G, bx);
        EpiStoreBf E{QP, D_MODEL};
        pg8::gemm_phase<EpiStoreBf, pg8::StaticOrder, true, true>(lds, g, S, E);
    }
    SEAM(5);
    if (IN(6)) REP(6) {
#pragma unroll
        for (int j = 0; j < 8; ++j) { const int c = tid + NTHREADS * j, half = c >> 11, row = (c >> 4) & 127, part = c & 15;
            *(LAS v4u*)(lds + half * TK_HALF + row * TK_KROW + part * 16) = *(const v4u*)((half ? K2B : K1B) + row * 128 + part * 8); }
        __syncthreads();
        for (int it = gw; it < (MTOK / 16) * PHEADS; it += NGW) topk_item(it, QP, lds, EIDX, GATE, lane);
        __syncthreads();
    }
    SEAM(6);
    if (IN(7)) REP(7) { const int cls = bx & 7, rk = bx >> 3;
        for (int sub = 0; sub < 2; ++sub) pu_sweep<0>(2 * cls + sub, rk * NWAVES + wave, (G >> 3) * NWAVES, X1B, EIDX, U8, HP, lane); }
    SEAM(7);
    if (IN(8)) REP(8) {
        for (int e = (gw * 64 + lane) * 4; e < MTOK * EPT; e += NGW * 64 * 4) {
            f32x4 h = {0.f, 0.f, 0.f, 0.f};
#pragma unroll
            for (int sl = 0; sl < 16; ++sl) h += *(const f32x4*)(HP + (size_t)sl * MTOK * EPT + e);
            const v4u id = *(const v4u*)(EIDX + e); const f32x4 gt = *(const f32x4*)(GATE + e);
            f32x4 a;
            a.x = gt.x * gelu_erf(h.x * SU[id.x]) * SV[id.x]; a.y = gt.y * gelu_erf(h.y * SU[id.y]) * SV[id.y];
            a.z = gt.z * gelu_erf(h.z * SU[id.z]) * SV[id.z]; a.w = gt.w * gelu_erf(h.w * SU[id.w]) * SV[id.w];
            *(f32x4*)(AV + e) = a;
        } }
    SEAM(8);
    if (IN(9)) REP(9) { const int cls = bx & 7, rk = bx >> 3;
        for (int sub = 0; sub < 2; ++sub) pv_sweep(2 * cls + sub, rk * NWAVES + wave, (G >> 3) * NWAVES, X1, EIDX, AV, V8, Y2, STAT, lane); }
    SEAM(9);
    if (IN(10)) REP(10) { for (int t = gw; t < MTOK; t += NGW) ln2_row(t, Y2, STAT, ln2_g, ln2_b, args.out, lane); }
#ifdef PROBE_P2PART
    if (lo <= 11 && 11 < hi) {
        if (PROBE_P2PART & 1) for (int it = vcu; it < 256; it += G) swa_item(lds, it, Q, Kb, Vb, sinks, CONCAT, tid, wave, lane);
        if (PROBE_P2PART & 2) for (int it = vcu; it < 256; it += G) mem_item(lds, it, QM, KVM, CONCAT, tid, wave, lane);
        if (PROBE_P2PART & 4) for (int it = gw; it < (MTOK / 16) * 4; it += NGW) pool_item(lds + wave * POOL_LDS_PER_WAVE, it, POOLV, WPT, pool_scale, CONCAT, lane);
    }
#endif
#ifdef PROBE_PHASE11
    if (lo <= 11 && 11 < hi) { const int cls = bx & 7, rk = bx >> 3;
        for (int sub = 0; sub < 2; ++sub) pu_sweep<1>(2 * cls + sub, rk * NWAVES + wave, (G >> 3) * NWAVES, X1B, EIDX, U8, HP, lane); }
#endif
#undef IN
#undef SEAM
}
#undef P_IN(T,
#undef P_WS(T,
#undef x_in
#undef mem_in
#undef positions
#undef w_in
#undef w_mem_kv
#undef w_pool
#undef pool_scale
#undef sinks
#undef w_out
#undef ln1_g
#undef ln1_b
#undef w_peer_q
#undef sk1
#undef sk2
#undef eu
#undef ev
#undef ln2_g
#undef ln2_b
#undef WINT
#undef WKVT
#undef WOT
#undef WQT
#undef WPT
#undef K1B
#undef K2B
#undef ROPE
#undef XB
#undef X1B
#undef MEMB
#undef KVM
#undef POOLV
#undef Q
#undef Kb
#undef Vb
#undef QM
#undef CONCAT
#undef Y1
#undef X1
#undef QP
#undef EIDX
#undef GATE
#undef U8
#undef V8
#undef SU
#undef SV
#undef HP
#undef AV
#undef STAT
#undef Y2

#if NAIVE_MASK != 0
__device__ __forceinline__ float toF(float v) { return v; }
__device__ __forceinline__ float toF(bf16_t v) { return bf2f(v); }

struct NvEpiF32 { float* C; int ldc, pad; __device__ void operator()(int r, int c, float v) const { C[(size_t)r * ldc + c] = v; } };
struct NvEpiBf { bf16_t* C; int ldc, pad; __device__ void operator()(int r, int c, float v) const { C[(size_t)r * ldc + c] = f2bf(v); } };
struct NvEpiY1 { const float* x; float* y; __device__ void operator()(int r, int c, float v) const { y[(size_t)r * D_MODEL + c] = ALPHA * x[(size_t)r * D_MODEL + c] + v; } };

template <class TA, class Epi>
__global__ void __launch_bounds__(256) nv_gemm(const TA* __restrict__ A, const float* __restrict__ B, int M, int N, int K, Epi epi) {
    __shared__ float As[16][65];
    __shared__ float Bs[16][64];
    const int tx = threadIdx.x & 15, ty = threadIdx.x >> 4;
    const int m0 = blockIdx.y * 64, n0 = blockIdx.x * 64;
    float acc[4][4];
#pragma unroll
    for (int i = 0; i < 4; ++i)
#pragma unroll
        for (int j = 0; j < 4; ++j) acc[i][j] = 0.f;
    for (int k0 = 0; k0 < K; k0 += 16) {
        for (int i = threadIdx.x; i < 1024; i += 256) { const int r = i >> 4, c = i & 15; As[c][r] = toF(A[(size_t)(m0 + r) * K + k0 + c]); }
        for (int i = threadIdx.x; i < 1024; i += 256) { const int r = i >> 6, c = i & 63; Bs[r][c] = B[(size_t)(k0 + r) * N + n0 + c]; }
        __syncthreads();
#pragma unroll
        for (int kk = 0; kk < 16; ++kk) {
            float a[4], b[4];
#pragma unroll
            for (int i = 0; i < 4; ++i) { a[i] = As[kk][ty * 4 + i]; b[i] = Bs[kk][tx * 4 + i]; }
#pragma unroll
            for (int i = 0; i < 4; ++i)
#pragma unroll
                for (int j = 0; j < 4; ++j) acc[i][j] += a[i] * b[j];
        }
        __syncthreads();
    }
#pragma unroll
    for (int i = 0; i < 4; ++i)
#pragma unroll
        for (int j = 0; j < 4; ++j) epi(m0 + ty * 4 + i, n0 + tx * 4 + j, acc[i][j]);
}

__global__ void nv_post1(const float* __restrict__ H, const int* __restrict__ positions, float* POOLV, bf16_t* Q, bf16_t* Kb, bf16_t* Vb, bf16_t* QM) {
    const size_t gid = (size_t)blockIdx.x * blockDim.x + threadIdx.x;
    if (gid >= (size_t)MTOK * IN_W) return;
    const int t = (int)(gid / IN_W), col = (int)(gid % IN_W);
    const float* hr = H + (size_t)t * IN_W;
    const float v = hr[col];
    if (col < POOL_W) { POOLV[(size_t)t * POOL_W + col] = v; return; }
    if (col < POOL_W + SWA_W + KV_W) {
        const bool isq = col < POOL_W + SWA_W;
        const int c = isq ? col - POOL_W : col - POOL_W - SWA_W;
        const int d = c & 63;
        float o = v;
        if (d < 16) {
            const int j = d & 7; float cs, sn; rope_cs(positions[t], j, cs, sn);
            if (d < 8) o = v * cs - hr[col + 8] * sn; else o = v * cs + hr[col - 8] * sn;
        }
        if (isq) Q[(size_t)t * SWA_W + c] = f2bf(o); else Kb[(size_t)t * KV_W + c] = f2bf(o);
        return;
    }
    if (col < POOL_W + SWA_W + 2 * KV_W) { Vb[(size_t)t * KV_W + (col - POOL_W - SWA_W - KV_W)] = f2bf(v); return; }
    QM[(size_t)t * MEM_W + (col - POOL_W - SWA_W - 2 * KV_W)] = f2bf(v);
}
__global__ void nv_cvt_bf16(const float* __restrict__ in, bf16_t* out, size_t n) {
    const size_t gid = (size_t)blockIdx.x * blockDim.x + threadIdx.x;
    if (gid < n) out[gid] = f2bf(in[gid]);
}
__global__ void nv_pool1(const float* __restrict__ POOLV, float* PS) {
    const size_t gid = (size_t)blockIdx.x * blockDim.x + threadIdx.x;
    if (gid >= (size_t)MTOK * POOL_W) return;
    const int t = (int)(gid / POOL_W), ch = (int)(gid % POOL_W);
    const int g = ch >> 7, w = 2 << g, s = t & (SEQ - 1);
    const int cnt = (s + 1) < w ? (s + 1) : w;
    float sum = 0.f;
    for (int i = 0; i < cnt; ++i) sum += POOLV[(size_t)(t - i) * POOL_W + ch];
    PS[gid] = sum / (float)cnt - POOLV[gid];
}
__global__ void nv_pool2(const float* __restrict__ PS, const float* __restrict__ w_pool, const float* __restrict__ pool_scale, bf16_t* CONCAT) {
    const size_t gid = (size_t)blockIdx.x * blockDim.x + threadIdx.x;
    if (gid >= (size_t)MTOK * POOL_W) return;
    const int t = (int)(gid / POOL_W), ch = (int)(gid % POOL_W);
    const int g = ch >> 7, d = ch & 127;
    const float* p = PS + (size_t)t * POOL_W + g * 128;
    const float* w = w_pool + (size_t)g * 128 * 128 + d;
    float y = 0.f;
    for (int c = 0; c < 128; ++c) y += p[c] * w[(size_t)c * 128];
    CONCAT[(size_t)t * D_MODEL + ch] = f2bf(y * pool_scale[ch]);
}
__global__ void __launch_bounds__(256) nv_swa(const bf16_t* __restrict__ Q, const bf16_t* __restrict__ Kb, const bf16_t* __restrict__ Vb, const float* __restrict__ sinks, bf16_t* CONCAT) {
    const int wv = (int)((blockIdx.x * 256 + threadIdx.x) >> 6), lane = threadIdx.x & 63;
    if (wv >= MTOK * NHEAD) return;
    const int t = wv / NHEAD, h = wv % NHEAD, kvh = h >> 2, s = t & (SEQ - 1), tb = t - s;
    const float q = bf2f(Q[(size_t)t * SWA_W + h * HD + lane]);
    float m = sinks[h], l = 1.0f, o = 0.f;
    const int k0 = s - (WINDOW - 1) < 0 ? 0 : s - (WINDOW - 1);
    for (int kk = k0; kk <= s; ++kk) {
        const size_t kt = (size_t)(tb + kk);
        const float sc = wave_sum(q * bf2f(Kb[kt * KV_W + kvh * HD + lane])) * 0.125f;
        const float mn = fmaxf(m, sc), r = expf(m - mn), p = expf(sc - mn);
        l = l * r + p; o = o * r + p * bf2f(Vb[kt * KV_W + kvh * HD + lane]); m = mn;
    }
    CONCAT[(size_t)t * D_MODEL + POOL_W + h * HD + lane] = f2bf(o / l);
}
__global__ void __launch_bounds__(256) nv_mem(const bf16_t* __restrict__ QM, const bf16_t* __restrict__ KVM, bf16_t* CONCAT) {
    const int wv = (int)((blockIdx.x * 256 + threadIdx.x) >> 6), lane = threadIdx.x & 63;
    if (wv >= MTOK * MHEADS) return;
    const int t = wv / MHEADS, hm = wv % MHEADS, b = t / SEQ;
    const float q0 = bf2f(QM[(size_t)t * MEM_W + hm * MHD + lane]), q1 = bf2f(QM[(size_t)t * MEM_W + hm * MHD + 64 + lane]);
    float m = -1e30f, l = 0.f, o0 = 0.f, o1 = 0.f;
    const float scale = 0.08838834764831845f;
    for (int j = 0; j < MEM_LEN; ++j) {
        const bf16_t* kr = KVM + (size_t)(b * MEM_LEN + j) * (2 * MEM_W) + hm * MHD;
        const bf16_t* vr = kr + MEM_W;
        const float sc = wave_sum(q0 * bf2f(kr[lane]) + q1 * bf2f(kr[64 + lane])) * scale;
        const float mn = fmaxf(m, sc), r = expf(m - mn), p = expf(sc - mn);
        l = l * r + p; o0 = o0 * r + p * bf2f(vr[lane]); o1 = o1 * r + p * bf2f(vr[64 + lane]); m = mn;
    }
    bf16_t* orow = CONCAT + (size_t)t * D_MODEL + POOL_W + SWA_W + hm * MHD;
    orow[lane] = f2bf(o0 / l); orow[64 + lane] = f2bf(o1 / l);
}
__global__ void __launch_bounds__(256) nv_ln(const float* __restrict__ in, const float* __restrict__ g, const float* __restrict__ bta, float* outf, bf16_t* outb) {
    const int row = (int)((blockIdx.x * 256 + threadIdx.x) >> 6), lane = threadIdx.x & 63;
    if (row >= MTOK) return;
    const float* r = in + (size_t)row * D_MODEL;
    float v[32]; float s = 0.f;
#pragma unroll
    for (int i = 0; i < 32; ++i) { v[i] = r[lane + 64 * i]; s += v[i]; }
    const float mean = wave_sum(s) * (1.f / D_MODEL); float q = 0.f;
#pragma unroll
    for (int i = 0; i < 32; ++i) { v[i] -= mean; q += v[i] * v[i]; }
    const float rstd = 1.0f / sqrtf(wave_sum(q) * (1.f / D_MODEL) + LN_EPS);
#pragma unroll
    for (int i = 0; i < 32; ++i) {
        const int c = lane + 64 * i; const float y = v[i] * rstd * g[c] + bta[c];
        if (outf) outf[(size_t)row * D_MODEL + c] = y;
        if (outb) outb[(size_t)row * D_MODEL + c] = f2bf(y);
    }
}
__global__ void __launch_bounds__(32) nv_topk(const bf16_t* __restrict__ QP, const float* __restrict__ K1, const float* __restrict__ K2, int* EIDX, float* GATE) {
    __shared__ float sc[256][32];
    __shared__ float lv[32][32];
    __shared__ int li[32][32];
    const int tid = threadIdx.x, gid = blockIdx.x * 32 + tid;
    const int t = gid / PHEADS, h = gid % PHEADS;
    const bf16_t* q = QP + (size_t)t * D_MODEL + h * 256;
    for (int half = 0; half < 2; ++half) {
        const float* Kk = half ? K2 : K1;
        for (int k = 0; k < NKEYS; ++k) {
            float a = 0.f;
            for (int c = 0; c < 128; ++c) a += bf2f(q[half * 128 + c]) * Kk[k * 128 + c];
            sc[half * 128 + k][tid] = a;
        }
        for (int r = 0; r < TOPK; ++r) {
            float best = -INFINITY; int bi = 0;
            for (int k = 0; k < NKEYS; ++k) { const float v = sc[half * 128 + k][tid]; if (v > best) { best = v; bi = k; } }
            lv[half * 16 + r][tid] = best; li[half * 16 + r][tid] = bi; sc[half * 128 + bi][tid] = -INFINITY;
        }
    }
    for (int a = 0; a < 16; ++a) for (int b = 0; b < 16; ++b) sc[a * 16 + b][tid] = lv[a][tid] + lv[16 + b][tid];
    float mx = 0.f, den = 0.f;
    float tv[16]; int ti[16];
#pragma unroll
    for (int r = 0; r < TOPK; ++r) {
        float best = -INFINITY; int bi = 0;
        for (int k = 0; k < 256; ++k) { const float v = sc[k][tid]; if (v > best) { best = v; bi = k; } }
        sc[bi][tid] = -INFINITY;
        if (r == 0) mx = best;
        tv[r] = expf(best - mx); den += tv[r]; ti[r] = li[bi >> 4][tid] * NKEYS + li[16 + (bi & 15)][tid];
    }
#pragma unroll
    for (int r = 0; r < TOPK; ++r) { EIDX[(size_t)t * EPT + h * TOPK + r] = ti[r]; GATE[(size_t)t * EPT + h * TOPK + r] = tv[r] / den; }
}
__global__ void __launch_bounds__(256) nv_gather(const float* __restrict__ X1, const int* __restrict__ EIDX, const float* __restrict__ GATE, const float* __restrict__ EU, const float* __restrict__ EV,
                                                  const float* __restrict__ g, const float* __restrict__ bta, float* out) {
    const int t = (int)((blockIdx.x * 256 + threadIdx.x) >> 6), lane = threadIdx.x & 63;
    if (t >= MTOK) return;
    float x[32], acc[32];
#pragma unroll
    for (int i = 0; i < 32; ++i) { x[i] = X1[(size_t)t * D_MODEL + lane + 64 * i]; acc[i] = 0.f; }
    for (int e = 0; e < EPT; ++e) {
        const int id = EIDX[(size_t)t * EPT + e]; const float gt = GATE[(size_t)t * EPT + e];
        const float* u = EU + (size_t)id * D_MODEL; const float* vv = EV + (size_t)id * D_MODEL;
        float p = 0.f;
#pragma unroll
        for (int i = 0; i < 32; ++i) p += x[i] * u[lane + 64 * i];
        const float a = gt * gelu_erf(wave_sum(p));
#pragma unroll
        for (int i = 0; i < 32; ++i) acc[i] += a * vv[lane + 64 * i];
    }
    float s = 0.f;
#pragma unroll
    for (int i = 0; i < 32; ++i) { acc[i] = ALPHA * x[i] + acc[i]; s += acc[i]; }
    const float mean = wave_sum(s) * (1.f / D_MODEL); float q = 0.f;
#pragma unroll
    for (int i = 0; i < 32; ++i) { acc[i] -= mean; q += acc[i] * acc[i]; }
    const float rstd = 1.0f / sqrtf(wave_sum(q) * (1.f / D_MODEL) + LN_EPS);
#pragma unroll
    for (int i = 0; i < 32; ++i) { const int c = lane + 64 * i; out[(size_t)t * D_MODEL + c] = acc[i] * rstd * g[c] + bta[c]; }
}

#endif
extern "C" void kernel_launch(void* const* d_in, const int* in_sizes, int n_in, void* d_out, int out_size, void* d_ws, size_t ws_size, hipStream_t stream) {
    static int grid = 0;
    if (grid == 0) {
        if (n_in != 18 || in_sizes[0] != MTOK * D_MODEL || out_size != MTOK * D_MODEL || ws_size < WS_END) {
            fprintf(stderr, "kernel_launch: unexpected shapes (n_in %d, in0 %d, out %d, ws %zu)\n", n_in, n_in > 0 ? in_sizes[0] : -1, out_size, ws_size); grid = -1; return; }
        int dev = 0, cus = 0, per_cu = 0;
        if (hipGetDevice(&dev) != hipSuccess || hipDeviceGetAttribute(&cus, hipDeviceAttributeMultiprocessorCount, dev) != hipSuccess) { fprintf(stderr, "kernel_launch: device query failed\n"); grid = -1; return; }
        if (hipFuncSetAttribute((const void*)mega_fwd, hipFuncAttributeMaxDynamicSharedMemorySize, LDS_BYTES) != hipSuccess) { fprintf(stderr, "kernel_launch: hipFuncSetAttribute failed\n"); grid = -1; return; }
        if (hipOccupancyMaxActiveBlocksPerMultiprocessor(&per_cu, (const void*)mega_fwd, NTHREADS, LDS_BYTES) != hipSuccess || per_cu < 1) {
            fprintf(stderr, "kernel_launch: occupancy query reports %d workgroups per CU\n", per_cu); (void)hipGetLastError(); grid = -1; return; }
        grid = cus;
    }
    if (grid < 0) return;
    unsigned char* ws = (unsigned char*)d_ws;
    (void)hipMemsetAsync(ws + WS_CTL, 0, 1 * MiB, stream);
    Args a{};
    for (int i = 0; i < 18; ++i) a.in[i] = d_in[i];
    a.out = (float*)d_out; a.ws = ws;
#if NAIVE_MASK != 0
    const float* x = (const float*)d_in[0]; const float* mem = (const float*)d_in[1]; const int* positions = (const int*)d_in[2];
    const float* w_in = (const float*)d_in[3]; const float* w_mem_kv = (const float*)d_in[4]; const float* w_pool = (const float*)d_in[5];
    const float* pool_scale = (const float*)d_in[6]; const float* sinks = (const float*)d_in[7]; const float* w_out = (const float*)d_in[8];
    const float* ln1_g = (const float*)d_in[9]; const float* ln1_b = (const float*)d_in[10]; const float* w_peer_q = (const float*)d_in[11];
    const float* sk1 = (const float*)d_in[12]; const float* sk2 = (const float*)d_in[13]; const float* eu = (const float*)d_in[14]; const float* ev = (const float*)d_in[15];
    const float* ln2_g = (const float*)d_in[16]; const float* ln2_b = (const float*)d_in[17];
    float* out = (float*)d_out;
    float* POOLV = (float*)(ws + WS_POOLV); bf16_t* Q = (bf16_t*)(ws + WS_Q); bf16_t* Kb = (bf16_t*)(ws + WS_K); bf16_t* Vb = (bf16_t*)(ws + WS_V); bf16_t* QM = (bf16_t*)(ws + WS_QM);
    bf16_t* KVM = (bf16_t*)(ws + WS_KVM); bf16_t* CONCAT = (bf16_t*)(ws + WS_CONCAT); float* Y1 = (float*)(ws + WS_Y1); float* X1 = (float*)(ws + WS_X1); bf16_t* X1B = (bf16_t*)(ws + WS_X1B);
    bf16_t* QP = (bf16_t*)(ws + WS_QP); int* EIDX = (int*)(ws + WS_EIDX); float* GATE = (float*)(ws + WS_GATE);
    float* NVH = (float*)(ws + WS_NV_H); float* NVPS = (float*)(ws + WS_NV_PS); float* NVKVM = (float*)(ws + WS_NV_KVM);
#endif
    int li = 0;
    for (int p = 0; p < N_PHASES;) {
#if NAIVE_MASK != 0
        if ((NAIVE_MASK >> p) & 1) {
            switch (p) {
            case 1:
                nv_gemm<float, NvEpiF32><<<dim3(IN_W / 64, MTOK / 64), 256, 0, stream>>>(x, w_in, MTOK, IN_W, D_MODEL, NvEpiF32{NVH, IN_W, 0});
                nv_gemm<float, NvEpiF32><<<dim3(2 * MEM_W / 64, MMEM / 64), 256, 0, stream>>>(mem, w_mem_kv, MMEM, 2 * MEM_W, D_MODEL, NvEpiF32{NVKVM, 2 * MEM_W, 0});
                nv_post1<<<(unsigned)(((size_t)MTOK * IN_W + 255) / 256), 256, 0, stream>>>(NVH, positions, POOLV, Q, Kb, Vb, QM);
                nv_cvt_bf16<<<(MMEM * 2 * MEM_W + 255) / 256, 256, 0, stream>>>(NVKVM, KVM, (size_t)MMEM * 2 * MEM_W);
                break;
            case 2:
                nv_pool1<<<MTOK * POOL_W / 256, 256, 0, stream>>>(POOLV, NVPS);
                nv_pool2<<<MTOK * POOL_W / 256, 256, 0, stream>>>(NVPS, w_pool, pool_scale, CONCAT);
                nv_swa<<<MTOK * NHEAD / 4, 256, 0, stream>>>(Q, Kb, Vb, sinks, CONCAT);
                nv_mem<<<MTOK * MHEADS / 4, 256, 0, stream>>>(QM, KVM, CONCAT);
                break;
            case 3: nv_gemm<bf16_t, NvEpiY1><<<dim3(D_MODEL / 64, MTOK / 64), 256, 0, stream>>>(CONCAT, w_out, MTOK, D_MODEL, D_MODEL, NvEpiY1{x, Y1}); break;
            case 4: nv_ln<<<MTOK / 4, 256, 0, stream>>>(Y1, ln1_g, ln1_b, X1, X1B); break;
            case 5: nv_gemm<float, NvEpiBf><<<dim3(D_MODEL / 64, MTOK / 64), 256, 0, stream>>>(X1, w_peer_q, MTOK, D_MODEL, D_MODEL, NvEpiBf{QP, D_MODEL, 0}); break;
            case 6: nv_topk<<<MTOK * PHEADS / 32, 32, 0, stream>>>(QP, sk1, sk2, EIDX, GATE); break;
            case 7: nv_gather<<<MTOK / 4, 256, 0, stream>>>(X1, EIDX, GATE, eu, ev, ln2_g, ln2_b, out); p = N_PHASES - 1; break;
            default: break;
            }
            ++p; continue;
        }
#endif
        int q = p;
        while (q < N_PHASES && !((NAIVE_MASK >> q) & 1)) ++q;
        a.ph_lo = p; a.ph_hi = q; a.li = li++;
        hipLaunchKernelGGL(mega_fwd, dim3(grid), dim3(NTHREADS), LDS_BYTES, stream, a);
        const hipError_t le = hipPeekAtLastError();
        if (le != hipSuccess) { fprintf(stderr, "kernel_launch: launch failed: %s\n", hipGetErrorName(le)); break; }
        p = q;
    }
#ifdef PROBE_EXTRA_LO
    a.ph_lo = PROBE_EXTRA_LO; a.ph_hi = PROBE_EXTRA_HI; a.li = li++;
    hipLaunchKernelGGL(mega_fwd, dim3(grid), dim3(NTHREADS), LDS_BYTES, stream, a);
#endif
}
```

```cpp
#include <hip/hip_runtime.h>
#include <cstdint>
#include <cstdio>
#ifndef NAIVE_MASK
#define NAIVE_MASK 0
#endif

constexpr int D_MODEL = 2048, BATCH = 2, SEQ = 4096, MTOK = BATCH * SEQ, MEM_LEN = 256, MMEM = BATCH * MEM_LEN;
constexpr int POOL_W = 512, SWA_W = 1024, KV_W = 256, MEM_W = 512, IN_W = 2560;
constexpr int NHEAD = 16, NKV = 4, HD = 64, WINDOW = 128, MHEADS = 4, MHD = 128;
constexpr int PHEADS = 8, NKEYS = 128, TOPK = 16, NEXP = NKEYS * NKEYS, EPT = PHEADS * TOPK;
constexpr float ALPHA = 1.18920711500272106672f;
constexpr float LN_EPS = 1e-5f;

typedef unsigned short bf16_t;
__device__ __forceinline__ float bf2f(bf16_t v) { return __uint_as_float((unsigned)v << 16); }
__device__ __forceinline__ bf16_t f2bf(float f) { unsigned u = __float_as_uint(f); return (bf16_t)((u + 0x7fffu + ((u >> 16) & 1u)) >> 16); }

constexpr size_t MiB = 1u << 20;
constexpr size_t WS_CTL = 0, WS_WINT = 1 * MiB, WS_WKVT = 11 * MiB, WS_WOT = 15 * MiB, WS_WQT = 23 * MiB, WS_SMALL = 31 * MiB;
constexpr size_t WS_XB = 32 * MiB, WS_X1B = 32 * MiB  , WS_MEMB = 64 * MiB, WS_KVM = 66 * MiB;
constexpr size_t WS_POOLV = 68 * MiB, WS_Q = 84 * MiB, WS_K = 100 * MiB, WS_V = 104 * MiB, WS_QM = 108 * MiB, WS_CONCAT = 116 * MiB;
constexpr size_t WS_Y1 = 148 * MiB, WS_X1 = 212 * MiB, WS_QP = 276 * MiB, WS_EIDX = 308 * MiB, WS_GATE = 312 * MiB, WS_UB = 316 * MiB, WS_VB = 380 * MiB, WS_END = 444 * MiB;
constexpr size_t WS_NV_H = 148 * MiB  , WS_NV_PS = 232 * MiB, WS_NV_KVM = 248 * MiB;

__device__ __forceinline__ void rope_cs(int pos, int j, float& c, float& s) {
    const double invf[8] = {1.0, 0.19392274474868576, 0.03760603093086393, 0.007292664737217109, 0.001414213562373095, 0.0002742481756762073, 5.318295896944988e-05, 1.031338537721246e-05};
    double f = j == 0 ? invf[0] : j == 1 ? invf[1] : j == 2 ? invf[2] : j == 3 ? invf[3] : j == 4 ? invf[4] : j == 5 ? invf[5] : j == 6 ? invf[6] : invf[7];
    double rev = (double)pos * f * 0.15915494309189533577;
    rev -= floor(rev);
    float fr = (float)rev;
    s = __builtin_amdgcn_sinf(fr); c = __builtin_amdgcn_cosf(fr);
}
__device__ __forceinline__ float gelu_erf(float h) { return 0.5f * h * (1.0f + erff(h * 0.70710678118654752440f)); }
__device__ __forceinline__ float wave_sum(float v) {
#pragma unroll
    for (int o = 1; o < 64; o <<= 1) v += __shfl_xor(v, o);
    return v;
}

namespace pg8 {
#define PG8_LAS __attribute__((address_space(3)))
typedef unsigned short bf16_t;
typedef short bf16x8 __attribute__((ext_vector_type(8)));
typedef float f32x4 __attribute__((ext_vector_type(4)));
typedef unsigned u32x4 __attribute__((ext_vector_type(4)));
constexpr int BM = 256, BK = 64, HALF = 128, HTB = HALF * BK * 2  , STAGE_BYTES = 8 * HTB, NXCD = 8, WGM = 8;

__host__ __device__ __forceinline__ int lds_byte(int r, int c) { const int st = (r >> 4) * 2 + (c >> 5), rr = r & 15, cc = c & 31, ob = rr * 64 + cc * 2; return st * 1024 + (ob ^ (((ob >> 9) & 1) << 5)); }
__host__ __device__ __forceinline__ void stage_rc(int b, int& R, int& C) { const int st = b / 1024, sb = b % 1024, swz = sb ^ (((sb >> 9) & 1) << 5); R = (st >> 1) * 16 + swz / 64; C = (st & 1) * 32 + (swz % 64) / 2; }
__host__ __device__ __forceinline__ int perm32(int rho) { const int n = rho >> 4, i = rho & 15; return 8 * (i >> 2) + 4 * n + (i & 3); }

struct Unit { int pm, pn; };
struct Gemm { const bf16_t* A; const bf16_t* Bt; int M, N, K; };

struct StaticOrder {
    int nM, nN, nwg, G, c;
    __host__ __device__ void init(int M, int N, int G_, int c_) { nM = M / BM; nN = N / BM; nwg = nM * nN; G = G_; c = c_; }
    __host__ __device__ bool next(int i, Unit& u) const {
        const long L = (long)i * G + c; if (L >= nwg) return false;
        int wgid = (int)L; { const int q = nwg / NXCD, r = nwg % NXCD, xcd = wgid % NXCD, off = wgid / NXCD; wgid = (xcd < r ? xcd * (q + 1) : r * (q + 1) + (xcd - r) * q) + off; }
        const int nig = WGM * nN, gid = wgid / nig, fm = gid * WGM, gsz = (nM - fm) < WGM ? (nM - fm) : WGM;
        u.pm = fm + ((wgid % nig) % gsz); u.pn = (wgid % nig) / gsz; return true;
    }
    __device__ __forceinline__ void a_ready(const Unit&) const {}
    __device__ __forceinline__ void done(const Unit&) const {}
};

__device__ __forceinline__ unsigned cvt_pk_bf16(float lo, float hi) { unsigned r; asm volatile("v_cvt_pk_bf16_f32 %0, %1, %2" : "=v"(r) : "v"(lo), "v"(hi)); return r; }
template <class Epi, class Sched, bool ALIGN_EPI = false, bool SP2 = false>
__device__ __forceinline__ void gemm_phase(PG8_LAS unsigned char* lds, const Gemm g, const Sched& S, const Epi& E) {
    const int tid = threadIdx.x, wid = __builtin_amdgcn_readfirstlane(tid >> 6), lane = tid & 63, wr = wid >> 2, wc = wid & 3, fr = lane & 15, fq = lane >> 4;
    const int K = g.K, nt = K / BK;
    unsigned voffA[2], voffB[2];
#pragma unroll
    for (int i = 0; i < 2; ++i) { int R, C; stage_rc(tid * 16 + i * 8192, R, C); const int Rb = Epi::PERM ? ((R & ~31) + perm32(R & 31)) : R;
        voffA[i] = (unsigned)(R * K + C) * 2u; voffB[i] = (unsigned)(Rb * K + C) * 2u; }
    const size_t kstep = (size_t)(BK * 2);
    const size_t hstep = (size_t)HALF * K * 2;
    const size_t tstep = 2 * hstep;
    const unsigned ldsw = (unsigned)wid * 1024u;
    const int aoff = lds_byte(wr * 64 + fr, fq * 8), boff = lds_byte(wc * 32 + fr, fq * 8);
#define PG8_SA(b, h) (((b) * 2 + (h)) * HTB)
#define PG8_SB(b, h) ((4 + (b) * 2 + (h)) * HTB)
#define PG8_STAGE(bufoff, gbase, voff) do { _Pragma("unroll") for (int _i = 0; _i < 2; ++_i) \
        __builtin_amdgcn_global_load_lds((const unsigned*)((const char*)(gbase) + (voff)[_i]), (PG8_LAS unsigned*)(lds + (bufoff) + ldsw + _i * 8192), 16, 0, 0); } while (0)
#define PG8_LDA(dst, b, h) do { _Pragma("unroll") for (int m = 0; m < 4; ++m) _Pragma("unroll") for (int k = 0; k < 2; ++k) dst[m][k] = *(const PG8_LAS bf16x8*)(lds + PG8_SA(b, h) + aoff + m * 2048 + k * 1024); } while (0)
#define PG8_LDB(dst, b, h) do { _Pragma("unroll") for (int n = 0; n < 2; ++n) _Pragma("unroll") for (int k = 0; k < 2; ++k) dst[n][k] = *(const PG8_LAS bf16x8*)(lds + PG8_SB(b, h) + boff + n * 2048 + k * 1024); } while (0)
#define PG8_MMA(ai, bj, At, Bt) do { __builtin_amdgcn_s_setprio(1); _Pragma("unroll") for (int m = 0; m < 4; ++m) _Pragma("unroll") for (int n = 0; n < 2; ++n) _Pragma("unroll") for (int k = 0; k < 2; ++k) \
        acc[ai][bj][m][n] = __builtin_amdgcn_mfma_f32_16x16x32_bf16(Bt[n][k], At[m][k], acc[ai][bj][m][n], 0, 0, 0); __builtin_amdgcn_s_setprio(0); } while (0)
#define PG8_WAIT_V(n) asm volatile("s_waitcnt vmcnt(" #n ")" ::: "memory")
#define PG8_WAIT_L(n) asm volatile("s_waitcnt lgkmcnt(" #n ")" ::: "memory")
#define PG8_BAR __builtin_amdgcn_s_barrier()
#define PG8_SCHED __builtin_amdgcn_sched_barrier(0)
    Unit cur, nxt; int ui = 0;
    if (!S.next(0, cur)) return;
    f32x4 acc[2][2][4][2];
#pragma unroll
    for (int a = 0; a < 2; ++a)
#pragma unroll
        for (int b = 0; b < 2; ++b)
#pragma unroll
            for (int m = 0; m < 4; ++m)
#pragma unroll
                for (int n = 0; n < 2; ++n) acc[a][b][m][n] = (f32x4){0.f, 0.f, 0.f, 0.f};
    bf16x8 At[4][2], B0[2][2], B1[2][2];
    const char* cA = (const char*)g.A + (size_t)cur.pm * tstep; const char* cB = (const char*)g.Bt + (size_t)cur.pn * tstep;
    S.a_ready(cur);
    if constexpr (SP2) {
        PG8_STAGE(PG8_SB(0, 0), cB, voffB); PG8_STAGE(PG8_SB(0, 1), cB + hstep, voffB); PG8_STAGE(PG8_SA(0, 0), cA, voffA); PG8_STAGE(PG8_SA(0, 1), cA + hstep, voffA);
        if (wr == 1) PG8_BAR;
        PG8_WAIT_V(2); PG8_BAR;
        PG8_STAGE(PG8_SB(1, 0), cB + kstep, voffB); PG8_STAGE(PG8_SA(1, 0), cA + kstep, voffA); PG8_STAGE(PG8_SB(1, 1), cB + hstep + kstep, voffB);
        PG8_WAIT_V(6); PG8_BAR;
    } else {
        PG8_STAGE(PG8_SB(0, 0), cB, voffB); PG8_STAGE(PG8_SA(0, 0), cA, voffA); PG8_STAGE(PG8_SB(0, 1), cB + hstep, voffB); PG8_STAGE(PG8_SA(0, 1), cA + hstep, voffA);
        if (wr == 1) PG8_BAR;
        PG8_WAIT_V(4); PG8_BAR;
        PG8_STAGE(PG8_SB(1, 0), cB + kstep, voffB); PG8_STAGE(PG8_SA(1, 0), cA + kstep, voffA); PG8_STAGE(PG8_SB(1, 1), cB + hstep + kstep, voffB);
        PG8_WAIT_V(6); PG8_BAR;
    }
    for (;;) {
        const bool has_next = S.next(ui + 1, nxt);
        const char* nA = has_next ? (const char*)g.A + (size_t)nxt.pm * tstep : cA; const char* nB = has_next ? (const char*)g.Bt + (size_t)nxt.pn * tstep : cB;
        for (int t = 0; t < nt; t += 2) {
            const bool last = (t == nt - 2);
            const char* a1 = cA + (size_t)(t + 1) * kstep;
            const char* a2 = last ? nA : cA + (size_t)(t + 2) * kstep; const char* b2 = last ? nB : cB + (size_t)(t + 2) * kstep;
            const char* a3 = a2 + kstep; const char* b3 = b2 + kstep;
            if (last && has_next) S.a_ready(nxt);
            if constexpr (SP2) {
            PG8_LDB(B0, 0, 0); PG8_LDB(B1, 0, 1); PG8_SCHED; PG8_LDA(At, 0, 0); PG8_STAGE(PG8_SA(1, 1), a1 + hstep, voffA);
            PG8_WAIT_V(8); PG8_WAIT_L(0); PG8_BAR; PG8_MMA(0, 0, At, B0); PG8_MMA(0, 1, At, B1); PG8_BAR; PG8_SCHED;
            PG8_LDA(At, 0, 1); PG8_STAGE(PG8_SB(0, 0), b2, voffB); PG8_STAGE(PG8_SB(0, 1), b2 + hstep, voffB); PG8_STAGE(PG8_SA(0, 0), a2, voffA);
            PG8_WAIT_V(8); PG8_WAIT_L(0); PG8_BAR; PG8_MMA(1, 0, At, B0); PG8_MMA(1, 1, At, B1); PG8_BAR; PG8_SCHED;
            PG8_LDB(B0, 1, 0); PG8_LDB(B1, 1, 1); PG8_SCHED; PG8_LDA(At, 1, 0); PG8_STAGE(PG8_SA(0, 1), a2 + hstep, voffA);
            PG8_WAIT_V(8); PG8_WAIT_L(0); PG8_BAR; PG8_MMA(0, 0, At, B0); PG8_MMA(0, 1, At, B1); PG8_BAR; PG8_SCHED;
            PG8_LDA(At, 1, 1); PG8_STAGE(PG8_SB(1, 0), b3, voffB); PG8_STAGE(PG8_SB(1, 1), b3 + hstep, voffB); PG8_STAGE(PG8_SA(1, 0), a3, voffA);
            PG8_WAIT_V(8); PG8_WAIT_L(0); PG8_BAR; PG8_MMA(1, 0, At, B0); PG8_MMA(1, 1, At, B1); PG8_BAR; PG8_SCHED;
            } else {
            PG8_LDB(B0, 0, 0); PG8_SCHED; PG8_LDA(At, 0, 0); PG8_STAGE(PG8_SA(1, 1), a1 + hstep, voffA);
            PG8_WAIT_L(8); PG8_BAR; PG8_WAIT_L(0); PG8_MMA(0, 0, At, B0); PG8_BAR; PG8_SCHED;
            PG8_LDB(B1, 0, 1); PG8_STAGE(PG8_SB(0, 0), b2, voffB);
            PG8_BAR; PG8_WAIT_L(0); PG8_MMA(0, 1, At, B1); PG8_BAR;
            PG8_LDA(At, 0, 1); PG8_STAGE(PG8_SA(0, 0), a2, voffA);
            PG8_BAR; PG8_WAIT_L(0); PG8_MMA(1, 0, At, B0); PG8_BAR; PG8_SCHED;
            PG8_STAGE(PG8_SB(0, 1), b2 + hstep, voffB);
            PG8_WAIT_V(6); PG8_BAR; PG8_MMA(1, 1, At, B1); PG8_BAR;
            PG8_LDB(B0, 1, 0); PG8_SCHED; PG8_LDA(At, 1, 0); PG8_STAGE(PG8_SA(0, 1), a2 + hstep, voffA);
            PG8_WAIT_L(8); PG8_BAR; PG8_WAIT_L(0); PG8_MMA(0, 0, At, B0); PG8_BAR; PG8_SCHED;
            PG8_LDB(B1, 1, 1); PG8_STAGE(PG8_SB(1, 0), b3, voffB);
            PG8_BAR; PG8_WAIT_L(0); PG8_MMA(0, 1, At, B1); PG8_BAR;
            PG8_LDA(At, 1, 1); PG8_STAGE(PG8_SA(1, 0), a3, voffA);
            PG8_BAR; PG8_WAIT_L(0); PG8_MMA(1, 0, At, B0); PG8_BAR; PG8_SCHED;
            PG8_STAGE(PG8_SB(1, 1), b3 + hstep, voffB);
            PG8_WAIT_V(6); PG8_BAR; PG8_MMA(1, 1, At, B1); PG8_BAR;
            }
        }
        if constexpr (ALIGN_EPI) { if (wr == 0) PG8_BAR; }
        if constexpr (!Epi::AFTER_DRAIN) { E(acc, cur, wr, wc, fr, fq); S.done(cur); }
        if (!has_next) break;
#pragma unroll
        for (int a = 0; a < 2; ++a)
#pragma unroll
            for (int b = 0; b < 2; ++b)
#pragma unroll
                for (int m = 0; m < 4; ++m)
#pragma unroll
                    for (int n = 0; n < 2; ++n) acc[a][b][m][n] = (f32x4){0.f, 0.f, 0.f, 0.f};
        cur = nxt; cA = nA; cB = nB; ++ui;
        if constexpr (ALIGN_EPI) { if (wr == 1) PG8_BAR; }
    }
    PG8_WAIT_V(0);
    if constexpr (!ALIGN_EPI) { if (wr == 0) PG8_BAR; }
    PG8_BAR;
    if constexpr (Epi::AFTER_DRAIN) { E.fused(acc, cur, wr, wc, fr, fq, lds, wid, lane); S.done(cur); }
#undef PG8_SA
#undef PG8_SB
#undef PG8_STAGE
#undef PG8_LDA
#undef PG8_LDB
#undef PG8_MMA
#undef PG8_WAIT_V
#undef PG8_WAIT_L
#undef PG8_BAR
#undef PG8_SCHED
}
}
#define GAS __attribute__((address_space(1)))
#define LAS __attribute__((address_space(3)))
typedef unsigned v4u __attribute__((ext_vector_type(4)));
typedef unsigned v2u __attribute__((ext_vector_type(2)));
typedef float f32x4 __attribute__((ext_vector_type(4)));
typedef float f32x2 __attribute__((ext_vector_type(2)));
typedef short bf16x8 __attribute__((ext_vector_type(8)));
typedef __bf16 bf16x2 __attribute__((ext_vector_type(2)));
constexpr int NWAVES = 8, NTHREADS = NWAVES * 64;
constexpr int LDS_BYTES = 147456, MISC_OFF = LDS_BYTES - 512;
constexpr int CW_BAR = 4096;
constexpr float LOG2E = 1.44269504088896340736f;

__device__ __forceinline__ unsigned cvtpk(float lo, float hi) { f32x2 v = {lo, hi}; bf16x2 b = __builtin_convertvector(v, bf16x2); return __builtin_bit_cast(unsigned, b); }
__device__ __forceinline__ f32x4 mfma16(bf16x8 a, bf16x8 b, f32x4 c) { return __builtin_amdgcn_mfma_f32_16x16x32_bf16(a, b, c, 0, 0, 0); }
__device__ __forceinline__ float dot2bf(unsigned w, unsigned x, float acc) { return __builtin_amdgcn_fdot2_f32_bf16(__builtin_bit_cast(bf16x2, w), __builtin_bit_cast(bf16x2, x), acc, false); }
__device__ __forceinline__ float fexp2(float x) { return __builtin_amdgcn_exp2f(x); }
#define LDS_WAIT() asm volatile("s_waitcnt lgkmcnt(0)" ::: "memory")
__device__ __forceinline__ unsigned umax(unsigned a, unsigned b) { return a > b ? a : b; }
__device__ __forceinline__ unsigned umin(unsigned a, unsigned b) { return a < b ? a : b; }
__device__ __forceinline__ unsigned xmin4(unsigned m) { auto r = __builtin_amdgcn_permlane16_swap(m, m, false, false); m = umin(r[0], r[1]); auto q = __builtin_amdgcn_permlane32_swap(m, m, false, false); return umin(q[0], q[1]); }
__device__ __forceinline__ unsigned xmax4(unsigned m) { auto r = __builtin_amdgcn_permlane16_swap(m, m, false, false); m = umax(r[0], r[1]); auto q = __builtin_amdgcn_permlane32_swap(m, m, false, false); return umax(q[0], q[1]); }
__device__ __forceinline__ float xfmax4(float v) { unsigned m = __float_as_uint(v); auto r = __builtin_amdgcn_permlane16_swap(m, m, false, false); v = fmaxf(__uint_as_float(r[0]), __uint_as_float(r[1])); m = __float_as_uint(v);
    auto q = __builtin_amdgcn_permlane32_swap(m, m, false, false); return fmaxf(__uint_as_float(q[0]), __uint_as_float(q[1])); }
__device__ __forceinline__ float xfsum4(float v) { unsigned m = __float_as_uint(v); auto r = __builtin_amdgcn_permlane16_swap(m, m, false, false); v = __uint_as_float(r[0]) + __uint_as_float(r[1]); m = __float_as_uint(v);
    auto q = __builtin_amdgcn_permlane32_swap(m, m, false, false); return __uint_as_float(q[0]) + __uint_as_float(q[1]); }

#define XB_TMO      128
#define XB_XCNT(j)  (256  + 64 * (j))
#define XB_XSUB(j)  (1280 + 64 * (j))
#define XB_XGEN(j)  (2304 + 64 * (j))
#define XB_TOP      3328
#define XB_TOPGEN   3392
#define XCD_BAR_WORDS 3456
#define XB_SPIN_CAP (1u << 18)
__device__ __forceinline__ unsigned xb_ld(unsigned* p)              { return __hip_atomic_load(p, __ATOMIC_RELAXED, __HIP_MEMORY_SCOPE_AGENT); }
__device__ __forceinline__ unsigned xb_add(unsigned* p, unsigned v) { return __hip_atomic_fetch_add(p, v, __ATOMIC_RELAXED, __HIP_MEMORY_SCOPE_AGENT); }
__device__ __forceinline__ unsigned xb_xcc_id() { return (unsigned)__builtin_amdgcn_s_getreg((3 << 11) | 20) & 0xFu; }
#define XB_SPIN(cond, bar) do { unsigned _sp = 0; while (cond) { __builtin_amdgcn_s_sleep(1); \
    if ((++_sp & 255u) == 0u) { if (xb_ld(&(bar)[XB_TMO])) break; if (_sp > XB_SPIN_CAP) { atomicAdd(&(bar)[XB_TMO], 1u); break; } } } } while (0)
struct XcdBarrier { unsigned* bar; unsigned x; volatile LAS unsigned* st; };
__device__ __forceinline__ XcdBarrier xcd_barrier_post(unsigned* bar, volatile LAS unsigned* st) {
    XcdBarrier b; b.bar = bar; b.x = xb_xcc_id(); b.st = st;
    if (threadIdx.x == 0) (void)xb_add(&bar[XB_XCNT(b.x)], 1u);
    return b;
}
__device__ __forceinline__ void xcd_barrier_complete(unsigned* bar, unsigned x, unsigned& nloc, unsigned& nx) {
    const unsigned G = gridDim.x * gridDim.y * gridDim.z;
    unsigned sum, cnt, mine, sp = 0u;
    for (;;) {
        sum = 0u; cnt = 0u; mine = 0u;
#pragma unroll
        for (unsigned j = 0; j < 16; ++j) { const unsigned c = xb_ld(&bar[XB_XCNT(j)]); sum += c; cnt += (c > 0u) ? 1u : 0u; mine = (j == x) ? c : mine; }
        if (sum == G) break;
        __builtin_amdgcn_s_sleep(1);
        if ((++sp & 255u) == 0u) { if (xb_ld(&bar[XB_TMO])) break; if (sp > XB_SPIN_CAP) { atomicAdd(&bar[XB_TMO], 1u); break; } }
    }
    nloc = mine > 0u ? mine : 1u; nx = cnt > 0u ? cnt : 1u;
}
__device__ __forceinline__ void xcd_barrier(const XcdBarrier& b) {
    asm volatile("s_waitcnt vmcnt(0)" ::: "memory");
    __syncthreads();
    if (threadIdx.x == 0) {
        unsigned* bar = b.bar;
        __builtin_amdgcn_s_waitcnt(0);
        unsigned nloc = b.st[0], nx = b.st[1];
        if (nloc == 0u) { xcd_barrier_complete(bar, b.x, nloc, nx); b.st[0] = nloc; b.st[1] = nx; }
        const unsigned old = xb_add(&bar[XB_XSUB(b.x)], 1u);
        const unsigned gen = old / nloc;
        if (old + 1u == (gen + 1u) * nloc) {
            __builtin_amdgcn_fence(__ATOMIC_RELEASE, "agent");
            asm volatile("s_waitcnt vmcnt(0)" ::: "memory");
            const unsigned og = xb_add(&bar[XB_TOP], 1u);
            const unsigned tg = og / nx;
            if (og + 1u == (tg + 1u) * nx) xb_add(&bar[XB_TOPGEN], 1u);
            else XB_SPIN(xb_ld(&bar[XB_TOPGEN]) == tg, bar);
            __builtin_amdgcn_fence(__ATOMIC_ACQUIRE, "agent");
            xb_add(&bar[XB_XGEN(b.x)], 1u);
            asm volatile("s_waitcnt vmcnt(0)" ::: "memory");
        } else {
            XB_SPIN(xb_ld(&bar[XB_XGEN(b.x)]) == gen, bar);
            __builtin_amdgcn_fence(__ATOMIC_ACQUIRE, "agent");
            asm volatile("s_waitcnt vmcnt(0)" ::: "memory");
        }
    }
    __syncthreads();
}

struct EpiStoreBf {
    static constexpr bool PERM = true, AFTER_DRAIN = false;
    bf16_t* O; int ldc;
    __device__ __forceinline__ void operator()(const pg8::f32x4 (&acc)[2][2][4][2], const pg8::Unit& u, int wr, int wc, int fr, int fq) const {
        const int row0 = u.pm * 256 + wr * 64 + fr, col0 = u.pn * 256 + wc * 32 + 8 * fq;
#pragma unroll
        for (int ai = 0; ai < 2; ++ai)
#pragma unroll
            for (int m = 0; m < 4; ++m) { bf16_t* rowp = O + (size_t)(row0 + ai * 128 + m * 16) * ldc + col0;
#pragma unroll
                for (int bj = 0; bj < 2; ++bj) { const pg8::f32x4 v0 = acc[ai][bj][m][0], v1 = acc[ai][bj][m][1];
                    v4u w; w.x = cvtpk(v0[0], v0[1]); w.y = cvtpk(v0[2], v0[3]); w.z = cvtpk(v1[0], v1[1]); w.w = cvtpk(v1[2], v1[3]);
                    *(v4u*)(rowp + bj * 128) = w; } }
    }
};
struct EpiY1 {
    static constexpr bool PERM = true, AFTER_DRAIN = false;
    const float* x; float* y;
    __device__ __forceinline__ void operator()(const pg8::f32x4 (&acc)[2][2][4][2], const pg8::Unit& u, int wr, int wc, int fr, int fq) const {
        const int row0 = u.pm * 256 + wr * 64 + fr, col0 = u.pn * 256 + wc * 32 + 8 * fq;
#pragma unroll
        for (int ai = 0; ai < 2; ++ai)
#pragma unroll
            for (int m = 0; m < 4; ++m) { const size_t off = (size_t)(row0 + ai * 128 + m * 16) * D_MODEL + col0;
#pragma unroll
                for (int bj = 0; bj < 2; ++bj) {
                    const f32x4 x0 = *(const f32x4*)(x + off + bj * 128), x1 = *(const f32x4*)(x + off + bj * 128 + 4);
                    *(f32x4*)(y + off + bj * 128) = x0 * ALPHA + acc[ai][bj][m][0]; *(f32x4*)(y + off + bj * 128 + 4) = x1 * ALPHA + acc[ai][bj][m][1]; } }
    }
};
struct EpiIn {
    static constexpr bool PERM = true, AFTER_DRAIN = false;
    float* POOLV; bf16_t *Q, *K, *V, *QM; const float* rope;
    __device__ __forceinline__ void operator()(const pg8::f32x4 (&acc)[2][2][4][2], const pg8::Unit& u, int wr, int wc, int fr, int fq) const {
        const int row0 = u.pm * 256 + wr * 64 + fr, cl = wc * 32 + 8 * fq, pn = u.pn;
        if (pn < 2) {
#pragma unroll
            for (int ai = 0; ai < 2; ++ai)
#pragma unroll
                for (int m = 0; m < 4; ++m) { float* rp = POOLV + (size_t)(row0 + ai * 128 + m * 16) * POOL_W + pn * 256 + cl;
#pragma unroll
                    for (int bj = 0; bj < 2; ++bj) { *(f32x4*)(rp + bj * 128) = acc[ai][bj][m][0]; *(f32x4*)(rp + bj * 128 + 4) = acc[ai][bj][m][1]; } }
            return;
        }
        bf16_t* base; int ld, c0; bool rot = false;
        if (pn < 6) { base = Q; ld = SWA_W; c0 = (pn - 2) * 256; rot = true; }
        else if (pn == 6) { base = K; ld = KV_W; c0 = 0; rot = true; }
        else if (pn == 7) { base = V; ld = KV_W; c0 = 0; }
        else { base = QM; ld = MEM_W; c0 = (pn - 8) * 256; }
        rot = rot && ((wc & 1) == 0);
#pragma unroll
        for (int ai = 0; ai < 2; ++ai)
#pragma unroll
            for (int m = 0; m < 4; ++m) {
                const int row = row0 + ai * 128 + m * 16;
                f32x4 v[2][2];
#pragma unroll
                for (int bj = 0; bj < 2; ++bj) { v[bj][0] = acc[ai][bj][m][0]; v[bj][1] = acc[ai][bj][m][1]; }
                if (rot) {
                    const f32x4* tp = (const f32x4*)(rope + (size_t)row * 16);
                    f32x4 cs[2][2]; cs[0][0] = tp[0]; cs[0][1] = tp[1]; cs[1][0] = tp[2]; cs[1][1] = tp[3];
#pragma unroll
                    for (int bj = 0; bj < 2; ++bj)
#pragma unroll
                        for (int n = 0; n < 2; ++n)
#pragma unroll
                            for (int i = 0; i < 4; ++i) {
                                const float xv = v[bj][n][i], pv = __shfl_xor(xv, 16);
                                const float c = cs[n][i >> 1][2 * (i & 1)], s = cs[n][i >> 1][2 * (i & 1) + 1];
                                const float o = fq == 0 ? xv * c - pv * s : (fq == 1 ? xv * c + pv * s : xv);
                                v[bj][n][i] = o; }
                }
                bf16_t* rowp = base + (size_t)row * ld + c0 + cl;
#pragma unroll
                for (int bj = 0; bj < 2; ++bj) { v4u w; w.x = cvtpk(v[bj][0][0], v[bj][0][1]); w.y = cvtpk(v[bj][0][2], v[bj][0][3]); w.z = cvtpk(v[bj][1][0], v[bj][1][1]); w.w = cvtpk(v[bj][1][2], v[bj][1][3]);
                    *(v4u*)(rowp + bj * 128) = w; }
            }
    }
};

__device__ __forceinline__ void p0_transpose_item(const float* W, int K, int N, bf16_t* WT, LAS float* scr, int item, int lane) {
    const int nblk = N / 32, kb = item / nblk, nb = item % nblk, k0 = 64 * kb, n0 = 32 * nb;
#pragma unroll 8
    for (int i = 0; i < 32; ++i) { const int kk = 2 * i + (lane >> 5); scr[kk * 33 + (lane & 31)] = W[(size_t)(k0 + kk) * N + n0 + (lane & 31)]; }
    LDS_WAIT(); asm volatile("" ::: "memory");
    const int c = lane & 7;
#pragma unroll
    for (int j = 0; j < 4; ++j) { const int n = (lane >> 3) + 8 * j; const LAS float* s = scr + (8 * c) * 33 + n;
        v4u o; o.x = cvtpk(s[0 * 33], s[1 * 33]); o.y = cvtpk(s[2 * 33], s[3 * 33]); o.z = cvtpk(s[4 * 33], s[5 * 33]); o.w = cvtpk(s[6 * 33], s[7 * 33]);
        *(v4u*)(WT + (size_t)(n0 + n) * K + k0 + 8 * c) = o; }
    LDS_WAIT(); asm volatile("" ::: "memory");
}
template <bool NT>
__device__ __forceinline__ void cvt_stream(const float* in, bf16_t* out, size_t n, int gw, int NGW, int lane) {
#pragma unroll 4
    for (size_t i = (size_t)gw * 512 + lane * 4; i < n; i += (size_t)NGW * 512) {
        f32x4 a, b;
        if (NT) { a = __builtin_nontemporal_load((const f32x4*)(in + i)); b = __builtin_nontemporal_load((const f32x4*)(in + i + 256)); }
        else { a = *(const f32x4*)(in + i); b = *(const f32x4*)(in + i + 256); }
        v2u o0, o1; o0.x = cvtpk(a.x, a.y); o0.y = cvtpk(a.z, a.w); o1.x = cvtpk(b.x, b.y); o1.y = cvtpk(b.z, b.w);
        *(v2u*)(out + i) = o0; *(v2u*)(out + i + 256) = o1;
    }
}

constexpr int SWA_KROW = 144, SWA_VROW = 528, SWA_VT_OFF = 256 * SWA_KROW;
__device__ __forceinline__ void swa_item(LAS unsigned char* lds, int item, const bf16_t* __restrict__ Q, const bf16_t* __restrict__ Kb, const bf16_t* __restrict__ Vb, const float* __restrict__ sinks,
                                         bf16_t* CONCAT, int tid, int wave, int lane) {
    const int qb = item & 31, kvh = (item >> 5) & 3, b = item >> 7;
    const int tok0 = b * SEQ + qb * 128;
    LAS unsigned char* Kl = lds; LAS unsigned char* Vt = lds + SWA_VT_OFF;
#pragma unroll
    for (int j = 0; j < 4; ++j) {
        const int c = tid + NTHREADS * j, row = c >> 3, part = c & 7;
        v4u kv = {0u, 0u, 0u, 0u}, vv = {0u, 0u, 0u, 0u};
        if (qb > 0 || row >= 128) { const size_t tk = (size_t)(tok0 - 128 + row); kv = *(const v4u*)(Kb + tk * KV_W + kvh * HD + part * 8); vv = *(const v4u*)(Vb + tk * KV_W + kvh * HD + part * 8); }
        *(LAS v4u*)(Kl + row * SWA_KROW + part * 16) = kv;
        LAS unsigned short* vp = (LAS unsigned short*)(Vt + (part * 8) * SWA_VROW + row * 2);
        vp[0 * (SWA_VROW / 2)] = (unsigned short)(vv.x & 0xffffu); vp[1 * (SWA_VROW / 2)] = (unsigned short)(vv.x >> 16);
        vp[2 * (SWA_VROW / 2)] = (unsigned short)(vv.y & 0xffffu); vp[3 * (SWA_VROW / 2)] = (unsigned short)(vv.y >> 16);
        vp[4 * (SWA_VROW / 2)] = (unsigned short)(vv.z & 0xffffu); vp[5 * (SWA_VROW / 2)] = (unsigned short)(vv.z >> 16);
        vp[6 * (SWA_VROW / 2)] = (unsigned short)(vv.w & 0xffffu); vp[7 * (SWA_VROW / 2)] = (unsigned short)(vv.w >> 16);
    }
    __syncthreads();
    const int g = wave & 3, h = kvh * 4 + g, q15 = lane & 15, qq = lane >> 4;
    const float sink2 = sinks[h] * LOG2E;
    const float SC = 0.125f * LOG2E;
#pragma unroll 1
    for (int cc = 0; cc < 2; ++cc) {
        const int c = 2 * (wave >> 2) + cc, kl0 = 32 * c;
        bf16x8 qf[2][2];
#pragma unroll
        for (int ni = 0; ni < 2; ++ni)
#pragma unroll
            for (int ks = 0; ks < 2; ++ks) qf[ni][ks] = *(const bf16x8*)(Q + (size_t)(tok0 + 32 * c + 16 * ni + q15) * SWA_W + h * HD + 32 * ks + 8 * qq);
        f32x4 s[10][2];
#pragma unroll
        for (int mi = 0; mi < 10; ++mi) { s[mi][0] = (f32x4){0.f, 0.f, 0.f, 0.f}; s[mi][1] = (f32x4){0.f, 0.f, 0.f, 0.f}; }
#pragma unroll
        for (int mi = 0; mi < 10; ++mi)
#pragma unroll
            for (int ks = 0; ks < 2; ++ks) {
                const bf16x8 kf = *(const LAS bf16x8*)(Kl + (kl0 + 16 * mi + q15) * SWA_KROW + (32 * ks + 8 * qq) * 2);
                s[mi][0] = mfma16(kf, qf[0][ks], s[mi][0]); s[mi][1] = mfma16(kf, qf[1][ks], s[mi][1]);
            }
        float rl[2];
#pragma unroll
        for (int ni = 0; ni < 2; ++ni) {
            const int ql = 32 * c + 16 * ni + q15;
            float mx = -INFINITY;
#pragma unroll
            for (int mi = 0; mi < 10; ++mi)
#pragma unroll
                for (int r = 0; r < 4; ++r) {
                    const int kl = kl0 + 16 * mi + 4 * qq + r;
                    const bool valid = (kl > ql) && (kl <= ql + 128) && (qb > 0 || kl >= 128);
                    const float t = valid ? s[mi][ni][r] * SC : -INFINITY;
                    s[mi][ni][r] = t; mx = fmaxf(mx, t);
                }
            mx = fmaxf(xfmax4(mx), sink2);
            float l = 0.f;
#pragma unroll
            for (int mi = 0; mi < 10; ++mi)
#pragma unroll
                for (int r = 0; r < 4; ++r) { const float p = fexp2(s[mi][ni][r] - mx); s[mi][ni][r] = p; l += p; }
            l = xfsum4(l) + fexp2(sink2 - mx);
            rl[ni] = 1.0f / l;
        }
        f32x4 o[4][2];
#pragma unroll
        for (int dt = 0; dt < 4; ++dt) { o[dt][0] = (f32x4){0.f, 0.f, 0.f, 0.f}; o[dt][1] = (f32x4){0.f, 0.f, 0.f, 0.f}; }
#pragma unroll
        for (int kk = 0; kk < 5; ++kk) {
            bf16x8 pf[2];
#pragma unroll
            for (int ni = 0; ni < 2; ++ni) {
                v4u w; w.x = cvtpk(s[2 * kk][ni][0], s[2 * kk][ni][1]); w.y = cvtpk(s[2 * kk][ni][2], s[2 * kk][ni][3]);
                w.z = cvtpk(s[2 * kk + 1][ni][0], s[2 * kk + 1][ni][1]); w.w = cvtpk(s[2 * kk + 1][ni][2], s[2 * kk + 1][ni][3]);
                pf[ni] = __builtin_bit_cast(bf16x8, w);
            }
#pragma unroll
            for (int dt = 0; dt < 4; ++dt) {
                const LAS unsigned char* vb = Vt + (16 * dt + q15) * SWA_VROW + (kl0 + 32 * kk + 4 * qq) * 2;
                const v2u lo = *(const LAS v2u*)vb, hi = *(const LAS v2u*)(vb + 32);
                v4u w; w.x = lo.x; w.y = lo.y; w.z = hi.x; w.w = hi.y;
                const bf16x8 vf = __builtin_bit_cast(bf16x8, w);
                o[dt][0] = mfma16(vf, pf[0], o[dt][0]); o[dt][1] = mfma16(vf, pf[1], o[dt][1]);
            }
        }
#pragma unroll
        for (int ni = 0; ni < 2; ++ni) {
            bf16_t* orow = CONCAT + (size_t)(tok0 + 32 * c + 16 * ni + q15) * D_MODEL + POOL_W + h * HD + 4 * qq;
#pragma unroll
            for (int dt = 0; dt < 4; ++dt) { v2u w; w.x = cvtpk(o[dt][ni][0] * rl[ni], o[dt][ni][1] * rl[ni]); w.y = cvtpk(o[dt][ni][2] * rl[ni], o[dt][ni][3] * rl[ni]); *(v2u*)(orow + 16 * dt) = w; }
        }
    }
    __syncthreads();
}
constexpr int MEM_KROW = 272, MEM_VROW = 528, MEM_VT_OFF = 256 * MEM_KROW;
__device__ __forceinline__ void mem_item(LAS unsigned char* lds, int item, const bf16_t* __restrict__ QM, const bf16_t* __restrict__ KVM, bf16_t* CONCAT, int tid, int wave, int lane) {
    const int qt = item & 31, hm = (item >> 5) & 3, b = item >> 7;
    LAS unsigned char* Kl = lds; LAS unsigned char* Vt = lds + MEM_VT_OFF;
#pragma unroll
    for (int j = 0; j < 8; ++j) {
        const int c = tid + NTHREADS * j, row = c >> 4, part = c & 15;
        const bf16_t* src = KVM + (size_t)(b * MEM_LEN + row) * (2 * MEM_W) + hm * MHD + part * 8;
        const v4u kv = *(const v4u*)src, vv = *(const v4u*)(src + MEM_W);
        *(LAS v4u*)(Kl + row * MEM_KROW + part * 16) = kv;
        LAS unsigned short* vp = (LAS unsigned short*)(Vt + (part * 8) * MEM_VROW + row * 2);
        vp[0 * (MEM_VROW / 2)] = (unsigned short)(vv.x & 0xffffu); vp[1 * (MEM_VROW / 2)] = (unsigned short)(vv.x >> 16);
        vp[2 * (MEM_VROW / 2)] = (unsigned short)(vv.y & 0xffffu); vp[3 * (MEM_VROW / 2)] = (unsigned short)(vv.y >> 16);
        vp[4 * (MEM_VROW / 2)] = (unsigned short)(vv.z & 0xffffu); vp[5 * (MEM_VROW / 2)] = (unsigned short)(vv.z >> 16);
        vp[6 * (MEM_VROW / 2)] = (unsigned short)(vv.w & 0xffffu); vp[7 * (MEM_VROW / 2)] = (unsigned short)(vv.w >> 16);
    }
    __syncthreads();
    const int q15 = lane & 15, qq = lane >> 4;
    const int tok = b * SEQ + qt * 128 + wave * 16 + q15;
    const float SC = 0.08838834764831845f * LOG2E;
    bf16x8 qf[4];
#pragma unroll
    for (int ks = 0; ks < 4; ++ks) qf[ks] = *(const bf16x8*)(QM + (size_t)tok * MEM_W + hm * MHD + 32 * ks + 8 * qq);
    f32x4 s[16];
#pragma unroll
    for (int mi = 0; mi < 16; ++mi) s[mi] = (f32x4){0.f, 0.f, 0.f, 0.f};
#pragma unroll
    for (int mi = 0; mi < 16; ++mi)
#pragma unroll
        for (int ks = 0; ks < 4; ++ks) {
            const bf16x8 kf = *(const LAS bf16x8*)(Kl + (16 * mi + q15) * MEM_KROW + (32 * ks + 8 * qq) * 2);
            s[mi] = mfma16(kf, qf[ks], s[mi]);
        }
    float mx = -INFINITY;
#pragma unroll
    for (int mi = 0; mi < 16; ++mi)
#pragma unroll
        for (int r = 0; r < 4; ++r) { const float t = s[mi][r] * SC; s[mi][r] = t; mx = fmaxf(mx, t); }
    mx = xfmax4(mx);
    float l = 0.f;
#pragma unroll
    for (int mi = 0; mi < 16; ++mi)
#pragma unroll
        for (int r = 0; r < 4; ++r) { const float p = fexp2(s[mi][r] - mx); s[mi][r] = p; l += p; }
    l = xfsum4(l);
    const float rl = 1.0f / l;
    f32x4 o[8];
#pragma unroll
    for (int dt = 0; dt < 8; ++dt) o[dt] = (f32x4){0.f, 0.f, 0.f, 0.f};
#pragma unroll
    for (int kk = 0; kk < 8; ++kk) {
        v4u pw; pw.x = cvtpk(s[2 * kk][0], s[2 * kk][1]); pw.y = cvtpk(s[2 * kk][2], s[2 * kk][3]); pw.z = cvtpk(s[2 * kk + 1][0], s[2 * kk + 1][1]); pw.w = cvtpk(s[2 * kk + 1][2], s[2 * kk + 1][3]);
        const bf16x8 pf = __builtin_bit_cast(bf16x8, pw);
#pragma unroll
        for (int dt = 0; dt < 8; ++dt) {
            const LAS unsigned char* vb = Vt + (16 * dt + q15) * MEM_VROW + (32 * kk + 4 * qq) * 2;
            const v2u lo = *(const LAS v2u*)vb, hi = *(const LAS v2u*)(vb + 32);
            v4u w; w.x = lo.x; w.y = lo.y; w.z = hi.x; w.w = hi.y;
            o[dt] = mfma16(__builtin_bit_cast(bf16x8, w), pf, o[dt]);
        }
    }
    bf16_t* orow = CONCAT + (size_t)tok * D_MODEL + POOL_W + SWA_W + hm * MHD + 4 * qq;
#pragma unroll
    for (int dt = 0; dt < 8; ++dt) { v2u w; w.x = cvtpk(o[dt][0] * rl, o[dt][1] * rl); w.y = cvtpk(o[dt][2] * rl, o[dt][3] * rl); *(v2u*)(orow + 16 * dt) = w; }
    __syncthreads();
}
constexpr int POOL_LROW = 272, POOL_LDS_PER_WAVE = 16 * POOL_LROW;
template <int W>
__device__ __forceinline__ void pool_window(LAS unsigned char* wl, const float* __restrict__ pv, int sp0, int lane) {
    f32x2 cur[16];
#pragma unroll
    for (int tt = 0; tt < 16; ++tt) cur[tt] = *(const f32x2*)(pv + (size_t)tt * POOL_W);
    f32x2 prev[W - 1];
#pragma unroll
    for (int i = 1; i < W; ++i) { const bool ok = (i <= sp0); const size_t back = ok ? (size_t)i * POOL_W : 0; const f32x2 v = *(const f32x2*)(pv - back); prev[i - 1] = ok ? v : (f32x2){0.f, 0.f}; }
    f32x2 S = {0.f, 0.f};
#pragma unroll
    for (int i = 1; i < W; ++i) S += prev[i - 1];
#pragma unroll
    for (int tt = 0; tt < 16; ++tt) {
        S += cur[tt];
        const int sp = sp0 + tt; const int cnt = (sp + 1) < W ? (sp + 1) : W;
        const f32x2 pooled = S * (1.0f / (float)cnt) - cur[tt];
        *(LAS unsigned*)(wl + tt * POOL_LROW + 4 * lane) = cvtpk(pooled.x, pooled.y);
        if (tt - W + 1 >= 0) S -= cur[tt - W + 1 >= 0 ? tt - W + 1 : 0]; else S -= prev[(W - 1 - tt) - 1 >= 0 ? (W - 1 - tt) - 1 : 0];
    }
}
__device__ __forceinline__ void pool_item(LAS unsigned char* wl, int item, const float* __restrict__ POOLV, const bf16_t* __restrict__ WPT, const float* __restrict__ pool_scale, bf16_t* CONCAT, int lane) {
    const int g = item & 3, t0 = (item >> 2) * 16, q15 = lane & 15, qq = lane >> 4;
    const int sp0 = t0 & (SEQ - 1);
    const float* pv = POOLV + (size_t)t0 * POOL_W + g * 128 + 2 * lane;
    if (g == 0) pool_window<2>(wl, pv, sp0, lane); else if (g == 1) pool_window<4>(wl, pv, sp0, lane); else if (g == 2) pool_window<8>(wl, pv, sp0, lane); else pool_window<16>(wl, pv, sp0, lane);
    LDS_WAIT(); asm volatile("" ::: "memory");
    bf16x8 pf[4];
#pragma unroll
    for (int ks = 0; ks < 4; ++ks) pf[ks] = *(const LAS bf16x8*)(wl + q15 * POOL_LROW + (32 * ks + 8 * qq) * 2);
    const int t = t0 + q15;
    bf16_t* orow = CONCAT + (size_t)t * D_MODEL + g * 128 + 4 * qq;
#pragma unroll
    for (int mt = 0; mt < 8; ++mt) {
        f32x4 acc = {0.f, 0.f, 0.f, 0.f};
#pragma unroll
        for (int ks = 0; ks < 4; ++ks) { const bf16x8 wf = *(const bf16x8*)(WPT + (size_t)g * 16384 + (16 * mt + q15) * 128 + 32 * ks + 8 * qq); acc = mfma16(wf, pf[ks], acc); }
        const f32x4 sc = *(const f32x4*)(pool_scale + g * 128 + 16 * mt + 4 * qq);
        v2u wv; wv.x = cvtpk(acc[0] * sc[0], acc[1] * sc[1]); wv.y = cvtpk(acc[2] * sc[2], acc[3] * sc[3]);
        *(v2u*)(orow + 16 * mt) = wv;
    }
    LDS_WAIT(); asm volatile("" ::: "memory");
}

__device__ __forceinline__ void ln1_row(const float* __restrict__ yrow, const float* __restrict__ g, const float* __restrict__ bta, float* xo, bf16_t* xb, int lane) {
    f32x4 v[8]; float s = 0.f;
#pragma unroll
    for (int j = 0; j < 8; ++j) { v[j] = *(const f32x4*)(yrow + 256 * j + 4 * lane); s += (v[j].x + v[j].y) + (v[j].z + v[j].w); }
    const float mean = wave_sum(s) * (1.f / D_MODEL); float q = 0.f;
#pragma unroll
    for (int j = 0; j < 8; ++j) { v[j] = v[j] - mean; q += (v[j].x * v[j].x + v[j].y * v[j].y) + (v[j].z * v[j].z + v[j].w * v[j].w); }
    const float rstd = 1.0f / sqrtf(wave_sum(q) * (1.f / D_MODEL) + LN_EPS);
#pragma unroll
    for (int j = 0; j < 8; ++j) {
        const f32x4 gg = *(const f32x4*)(g + 256 * j + 4 * lane), bb = *(const f32x4*)(bta + 256 * j + 4 * lane);
        const f32x4 y = v[j] * rstd * gg + bb;
        *(f32x4*)(xo + 256 * j + 4 * lane) = y;
        v2u w; w.x = cvtpk(y.x, y.y); w.y = cvtpk(y.z, y.w); *(v2u*)(xb + 256 * j + 4 * lane) = w;
    }
}

__device__ __forceinline__ unsigned f2ord(float f) { const unsigned u = __float_as_uint(f); return u ^ ((unsigned)((int)u >> 31) | 0x80000000u); }
__device__ __forceinline__ float ord2f(unsigned o) { const unsigned u = (o & 0x80000000u) ? (o ^ 0x80000000u) : ~o; return __uint_as_float(u); }
constexpr int TK_KROW = 272, TK_HALF = 128 * TK_KROW;
__device__ __forceinline__ void topk_item(int item, const bf16_t* __restrict__ QP, const LAS unsigned char* Kl, LAS unsigned char* et, int* EIDX, float* GATE, int lane) {
    const int h = item & 7, t0 = (item >> 3) * 16, q15 = lane & 15, qq = lane >> 4;
    const int t = t0 + q15;
    unsigned top[2][16];
    unsigned key[2][32];
#pragma unroll
    for (int half = 0; half < 2; ++half) {
        bf16x8 qf[4];
#pragma unroll
        for (int ks = 0; ks < 4; ++ks) qf[ks] = *(const bf16x8*)(QP + (size_t)t * D_MODEL + h * 256 + half * 128 + 32 * ks + 8 * qq);
#pragma unroll
        for (int mi = 0; mi < 8; ++mi) {
            f32x4 acc = {0.f, 0.f, 0.f, 0.f};
#pragma unroll
            for (int ks = 0; ks < 4; ++ks) { const bf16x8 kf = *(const LAS bf16x8*)(Kl + half * TK_HALF + (16 * mi + q15) * TK_KROW + (32 * ks + 8 * qq) * 2); acc = mfma16(kf, qf[ks], acc); }
#pragma unroll
            for (int r = 0; r < 4; ++r) key[half][mi * 4 + r] = (f2ord(acc[r]) & ~0x7Fu) | (unsigned)(127 - (16 * mi + 4 * qq + r));
        }
    }
    unsigned C0 = 0xFFFFFFFFu, C1 = 0xFFFFFFFFu;
#pragma unroll
    for (int r = 0; r < 16; ++r) {
        unsigned L[2];
#pragma unroll
        for (int half = 0; half < 2; ++half) {
            const unsigned C = half ? C1 : C0;
            unsigned t1[11];
#pragma unroll
            for (int i = 0; i < 10; ++i) t1[i] = umin(umin(C - key[half][3 * i], C - key[half][3 * i + 1]), C - key[half][3 * i + 2]);
            t1[10] = umin(C - key[half][30], C - key[half][31]);
            const unsigned u0 = umin(umin(t1[0], t1[1]), t1[2]), u1 = umin(umin(t1[3], t1[4]), t1[5]), u2 = umin(umin(t1[6], t1[7]), t1[8]), u3 = umin(t1[9], t1[10]);
            L[half] = umin(umin(umin(u0, u1), u2), u3);
        }
        const unsigned M0 = C0 - xmin4(L[0]), M1 = C1 - xmin4(L[1]);
        top[0][r] = M0; top[1][r] = M1; C0 = M0 - 1u; C1 = M1 - 1u;
    }
    float v1[16], v2[16];
#pragma unroll
    for (int r = 0; r < 16; ++r) { v1[r] = ord2f(top[0][r] & ~0x7Fu); v2[r] = ord2f(top[1][r] & ~0x7Fu); }
    if (qq < 2) {
#pragma unroll
        for (int r4 = 0; r4 < 4; ++r4) { v4u ev;
#pragma unroll
            for (int i = 0; i < 4; ++i) { const unsigned tk = qq ? top[1][4 * r4 + i] : top[0][4 * r4 + i]; const unsigned id7 = 127u - (tk & 0x7Fu); ev[i] = qq ? id7 : id7 * 128u; }
            *(LAS v4u*)(et + q15 * 128 + qq * 64 + r4 * 16) = ev; }
    }
    unsigned ck[13];
#pragma unroll
    for (int i = 0; i < 13; ++i) ck[i] = 0u;
    {
        int n = 0;
#pragma unroll
        for (int a = 0; a < 16; ++a)
#pragma unroll
            for (int bb = 0; bb < 16; ++bb)
                if ((a + 1) * (bb + 1) <= 16) {
                    const unsigned pk = (f2ord(v1[a] + v2[bb]) & ~0xFFu) | (unsigned)(255 - (a * 16 + bb));
                    ck[n >> 2] = (qq == (n & 3)) ? pk : ck[n >> 2];
                    ++n;
                }
    }
    LDS_WAIT();
    float sc[16];
    unsigned CC = 0xFFFFFFFFu;
#pragma unroll
    for (int r = 0; r < 16; ++r) {
        const unsigned c0 = umin(umin(CC - ck[0], CC - ck[1]), CC - ck[2]), c1 = umin(umin(CC - ck[3], CC - ck[4]), CC - ck[5]), c2 = umin(umin(CC - ck[6], CC - ck[7]), CC - ck[8]), c3 = umin(umin(CC - ck[9], CC - ck[10]), CC - ck[11]);
        const unsigned M = CC - xmin4(umin(umin(umin(c0, c1), umin(c2, c3)), CC - ck[12]));
        CC = M - 1u;
        sc[r] = ord2f(M & ~0xFFu);
        const unsigned id8 = 255u - (M & 0xFFu);
        const unsigned we = *(const LAS unsigned*)(et + q15 * 128 + (id8 >> 4) * 4) + *(const LAS unsigned*)(et + q15 * 128 + 64 + (id8 & 15u) * 4);
        if (qq == (r & 3)) EIDX[(size_t)t * EPT + h * TOPK + r] = (int)we;
    }
    const float smax = sc[0];
    float den = 0.f;
#pragma unroll
    for (int r = 0; r < 16; ++r) { sc[r] = fexp2((sc[r] - smax) * LOG2E); den += sc[r]; }
    const float rden = 1.0f / den;
    if (qq == 0) {
        float* gp = GATE + (size_t)t * EPT + h * TOPK;
#pragma unroll
        for (int r = 0; r < 16; r += 4) *(f32x4*)(gp + r) = (f32x4){sc[r] * rden, sc[r + 1] * rden, sc[r + 2] * rden, sc[r + 3] * rden};
    }
    LDS_WAIT();
}

struct SliceMeta { int idx[16]; };
__device__ __forceinline__ void slice_meta(SliceMeta& m, const int* __restrict__ EIDX, int t, int g) {
#pragma unroll
    for (int k4 = 0; k4 < 4; ++k4) { const v4u iv = *(const v4u*)(EIDX + (size_t)t * EPT + 16 * g + 4 * k4); m.idx[4 * k4] = (int)iv.x; m.idx[4 * k4 + 1] = (int)iv.y; m.idx[4 * k4 + 2] = (int)iv.z; m.idx[4 * k4 + 3] = (int)iv.w; }
}
#define PU_GATHER(W, IDX) do { _Pragma("unroll") for (int _k = 0; _k < 16; ++_k) W[_k] = *(const v4u*)(base + (size_t)(IDX).idx[_k] * 128); } while (0)
#define PU_META(M, XA, XC, T) do { slice_meta(M, EIDX, (T), g); XA = *(const v4u*)(X1B + (size_t)(T) * D_MODEL + 128 * s + 16 * c); XC = *(const v4u*)(X1B + (size_t)(T) * D_MODEL + 128 * s + 16 * c + 8); } while (0)
#define PU_COMPUTE(W, XA, XC, T) do { const unsigned xb[8] = {XA.x, XA.y, XA.z, XA.w, XC.x, XC.y, XC.z, XC.w}; float p[16]; \
        if (VARIANT == 1) { _Pragma("unroll") for (int k = 0; k < 16; ++k) p[k] = __uint_as_float((W[k][0] ^ W[k][1]) ^ (W[k][2] ^ W[k][3]) ^ xb[k & 7]); } else \
        _Pragma("unroll") for (int k = 0; k < 16; ++k) { float a = 0.f, b = 0.f; \
            _Pragma("unroll") for (int j = 0; j < 4; ++j) { const unsigned wv = W[k][j]; \
                a = __builtin_amdgcn_fdot2_f32_bf16(__builtin_amdgcn_cvt_scalef32_pk_bf16_fp8(wv, 1.0f, false), __builtin_bit_cast(bf16x2, xb[2 * j]), a, false); \
                b = __builtin_amdgcn_fdot2_f32_bf16(__builtin_amdgcn_cvt_scalef32_pk_bf16_fp8(wv, 1.0f, true), __builtin_bit_cast(bf16x2, xb[2 * j + 1]), b, false); } \
            p[k] = a + b; } \
        float r8[8], r4[4], r2[2]; \
        _Pragma("unroll") for (int m = 0; m < 8; ++m) { const float keep = b4 ? p[m + 8] : p[m], send = b4 ? p[m] : p[m + 8]; r8[m] = keep + __shfl_xor(send, 4); } \
        _Pragma("unroll") for (int m = 0; m < 4; ++m) { const float keep = b2 ? r8[m + 4] : r8[m], send = b2 ? r8[m] : r8[m + 4]; r4[m] = keep + __shfl_xor(send, 2); } \
        _Pragma("unroll") for (int m = 0; m < 2; ++m) { const float keep = b1 ? r4[m + 2] : r4[m], send = b1 ? r4[m] : r4[m + 2]; r2[m] = keep + __shfl_xor(send, 1); } \
        *(f32x2*)(HP + ((size_t)s * MTOK + (T)) * EPT + 16 * g + k0) = (f32x2){r2[0], r2[1]}; } while (0)
template <int VARIANT>
__device__ __forceinline__ void pu_sweep(int s, int tfirst, int tstep, const bf16_t* __restrict__ X1B, const int* __restrict__ EIDX, const unsigned char* __restrict__ U8S, float* HP, int lane) {
    const int g = lane >> 3, c = lane & 7;
    const unsigned char* base = U8S + (size_t)s * NEXP * 128 + 16 * c;
    const bool b4 = c & 4, b2 = c & 2, b1 = c & 1;
    const int k0 = (b4 ? 8 : 0) + (b2 ? 4 : 0) + (b1 ? 2 : 0);
    const int n = (MTOK - tfirst + tstep - 1) / tstep;
    const int tlast = tfirst + (n - 1) * tstep;
    SliceMeta mA, mB; v4u xaA, xcA, xaB, xcB; v4u wA[16], wB[16];
    PU_META(mA, xaA, xcA, tfirst);
    PU_META(mB, xaB, xcB, (tfirst + tstep <= tlast ? tfirst + tstep : tlast));
    PU_GATHER(wA, mA);
#pragma unroll 1
    for (int t = tfirst; t <= tlast; t += 2 * tstep) {
        const int t1 = t + tstep <= tlast ? t + tstep : tlast, t2 = t + 2 * tstep <= tlast ? t + 2 * tstep : tlast, t3 = t + 3 * tstep <= tlast ? t + 3 * tstep : tlast;
        PU_GATHER(wB, mB);
        SliceMeta mN; v4u xaN, xcN; PU_META(mN, xaN, xcN, t2);
        PU_COMPUTE(wA, xaA, xcA, t);
        mA = mN; xaA = xaN; xcA = xcN;
        PU_GATHER(wA, mA);
        PU_META(mN, xaN, xcN, t3);
        if (t + tstep <= tlast) PU_COMPUTE(wB, xaB, xcB, t1);
        mB = mN; xaB = xaN; xcB = xcN;
    }
}
__device__ __forceinline__ void pv_sweep(int s, int tfirst, int tstep, const float* __restrict__ X1, const int* __restrict__ EIDX, const float* __restrict__ A, const unsigned char* __restrict__ V8S,
                                         float* Y2, float* STAT, int lane) {
    const int g = lane >> 3, c = lane & 7;
    const unsigned char* base = V8S + (size_t)s * NEXP * 128 + 16 * c;
    const bool b3 = lane & 8;
    const int col = 16 * c + ((lane & 32) ? 8 : 0) + ((lane & 16) ? 4 : 0) + (b3 ? 2 : 0);
    SliceMeta cur; f32x4 av[4];
    slice_meta(cur, EIDX, tfirst, g);
#pragma unroll
    for (int k4 = 0; k4 < 4; ++k4) av[k4] = *(const f32x4*)(A + (size_t)tfirst * EPT + 16 * g + 4 * k4);
#pragma unroll 1
    for (int t = tfirst; t < MTOK; t += tstep) {
        v4u w[16];
#pragma unroll
        for (int k = 0; k < 16; ++k) w[k] = *(const v4u*)(base + (size_t)cur.idx[k] * 128);
        const int tn = (t + tstep < MTOK) ? t + tstep : t;
        SliceMeta nxt; slice_meta(nxt, EIDX, tn, g);
        f32x4 avn[4];
#pragma unroll
        for (int k4 = 0; k4 < 4; ++k4) avn[k4] = *(const f32x4*)(A + (size_t)tn * EPT + 16 * g + 4 * k4);
        const f32x2 xr = *(const f32x2*)(X1 + (size_t)t * D_MODEL + 128 * s + col);
        f32x4 acc[4];
#pragma unroll
        for (int j = 0; j < 4; ++j) acc[j] = (f32x4){0.f, 0.f, 0.f, 0.f};
#pragma unroll
        for (int k = 0; k < 16; ++k) { const float a = av[k >> 2][k & 3];
#pragma unroll
            for (int j = 0; j < 4; ++j) { const unsigned wv = w[k][j]; const f32x2 lo = __builtin_amdgcn_cvt_pk_f32_fp8(wv, false), hi = __builtin_amdgcn_cvt_pk_f32_fp8(wv, true);
                acc[j] += (f32x4){lo.x, lo.y, hi.x, hi.y} * a; } }
        float r8[8], r4[4], r2[2];
#pragma unroll
        for (int m = 0; m < 8; ++m) { auto r = __builtin_amdgcn_permlane32_swap(__float_as_uint(acc[m >> 2][m & 3]), __float_as_uint(acc[(m + 8) >> 2][m & 3]), false, false); r8[m] = __uint_as_float(r[0]) + __uint_as_float(r[1]); }
#pragma unroll
        for (int m = 0; m < 4; ++m) { auto r = __builtin_amdgcn_permlane16_swap(__float_as_uint(r8[m]), __float_as_uint(r8[m + 4]), false, false); r4[m] = __uint_as_float(r[0]) + __uint_as_float(r[1]); }
#pragma unroll
        for (int m = 0; m < 2; ++m) { const float keep = b3 ? r4[m + 2] : r4[m], send = b3 ? r4[m] : r4[m + 2]; r2[m] = keep + __shfl_xor(send, 8); }
        const float y0 = xr.x * ALPHA + r2[0], y1 = xr.y * ALPHA + r2[1];
        *(f32x2*)(Y2 + (size_t)t * D_MODEL + 128 * s + col) = (f32x2){y0, y1};
        const float s1 = wave_sum(y0 + y1), s2 = wave_sum(y0 * y0 + y1 * y1);
        if (lane == 0) *(f32x2*)(STAT + ((size_t)t * 16 + s) * 2) = (f32x2){s1, s2};
        cur = nxt;
#pragma unroll
        for (int k4 = 0; k4 < 4; ++k4) av[k4] = avn[k4];
    }
}
__device__ __forceinline__ void ln2_row(int t, const float* __restrict__ Y2, const float* __restrict__ STAT, const float* __restrict__ g2, const float* __restrict__ b2, float* out, int lane) {
    f32x2 st = {0.f, 0.f};
    if (lane < 16) st = *(const f32x2*)(STAT + ((size_t)t * 16 + lane) * 2);
    const float mean = wave_sum(st.x) * (1.f / D_MODEL), ex2 = wave_sum(st.y) * (1.f / D_MODEL);
    const float rstd = 1.0f / sqrtf(fmaxf(ex2 - mean * mean, 0.f) + LN_EPS);
#pragma unroll
    for (int j = 0; j < 8; ++j) {
        const int c = 256 * j + 4 * lane;
        const f32x4 y = *(const f32x4*)(Y2 + (size_t)t * D_MODEL + c), gg = *(const f32x4*)(g2 + c), bb = *(const f32x4*)(b2 + c);
        *(f32x4*)(out + (size_t)t * D_MODEL + c) = (y - mean) * rstd * gg + bb;
    }
}
template <int R>
__device__ __forceinline__ void cvt_rows_fp8(const float* __restrict__ in, unsigned char* outs, float* sc, int row0, int lane) {
    f32x4 v[R][8];
#pragma unroll
    for (int r = 0; r < R; ++r)
#pragma unroll
        for (int j = 0; j < 8; ++j) v[r][j] = __builtin_nontemporal_load((const f32x4*)(in + (size_t)(row0 + r) * D_MODEL + 256 * j + 4 * lane));
#pragma unroll
    for (int r = 0; r < R; ++r) {
        float am = 0.f;
#pragma unroll
        for (int j = 0; j < 8; ++j) am = fmaxf(am, fmaxf(fmaxf(fabsf(v[r][j].x), fabsf(v[r][j].y)), fmaxf(fabsf(v[r][j].z), fabsf(v[r][j].w))));
#pragma unroll
        for (int o = 1; o < 64; o <<= 1) am = fmaxf(am, __shfl_xor(am, o));
        const float inv = am > 0.f ? 256.0f / am : 1.0f, scale = am > 0.f ? am * (1.0f / 256.0f) : 1.0f;
#pragma unroll
        for (int j = 0; j < 8; ++j) {
            int w = 0; w = __builtin_amdgcn_cvt_pk_fp8_f32(v[r][j].x * inv, v[r][j].y * inv, w, false); w = __builtin_amdgcn_cvt_pk_fp8_f32(v[r][j].z * inv, v[r][j].w * inv, w, true);
            *(unsigned*)(outs + ((size_t)(2 * j + (lane >> 5)) * NEXP + (row0 + r)) * 128 + 4 * (lane & 31)) = (unsigned)w;
        }
        if (lane == 0) sc[row0 + r] = scale;
    }
}

struct Args { const void* in[18]; float* out; unsigned char* ws; int ph_lo, ph_hi, li, pad; };
constexpr int N_PHASES = 11;

#define P_IN(T, i) ((const T*)args.in[i])
#define P_WS(T, off) ((T*)(ws + (off)))
#define x_in P_IN(float, 0)
#define mem_in P_IN(float, 1)
#define positions P_IN(int, 2)
#define w_in P_IN(float, 3)
#define w_mem_kv P_IN(float, 4)
#define w_pool P_IN(float, 5)
#define pool_scale P_IN(float, 6)
#define sinks P_IN(float, 7)
#define w_out P_IN(float, 8)
#define ln1_g P_IN(float, 9)
#define ln1_b P_IN(float, 10)
#define w_peer_q P_IN(float, 11)
#define sk1 P_IN(float, 12)
#define sk2 P_IN(float, 13)
#define eu P_IN(float, 14)
#define ev P_IN(float, 15)
#define ln2_g P_IN(float, 16)
#define ln2_b P_IN(float, 17)
#define WINT P_WS(bf16_t, WS_WINT)
#define WKVT P_WS(bf16_t, WS_WKVT)
#define WOT P_WS(bf16_t, WS_WOT)
#define WQT P_WS(bf16_t, WS_WQT)
#define WPT P_WS(bf16_t, WS_SMALL)
#define K1B P_WS(bf16_t, WS_SMALL + 131072)
#define K2B P_WS(bf16_t, WS_SMALL + 163840)
#define ROPE P_WS(float, WS_SMALL + 262144)
#define XB P_WS(bf16_t, WS_XB)
#define X1B P_WS(bf16_t, WS_X1B)
#define MEMB P_WS(bf16_t, WS_MEMB)
#define KVM P_WS(bf16_t, WS_KVM)
#define POOLV P_WS(float, WS_POOLV)
#define Q P_WS(bf16_t, WS_Q)
#define Kb P_WS(bf16_t, WS_K)
#define Vb P_WS(bf16_t, WS_V)
#define QM P_WS(bf16_t, WS_QM)
#define CONCAT P_WS(bf16_t, WS_CONCAT)
#define Y1 P_WS(float, WS_Y1)
#define X1 P_WS(float, WS_X1)
#define QP P_WS(bf16_t, WS_QP)
#define EIDX P_WS(int, WS_EIDX)
#define GATE P_WS(float, WS_GATE)
#define U8 P_WS(unsigned char, WS_UB)
#define V8 P_WS(unsigned char, WS_VB)
#define SU P_WS(float, WS_UB + 48 * MiB)
#define SV P_WS(float, WS_VB + 48 * MiB)
#define HP P_WS(float, WS_POOLV)
#define AV P_WS(float, WS_POOLV + 64 * MiB)
#define STAT P_WS(float, WS_POOLV + 68 * MiB)
#define Y2 P_WS(float, WS_Y1)
__global__ void __launch_bounds__(NTHREADS, 2) mega_fwd(Args args) {
    extern __shared__ __attribute__((aligned(16))) unsigned char lds_raw[];
    LAS unsigned char* lds = (LAS unsigned char*)lds_raw;
    volatile LAS unsigned* MISC = (volatile LAS unsigned*)(lds + MISC_OFF);
    const int tid = threadIdx.x, lane = tid & 63, wave = __builtin_amdgcn_readfirstlane(tid >> 6);
    const int G = gridDim.x, bx = blockIdx.x;
    const int vcu = (G % 8 == 0) ? (bx % 8) * (G / 8) + bx / 8 : bx;
    const int gw = vcu * NWAVES + wave, NGW = G * NWAVES;
    unsigned char* ws = args.ws;
    for (int u = tid; u < (LDS_BYTES - MISC_OFF) / 4; u += NTHREADS) MISC[u] = 0u;
    __syncthreads();
    XcdBarrier bar = xcd_barrier_post((unsigned*)(ws + WS_CTL) + CW_BAR + args.li * XCD_BAR_WORDS, MISC + 8);
    const int lo = args.ph_lo, hi = args.ph_hi;
#ifndef ONLY_PHASES
#define ONLY_PHASES 2047
#endif
#define IN(k) (((ONLY_PHASES >> (k)) & 1) && lo <= (k) && (k) < hi)
#ifndef REPEAT_MASK
#define REPEAT_MASK 0
#endif
#define REP(k) for (int _rep = 0; _rep < 1 + ((REPEAT_MASK >> (k)) & 1); ++_rep)
#define SEAM(k) do { if (IN(k) && IN((k) + 1)) xcd_barrier(bar); } while (0)

    if (IN(0)) REP(0) {
        LAS float* scr = (LAS float*)(lds + wave * 16384);
        constexpr int I_IN = (D_MODEL / 64) * (IN_W / 32), I_KV = (D_MODEL / 64) * (2 * MEM_W / 32), I_O = (D_MODEL / 64) * (D_MODEL / 32), I_Q = I_O, I_P = 4 * 2 * 4;
        constexpr int NITEMS = I_IN + I_KV + I_O + I_Q + I_P;
        for (int it = gw; it < NITEMS; it += NGW) {
            int r = it;
            if (r < I_IN) { p0_transpose_item(w_in, D_MODEL, IN_W, WINT, scr, r, lane); continue; } r -= I_IN;
            if (r < I_KV) { p0_transpose_item(w_mem_kv, D_MODEL, 2 * MEM_W, WKVT, scr, r, lane); continue; } r -= I_KV;
            if (r < I_O) { p0_transpose_item(w_out, D_MODEL, D_MODEL, WOT, scr, r, lane); continue; } r -= I_O;
            if (r < I_Q) { p0_transpose_item(w_peer_q, D_MODEL, D_MODEL, WQT, scr, r, lane); continue; } r -= I_Q;
            { const int gpl = r >> 3; p0_transpose_item(w_pool + (size_t)gpl * 16384, 128, 128, WPT + (size_t)gpl * 16384, scr, r & 7, lane); }
        }
        cvt_stream<false>(x_in, XB, (size_t)MTOK * D_MODEL, gw, NGW, lane);
        cvt_stream<false>(mem_in, MEMB, (size_t)MMEM * D_MODEL, gw, NGW, lane);
        cvt_stream<false>(sk1, K1B, (size_t)NKEYS * 128, gw, NGW, lane);
        cvt_stream<false>(sk2, K2B, (size_t)NKEYS * 128, gw, NGW, lane);
        for (int i = gw * 64 + lane; i < MTOK * 8; i += NGW * 64) { float c, s; rope_cs(positions[i >> 3], i & 7, c, s); *(f32x2*)(ROPE + 2 * (size_t)i) = (f32x2){c, s}; }
    }
    SEAM(0);
    if (IN(1)) REP(1) {
        { pg8::Gemm g{XB, WINT, MTOK, IN_W, D_MODEL}; pg8::StaticOrder S; S.init(MTOK, IN_W, G, bx);
          EpiIn E{POOLV, Q, Kb, Vb, QM, ROPE};
          pg8::gemm_phase<EpiIn, pg8::StaticOrder, true, true>(lds, g, S, E); }
        { pg8::Gemm g{MEMB, WKVT, MMEM, 2 * MEM_W, D_MODEL}; pg8::StaticOrder S; S.init(MMEM, 2 * MEM_W, G, (bx + G - 64) % G);
          EpiStoreBf E{KVM, 2 * MEM_W};
          pg8::gemm_phase<EpiStoreBf, pg8::StaticOrder, true, true>(lds, g, S, E); }
        { const int f0 = (G == 256) ? 72 : 0;
          if (bx >= f0) { const int fw = (bx - f0) * NWAVES + wave, NFW = (G - f0) * NWAVES;
            for (int r = fw * 4; r < 2 * NEXP; r += NFW * 4) { if (r < NEXP) cvt_rows_fp8<4>(eu, U8, SU, r, lane); else cvt_rows_fp8<4>(ev, V8, SV, r - NEXP, lane); } } }
    }
    SEAM(1);
    if (IN(2)) REP(2) {
        for (int it = vcu; it < 512; it += G) {
            if (it < 256) swa_item(lds, it, Q, Kb, Vb, sinks, CONCAT, tid, wave, lane);
            else mem_item(lds, it - 256, QM, KVM, CONCAT, tid, wave, lane);
        }
        for (int it = gw; it < (MTOK / 16) * 4; it += NGW) pool_item(lds + wave * POOL_LDS_PER_WAVE, it, POOLV, WPT, pool_scale, CONCAT, lane);
    }
    SEAM(2);
    if (IN(3)) REP(3) {
        pg8::Gemm g{CONCAT, WOT, MTOK, D_MODEL, D_MODEL}; pg8::StaticOrder S; S.init(MTOK, D_MODEL, G, bx);
        EpiY1 E{x_in, Y1};
        pg8::gemm_phase<EpiY1, pg8::StaticOrder, true, true>(lds, g, S, E);
    }
    SEAM(3);
    if (IN(4)) REP(4) { for (int r = gw; r < MTOK; r += NGW) ln1_row(Y1 + (size_t)r * D_MODEL, ln1_g, ln1_b, X1 + (size_t)r * D_MODEL, X1B + (size_t)r * D_MODEL, lane); }
    SEAM(4);
    if (IN(5)) REP(5) {
        pg8::Gemm g{X1B, WQT, MTOK, D_MODEL, D_MODEL}; pg8::StaticOrder S; S.init(MTOK, D_MODEL, G, bx);
        EpiStoreBf E{QP, D_MODEL};
        pg8::gemm_phase<EpiStoreBf, pg8::StaticOrder, true, true>(lds, g, S, E);
    }
    SEAM(5);
    if (IN(6)) REP(6) {
#pragma unroll
        for (int j = 0; j < 8; ++j) { const int c = tid + NTHREADS * j, half = c >> 11, row = (c >> 4) & 127, part = c & 15;
            *(LAS v4u*)(lds + half * TK_HALF + row * TK_KROW + part * 16) = *(const v4u*)((half ? K2B : K1B) + row * 128 + part * 8); }
        __syncthreads();
        for (int it = gw; it < (MTOK / 16) * PHEADS; it += NGW) topk_item(it, QP, lds, lds + 2 * TK_HALF + wave * 2048, EIDX, GATE, lane);
        __syncthreads();
    }
    SEAM(6);
    if (IN(7)) REP(7) { const int cls = bx & 7, rk = bx >> 3;
        for (int sub = 0; sub < 2; ++sub) pu_sweep<0>(2 * cls + sub, rk * NWAVES + wave, (G >> 3) * NWAVES, X1B, EIDX, U8, HP, lane); }
    SEAM(7);
    if (IN(8)) REP(8) {
        for (int e = (gw * 64 + lane) * 4; e < MTOK * EPT; e += NGW * 64 * 4) {
            f32x4 h = {0.f, 0.f, 0.f, 0.f};
#pragma unroll
            for (int sl = 0; sl < 16; ++sl) h += *(const f32x4*)(HP + (size_t)sl * MTOK * EPT + e);
            const v4u id = *(const v4u*)(EIDX + e); const f32x4 gt = *(const f32x4*)(GATE + e);
            f32x4 a;
            a.x = gt.x * gelu_erf(h.x * SU[id.x]) * SV[id.x]; a.y = gt.y * gelu_erf(h.y * SU[id.y]) * SV[id.y];
            a.z = gt.z * gelu_erf(h.z * SU[id.z]) * SV[id.z]; a.w = gt.w * gelu_erf(h.w * SU[id.w]) * SV[id.w];
            *(f32x4*)(AV + e) = a;
        } }
    SEAM(8);
    if (IN(9)) REP(9) { const int cls = bx & 7, rk = bx >> 3;
        for (int sub = 0; sub < 2; ++sub) pv_sweep(2 * cls + sub, rk * NWAVES + wave, (G >> 3) * NWAVES, X1, EIDX, AV, V8, Y2, STAT, lane); }
    SEAM(9);
    if (IN(10)) REP(10) { for (int t = gw; t < MTOK; t += NGW) ln2_row(t, Y2, STAT, ln2_g, ln2_b, args.out, lane); }
#ifdef PROBE_P2PART
    if (lo <= 11 && 11 < hi) {
        if (PROBE_P2PART & 1) for (int it = vcu; it < 256; it += G) swa_item(lds, it, Q, Kb, Vb, sinks, CONCAT, tid, wave, lane);
        if (PROBE_P2PART & 2) for (int it = vcu; it < 256; it += G) mem_item(lds, it, QM, KVM, CONCAT, tid, wave, lane);
        if (PROBE_P2PART & 4) for (int it = gw; it < (MTOK / 16) * 4; it += NGW) pool_item(lds + wave * POOL_LDS_PER_WAVE, it, POOLV, WPT, pool_scale, CONCAT, lane);
    }
#endif
#ifdef PROBE_PHASE11
    if (lo <= 11 && 11 < hi) { const int cls = bx & 7, rk = bx >> 3;
        for (int sub = 0; sub < 2; ++sub) pu_sweep<1>(2 * cls + sub, rk * NWAVES + wave, (G >> 3) * NWAVES, X1B, EIDX, U8, HP, lane); }
#endif
#undef IN
#undef SEAM
}
#undef P_IN(T,
#undef P_WS(T,
#undef x_in
#undef mem_in
#undef positions
#undef w_in
#undef w_mem_kv
#undef w_pool
#undef pool_scale
#undef sinks
#undef w_out
#undef ln1_g
#undef ln1_b
#undef w_peer_q
#undef sk1
#undef sk2
#undef eu
#undef ev
#undef ln2_g
#undef ln2_b
#undef WINT
#undef WKVT
#undef WOT
#undef WQT
#undef WPT
#undef K1B
#undef K2B
#undef ROPE
#undef XB
#undef X1B
#undef MEMB
#undef KVM
#undef POOLV
#undef Q
#undef Kb
#undef Vb
#undef QM
#undef CONCAT
#undef Y1
#undef X1
#undef QP
#undef EIDX
#undef GATE
#undef U8
#undef V8
#undef SU
#undef SV
#undef HP
#undef AV
#undef STAT
#undef Y2

#if NAIVE_MASK != 0
__device__ __forceinline__ float toF(float v) { return v; }
__device__ __forceinline__ float toF(bf16_t v) { return bf2f(v); }

struct NvEpiF32 { float* C; int ldc, pad; __device__ void operator()(int r, int c, float v) const { C[(size_t)r * ldc + c] = v; } };
struct NvEpiBf { bf16_t* C; int ldc, pad; __device__ void operator()(int r, int c, float v) const { C[(size_t)r * ldc + c] = f2bf(v); } };
struct NvEpiY1 { const float* x; float* y; __device__ void operator()(int r, int c, float v) const { y[(size_t)r * D_MODEL + c] = ALPHA * x[(size_t)r * D_MODEL + c] + v; } };

template <class TA, class Epi>
__global__ void __launch_bounds__(256) nv_gemm(const TA* __restrict__ A, const float* __restrict__ B, int M, int N, int K, Epi epi) {
    __shared__ float As[16][65];
    __shared__ float Bs[16][64];
    const int tx = threadIdx.x & 15, ty = threadIdx.x >> 4;
    const int m0 = blockIdx.y * 64, n0 = blockIdx.x * 64;
    float acc[4][4];
#pragma unroll
    for (int i = 0; i < 4; ++i)
#pragma unroll
        for (int j = 0; j < 4; ++j) acc[i][j] = 0.f;
    for (int k0 = 0; k0 < K; k0 += 16) {
        for (int i = threadIdx.x; i < 1024; i += 256) { const int r = i >> 4, c = i & 15; As[c][r] = toF(A[(size_t)(m0 + r) * K + k0 + c]); }
        for (int i = threadIdx.x; i < 1024; i += 256) { const int r = i >> 6, c = i & 63; Bs[r][c] = B[(size_t)(k0 + r) * N + n0 + c]; }
        __syncthreads();
#pragma unroll
        for (int kk = 0; kk < 16; ++kk) {
            float a[4], b[4];
#pragma unroll
            for (int i = 0; i < 4; ++i) { a[i] = As[kk][ty * 4 + i]; b[i] = Bs[kk][tx * 4 + i]; }
#pragma unroll
            for (int i = 0; i < 4; ++i)
#pragma unroll
                for (int j = 0; j < 4; ++j) acc[i][j] += a[i] * b[j];
        }
        __syncthreads();
    }
#pragma unroll
    for (int i = 0; i < 4; ++i)
#pragma unroll
        for (int j = 0; j < 4; ++j) epi(m0 + ty * 4 + i, n0 + tx * 4 + j, acc[i][j]);
}

__global__ void nv_post1(const float* __restrict__ H, const int* __restrict__ positions, float* POOLV, bf16_t* Q, bf16_t* Kb, bf16_t* Vb, bf16_t* QM) {
    const size_t gid = (size_t)blockIdx.x * blockDim.x + threadIdx.x;
    if (gid >= (size_t)MTOK * IN_W) return;
    const int t = (int)(gid / IN_W), col = (int)(gid % IN_W);
    const float* hr = H + (size_t)t * IN_W;
    const float v = hr[col];
    if (col < POOL_W) { POOLV[(size_t)t * POOL_W + col] = v; return; }
    if (col < POOL_W + SWA_W + KV_W) {
        const bool isq = col < POOL_W + SWA_W;
        const int c = isq ? col - POOL_W : col - POOL_W - SWA_W;
        const int d = c & 63;
        float o = v;
        if (d < 16) {
            const int j = d & 7; float cs, sn; rope_cs(positions[t], j, cs, sn);
            if (d < 8) o = v * cs - hr[col + 8] * sn; else o = v * cs + hr[col - 8] * sn;
        }
        if (isq) Q[(size_t)t * SWA_W + c] = f2bf(o); else Kb[(size_t)t * KV_W + c] = f2bf(o);
        return;
    }
    if (col < POOL_W + SWA_W + 2 * KV_W) { Vb[(size_t)t * KV_W + (col - POOL_W - SWA_W - KV_W)] = f2bf(v); return; }
    QM[(size_t)t * MEM_W + (col - POOL_W - SWA_W - 2 * KV_W)] = f2bf(v);
}
__global__ void nv_cvt_bf16(const float* __restrict__ in, bf16_t* out, size_t n) {
    const size_t gid = (size_t)blockIdx.x * blockDim.x + threadIdx.x;
    if (gid < n) out[gid] = f2bf(in[gid]);
}
__global__ void nv_pool1(const float* __restrict__ POOLV, float* PS) {
    const size_t gid = (size_t)blockIdx.x * blockDim.x + threadIdx.x;
    if (gid >= (size_t)MTOK * POOL_W) return;
    const int t = (int)(gid / POOL_W), ch = (int)(gid % POOL_W);
    const int g = ch >> 7, w = 2 << g, s = t & (SEQ - 1);
    const int cnt = (s + 1) < w ? (s + 1) : w;
    float sum = 0.f;
    for (int i = 0; i < cnt; ++i) sum += POOLV[(size_t)(t - i) * POOL_W + ch];
    PS[gid] = sum / (float)cnt - POOLV[gid];
}
__global__ void nv_pool2(const float* __restrict__ PS, const float* __restrict__ w_pool, const float* __restrict__ pool_scale, bf16_t* CONCAT) {
    const size_t gid = (size_t)blockIdx.x * blockDim.x + threadIdx.x;
    if (gid >= (size_t)MTOK * POOL_W) return;
    const int t = (int)(gid / POOL_W), ch = (int)(gid % POOL_W);
    const int g = ch >> 7, d = ch & 127;
    const float* p = PS + (size_t)t * POOL_W + g * 128;
    const float* w = w_pool + (size_t)g * 128 * 128 + d;
    float y = 0.f;
    for (int c = 0; c < 128; ++c) y += p[c] * w[(size_t)c * 128];
    CONCAT[(size_t)t * D_MODEL + ch] = f2bf(y * pool_scale[ch]);
}
__global__ void __launch_bounds__(256) nv_swa(const bf16_t* __restrict__ Q, const bf16_t* __restrict__ Kb, const bf16_t* __restrict__ Vb, const float* __restrict__ sinks, bf16_t* CONCAT) {
    const int wv = (int)((blockIdx.x * 256 + threadIdx.x) >> 6), lane = threadIdx.x & 63;
    if (wv >= MTOK * NHEAD) return;
    const int t = wv / NHEAD, h = wv % NHEAD, kvh = h >> 2, s = t & (SEQ - 1), tb = t - s;
    const float q = bf2f(Q[(size_t)t * SWA_W + h * HD + lane]);
    float m = sinks[h], l = 1.0f, o = 0.f;
    const int k0 = s - (WINDOW - 1) < 0 ? 0 : s - (WINDOW - 1);
    for (int kk = k0; kk <= s; ++kk) {
        const size_t kt = (size_t)(tb + kk);
        const float sc = wave_sum(q * bf2f(Kb[kt * KV_W + kvh * HD + lane])) * 0.125f;
        const float mn = fmaxf(m, sc), r = expf(m - mn), p = expf(sc - mn);
        l = l * r + p; o = o * r + p * bf2f(Vb[kt * KV_W + kvh * HD + lane]); m = mn;
    }
    CONCAT[(size_t)t * D_MODEL + POOL_W + h * HD + lane] = f2bf(o / l);
}
__global__ void __launch_bounds__(256) nv_mem(const bf16_t* __restrict__ QM, const bf16_t* __restrict__ KVM, bf16_t* CONCAT) {
    const int wv = (int)((blockIdx.x * 256 + threadIdx.x) >> 6), lane = threadIdx.x & 63;
    if (wv >= MTOK * MHEADS) return;
    const int t = wv / MHEADS, hm = wv % MHEADS, b = t / SEQ;
    const float q0 = bf2f(QM[(size_t)t * MEM_W + hm * MHD + lane]), q1 = bf2f(QM[(size_t)t * MEM_W + hm * MHD + 64 + lane]);
    float m = -1e30f, l = 0.f, o0 = 0.f, o1 = 0.f;
    const float scale = 0.08838834764831845f;
    for (int j = 0; j < MEM_LEN; ++j) {
        const bf16_t* kr = KVM + (size_t)(b * MEM_LEN + j) * (2 * MEM_W) + hm * MHD;
        const bf16_t* vr = kr + MEM_W;
        const float sc = wave_sum(q0 * bf2f(kr[lane]) + q1 * bf2f(kr[64 + lane])) * scale;
        const float mn = fmaxf(m, sc), r = expf(m - mn), p = expf(sc - mn);
        l = l * r + p; o0 = o0 * r + p * bf2f(vr[lane]); o1 = o1 * r + p * bf2f(vr[64 + lane]); m = mn;
    }
    bf16_t* orow = CONCAT + (size_t)t * D_MODEL + POOL_W + SWA_W + hm * MHD;
    orow[lane] = f2bf(o0 / l); orow[64 + lane] = f2bf(o1 / l);
}
__global__ void __launch_bounds__(256) nv_ln(const float* __restrict__ in, const float* __restrict__ g, const float* __restrict__ bta, float* outf, bf16_t* outb) {
    const int row = (int)((blockIdx.x * 256 + threadIdx.x) >> 6), lane = threadIdx.x & 63;
    if (row >= MTOK) return;
    const float* r = in + (size_t)row * D_MODEL;
    float v[32]; float s = 0.f;
#pragma unroll
    for (int i = 0; i < 32; ++i) { v[i] = r[lane + 64 * i]; s += v[i]; }
    const float mean = wave_sum(s) * (1.f / D_MODEL); float q = 0.f;
#pragma unroll
    for (int i = 0; i < 32; ++i) { v[i] -= mean; q += v[i] * v[i]; }
    const float rstd = 1.0f / sqrtf(wave_sum(q) * (1.f / D_MODEL) + LN_EPS);
#pragma unroll
    for (int i = 0; i < 32; ++i) {
        const int c = lane + 64 * i; const float y = v[i] * rstd * g[c] + bta[c];
        if (outf) outf[(size_t)row * D_MODEL + c] = y;
        if (outb) outb[(size_t)row * D_MODEL + c] = f2bf(y);
    }
}
__global__ void __launch_bounds__(32) nv_topk(const bf16_t* __restrict__ QP, const float* __restrict__ K1, const float* __restrict__ K2, int* EIDX, float* GATE) {
    __shared__ float sc[256][32];
    __shared__ float lv[32][32];
    __shared__ int li[32][32];
    const int tid = threadIdx.x, gid = blockIdx.x * 32 + tid;
    const int t = gid / PHEADS, h = gid % PHEADS;
    const bf16_t* q = QP + (size_t)t * D_MODEL + h * 256;
    for (int half = 0; half < 2; ++half) {
        const float* Kk = half ? K2 : K1;
        for (int k = 0; k < NKEYS; ++k) {
            float a = 0.f;
            for (int c = 0; c < 128; ++c) a += bf2f(q[half * 128 + c]) * Kk[k * 128 + c];
            sc[half * 128 + k][tid] = a;
        }
        for (int r = 0; r < TOPK; ++r) {
            float best = -INFINITY; int bi = 0;
            for (int k = 0; k < NKEYS; ++k) { const float v = sc[half * 128 + k][tid]; if (v > best) { best = v; bi = k; } }
            lv[half * 16 + r][tid] = best; li[half * 16 + r][tid] = bi; sc[half * 128 + bi][tid] = -INFINITY;
        }
    }
    for (int a = 0; a < 16; ++a) for (int b = 0; b < 16; ++b) sc[a * 16 + b][tid] = lv[a][tid] + lv[16 + b][tid];
    float mx = 0.f, den = 0.f;
    float tv[16]; int ti[16];
#pragma unroll
    for (int r = 0; r < TOPK; ++r) {
        float best = -INFINITY; int bi = 0;
        for (int k = 0; k < 256; ++k) { const float v = sc[k][tid]; if (v > best) { best = v; bi = k; } }
        sc[bi][tid] = -INFINITY;
        if (r == 0) mx = best;
        tv[r] = expf(best - mx); den += tv[r]; ti[r] = li[bi >> 4][tid] * NKEYS + li[16 + (bi & 15)][tid];
    }
#pragma unroll
    for (int r = 0; r < TOPK; ++r) { EIDX[(size_t)t * EPT + h * TOPK + r] = ti[r]; GATE[(size_t)t * EPT + h * TOPK + r] = tv[r] / den; }
}
__global__ void __launch_bounds__(256) nv_gather(const float* __restrict__ X1, const int* __restrict__ EIDX, const float* __restrict__ GATE, const float* __restrict__ EU, const float* __restrict__ EV,
                                                  const float* __restrict__ g, const float* __restrict__ bta, float* out) {
    const int t = (int)((blockIdx.x * 256 + threadIdx.x) >> 6), lane = threadIdx.x & 63;
    if (t >= MTOK) return;
    float x[32], acc[32];
#pragma unroll
    for (int i = 0; i < 32; ++i) { x[i] = X1[(size_t)t * D_MODEL + lane + 64 * i]; acc[i] = 0.f; }
    for (int e = 0; e < EPT; ++e) {
        const int id = EIDX[(size_t)t * EPT + e]; const float gt = GATE[(size_t)t * EPT + e];
        const float* u = EU + (size_t)id * D_MODEL; const float* vv = EV + (size_t)id * D_MODEL;
        float p = 0.f;
#pragma unroll
        for (int i = 0; i < 32; ++i) p += x[i] * u[lane + 64 * i];
        const float a = gt * gelu_erf(wave_sum(p));
#pragma unroll
        for (int i = 0; i < 32; ++i) acc[i] += a * vv[lane + 64 * i];
    }
    float s = 0.f;
#pragma unroll
    for (int i = 0; i < 32; ++i) { acc[i] = ALPHA * x[i] + acc[i]; s += acc[i]; }
    const float mean = wave_sum(s) * (1.f / D_MODEL); float q = 0.f;
#pragma unroll
    for (int i = 0; i < 32; ++i) { acc[i] -= mean; q += acc[i] * acc[i]; }
    const float rstd = 1.0f / sqrtf(wave_sum(q) * (1.f / D_MODEL) + LN_EPS);
#pragma unroll
    for (int i = 0; i < 32; ++i) { const int c = lane + 64 * i; out[(size_t)t * D_MODEL + c] = acc[i] * rstd * g[c] + bta[c]; }
}

#endif
extern "C" void kernel_launch(void* const* d_in, const int* in_sizes, int n_in, void* d_out, int out_size, void* d_ws, size_t ws_size, hipStream_t stream) {
    static int grid = 0;
    if (grid == 0) {
        if (n_in != 18 || in_sizes[0] != MTOK * D_MODEL || out_size != MTOK * D_MODEL || ws_size < WS_END) {
            fprintf(stderr, "kernel_launch: unexpected shapes (n_in %d, in0 %d, out %d, ws %zu)\n", n_in, n_in > 0 ? in_sizes[0] : -1, out_size, ws_size); grid = -1; return; }
        int dev = 0, cus = 0, per_cu = 0;
        if (hipGetDevice(&dev) != hipSuccess || hipDeviceGetAttribute(&cus, hipDeviceAttributeMultiprocessorCount, dev) != hipSuccess) { fprintf(stderr, "kernel_launch: device query failed\n"); grid = -1; return; }
        if (hipFuncSetAttribute((const void*)mega_fwd, hipFuncAttributeMaxDynamicSharedMemorySize, LDS_BYTES) != hipSuccess) { fprintf(stderr, "kernel_launch: hipFuncSetAttribute failed\n"); grid = -1; return; }
        if (hipOccupancyMaxActiveBlocksPerMultiprocessor(&per_cu, (const void*)mega_fwd, NTHREADS, LDS_BYTES) != hipSuccess || per_cu < 1) {
            fprintf(stderr, "kernel_launch: occupancy query reports %d workgroups per CU\n", per_cu); (void)hipGetLastError(); grid = -1; return; }
        grid = cus;
    }
    if (grid < 0) return;
    unsigned char* ws = (unsigned char*)d_ws;
    (void)hipMemsetAsync(ws + WS_CTL, 0, 1 * MiB, stream);
    Args a{};
    for (int i = 0; i < 18; ++i) a.in[i] = d_in[i];
    a.out = (float*)d_out; a.ws = ws;
#if NAIVE_MASK != 0
    const float* x = (const float*)d_in[0]; const float* mem = (const float*)d_in[1]; const int* positions = (const int*)d_in[2];
    const float* w_in = (const float*)d_in[3]; const float* w_mem_kv = (const float*)d_in[4]; const float* w_pool = (const float*)d_in[5];
    const float* pool_scale = (const float*)d_in[6]; const float* sinks = (const float*)d_in[7]; const float* w_out = (const float*)d_in[8];
    const float* ln1_g = (const float*)d_in[9]; const float* ln1_b = (const float*)d_in[10]; const float* w_peer_q = (const float*)d_in[11];
    const float* sk1 = (const float*)d_in[12]; const float* sk2 = (const float*)d_in[13]; const float* eu = (const float*)d_in[14]; const float* ev = (const float*)d_in[15];
    const float* ln2_g = (const float*)d_in[16]; const float* ln2_b = (const float*)d_in[17];
    float* out = (float*)d_out;
    float* POOLV = (float*)(ws + WS_POOLV); bf16_t* Q = (bf16_t*)(ws + WS_Q); bf16_t* Kb = (bf16_t*)(ws + WS_K); bf16_t* Vb = (bf16_t*)(ws + WS_V); bf16_t* QM = (bf16_t*)(ws + WS_QM);
    bf16_t* KVM = (bf16_t*)(ws + WS_KVM); bf16_t* CONCAT = (bf16_t*)(ws + WS_CONCAT); float* Y1 = (float*)(ws + WS_Y1); float* X1 = (float*)(ws + WS_X1); bf16_t* X1B = (bf16_t*)(ws + WS_X1B);
    bf16_t* QP = (bf16_t*)(ws + WS_QP); int* EIDX = (int*)(ws + WS_EIDX); float* GATE = (float*)(ws + WS_GATE);
    float* NVH = (float*)(ws + WS_NV_H); float* NVPS = (float*)(ws + WS_NV_PS); float* NVKVM = (float*)(ws + WS_NV_KVM);
#endif
    int li = 0;
    for (int p = 0; p < N_PHASES;) {
#if NAIVE_MASK != 0
        if ((NAIVE_MASK >> p) & 1) {
            switch (p) {
            case 1:
                nv_gemm<float, NvEpiF32><<<dim3(IN_W / 64, MTOK / 64), 256, 0, stream>>>(x, w_in, MTOK, IN_W, D_MODEL, NvEpiF32{NVH, IN_W, 0});
                nv_gemm<float, NvEpiF32><<<dim3(2 * MEM_W / 64, MMEM / 64), 256, 0, stream>>>(mem, w_mem_kv, MMEM, 2 * MEM_W, D_MODEL, NvEpiF32{NVKVM, 2 * MEM_W, 0});
                nv_post1<<<(unsigned)(((size_t)MTOK * IN_W + 255) / 256), 256, 0, stream>>>(NVH, positions, POOLV, Q, Kb, Vb, QM);
                nv_cvt_bf16<<<(MMEM * 2 * MEM_W + 255) / 256, 256, 0, stream>>>(NVKVM, KVM, (size_t)MMEM * 2 * MEM_W);
                break;
            case 2:
                nv_pool1<<<MTOK * POOL_W / 256, 256, 0, stream>>>(POOLV, NVPS);
                nv_pool2<<<MTOK * POOL_W / 256, 256, 0, stream>>>(NVPS, w_pool, pool_scale, CONCAT);
                nv_swa<<<MTOK * NHEAD / 4, 256, 0, stream>>>(Q, Kb, Vb, sinks, CONCAT);
                nv_mem<<<MTOK * MHEADS / 4, 256, 0, stream>>>(QM, KVM, CONCAT);
                break;
            case 3: nv_gemm<bf16_t, NvEpiY1><<<dim3(D_MODEL / 64, MTOK / 64), 256, 0, stream>>>(CONCAT, w_out, MTOK, D_MODEL, D_MODEL, NvEpiY1{x, Y1}); break;
            case 4: nv_ln<<<MTOK / 4, 256, 0, stream>>>(Y1, ln1_g, ln1_b, X1, X1B); break;
            case 5: nv_gemm<float, NvEpiBf><<<dim3(D_MODEL / 64, MTOK / 64), 256, 0, stream>>>(X1, w_peer_q, MTOK, D_MODEL, D_MODEL, NvEpiBf{QP, D_MODEL, 0}); break;
            case 6: nv_topk<<<MTOK * PHEADS / 32, 32, 0, stream>>>(QP, sk1, sk2, EIDX, GATE); break;
            case 7: nv_gather<<<MTOK / 4, 256, 0, stream>>>(X1, EIDX, GATE, eu, ev, ln2_g, ln2_b, out); p = N_PHASES - 1; break;
            default: break;
            }
            ++p; continue;
        }
#endif
        int q = p;
        while (q < N_PHASES && !((NAIVE_MASK >> q) & 1)) ++q;
        a.ph_lo = p; a.ph_hi = q; a.li = li++;
        hipLaunchKernelGGL(mega_fwd, dim3(grid), dim3(NTHREADS), LDS_BYTES, stream, a);
        const hipError_t le = hipPeekAtLastError();
        if (le != hipSuccess) { fprintf(stderr, "kernel_launch: launch failed: %s\n", hipGetErrorName(le)); break; }
        p = q;
    }
#ifdef PROBE_EXTRA_LO
    a.ph_lo = PROBE_EXTRA_LO; a.ph_hi = PROBE_EXTRA_HI; a.li = li++;
    hipLaunchKernelGGL(mega_fwd, dim3(grid), dim3(NTHREADS), LDS_BYTES, stream, a);
#endif
}
```

```cpp
#include <hip/hip_runtime.h>
#include <cstdint>
#include <cstdio>
#ifndef NAIVE_MASK
#define NAIVE_MASK 0
#endif

constexpr int D_MODEL = 2048, BATCH = 2, SEQ = 4096, MTOK = BATCH * SEQ, MEM_LEN = 256, MMEM = BATCH * MEM_LEN;
constexpr int POOL_W = 512, SWA_W = 1024, KV_W = 256, MEM_W = 512, IN_W = 2560;
constexpr int NHEAD = 16, NKV = 4, HD = 64, WINDOW = 128, MHEADS = 4, MHD = 128;
constexpr int PHEADS = 8, NKEYS = 128, TOPK = 16, NEXP = NKEYS * NKEYS, EPT = PHEADS * TOPK;
constexpr float ALPHA = 1.18920711500272106672f;
constexpr float LN_EPS = 1e-5f;

typedef unsigned short bf16_t;
__device__ __forceinline__ float bf2f(bf16_t v) { return __uint_as_float((unsigned)v << 16); }
__device__ __forceinline__ bf16_t f2bf(float f) { unsigned u = __float_as_uint(f); return (bf16_t)((u + 0x7fffu + ((u >> 16) & 1u)) >> 16); }

constexpr size_t MiB = 1u << 20;
constexpr size_t WS_CTL = 0, WS_WINT = 1 * MiB, WS_WKVT = 11 * MiB, WS_WOT = 15 * MiB, WS_WQT = 23 * MiB, WS_SMALL = 31 * MiB;
constexpr size_t WS_XB = 32 * MiB, WS_X1B = 32 * MiB  , WS_MEMB = 64 * MiB, WS_KVM = 66 * MiB;
constexpr size_t WS_POOLV = 68 * MiB, WS_Q = 84 * MiB, WS_K = 100 * MiB, WS_V = 104 * MiB, WS_QM = 108 * MiB, WS_CONCAT = 116 * MiB;
constexpr size_t WS_Y1 = 148 * MiB, WS_X1 = 212 * MiB, WS_QP = 276 * MiB, WS_EIDX = 308 * MiB, WS_GATE = 312 * MiB, WS_UB = 316 * MiB, WS_VB = 380 * MiB, WS_END = 444 * MiB;
constexpr size_t WS_NV_H = 148 * MiB  , WS_NV_PS = 232 * MiB, WS_NV_KVM = 248 * MiB;

__device__ __forceinline__ void rope_cs(int pos, int j, float& c, float& s) {
    const double invf[8] = {1.0, 0.19392274474868576, 0.03760603093086393, 0.007292664737217109, 0.001414213562373095, 0.0002742481756762073, 5.318295896944988e-05, 1.031338537721246e-05};
    double f = j == 0 ? invf[0] : j == 1 ? invf[1] : j == 2 ? invf[2] : j == 3 ? invf[3] : j == 4 ? invf[4] : j == 5 ? invf[5] : j == 6 ? invf[6] : invf[7];
    double rev = (double)pos * f * 0.15915494309189533577;
    rev -= floor(rev);
    float fr = (float)rev;
    s = __builtin_amdgcn_sinf(fr); c = __builtin_amdgcn_cosf(fr);
}
__device__ __forceinline__ float gelu_erf(float h) { return 0.5f * h * (1.0f + erff(h * 0.70710678118654752440f)); }
__device__ __forceinline__ float wave_sum(float v) {
#pragma unroll
    for (int o = 1; o < 64; o <<= 1) v += __shfl_xor(v, o);
    return v;
}

namespace pg8 {
#define PG8_LAS __attribute__((address_space(3)))
typedef unsigned short bf16_t;
typedef short bf16x8 __attribute__((ext_vector_type(8)));
typedef float f32x4 __attribute__((ext_vector_type(4)));
typedef unsigned u32x4 __attribute__((ext_vector_type(4)));
constexpr int BM = 256, BK = 64, HALF = 128, HTB = HALF * BK * 2  , STAGE_BYTES = 8 * HTB, NXCD = 8, WGM = 8;

__host__ __device__ __forceinline__ int lds_byte(int r, int c) { const int st = (r >> 4) * 2 + (c >> 5), rr = r & 15, cc = c & 31, ob = rr * 64 + cc * 2; return st * 1024 + (ob ^ (((ob >> 9) & 1) << 5)); }
__host__ __device__ __forceinline__ void stage_rc(int b, int& R, int& C) { const int st = b / 1024, sb = b % 1024, swz = sb ^ (((sb >> 9) & 1) << 5); R = (st >> 1) * 16 + swz / 64; C = (st & 1) * 32 + (swz % 64) / 2; }
__host__ __device__ __forceinline__ int perm32(int rho) { const int n = rho >> 4, i = rho & 15; return 8 * (i >> 2) + 4 * n + (i & 3); }

struct Unit { int pm, pn; };
struct Gemm { const bf16_t* A; const bf16_t* Bt; int M, N, K; };

struct StaticOrder {
    int nM, nN, nwg, G, c;
    __host__ __device__ void init(int M, int N, int G_, int c_) { nM = M / BM; nN = N / BM; nwg = nM * nN; G = G_; c = c_; }
    __host__ __device__ bool next(int i, Unit& u) const {
        const long L = (long)i * G + c; if (L >= nwg) return false;
        int wgid = (int)L; { const int q = nwg / NXCD, r = nwg % NXCD, xcd = wgid % NXCD, off = wgid / NXCD; wgid = (xcd < r ? xcd * (q + 1) : r * (q + 1) + (xcd - r) * q) + off; }
        const int nig = WGM * nN, gid = wgid / nig, fm = gid * WGM, gsz = (nM - fm) < WGM ? (nM - fm) : WGM;
        u.pm = fm + ((wgid % nig) % gsz); u.pn = (wgid % nig) / gsz; return true;
    }
    __device__ __forceinline__ void a_ready(const Unit&) const {}
    __device__ __forceinline__ void done(const Unit&) const {}
};

__device__ __forceinline__ unsigned cvt_pk_bf16(float lo, float hi) { unsigned r; asm volatile("v_cvt_pk_bf16_f32 %0, %1, %2" : "=v"(r) : "v"(lo), "v"(hi)); return r; }
template <class Epi, class Sched, bool ALIGN_EPI = false, bool SP2 = false>
__device__ __forceinline__ void gemm_phase(PG8_LAS unsigned char* lds, const Gemm g, const Sched& S, const Epi& E) {
    const int tid = threadIdx.x, wid = __builtin_amdgcn_readfirstlane(tid >> 6), lane = tid & 63, wr = wid >> 2, wc = wid & 3, fr = lane & 15, fq = lane >> 4;
    const int K = g.K, nt = K / BK;
    unsigned voffA[2], voffB[2];
#pragma unroll
    for (int i = 0; i < 2; ++i) { int R, C; stage_rc(tid * 16 + i * 8192, R, C); const int Rb = Epi::PERM ? ((R & ~31) + perm32(R & 31)) : R;
        voffA[i] = (unsigned)(R * K + C) * 2u; voffB[i] = (unsigned)(Rb * K + C) * 2u; }
    const size_t kstep = (size_t)(BK * 2);
    const size_t hstep = (size_t)HALF * K * 2;
    const size_t tstep = 2 * hstep;
    const unsigned ldsw = (unsigned)wid * 1024u;
    const int aoff = lds_byte(wr * 64 + fr, fq * 8), boff = lds_byte(wc * 32 + fr, fq * 8);
#define PG8_SA(b, h) (((b) * 2 + (h)) * HTB)
#define PG8_SB(b, h) ((4 + (b) * 2 + (h)) * HTB)
#define PG8_STAGE(bufoff, gbase, voff) do { _Pragma("unroll") for (int _i = 0; _i < 2; ++_i) \
        __builtin_amdgcn_global_load_lds((const unsigned*)((const char*)(gbase) + (voff)[_i]), (PG8_LAS unsigned*)(lds + (bufoff) + ldsw + _i * 8192), 16, 0, 0); } while (0)
#define PG8_LDA(dst, b, h) do { _Pragma("unroll") for (int m = 0; m < 4; ++m) _Pragma("unroll") for (int k = 0; k < 2; ++k) dst[m][k] = *(const PG8_LAS bf16x8*)(lds + PG8_SA(b, h) + aoff + m * 2048 + k * 1024); } while (0)
#define PG8_LDB(dst, b, h) do { _Pragma("unroll") for (int n = 0; n < 2; ++n) _Pragma("unroll") for (int k = 0; k < 2; ++k) dst[n][k] = *(const PG8_LAS bf16x8*)(lds + PG8_SB(b, h) + boff + n * 2048 + k * 1024); } while (0)
#define PG8_MMA(ai, bj, At, Bt) do { __builtin_amdgcn_s_setprio(1); _Pragma("unroll") for (int m = 0; m < 4; ++m) _Pragma("unroll") for (int n = 0; n < 2; ++n) _Pragma("unroll") for (int k = 0; k < 2; ++k) \
        acc[ai][bj][m][n] = __builtin_amdgcn_mfma_f32_16x16x32_bf16(Bt[n][k], At[m][k], acc[ai][bj][m][n], 0, 0, 0); __builtin_amdgcn_s_setprio(0); } while (0)
#define PG8_WAIT_V(n) asm volatile("s_waitcnt vmcnt(" #n ")" ::: "memory")
#define PG8_WAIT_L(n) asm volatile("s_waitcnt lgkmcnt(" #n ")" ::: "memory")
#define PG8_BAR __builtin_amdgcn_s_barrier()
#define PG8_SCHED __builtin_amdgcn_sched_barrier(0)
    Unit cur, nxt; int ui = 0;
    if (!S.next(0, cur)) return;
    f32x4 acc[2][2][4][2];
#pragma unroll
    for (int a = 0; a < 2; ++a)
#pragma unroll
        for (int b = 0; b < 2; ++b)
#pragma unroll
            for (int m = 0; m < 4; ++m)
#pragma unroll
                for (int n = 0; n < 2; ++n) acc[a][b][m][n] = (f32x4){0.f, 0.f, 0.f, 0.f};
    bf16x8 At[4][2], B0[2][2], B1[2][2];
    const char* cA = (const char*)g.A + (size_t)cur.pm * tstep; const char* cB = (const char*)g.Bt + (size_t)cur.pn * tstep;
    S.a_ready(cur);
    if constexpr (SP2) {
        PG8_STAGE(PG8_SB(0, 0), cB, voffB); PG8_STAGE(PG8_SB(0, 1), cB + hstep, voffB); PG8_STAGE(PG8_SA(0, 0), cA, voffA); PG8_STAGE(PG8_SA(0, 1), cA + hstep, voffA);
        if (wr == 1) PG8_BAR;
        PG8_WAIT_V(2); PG8_BAR;
        PG8_STAGE(PG8_SB(1, 0), cB + kstep, voffB); PG8_STAGE(PG8_SA(1, 0), cA + kstep, voffA); PG8_STAGE(PG8_SB(1, 1), cB + hstep + kstep, voffB);
        PG8_WAIT_V(6); PG8_BAR;
    } else {
        PG8_STAGE(PG8_SB(0, 0), cB, voffB); PG8_STAGE(PG8_SA(0, 0), cA, voffA); PG8_STAGE(PG8_SB(0, 1), cB + hstep, voffB); PG8_STAGE(PG8_SA(0, 1), cA + hstep, voffA);
        if (wr == 1) PG8_BAR;
        PG8_WAIT_V(4); PG8_BAR;
        PG8_STAGE(PG8_SB(1, 0), cB + kstep, voffB); PG8_STAGE(PG8_SA(1, 0), cA + kstep, voffA); PG8_STAGE(PG8_SB(1, 1), cB + hstep + kstep, voffB);
        PG8_WAIT_V(6); PG8_BAR;
    }
    for (;;) {
        const bool has_next = S.next(ui + 1, nxt);
        const char* nA = has_next ? (const char*)g.A + (size_t)nxt.pm * tstep : cA; const char* nB = has_next ? (const char*)g.Bt + (size_t)nxt.pn * tstep : cB;
        for (int t = 0; t < nt; t += 2) {
            const bool last = (t == nt - 2);
            const char* a1 = cA + (size_t)(t + 1) * kstep;
            const char* a2 = last ? nA : cA + (size_t)(t + 2) * kstep; const char* b2 = last ? nB : cB + (size_t)(t + 2) * kstep;
            const char* a3 = a2 + kstep; const char* b3 = b2 + kstep;
            if (last && has_next) S.a_ready(nxt);
            if constexpr (SP2) {
            PG8_LDB(B0, 0, 0); PG8_LDB(B1, 0, 1); PG8_SCHED; PG8_LDA(At, 0, 0); PG8_STAGE(PG8_SA(1, 1), a1 + hstep, voffA);
            PG8_WAIT_V(8); PG8_WAIT_L(0); PG8_BAR; PG8_MMA(0, 0, At, B0); PG8_MMA(0, 1, At, B1); PG8_BAR; PG8_SCHED;
            PG8_LDA(At, 0, 1); PG8_STAGE(PG8_SB(0, 0), b2, voffB); PG8_STAGE(PG8_SB(0, 1), b2 + hstep, voffB); PG8_STAGE(PG8_SA(0, 0), a2, voffA);
            PG8_WAIT_V(8); PG8_WAIT_L(0); PG8_BAR; PG8_MMA(1, 0, At, B0); PG8_MMA(1, 1, At, B1); PG8_BAR; PG8_SCHED;
            PG8_LDB(B0, 1, 0); PG8_LDB(B1, 1, 1); PG8_SCHED; PG8_LDA(At, 1, 0); PG8_STAGE(PG8_SA(0, 1), a2 + hstep, voffA);
            PG8_WAIT_V(8); PG8_WAIT_L(0); PG8_BAR; PG8_MMA(0, 0, At, B0); PG8_MMA(0, 1, At, B1); PG8_BAR; PG8_SCHED;
            PG8_LDA(At, 1, 1); PG8_STAGE(PG8_SB(1, 0), b3, voffB); PG8_STAGE(PG8_SB(1, 1), b3 + hstep, voffB); PG8_STAGE(PG8_SA(1, 0), a3, voffA);
            PG8_WAIT_V(8); PG8_WAIT_L(0); PG8_BAR; PG8_MMA(1, 0, At, B0); PG8_MMA(1, 1, At, B1); PG8_BAR; PG8_SCHED;
            } else {
            PG8_LDB(B0, 0, 0); PG8_SCHED; PG8_LDA(At, 0, 0); PG8_STAGE(PG8_SA(1, 1), a1 + hstep, voffA);
            PG8_WAIT_L(8); PG8_BAR; PG8_WAIT_L(0); PG8_MMA(0, 0, At, B0); PG8_BAR; PG8_SCHED;
            PG8_LDB(B1, 0, 1); PG8_STAGE(PG8_SB(0, 0), b2, voffB);
            PG8_BAR; PG8_WAIT_L(0); PG8_MMA(0, 1, At, B1); PG8_BAR;
            PG8_LDA(At, 0, 1); PG8_STAGE(PG8_SA(0, 0), a2, voffA);
            PG8_BAR; PG8_WAIT_L(0); PG8_MMA(1, 0, At, B0); PG8_BAR; PG8_SCHED;
            PG8_STAGE(PG8_SB(0, 1), b2 + hstep, voffB);
            PG8_WAIT_V(6); PG8_BAR; PG8_MMA(1, 1, At, B1); PG8_BAR;
            PG8_LDB(B0, 1, 0); PG8_SCHED; PG8_LDA(At, 1, 0); PG8_STAGE(PG8_SA(0, 1), a2 + hstep, voffA);
            PG8_WAIT_L(8); PG8_BAR; PG8_WAIT_L(0); PG8_MMA(0, 0, At, B0); PG8_BAR; PG8_SCHED;
            PG8_LDB(B1, 1, 1); PG8_STAGE(PG8_SB(1, 0), b3, voffB);
            PG8_BAR; PG8_WAIT_L(0); PG8_MMA(0, 1, At, B1); PG8_BAR;
            PG8_LDA(At, 1, 1); PG8_STAGE(PG8_SA(1, 0), a3, voffA);
            PG8_BAR; PG8_WAIT_L(0); PG8_MMA(1, 0, At, B0); PG8_BAR; PG8_SCHED;
            PG8_STAGE(PG8_SB(1, 1), b3 + hstep, voffB);
            PG8_WAIT_V(6); PG8_BAR; PG8_MMA(1, 1, At, B1); PG8_BAR;
            }
        }
        if constexpr (ALIGN_EPI) { if (wr == 0) PG8_BAR; }
        if constexpr (!Epi::AFTER_DRAIN) { E(acc, cur, wr, wc, fr, fq); S.done(cur); }
        if (!has_next) break;
#pragma unroll
        for (int a = 0; a < 2; ++a)
#pragma unroll
            for (int b = 0; b < 2; ++b)
#pragma unroll
                for (int m = 0; m < 4; ++m)
#pragma unroll
                    for (int n = 0; n < 2; ++n) acc[a][b][m][n] = (f32x4){0.f, 0.f, 0.f, 0.f};
        cur = nxt; cA = nA; cB = nB; ++ui;
        if constexpr (ALIGN_EPI) { if (wr == 1) PG8_BAR; }
    }
    PG8_WAIT_V(0);
    if constexpr (!ALIGN_EPI) { if (wr == 0) PG8_BAR; }
    PG8_BAR;
    if constexpr (Epi::AFTER_DRAIN) { E.fused(acc, cur, wr, wc, fr, fq, lds, wid, lane); S.done(cur); }
#undef PG8_SA
#undef PG8_SB
#undef PG8_STAGE
#undef PG8_LDA
#undef PG8_LDB
#undef PG8_MMA
#undef PG8_WAIT_V
#undef PG8_WAIT_L
#undef PG8_BAR
#undef PG8_SCHED
}
}
#define GAS __attribute__((address_space(1)))
#define LAS __attribute__((address_space(3)))
typedef unsigned v4u __attribute__((ext_vector_type(4)));
typedef unsigned v2u __attribute__((ext_vector_type(2)));
typedef float f32x4 __attribute__((ext_vector_type(4)));
typedef float f32x2 __attribute__((ext_vector_type(2)));
typedef short bf16x8 __attribute__((ext_vector_type(8)));
typedef __bf16 bf16x2 __attribute__((ext_vector_type(2)));
constexpr int NWAVES = 8, NTHREADS = NWAVES * 64;
constexpr int LDS_BYTES = 147456, MISC_OFF = LDS_BYTES - 512;
constexpr int CW_BAR = 4096;
constexpr float LOG2E = 1.44269504088896340736f;

__device__ __forceinline__ unsigned cvtpk(float lo, float hi) { f32x2 v = {lo, hi}; bf16x2 b = __builtin_convertvector(v, bf16x2); return __builtin_bit_cast(unsigned, b); }
__device__ __forceinline__ f32x4 mfma16(bf16x8 a, bf16x8 b, f32x4 c) { return __builtin_amdgcn_mfma_f32_16x16x32_bf16(a, b, c, 0, 0, 0); }
__device__ __forceinline__ float dot2bf(unsigned w, unsigned x, float acc) { return __builtin_amdgcn_fdot2_f32_bf16(__builtin_bit_cast(bf16x2, w), __builtin_bit_cast(bf16x2, x), acc, false); }
__device__ __forceinline__ float fexp2(float x) { return __builtin_amdgcn_exp2f(x); }
#define LDS_WAIT() asm volatile("s_waitcnt lgkmcnt(0)" ::: "memory")
__device__ __forceinline__ unsigned umax(unsigned a, unsigned b) { return a > b ? a : b; }
__device__ __forceinline__ unsigned umin(unsigned a, unsigned b) { return a < b ? a : b; }
__device__ __forceinline__ unsigned xmin4(unsigned m) { auto r = __builtin_amdgcn_permlane16_swap(m, m, false, false); m = umin(r[0], r[1]); auto q = __builtin_amdgcn_permlane32_swap(m, m, false, false); return umin(q[0], q[1]); }
__device__ __forceinline__ unsigned xmax4(unsigned m) { auto r = __builtin_amdgcn_permlane16_swap(m, m, false, false); m = umax(r[0], r[1]); auto q = __builtin_amdgcn_permlane32_swap(m, m, false, false); return umax(q[0], q[1]); }
__device__ __forceinline__ float xfmax4(float v) { unsigned m = __float_as_uint(v); auto r = __builtin_amdgcn_permlane16_swap(m, m, false, false); v = fmaxf(__uint_as_float(r[0]), __uint_as_float(r[1])); m = __float_as_uint(v);
    auto q = __builtin_amdgcn_permlane32_swap(m, m, false, false); return fmaxf(__uint_as_float(q[0]), __uint_as_float(q[1])); }
__device__ __forceinline__ float xfsum4(float v) { unsigned m = __float_as_uint(v); auto r = __builtin_amdgcn_permlane16_swap(m, m, false, false); v = __uint_as_float(r[0]) + __uint_as_float(r[1]); m = __float_as_uint(v);
    auto q = __builtin_amdgcn_permlane32_swap(m, m, false, false); return __uint_as_float(q[0]) + __uint_as_float(q[1]); }

#define XB_TMO      128
#define XB_XCNT(j)  (256  + 64 * (j))
#define XB_XSUB(j)  (1280 + 64 * (j))
#define XB_XGEN(j)  (2304 + 64 * (j))
#define XB_TOP      3328
#define XB_TOPGEN   3392
#define XCD_BAR_WORDS 3456
#define XB_SPIN_CAP (1u << 18)
__device__ __forceinline__ unsigned xb_ld(unsigned* p)              { return __hip_atomic_load(p, __ATOMIC_RELAXED, __HIP_MEMORY_SCOPE_AGENT); }
__device__ __forceinline__ unsigned xb_add(unsigned* p, unsigned v) { return __hip_atomic_fetch_add(p, v, __ATOMIC_RELAXED, __HIP_MEMORY_SCOPE_AGENT); }
__device__ __forceinline__ unsigned xb_xcc_id() { return (unsigned)__builtin_amdgcn_s_getreg((3 << 11) | 20) & 0xFu; }
#define XB_SPIN(cond, bar) do { unsigned _sp = 0; while (cond) { __builtin_amdgcn_s_sleep(1); \
    if ((++_sp & 255u) == 0u) { if (xb_ld(&(bar)[XB_TMO])) break; if (_sp > XB_SPIN_CAP) { atomicAdd(&(bar)[XB_TMO], 1u); break; } } } } while (0)
struct XcdBarrier { unsigned* bar; unsigned x; volatile LAS unsigned* st; };
__device__ __forceinline__ XcdBarrier xcd_barrier_post(unsigned* bar, volatile LAS unsigned* st) {
    XcdBarrier b; b.bar = bar; b.x = xb_xcc_id(); b.st = st;
    if (threadIdx.x == 0) (void)xb_add(&bar[XB_XCNT(b.x)], 1u);
    return b;
}
__device__ __forceinline__ void xcd_barrier_complete(unsigned* bar, unsigned x, unsigned& nloc, unsigned& nx) {
    const unsigned G = gridDim.x * gridDim.y * gridDim.z;
    unsigned sum, cnt, mine, sp = 0u;
    for (;;) {
        sum = 0u; cnt = 0u; mine = 0u;
#pragma unroll
        for (unsigned j = 0; j < 16; ++j) { const unsigned c = xb_ld(&bar[XB_XCNT(j)]); sum += c; cnt += (c > 0u) ? 1u : 0u; mine = (j == x) ? c : mine; }
        if (sum == G) break;
        __builtin_amdgcn_s_sleep(1);
        if ((++sp & 255u) == 0u) { if (xb_ld(&bar[XB_TMO])) break; if (sp > XB_SPIN_CAP) { atomicAdd(&bar[XB_TMO], 1u); break; } }
    }
    nloc = mine > 0u ? mine : 1u; nx = cnt > 0u ? cnt : 1u;
}
__device__ __forceinline__ void xcd_barrier(const XcdBarrier& b) {
    asm volatile("s_waitcnt vmcnt(0)" ::: "memory");
    __syncthreads();
    if (threadIdx.x == 0) {
        unsigned* bar = b.bar;
        __builtin_amdgcn_s_waitcnt(0);
        unsigned nloc = b.st[0], nx = b.st[1];
        if (nloc == 0u) { xcd_barrier_complete(bar, b.x, nloc, nx); b.st[0] = nloc; b.st[1] = nx; }
        const unsigned old = xb_add(&bar[XB_XSUB(b.x)], 1u);
        const unsigned gen = old / nloc;
        if (old + 1u == (gen + 1u) * nloc) {
            __builtin_amdgcn_fence(__ATOMIC_RELEASE, "agent");
            asm volatile("s_waitcnt vmcnt(0)" ::: "memory");
            const unsigned og = xb_add(&bar[XB_TOP], 1u);
            const unsigned tg = og / nx;
            if (og + 1u == (tg + 1u) * nx) xb_add(&bar[XB_TOPGEN], 1u);
            else XB_SPIN(xb_ld(&bar[XB_TOPGEN]) == tg, bar);
            __builtin_amdgcn_fence(__ATOMIC_ACQUIRE, "agent");
            xb_add(&bar[XB_XGEN(b.x)], 1u);
            asm volatile("s_waitcnt vmcnt(0)" ::: "memory");
        } else {
            XB_SPIN(xb_ld(&bar[XB_XGEN(b.x)]) == gen, bar);
            __builtin_amdgcn_fence(__ATOMIC_ACQUIRE, "agent");
            asm volatile("s_waitcnt vmcnt(0)" ::: "memory");
        }
    }
    __syncthreads();
}

struct EpiStoreBf {
    static constexpr bool PERM = true, AFTER_DRAIN = false;
    bf16_t* O; int ldc;
    __device__ __forceinline__ void operator()(const pg8::f32x4 (&acc)[2][2][4][2], const pg8::Unit& u, int wr, int wc, int fr, int fq) const {
        const int row0 = u.pm * 256 + wr * 64 + fr, col0 = u.pn * 256 + wc * 32 + 8 * fq;
#pragma unroll
        for (int ai = 0; ai < 2; ++ai)
#pragma unroll
            for (int m = 0; m < 4; ++m) { bf16_t* rowp = O + (size_t)(row0 + ai * 128 + m * 16) * ldc + col0;
#pragma unroll
                for (int bj = 0; bj < 2; ++bj) { const pg8::f32x4 v0 = acc[ai][bj][m][0], v1 = acc[ai][bj][m][1];
                    v4u w; w.x = cvtpk(v0[0], v0[1]); w.y = cvtpk(v0[2], v0[3]); w.z = cvtpk(v1[0], v1[1]); w.w = cvtpk(v1[2], v1[3]);
                    *(v4u*)(rowp + bj * 128) = w; } }
    }
};
struct EpiY1 {
    static constexpr bool PERM = true, AFTER_DRAIN = false;
    const float* x; float* y;
    __device__ __forceinline__ void operator()(const pg8::f32x4 (&acc)[2][2][4][2], const pg8::Unit& u, int wr, int wc, int fr, int fq) const {
        const int row0 = u.pm * 256 + wr * 64 + fr, col0 = u.pn * 256 + wc * 32 + 8 * fq;
#pragma unroll
        for (int ai = 0; ai < 2; ++ai)
#pragma unroll
            for (int m = 0; m < 4; ++m) { const size_t off = (size_t)(row0 + ai * 128 + m * 16) * D_MODEL + col0;
#pragma unroll
                for (int bj = 0; bj < 2; ++bj) {
                    const f32x4 x0 = *(const f32x4*)(x + off + bj * 128), x1 = *(const f32x4*)(x + off + bj * 128 + 4);
                    *(f32x4*)(y + off + bj * 128) = x0 * ALPHA + acc[ai][bj][m][0]; *(f32x4*)(y + off + bj * 128 + 4) = x1 * ALPHA + acc[ai][bj][m][1]; } }
    }
};
struct EpiIn {
    static constexpr bool PERM = true, AFTER_DRAIN = false;
    float* POOLV; bf16_t *Q, *K, *V, *QM; const float* rope;
    __device__ __forceinline__ void operator()(const pg8::f32x4 (&acc)[2][2][4][2], const pg8::Unit& u, int wr, int wc, int fr, int fq) const {
        const int row0 = u.pm * 256 + wr * 64 + fr, cl = wc * 32 + 8 * fq, pn = u.pn;
        if (pn < 2) {
#pragma unroll
            for (int ai = 0; ai < 2; ++ai)
#pragma unroll
                for (int m = 0; m < 4; ++m) { float* rp = POOLV + (size_t)(row0 + ai * 128 + m * 16) * POOL_W + pn * 256 + cl;
#pragma unroll
                    for (int bj = 0; bj < 2; ++bj) { *(f32x4*)(rp + bj * 128) = acc[ai][bj][m][0]; *(f32x4*)(rp + bj * 128 + 4) = acc[ai][bj][m][1]; } }
            return;
        }
        bf16_t* base; int ld, c0; bool rot = false;
        if (pn < 6) { base = Q; ld = SWA_W; c0 = (pn - 2) * 256; rot = true; }
        else if (pn == 6) { base = K; ld = KV_W; c0 = 0; rot = true; }
        else if (pn == 7) { base = V; ld = KV_W; c0 = 0; }
        else { base = QM; ld = MEM_W; c0 = (pn - 8) * 256; }
        rot = rot && ((wc & 1) == 0);
#pragma unroll
        for (int ai = 0; ai < 2; ++ai)
#pragma unroll
            for (int m = 0; m < 4; ++m) {
                const int row = row0 + ai * 128 + m * 16;
                f32x4 v[2][2];
#pragma unroll
                for (int bj = 0; bj < 2; ++bj) { v[bj][0] = acc[ai][bj][m][0]; v[bj][1] = acc[ai][bj][m][1]; }
                if (rot) {
                    const f32x4* tp = (const f32x4*)(rope + (size_t)row * 16);
                    f32x4 cs[2][2]; cs[0][0] = tp[0]; cs[0][1] = tp[1]; cs[1][0] = tp[2]; cs[1][1] = tp[3];
#pragma unroll
                    for (int bj = 0; bj < 2; ++bj)
#pragma unroll
                        for (int n = 0; n < 2; ++n)
#pragma unroll
                            for (int i = 0; i < 4; ++i) {
                                const float xv = v[bj][n][i], pv = __shfl_xor(xv, 16);
                                const float c = cs[n][i >> 1][2 * (i & 1)], s = cs[n][i >> 1][2 * (i & 1) + 1];
                                const float o = fq == 0 ? xv * c - pv * s : (fq == 1 ? xv * c + pv * s : xv);
                                v[bj][n][i] = o; }
                }
                bf16_t* rowp = base + (size_t)row * ld + c0 + cl;
#pragma unroll
                for (int bj = 0; bj < 2; ++bj) { v4u w; w.x = cvtpk(v[bj][0][0], v[bj][0][1]); w.y = cvtpk(v[bj][0][2], v[bj][0][3]); w.z = cvtpk(v[bj][1][0], v[bj][1][1]); w.w = cvtpk(v[bj][1][2], v[bj][1][3]);
                    *(v4u*)(rowp + bj * 128) = w; }
            }
    }
};

__device__ __forceinline__ void p0_transpose_item(const float* W, int K, int N, bf16_t* WT, LAS float* scr, int item, int lane) {
    const int nblk = N / 32, kb = item / nblk, nb = item % nblk, k0 = 64 * kb, n0 = 32 * nb;
#pragma unroll 8
    for (int i = 0; i < 32; ++i) { const int kk = 2 * i + (lane >> 5); scr[kk * 33 + (lane & 31)] = W[(size_t)(k0 + kk) * N + n0 + (lane & 31)]; }
    LDS_WAIT(); asm volatile("" ::: "memory");
    const int c = lane & 7;
#pragma unroll
    for (int j = 0; j < 4; ++j) { const int n = (lane >> 3) + 8 * j; const LAS float* s = scr + (8 * c) * 33 + n;
        v4u o; o.x = cvtpk(s[0 * 33], s[1 * 33]); o.y = cvtpk(s[2 * 33], s[3 * 33]); o.z = cvtpk(s[4 * 33], s[5 * 33]); o.w = cvtpk(s[6 * 33], s[7 * 33]);
        *(v4u*)(WT + (size_t)(n0 + n) * K + k0 + 8 * c) = o; }
    LDS_WAIT(); asm volatile("" ::: "memory");
}
template <bool NT>
__device__ __forceinline__ void cvt_stream(const float* in, bf16_t* out, size_t n, int gw, int NGW, int lane) {
#pragma unroll 4
    for (size_t i = (size_t)gw * 512 + lane * 4; i < n; i += (size_t)NGW * 512) {
        f32x4 a, b;
        if (NT) { a = __builtin_nontemporal_load((const f32x4*)(in + i)); b = __builtin_nontemporal_load((const f32x4*)(in + i + 256)); }
        else { a = *(const f32x4*)(in + i); b = *(const f32x4*)(in + i + 256); }
        v2u o0, o1; o0.x = cvtpk(a.x, a.y); o0.y = cvtpk(a.z, a.w); o1.x = cvtpk(b.x, b.y); o1.y = cvtpk(b.z, b.w);
        *(v2u*)(out + i) = o0; *(v2u*)(out + i + 256) = o1;
    }
}

constexpr int SWA_KROW = 144, SWA_VROW = 528, SWA_VT_OFF = 256 * SWA_KROW;
__device__ __forceinline__ void swa_item(LAS unsigned char* lds, int item, const bf16_t* __restrict__ Q, const bf16_t* __restrict__ Kb, const bf16_t* __restrict__ Vb, const float* __restrict__ sinks,
                                         bf16_t* CONCAT, int tid, int wave, int lane) {
    const int qb = item & 31, kvh = (item >> 5) & 3, b = item >> 7;
    const int tok0 = b * SEQ + qb * 128;
    LAS unsigned char* Kl = lds; LAS unsigned char* Vt = lds + SWA_VT_OFF;
#pragma unroll
    for (int j = 0; j < 4; ++j) {
        const int c = tid + NTHREADS * j, row = c >> 3, part = c & 7;
        v4u kv = {0u, 0u, 0u, 0u}, vv = {0u, 0u, 0u, 0u};
        if (qb > 0 || row >= 128) { const size_t tk = (size_t)(tok0 - 128 + row); kv = *(const v4u*)(Kb + tk * KV_W + kvh * HD + part * 8); vv = *(const v4u*)(Vb + tk * KV_W + kvh * HD + part * 8); }
        *(LAS v4u*)(Kl + row * SWA_KROW + part * 16) = kv;
        LAS unsigned short* vp = (LAS unsigned short*)(Vt + (part * 8) * SWA_VROW + row * 2);
        vp[0 * (SWA_VROW / 2)] = (unsigned short)(vv.x & 0xffffu); vp[1 * (SWA_VROW / 2)] = (unsigned short)(vv.x >> 16);
        vp[2 * (SWA_VROW / 2)] = (unsigned short)(vv.y & 0xffffu); vp[3 * (SWA_VROW / 2)] = (unsigned short)(vv.y >> 16);
        vp[4 * (SWA_VROW / 2)] = (unsigned short)(vv.z & 0xffffu); vp[5 * (SWA_VROW / 2)] = (unsigned short)(vv.z >> 16);
        vp[6 * (SWA_VROW / 2)] = (unsigned short)(vv.w & 0xffffu); vp[7 * (SWA_VROW / 2)] = (unsigned short)(vv.w >> 16);
    }
    __syncthreads();
    const int g = wave & 3, h = kvh * 4 + g, q15 = lane & 15, qq = lane >> 4;
    const float sink2 = sinks[h] * LOG2E;
    const float SC = 0.125f * LOG2E;
#pragma unroll 1
    for (int cc = 0; cc < 2; ++cc) {
        const int c = 2 * (wave >> 2) + cc, kl0 = 32 * c;
        bf16x8 qf[2][2];
#pragma unroll
        for (int ni = 0; ni < 2; ++ni)
#pragma unroll
            for (int ks = 0; ks < 2; ++ks) qf[ni][ks] = *(const bf16x8*)(Q + (size_t)(tok0 + 32 * c + 16 * ni + q15) * SWA_W + h * HD + 32 * ks + 8 * qq);
        f32x4 s[10][2];
#pragma unroll
        for (int mi = 0; mi < 10; ++mi) { s[mi][0] = (f32x4){0.f, 0.f, 0.f, 0.f}; s[mi][1] = (f32x4){0.f, 0.f, 0.f, 0.f}; }
#pragma unroll
        for (int mi = 0; mi < 10; ++mi)
#pragma unroll
            for (int ks = 0; ks < 2; ++ks) {
                const bf16x8 kf = *(const LAS bf16x8*)(Kl + (kl0 + 16 * mi + q15) * SWA_KROW + (32 * ks + 8 * qq) * 2);
                s[mi][0] = mfma16(kf, qf[0][ks], s[mi][0]); s[mi][1] = mfma16(kf, qf[1][ks], s[mi][1]);
            }
        float rl[2];
#pragma unroll
        for (int ni = 0; ni < 2; ++ni) {
            const int ql = 32 * c + 16 * ni + q15;
            float mx = -INFINITY;
#pragma unroll
            for (int mi = 0; mi < 10; ++mi)
#pragma unroll
                for (int r = 0; r < 4; ++r) {
                    const int kl = kl0 + 16 * mi + 4 * qq + r;
                    const bool valid = (kl > ql) && (kl <= ql + 128) && (qb > 0 || kl >= 128);
                    const float t = valid ? s[mi][ni][r] * SC : -INFINITY;
                    s[mi][ni][r] = t; mx = fmaxf(mx, t);
                }
            mx = fmaxf(xfmax4(mx), sink2);
            float l = 0.f;
#pragma unroll
            for (int mi = 0; mi < 10; ++mi)
#pragma unroll
                for (int r = 0; r < 4; ++r) { const float p = fexp2(s[mi][ni][r] - mx); s[mi][ni][r] = p; l += p; }
            l = xfsum4(l) + fexp2(sink2 - mx);
            rl[ni] = 1.0f / l;
        }
        f32x4 o[4][2];
#pragma unroll
        for (int dt = 0; dt < 4; ++dt) { o[dt][0] = (f32x4){0.f, 0.f, 0.f, 0.f}; o[dt][1] = (f32x4){0.f, 0.f, 0.f, 0.f}; }
#pragma unroll
        for (int kk = 0; kk < 5; ++kk) {
            bf16x8 pf[2];
#pragma unroll
            for (int ni = 0; ni < 2; ++ni) {
                v4u w; w.x = cvtpk(s[2 * kk][ni][0], s[2 * kk][ni][1]); w.y = cvtpk(s[2 * kk][ni][2], s[2 * kk][ni][3]);
                w.z = cvtpk(s[2 * kk + 1][ni][0], s[2 * kk + 1][ni][1]); w.w = cvtpk(s[2 * kk + 1][ni][2], s[2 * kk + 1][ni][3]);
                pf[ni] = __builtin_bit_cast(bf16x8, w);
            }
#pragma unroll
            for (int dt = 0; dt < 4; ++dt) {
                const LAS unsigned char* vb = Vt + (16 * dt + q15) * SWA_VROW + (kl0 + 32 * kk + 4 * qq) * 2;
                const v2u lo = *(const LAS v2u*)vb, hi = *(const LAS v2u*)(vb + 32);
                v4u w; w.x = lo.x; w.y = lo.y; w.z = hi.x; w.w = hi.y;
                const bf16x8 vf = __builtin_bit_cast(bf16x8, w);
                o[dt][0] = mfma16(vf, pf[0], o[dt][0]); o[dt][1] = mfma16(vf, pf[1], o[dt][1]);
            }
        }
#pragma unroll
        for (int ni = 0; ni < 2; ++ni) {
            bf16_t* orow = CONCAT + (size_t)(tok0 + 32 * c + 16 * ni + q15) * D_MODEL + POOL_W + h * HD + 4 * qq;
#pragma unroll
            for (int dt = 0; dt < 4; ++dt) { v2u w; w.x = cvtpk(o[dt][ni][0] * rl[ni], o[dt][ni][1] * rl[ni]); w.y = cvtpk(o[dt][ni][2] * rl[ni], o[dt][ni][3] * rl[ni]); *(v2u*)(orow + 16 * dt) = w; }
        }
    }
    __syncthreads();
}
constexpr int MEM_KROW = 272, MEM_VROW = 528, MEM_VT_OFF = 256 * MEM_KROW;
__device__ __forceinline__ void mem_item(LAS unsigned char* lds, int item, const bf16_t* __restrict__ QM, const bf16_t* __restrict__ KVM, bf16_t* CONCAT, int tid, int wave, int lane) {
    const int qt = item & 31, hm = (item >> 5) & 3, b = item >> 7;
    LAS unsigned char* Kl = lds; LAS unsigned char* Vt = lds + MEM_VT_OFF;
#pragma unroll
    for (int j = 0; j < 8; ++j) {
        const int c = tid + NTHREADS * j, row = c >> 4, part = c & 15;
        const bf16_t* src = KVM + (size_t)(b * MEM_LEN + row) * (2 * MEM_W) + hm * MHD + part * 8;
        const v4u kv = *(const v4u*)src, vv = *(const v4u*)(src + MEM_W);
        *(LAS v4u*)(Kl + row * MEM_KROW + part * 16) = kv;
        LAS unsigned short* vp = (LAS unsigned short*)(Vt + (part * 8) * MEM_VROW + row * 2);
        vp[0 * (MEM_VROW / 2)] = (unsigned short)(vv.x & 0xffffu); vp[1 * (MEM_VROW / 2)] = (unsigned short)(vv.x >> 16);
        vp[2 * (MEM_VROW / 2)] = (unsigned short)(vv.y & 0xffffu); vp[3 * (MEM_VROW / 2)] = (unsigned short)(vv.y >> 16);
        vp[4 * (MEM_VROW / 2)] = (unsigned short)(vv.z & 0xffffu); vp[5 * (MEM_VROW / 2)] = (unsigned short)(vv.z >> 16);
        vp[6 * (MEM_VROW / 2)] = (unsigned short)(vv.w & 0xffffu); vp[7 * (MEM_VROW / 2)] = (unsigned short)(vv.w >> 16);
    }
    __syncthreads();
    const int q15 = lane & 15, qq = lane >> 4;
    const int tok = b * SEQ + qt * 128 + wave * 16 + q15;
    const float SC = 0.08838834764831845f * LOG2E;
    bf16x8 qf[4];
#pragma unroll
    for (int ks = 0; ks < 4; ++ks) qf[ks] = *(const bf16x8*)(QM + (size_t)tok * MEM_W + hm * MHD + 32 * ks + 8 * qq);
    f32x4 s[16];
#pragma unroll
    for (int mi = 0; mi < 16; ++mi) s[mi] = (f32x4){0.f, 0.f, 0.f, 0.f};
#pragma unroll
    for (int mi = 0; mi < 16; ++mi)
#pragma unroll
        for (int ks = 0; ks < 4; ++ks) {
            const bf16x8 kf = *(const LAS bf16x8*)(Kl + (16 * mi + q15) * MEM_KROW + (32 * ks + 8 * qq) * 2);
            s[mi] = mfma16(kf, qf[ks], s[mi]);
        }
    float mx = -INFINITY;
#pragma unroll
    for (int mi = 0; mi < 16; ++mi)
#pragma unroll
        for (int r = 0; r < 4; ++r) { const float t = s[mi][r] * SC; s[mi][r] = t; mx = fmaxf(mx, t); }
    mx = xfmax4(mx);
    float l = 0.f;
#pragma unroll
    for (int mi = 0; mi < 16; ++mi)
#pragma unroll
        for (int r = 0; r < 4; ++r) { const float p = fexp2(s[mi][r] - mx); s[mi][r] = p; l += p; }
    l = xfsum4(l);
    const float rl = 1.0f / l;
    f32x4 o[8];
#pragma unroll
    for (int dt = 0; dt < 8; ++dt) o[dt] = (f32x4){0.f, 0.f, 0.f, 0.f};
#pragma unroll
    for (int kk = 0; kk < 8; ++kk) {
        v4u pw; pw.x = cvtpk(s[2 * kk][0], s[2 * kk][1]); pw.y = cvtpk(s[2 * kk][2], s[2 * kk][3]); pw.z = cvtpk(s[2 * kk + 1][0], s[2 * kk + 1][1]); pw.w = cvtpk(s[2 * kk + 1][2], s[2 * kk + 1][3]);
        const bf16x8 pf = __builtin_bit_cast(bf16x8, pw);
#pragma unroll
        for (int dt = 0; dt < 8; ++dt) {
            const LAS unsigned char* vb = Vt + (16 * dt + q15) * MEM_VROW + (32 * kk + 4 * qq) * 2;
            const v2u lo = *(const LAS v2u*)vb, hi = *(const LAS v2u*)(vb + 32);
            v4u w; w.x = lo.x; w.y = lo.y; w.z = hi.x; w.w = hi.y;
            o[dt] = mfma16(__builtin_bit_cast(bf16x8, w), pf, o[dt]);
        }
    }
    bf16_t* orow = CONCAT + (size_t)tok * D_MODEL + POOL_W + SWA_W + hm * MHD + 4 * qq;
#pragma unroll
    for (int dt = 0; dt < 8; ++dt) { v2u w; w.x = cvtpk(o[dt][0] * rl, o[dt][1] * rl); w.y = cvtpk(o[dt][2] * rl, o[dt][3] * rl); *(v2u*)(orow + 16 * dt) = w; }
    __syncthreads();
}
constexpr int POOL_LROW = 272, POOL_LDS_PER_WAVE = 16 * POOL_LROW;
template <int W>
__device__ __forceinline__ void pool_window(LAS unsigned char* wl, const float* __restrict__ pv, int sp0, int lane) {
    f32x2 cur[16];
#pragma unroll
    for (int tt = 0; tt < 16; ++tt) cur[tt] = *(const f32x2*)(pv + (size_t)tt * POOL_W);
    f32x2 prev[W - 1];
#pragma unroll
    for (int i = 1; i < W; ++i) { const bool ok = (i <= sp0); const size_t back = ok ? (size_t)i * POOL_W : 0; const f32x2 v = *(const f32x2*)(pv - back); prev[i - 1] = ok ? v : (f32x2){0.f, 0.f}; }
    f32x2 S = {0.f, 0.f};
#pragma unroll
    for (int i = 1; i < W; ++i) S += prev[i - 1];
#pragma unroll
    for (int tt = 0; tt < 16; ++tt) {
        S += cur[tt];
        const int sp = sp0 + tt; const int cnt = (sp + 1) < W ? (sp + 1) : W;
        const f32x2 pooled = S * (1.0f / (float)cnt) - cur[tt];
        *(LAS unsigned*)(wl + tt * POOL_LROW + 4 * lane) = cvtpk(pooled.x, pooled.y);
        if (tt - W + 1 >= 0) S -= cur[tt - W + 1 >= 0 ? tt - W + 1 : 0]; else S -= prev[(W - 1 - tt) - 1 >= 0 ? (W - 1 - tt) - 1 : 0];
    }
}
__device__ __forceinline__ void pool_item(LAS unsigned char* wl, int item, const float* __restrict__ POOLV, const bf16_t* __restrict__ WPT, const float* __restrict__ pool_scale, bf16_t* CONCAT, int lane) {
    const int g = item & 3, t0 = (item >> 2) * 16, q15 = lane & 15, qq = lane >> 4;
    const int sp0 = t0 & (SEQ - 1);
    const float* pv = POOLV + (size_t)t0 * POOL_W + g * 128 + 2 * lane;
    if (g == 0) pool_window<2>(wl, pv, sp0, lane); else if (g == 1) pool_window<4>(wl, pv, sp0, lane); else if (g == 2) pool_window<8>(wl, pv, sp0, lane); else pool_window<16>(wl, pv, sp0, lane);
    LDS_WAIT(); asm volatile("" ::: "memory");
    bf16x8 pf[4];
#pragma unroll
    for (int ks = 0; ks < 4; ++ks) pf[ks] = *(const LAS bf16x8*)(wl + q15 * POOL_LROW + (32 * ks + 8 * qq) * 2);
    const int t = t0 + q15;
    bf16_t* orow = CONCAT + (size_t)t * D_MODEL + g * 128 + 4 * qq;
#pragma unroll
    for (int mt = 0; mt < 8; ++mt) {
        f32x4 acc = {0.f, 0.f, 0.f, 0.f};
#pragma unroll
        for (int ks = 0; ks < 4; ++ks) { const bf16x8 wf = *(const bf16x8*)(WPT + (size_t)g * 16384 + (16 * mt + q15) * 128 + 32 * ks + 8 * qq); acc = mfma16(wf, pf[ks], acc); }
        const f32x4 sc = *(const f32x4*)(pool_scale + g * 128 + 16 * mt + 4 * qq);
        v2u wv; wv.x = cvtpk(acc[0] * sc[0], acc[1] * sc[1]); wv.y = cvtpk(acc[2] * sc[2], acc[3] * sc[3]);
        *(v2u*)(orow + 16 * mt) = wv;
    }
    LDS_WAIT(); asm volatile("" ::: "memory");
}

__device__ __forceinline__ void ln1_row(const float* __restrict__ yrow, const float* __restrict__ g, const float* __restrict__ bta, float* xo, bf16_t* xb, int lane) {
    f32x4 v[8]; float s = 0.f;
#pragma unroll
    for (int j = 0; j < 8; ++j) { v[j] = *(const f32x4*)(yrow + 256 * j + 4 * lane); s += (v[j].x + v[j].y) + (v[j].z + v[j].w); }
    const float mean = wave_sum(s) * (1.f / D_MODEL); float q = 0.f;
#pragma unroll
    for (int j = 0; j < 8; ++j) { v[j] = v[j] - mean; q += (v[j].x * v[j].x + v[j].y * v[j].y) + (v[j].z * v[j].z + v[j].w * v[j].w); }
    const float rstd = 1.0f / sqrtf(wave_sum(q) * (1.f / D_MODEL) + LN_EPS);
#pragma unroll
    for (int j = 0; j < 8; ++j) {
        const f32x4 gg = *(const f32x4*)(g + 256 * j + 4 * lane), bb = *(const f32x4*)(bta + 256 * j + 4 * lane);
        const f32x4 y = v[j] * rstd * gg + bb;
        *(f32x4*)(xo + 256 * j + 4 * lane) = y;
        v2u w; w.x = cvtpk(y.x, y.y); w.y = cvtpk(y.z, y.w); *(v2u*)(xb + 256 * j + 4 * lane) = w;
    }
}

__device__ __forceinline__ unsigned f2ord(float f) { const unsigned u = __float_as_uint(f); return u ^ ((unsigned)((int)u >> 31) | 0x80000000u); }
__device__ __forceinline__ float ord2f(unsigned o) { const unsigned u = (o & 0x80000000u) ? (o ^ 0x80000000u) : ~o; return __uint_as_float(u); }
constexpr int TK_KROW = 272, TK_HALF = 128 * TK_KROW;
__device__ __forceinline__ void topk_item(int item, const bf16_t* __restrict__ QP, const LAS unsigned char* Kl, LAS unsigned char* et, int* EIDX, float* GATE, int lane) {
    const int h = item & 7, t0 = (item >> 3) * 16, q15 = lane & 15, qq = lane >> 4;
    const int t = t0 + q15;
    unsigned top[2][16];
    unsigned key[2][32];
#pragma unroll
    for (int half = 0; half < 2; ++half) {
        bf16x8 qf[4];
#pragma unroll
        for (int ks = 0; ks < 4; ++ks) qf[ks] = *(const bf16x8*)(QP + (size_t)t * D_MODEL + h * 256 + half * 128 + 32 * ks + 8 * qq);
#pragma unroll
        for (int mi = 0; mi < 8; ++mi) {
            f32x4 acc = {0.f, 0.f, 0.f, 0.f};
#pragma unroll
            for (int ks = 0; ks < 4; ++ks) { const bf16x8 kf = *(const LAS bf16x8*)(Kl + half * TK_HALF + (16 * mi + q15) * TK_KROW + (32 * ks + 8 * qq) * 2); acc = mfma16(kf, qf[ks], acc); }
#pragma unroll
            for (int r = 0; r < 4; ++r) key[half][mi * 4 + r] = (f2ord(acc[r]) & ~0x7Fu) | (unsigned)(127 - (16 * mi + 4 * qq + r));
        }
    }
    unsigned C0 = 0xFFFFFFFFu, C1 = 0xFFFFFFFFu;
#pragma unroll
    for (int r = 0; r < 16; ++r) {
        unsigned L[2];
#pragma unroll
        for (int half = 0; half < 2; ++half) {
            const unsigned C = half ? C1 : C0;
            unsigned t1[11];
#pragma unroll
            for (int i = 0; i < 10; ++i) t1[i] = umin(umin(C - key[half][3 * i], C - key[half][3 * i + 1]), C - key[half][3 * i + 2]);
            t1[10] = umin(C - key[half][30], C - key[half][31]);
            const unsigned u0 = umin(umin(t1[0], t1[1]), t1[2]), u1 = umin(umin(t1[3], t1[4]), t1[5]), u2 = umin(umin(t1[6], t1[7]), t1[8]), u3 = umin(t1[9], t1[10]);
            L[half] = umin(umin(umin(u0, u1), u2), u3);
        }
        const unsigned M0 = C0 - xmin4(L[0]), M1 = C1 - xmin4(L[1]);
        top[0][r] = M0; top[1][r] = M1; C0 = M0 - 1u; C1 = M1 - 1u;
    }
    float v1[16], v2[16];
#pragma unroll
    for (int r = 0; r < 16; ++r) { v1[r] = ord2f(top[0][r] & ~0x7Fu); v2[r] = ord2f(top[1][r] & ~0x7Fu); }
    if (qq < 2) {
#pragma unroll
        for (int r4 = 0; r4 < 4; ++r4) { v4u ev;
#pragma unroll
            for (int i = 0; i < 4; ++i) { const unsigned tk = qq ? top[1][4 * r4 + i] : top[0][4 * r4 + i]; const unsigned id7 = 127u - (tk & 0x7Fu); ev[i] = qq ? id7 : id7 * 128u; }
            *(LAS v4u*)(et + q15 * 128 + qq * 64 + r4 * 16) = ev; }
    }
    unsigned ck[13];
#pragma unroll
    for (int i = 0; i < 13; ++i) ck[i] = 0u;
    {
        int n = 0;
#pragma unroll
        for (int a = 0; a < 16; ++a)
#pragma unroll
            for (int bb = 0; bb < 16; ++bb)
                if ((a + 1) * (bb + 1) <= 16) {
                    const unsigned pk = (f2ord(v1[a] + v2[bb]) & ~0xFFu) | (unsigned)(255 - (a * 16 + bb));
                    ck[n >> 2] = (qq == (n & 3)) ? pk : ck[n >> 2];
                    ++n;
                }
    }
    LDS_WAIT();
    float sc[16];
    unsigned CC = 0xFFFFFFFFu;
#pragma unroll
    for (int r = 0; r < 16; ++r) {
        const unsigned c0 = umin(umin(CC - ck[0], CC - ck[1]), CC - ck[2]), c1 = umin(umin(CC - ck[3], CC - ck[4]), CC - ck[5]), c2 = umin(umin(CC - ck[6], CC - ck[7]), CC - ck[8]), c3 = umin(umin(CC - ck[9], CC - ck[10]), CC - ck[11]);
        const unsigned M = CC - xmin4(umin(umin(umin(c0, c1), umin(c2, c3)), CC - ck[12]));
        CC = M - 1u;
        sc[r] = ord2f(M & ~0xFFu);
        const unsigned id8 = 255u - (M & 0xFFu);
        const unsigned we = *(const LAS unsigned*)(et + q15 * 128 + (id8 >> 4) * 4) + *(const LAS unsigned*)(et + q15 * 128 + 64 + (id8 & 15u) * 4);
        if (qq == (r & 3)) EIDX[(size_t)t * EPT + h * TOPK + r] = (int)we;
    }
    const float smax = sc[0];
    float den = 0.f;
#pragma unroll
    for (int r = 0; r < 16; ++r) { sc[r] = fexp2((sc[r] - smax) * LOG2E); den += sc[r]; }
    const float rden = 1.0f / den;
    if (qq == 0) {
        float* gp = GATE + (size_t)t * EPT + h * TOPK;
#pragma unroll
        for (int r = 0; r < 16; r += 4) *(f32x4*)(gp + r) = (f32x4){sc[r] * rden, sc[r + 1] * rden, sc[r + 2] * rden, sc[r + 3] * rden};
    }
    LDS_WAIT();
}

struct SliceMeta { int idx[16]; };
__device__ __forceinline__ void slice_meta(SliceMeta& m, const int* __restrict__ EIDX, int t, int g) {
#pragma unroll
    for (int k4 = 0; k4 < 4; ++k4) { const v4u iv = *(const v4u*)(EIDX + (size_t)t * EPT + 16 * g + 4 * k4); m.idx[4 * k4] = (int)iv.x; m.idx[4 * k4 + 1] = (int)iv.y; m.idx[4 * k4 + 2] = (int)iv.z; m.idx[4 * k4 + 3] = (int)iv.w; }
}
#define PU_GATHER(W, IDX) do { _Pragma("unroll") for (int _k = 0; _k < 16; ++_k) W[_k] = *(const v4u*)(base + (size_t)(IDX).idx[_k] * 128); } while (0)
#define PU_META(M, XA, XC, T) do { slice_meta(M, EIDX, (T), g); XA = *(const v4u*)(X1B + (size_t)(T) * D_MODEL + 128 * s + 16 * c); XC = *(const v4u*)(X1B + (size_t)(T) * D_MODEL + 128 * s + 16 * c + 8); } while (0)
#define PU_COMPUTE(W, XA, XC, T) do { const unsigned xb[8] = {XA.x, XA.y, XA.z, XA.w, XC.x, XC.y, XC.z, XC.w}; float p[16]; \
        if (VARIANT == 1) { _Pragma("unroll") for (int k = 0; k < 16; ++k) p[k] = __uint_as_float((W[k][0] ^ W[k][1]) ^ (W[k][2] ^ W[k][3]) ^ xb[k & 7]); } else \
        _Pragma("unroll") for (int k = 0; k < 16; ++k) { float a = 0.f, b = 0.f; \
            _Pragma("unroll") for (int j = 0; j < 4; ++j) { const unsigned wv = W[k][j]; \
                a = __builtin_amdgcn_fdot2_f32_bf16(__builtin_amdgcn_cvt_scalef32_pk_bf16_fp8(wv, 1.0f, false), __builtin_bit_cast(bf16x2, xb[2 * j]), a, false); \
                b = __builtin_amdgcn_fdot2_f32_bf16(__builtin_amdgcn_cvt_scalef32_pk_bf16_fp8(wv, 1.0f, true), __builtin_bit_cast(bf16x2, xb[2 * j + 1]), b, false); } \
            p[k] = a + b; } \
        float r8[8], r4[4], r2[2]; \
        _Pragma("unroll") for (int m = 0; m < 8; ++m) { const float keep = b4 ? p[m + 8] : p[m], send = b4 ? p[m] : p[m + 8]; r8[m] = keep + __shfl_xor(send, 4); } \
        _Pragma("unroll") for (int m = 0; m < 4; ++m) { const float keep = b2 ? r8[m + 4] : r8[m], send = b2 ? r8[m] : r8[m + 4]; r4[m] = keep + __shfl_xor(send, 2); } \
        _Pragma("unroll") for (int m = 0; m < 2; ++m) { const float keep = b1 ? r4[m + 2] : r4[m], send = b1 ? r4[m] : r4[m + 2]; r2[m] = keep + __shfl_xor(send, 1); } \
        *(f32x2*)(HP + ((size_t)s * MTOK + (T)) * EPT + 16 * g + k0) = (f32x2){r2[0], r2[1]}; } while (0)
template <int VARIANT>
__device__ __forceinline__ void pu_sweep(int s, int tfirst, int tstep, const bf16_t* __restrict__ X1B, const int* __restrict__ EIDX, const unsigned char* __restrict__ U8S, float* HP, int lane) {
    const int g = lane >> 3, c = lane & 7;
    const unsigned char* base = U8S + (size_t)s * NEXP * 128 + 16 * c;
    const bool b4 = c & 4, b2 = c & 2, b1 = c & 1;
    const int k0 = (b4 ? 8 : 0) + (b2 ? 4 : 0) + (b1 ? 2 : 0);
    const int n = (MTOK - tfirst + tstep - 1) / tstep;
    const int tlast = tfirst + (n - 1) * tstep;
    SliceMeta mA, mB; v4u xaA, xcA, xaB, xcB; v4u wA[16], wB[16];
    PU_META(mA, xaA, xcA, tfirst);
    PU_META(mB, xaB, xcB, (tfirst + tstep <= tlast ? tfirst + tstep : tlast));
    PU_GATHER(wA, mA);
#pragma unroll 1
    for (int t = tfirst; t <= tlast; t += 2 * tstep) {
        const int t1 = t + tstep <= tlast ? t + tstep : tlast, t2 = t + 2 * tstep <= tlast ? t + 2 * tstep : tlast, t3 = t + 3 * tstep <= tlast ? t + 3 * tstep : tlast;
        PU_GATHER(wB, mB);
        SliceMeta mN; v4u xaN, xcN; PU_META(mN, xaN, xcN, t2);
        PU_COMPUTE(wA, xaA, xcA, t);
        mA = mN; xaA = xaN; xcA = xcN;
        PU_GATHER(wA, mA);
        PU_META(mN, xaN, xcN, t3);
        if (t + tstep <= tlast) PU_COMPUTE(wB, xaB, xcB, t1);
        mB = mN; xaB = xaN; xcB = xcN;
    }
}
__device__ __forceinline__ void pv_sweep(int s, int tfirst, int tstep, const float* __restrict__ X1, const int* __restrict__ EIDX, const float* __restrict__ A, const unsigned char* __restrict__ V8S,
                                         float* Y2, float* STAT, int lane) {
    const int g = lane >> 3, c = lane & 7;
    const unsigned char* base = V8S + (size_t)s * NEXP * 128 + 16 * c;
    const bool b3 = lane & 8;
    const int col = 16 * c + ((lane & 32) ? 8 : 0) + ((lane & 16) ? 4 : 0) + (b3 ? 2 : 0);
    SliceMeta cur; f32x4 av[4];
    slice_meta(cur, EIDX, tfirst, g);
#pragma unroll
    for (int k4 = 0; k4 < 4; ++k4) av[k4] = *(const f32x4*)(A + (size_t)tfirst * EPT + 16 * g + 4 * k4);
#pragma unroll 1
    for (int t = tfirst; t < MTOK; t += tstep) {
        v4u w[16];
#pragma unroll
        for (int k = 0; k < 16; ++k) w[k] = *(const v4u*)(base + (size_t)cur.idx[k] * 128);
        const int tn = (t + tstep < MTOK) ? t + tstep : t;
        SliceMeta nxt; slice_meta(nxt, EIDX, tn, g);
        f32x4 avn[4];
#pragma unroll
        for (int k4 = 0; k4 < 4; ++k4) avn[k4] = *(const f32x4*)(A + (size_t)tn * EPT + 16 * g + 4 * k4);
        const f32x2 xr = *(const f32x2*)(X1 + (size_t)t * D_MODEL + 128 * s + col);
        f32x4 acc[4];
#pragma unroll
        for (int j = 0; j < 4; ++j) acc[j] = (f32x4){0.f, 0.f, 0.f, 0.f};
#pragma unroll
        for (int k = 0; k < 16; ++k) { const float a = av[k >> 2][k & 3];
#pragma unroll
            for (int j = 0; j < 4; ++j) { const unsigned wv = w[k][j]; const f32x2 lo = __builtin_amdgcn_cvt_pk_f32_fp8(wv, false), hi = __builtin_amdgcn_cvt_pk_f32_fp8(wv, true);
                acc[j] += (f32x4){lo.x, lo.y, hi.x, hi.y} * a; } }
        float r8[8], r4[4], r2[2];
#pragma unroll
        for (int m = 0; m < 8; ++m) { auto r = __builtin_amdgcn_permlane32_swap(__float_as_uint(acc[m >> 2][m & 3]), __float_as_uint(acc[(m + 8) >> 2][m & 3]), false, false); r8[m] = __uint_as_float(r[0]) + __uint_as_float(r[1]); }
#pragma unroll
        for (int m = 0; m < 4; ++m) { auto r = __builtin_amdgcn_permlane16_swap(__float_as_uint(r8[m]), __float_as_uint(r8[m + 4]), false, false); r4[m] = __uint_as_float(r[0]) + __uint_as_float(r[1]); }
#pragma unroll
        for (int m = 0; m < 2; ++m) { const float keep = b3 ? r4[m + 2] : r4[m], send = b3 ? r4[m] : r4[m + 2]; r2[m] = keep + __shfl_xor(send, 8); }
        const float y0 = xr.x * ALPHA + r2[0], y1 = xr.y * ALPHA + r2[1];
        *(f32x2*)(Y2 + (size_t)t * D_MODEL + 128 * s + col) = (f32x2){y0, y1};
        const float s1 = wave_sum(y0 + y1), s2 = wave_sum(y0 * y0 + y1 * y1);
        if (lane == 0) *(f32x2*)(STAT + ((size_t)t * 16 + s) * 2) = (f32x2){s1, s2};
        cur = nxt;
#pragma unroll
        for (int k4 = 0; k4 < 4; ++k4) av[k4] = avn[k4];
    }
}
__device__ __forceinline__ void ln2_row(int t, const float* __restrict__ Y2, const float* __restrict__ STAT, const float* __restrict__ g2, const float* __restrict__ b2, float* out, int lane) {
    f32x2 st = {0.f, 0.f};
    if (lane < 16) st = *(const f32x2*)(STAT + ((size_t)t * 16 + lane) * 2);
    const float mean = wave_sum(st.x) * (1.f / D_MODEL), ex2 = wave_sum(st.y) * (1.f / D_MODEL);
    const float rstd = 1.0f / sqrtf(fmaxf(ex2 - mean * mean, 0.f) + LN_EPS);
#pragma unroll
    for (int j = 0; j < 8; ++j) {
        const int c = 256 * j + 4 * lane;
        const f32x4 y = *(const f32x4*)(Y2 + (size_t)t * D_MODEL + c), gg = *(const f32x4*)(g2 + c), bb = *(const f32x4*)(b2 + c);
        *(f32x4*)(out + (size_t)t * D_MODEL + c) = (y - mean) * rstd * gg + bb;
    }
}
template <int R>
__device__ __forceinline__ void cvt_rows_fp8(const float* __restrict__ in, unsigned char* outs, float* sc, int row0, int lane) {
    f32x4 v[R][8];
#pragma unroll
    for (int r = 0; r < R; ++r)
#pragma unroll
        for (int j = 0; j < 8; ++j) v[r][j] = __builtin_nontemporal_load((const f32x4*)(in + (size_t)(row0 + r) * D_MODEL + 256 * j + 4 * lane));
#pragma unroll
    for (int r = 0; r < R; ++r) {
        float am = 0.f;
#pragma unroll
        for (int j = 0; j < 8; ++j) am = fmaxf(am, fmaxf(fmaxf(fabsf(v[r][j].x), fabsf(v[r][j].y)), fmaxf(fabsf(v[r][j].z), fabsf(v[r][j].w))));
#pragma unroll
        for (int o = 1; o < 64; o <<= 1) am = fmaxf(am, __shfl_xor(am, o));
        const float inv = am > 0.f ? 256.0f / am : 1.0f, scale = am > 0.f ? am * (1.0f / 256.0f) : 1.0f;
#pragma unroll
        for (int j = 0; j < 8; ++j) {
            int w = 0; w = __builtin_amdgcn_cvt_pk_fp8_f32(v[r][j].x * inv, v[r][j].y * inv, w, false); w = __builtin_amdgcn_cvt_pk_fp8_f32(v[r][j].z * inv, v[r][j].w * inv, w, true);
            *(unsigned*)(outs + ((size_t)(2 * j + (lane >> 5)) * NEXP + (row0 + r)) * 128 + 4 * (lane & 31)) = (unsigned)w;
        }
        if (lane == 0) sc[row0 + r] = scale;
    }
}

struct Args { const void* in[18]; float* out; unsigned char* ws; int ph_lo, ph_hi, li, pad; };
constexpr int N_PHASES = 11;

#define P_IN(T, i) ((const T*)args.in[i])
#define P_WS(T, off) ((T*)(ws + (off)))
#define x_in P_IN(float, 0)
#define mem_in P_IN(float, 1)
#define positions P_IN(int, 2)
#define w_in P_IN(float, 3)
#define w_mem_kv P_IN(float, 4)
#define w_pool P_IN(float, 5)
#define pool_scale P_IN(float, 6)
#define sinks P_IN(float, 7)
#define w_out P_IN(float, 8)
#define ln1_g P_IN(float, 9)
#define ln1_b P_IN(float, 10)
#define w_peer_q P_IN(float, 11)
#define sk1 P_IN(float, 12)
#define sk2 P_IN(float, 13)
#define eu P_IN(float, 14)
#define ev P_IN(float, 15)
#define ln2_g P_IN(float, 16)
#define ln2_b P_IN(float, 17)
#define WINT P_WS(bf16_t, WS_WINT)
#define WKVT P_WS(bf16_t, WS_WKVT)
#define WOT P_WS(bf16_t, WS_WOT)
#define WQT P_WS(bf16_t, WS_WQT)
#define WPT P_WS(bf16_t, WS_SMALL)
#define K1B P_WS(bf16_t, WS_SMALL + 131072)
#define K2B P_WS(bf16_t, WS_SMALL + 163840)
#define ROPE P_WS(float, WS_SMALL + 262144)
#define XB P_WS(bf16_t, WS_XB)
#define X1B P_WS(bf16_t, WS_X1B)
#define MEMB P_WS(bf16_t, WS_MEMB)
#define KVM P_WS(bf16_t, WS_KVM)
#define POOLV P_WS(float, WS_POOLV)
#define Q P_WS(bf16_t, WS_Q)
#define Kb P_WS(bf16_t, WS_K)
#define Vb P_WS(bf16_t, WS_V)
#define QM P_WS(bf16_t, WS_QM)
#define CONCAT P_WS(bf16_t, WS_CONCAT)
#define Y1 P_WS(float, WS_Y1)
#define X1 P_WS(float, WS_X1)
#define QP P_WS(bf16_t, WS_QP)
#define EIDX P_WS(int, WS_EIDX)
#define GATE P_WS(float, WS_GATE)
#define U8 P_WS(unsigned char, WS_UB)
#define V8 P_WS(unsigned char, WS_VB)
#define SU P_WS(float, WS_UB + 48 * MiB)
#define SV P_WS(float, WS_VB + 48 * MiB)
#define HP P_WS(float, WS_POOLV)
#define AV P_WS(float, WS_POOLV + 64 * MiB)
#define STAT P_WS(float, WS_POOLV + 68 * MiB)
#define Y2 P_WS(float, WS_Y1)
__global__ void __launch_bounds__(NTHREADS, 2) mega_fwd(Args args) {
    extern __shared__ __attribute__((aligned(16))) unsigned char lds_raw[];
    LAS unsigned char* lds = (LAS unsigned char*)lds_raw;
    volatile LAS unsigned* MISC = (volatile LAS unsigned*)(lds + MISC_OFF);
    const int tid = threadIdx.x, lane = tid & 63, wave = __builtin_amdgcn_readfirstlane(tid >> 6);
    const int G = gridDim.x, bx = blockIdx.x;
    const int vcu = (G % 8 == 0) ? (bx % 8) * (G / 8) + bx / 8 : bx;
    const int gw = vcu * NWAVES + wave, NGW = G * NWAVES;
    unsigned char* ws = args.ws;
    for (int u = tid; u < (LDS_BYTES - MISC_OFF) / 4; u += NTHREADS) MISC[u] = 0u;
    __syncthreads();
    XcdBarrier bar = xcd_barrier_post((unsigned*)(ws + WS_CTL) + CW_BAR + args.li * XCD_BAR_WORDS, MISC + 8);
    const int lo = args.ph_lo, hi = args.ph_hi;
#ifndef ONLY_PHASES
#define ONLY_PHASES 2047
#endif
#define IN(k) (((ONLY_PHASES >> (k)) & 1) && lo <= (k) && (k) < hi)
#ifndef REPEAT_MASK
#define REPEAT_MASK 0
#endif
#define REP(k) for (int _rep = 0; _rep < 1 + ((REPEAT_MASK >> (k)) & 1); ++_rep)
#define SEAM(k) do { if (IN(k) && IN((k) + 1)) xcd_barrier(bar); } while (0)

    if (IN(0)) REP(0) {
        LAS float* scr = (LAS float*)(lds + wave * 16384);
        constexpr int I_IN = (D_MODEL / 64) * (IN_W / 32), I_KV = (D_MODEL / 64) * (2 * MEM_W / 32), I_O = (D_MODEL / 64) * (D_MODEL / 32), I_Q = I_O, I_P = 4 * 2 * 4;
        constexpr int NITEMS = I_IN + I_KV + I_O + I_Q + I_P;
        for (int it = gw; it < NITEMS; it += NGW) {
            int r = it;
            if (r < I_IN) { p0_transpose_item(w_in, D_MODEL, IN_W, WINT, scr, r, lane); continue; } r -= I_IN;
            if (r < I_KV) { p0_transpose_item(w_mem_kv, D_MODEL, 2 * MEM_W, WKVT, scr, r, lane); continue; } r -= I_KV;
            if (r < I_O) { p0_transpose_item(w_out, D_MODEL, D_MODEL, WOT, scr, r, lane); continue; } r -= I_O;
            if (r < I_Q) { p0_transpose_item(w_peer_q, D_MODEL, D_MODEL, WQT, scr, r, lane); continue; } r -= I_Q;
            { const int gpl = r >> 3; p0_transpose_item(w_pool + (size_t)gpl * 16384, 128, 128, WPT + (size_t)gpl * 16384, scr, r & 7, lane); }
        }
        cvt_stream<false>(x_in, XB, (size_t)MTOK * D_MODEL, gw, NGW, lane);
        cvt_stream<false>(mem_in, MEMB, (size_t)MMEM * D_MODEL, gw, NGW, lane);
        cvt_stream<false>(sk1, K1B, (size_t)NKEYS * 128, gw, NGW, lane);
        cvt_stream<false>(sk2, K2B, (size_t)NKEYS * 128, gw, NGW, lane);
        for (int i = gw * 64 + lane; i < MTOK * 8; i += NGW * 64) { float c, s; rope_cs(positions[i >> 3], i & 7, c, s); *(f32x2*)(ROPE + 2 * (size_t)i) = (f32x2){c, s}; }
    }
    SEAM(0);
    if (IN(1)) REP(1) {
        { pg8::Gemm g{XB, WINT, MTOK, IN_W, D_MODEL}; pg8::StaticOrder S; S.init(MTOK, IN_W, G, bx);
          EpiIn E{POOLV, Q, Kb, Vb, QM, ROPE};
          pg8::gemm_phase<EpiIn, pg8::StaticOrder, true, true>(lds, g, S, E); }
        { pg8::Gemm g{MEMB, WKVT, MMEM, 2 * MEM_W, D_MODEL}; pg8::StaticOrder S; S.init(MMEM, 2 * MEM_W, G, (bx + G - 64) % G);
          EpiStoreBf E{KVM, 2 * MEM_W};
          pg8::gemm_phase<EpiStoreBf, pg8::StaticOrder, true, true>(lds, g, S, E); }
        { const int f0 = (G == 256) ? 72 : 0;
          if (bx >= f0) { const int fw = (bx - f0) * NWAVES + wave, NFW = (G - f0) * NWAVES;
            for (int r = fw * 4; r < 2 * NEXP; r += NFW * 4) { if (r < NEXP) cvt_rows_fp8<4>(eu, U8, SU, r, lane); else cvt_rows_fp8<4>(ev, V8, SV, r - NEXP, lane); } } }
    }
    SEAM(1);
    if (IN(2)) REP(2) {
        for (int it = vcu; it < 512; it += G) {
            if (it < 256) swa_item(lds, it, Q, Kb, Vb, sinks, CONCAT, tid, wave, lane);
            else mem_item(lds, it - 256, QM, KVM, CONCAT, tid, wave, lane);
        }
        for (int it = gw; it < (MTOK / 16) * 4; it += NGW) pool_item(lds + wave * POOL_LDS_PER_WAVE, it, POOLV, WPT, pool_scale, CONCAT, lane);
    }
    SEAM(2);
    if (IN(3)) REP(3) {
        pg8::Gemm g{CONCAT, WOT, MTOK, D_MODEL, D_MODEL}; pg8::StaticOrder S; S.init(MTOK, D_MODEL, G, bx);
        EpiY1 E{x_in, Y1};
        pg8::gemm_phase<EpiY1, pg8::StaticOrder, true, true>(lds, g, S, E);
    }
    SEAM(3);
    if (IN(4)) REP(4) { for (int r = gw; r < MTOK; r += NGW) ln1_row(Y1 + (size_t)r * D_MODEL, ln1_g, ln1_b, X1 + (size_t)r * D_MODEL, X1B + (size_t)r * D_MODEL, lane); }
    SEAM(4);
    if (IN(5)) REP(5) {
        pg8::Gemm g{X1B, WQT, MTOK, D_MODEL, D_MODEL}; pg8::StaticOrder S; S.init(MTOK, D_MODEL, G, bx);
        EpiStoreBf E{QP, D_MODEL};
        pg8::gemm_phase<EpiStoreBf, pg8::StaticOrder, true, true>(lds, g, S, E);
    }
    if (IN(6)) REP(6) {
        asm volatile("s_waitcnt vmcnt(0)" ::: "memory"); __syncthreads();
        if (tid == 0) { __builtin_amdgcn_fence(__ATOMIC_ACQUIRE, "agent"); asm volatile("s_waitcnt vmcnt(0)" ::: "memory"); }
#pragma unroll
        for (int j = 0; j < 8; ++j) { const int c = tid + NTHREADS * j, half = c >> 11, row = (c >> 4) & 127, part = c & 15;
            *(LAS v4u*)(lds + half * TK_HALF + row * TK_KROW + part * 16) = *(const v4u*)((half ? K2B : K1B) + row * 128 + part * 8); }
        __syncthreads();
        for (int L = bx; L < (MTOK / 256) * (D_MODEL / 256); L += G) {
            constexpr int nM = MTOK / 256, nN = D_MODEL / 256, nwg = nM * nN;
            int wgid = L; { const int q = nwg / 8, r = nwg % 8, xcd = wgid % 8, off = wgid / 8; wgid = (xcd < r ? xcd * (q + 1) : r * (q + 1) + (xcd - r) * q) + off; }
            const int nig = 8 * nN, gid = wgid / nig, fm = gid * 8, gsz = (nM - fm) < 8 ? (nM - fm) : 8;
            const int pm = fm + ((wgid % nig) % gsz), pn = (wgid % nig) / gsz;
            for (int j = wave; j < 16; j += NWAVES) topk_item((pm * 16 + j) * PHEADS + pn, QP, lds, lds + 2 * TK_HALF + wave * 2048, EIDX, GATE, lane);
        }
        __syncthreads();
    }
    SEAM(6);
    if (IN(7)) REP(7) { const int cls = bx & 7, rk = bx >> 3;
        for (int sub = 0; sub < 2; ++sub) pu_sweep<0>(2 * cls + sub, rk * NWAVES + wave, (G >> 3) * NWAVES, X1B, EIDX, U8, HP, lane); }
    SEAM(7);
    if (IN(8)) REP(8) {
        for (int e0 = (gw * 64 + lane) * 4; e0 < MTOK * EPT; e0 += NGW * 64 * 8) {
            f32x4 h[2]; v4u id[2]; f32x4 gt[2];
#pragma unroll
            for (int u2 = 0; u2 < 2; ++u2) { const int e = e0 + u2 * NGW * 64 * 4; h[u2] = (f32x4){0.f, 0.f, 0.f, 0.f}; id[u2] = *(const v4u*)(EIDX + e); gt[u2] = *(const f32x4*)(GATE + e);
#pragma unroll
                for (int sl = 0; sl < 16; ++sl) h[u2] += *(const f32x4*)(HP + (size_t)sl * MTOK * EPT + e); }
            float su[2][4], sv[2][4];
#pragma unroll
            for (int u2 = 0; u2 < 2; ++u2)
#pragma unroll
                for (int i = 0; i < 4; ++i) { su[u2][i] = SU[id[u2][i]]; sv[u2][i] = SV[id[u2][i]]; }
#pragma unroll
            for (int u2 = 0; u2 < 2; ++u2) { const int e = e0 + u2 * NGW * 64 * 4; f32x4 a;
#pragma unroll
                for (int i = 0; i < 4; ++i) a[i] = gt[u2][i] * gelu_erf(h[u2][i] * su[u2][i]) * sv[u2][i];
                *(f32x4*)(AV + e) = a; }
        } }
    SEAM(8);
    if (IN(9)) REP(9) { const int cls = bx & 7, rk = bx >> 3;
        for (int sub = 0; sub < 2; ++sub) pv_sweep(2 * cls + sub, rk * NWAVES + wave, (G >> 3) * NWAVES, X1, EIDX, AV, V8, Y2, STAT, lane); }
    SEAM(9);
    if (IN(10)) REP(10) { for (int t = gw; t < MTOK; t += NGW) ln2_row(t, Y2, STAT, ln2_g, ln2_b, args.out, lane); }
#ifdef PROBE_P2PART
    if (lo <= 11 && 11 < hi) {
        if (PROBE_P2PART & 1) for (int it = vcu; it < 256; it += G) swa_item(lds, it, Q, Kb, Vb, sinks, CONCAT, tid, wave, lane);
        if (PROBE_P2PART & 2) for (int it = vcu; it < 256; it += G) mem_item(lds, it, QM, KVM, CONCAT, tid, wave, lane);
        if (PROBE_P2PART & 4) for (int it = gw; it < (MTOK / 16) * 4; it += NGW) pool_item(lds + wave * POOL_LDS_PER_WAVE, it, POOLV, WPT, pool_scale, CONCAT, lane);
    }
#endif
#ifdef PROBE_PHASE11
    if (lo <= 11 && 11 < hi) { const int cls = bx & 7, rk = bx >> 3;
        for (int sub = 0; sub < 2; ++sub) pu_sweep<1>(2 * cls + sub, rk * NWAVES + wave, (G >> 3) * NWAVES, X1B, EIDX, U8, HP, lane); }
#endif
#undef IN
#undef SEAM
}
#undef P_IN(T,
#undef P_WS(T,
#undef x_in
#undef mem_in
#undef positions
#undef w_in
#undef w_mem_kv
#undef w_pool
#undef pool_scale
#undef sinks
#undef w_out
#undef ln1_g
#undef ln1_b
#undef w_peer_q
#undef sk1
#undef sk2
#undef eu
#undef ev
#undef ln2_g
#undef ln2_b
#undef WINT
#undef WKVT
#undef WOT
#undef WQT
#undef WPT
#undef K1B
#undef K2B
#undef ROPE
#undef XB
#undef X1B
#undef MEMB
#undef KVM
#undef POOLV
#undef Q
#undef Kb
#undef Vb
#undef QM
#undef CONCAT
#undef Y1
#undef X1
#undef QP
#undef EIDX
#undef GATE
#undef U8
#undef V8
#undef SU
#undef SV
#undef HP
#undef AV
#undef STAT
#undef Y2

#if NAIVE_MASK != 0
__device__ __forceinline__ float toF(float v) { return v; }
__device__ __forceinline__ float toF(bf16_t v) { return bf2f(v); }

struct NvEpiF32 { float* C; int ldc, pad; __device__ void operator()(int r, int c, float v) const { C[(size_t)r * ldc + c] = v; } };
struct NvEpiBf { bf16_t* C; int ldc, pad; __device__ void operator()(int r, int c, float v) const { C[(size_t)r * ldc + c] = f2bf(v); } };
struct NvEpiY1 { const float* x; float* y; __device__ void operator()(int r, int c, float v) const { y[(size_t)r * D_MODEL + c] = ALPHA * x[(size_t)r * D_MODEL + c] + v; } };

template <class TA, class Epi>
__global__ void __launch_bounds__(256) nv_gemm(const TA* __restrict__ A, const float* __restrict__ B, int M, int N, int K, Epi epi) {
    __shared__ float As[16][65];
    __shared__ float Bs[16][64];
    const int tx = threadIdx.x & 15, ty = threadIdx.x >> 4;
    const int m0 = blockIdx.y * 64, n0 = blockIdx.x * 64;
    float acc[4][4];
#pragma unroll
    for (int i = 0; i < 4; ++i)
#pragma unroll
        for (int j = 0; j < 4; ++j) acc[i][j] = 0.f;
    for (int k0 = 0; k0 < K; k0 += 16) {
        for (int i = threadIdx.x; i < 1024; i += 256) { const int r = i >> 4, c = i & 15; As[c][r] = toF(A[(size_t)(m0 + r) * K + k0 + c]); }
        for (int i = threadIdx.x; i < 1024; i += 256) { const int r = i >> 6, c = i & 63; Bs[r][c] = B[(size_t)(k0 + r) * N + n0 + c]; }
        __syncthreads();
#pragma unroll
        for (int kk = 0; kk < 16; ++kk) {
            float a[4], b[4];
#pragma unroll
            for (int i = 0; i < 4; ++i) { a[i] = As[kk][ty * 4 + i]; b[i] = Bs[kk][tx * 4 + i]; }
#pragma unroll
            for (int i = 0; i < 4; ++i)
#pragma unroll
                for (int j = 0; j < 4; ++j) acc[i][j] += a[i] * b[j];
        }
        __syncthreads();
    }
#pragma unroll
    for (int i = 0; i < 4; ++i)
#pragma unroll
        for (int j = 0; j < 4; ++j) epi(m0 + ty * 4 + i, n0 + tx * 4 + j, acc[i][j]);
}

__global__ void nv_post1(const float* __restrict__ H, const int* __restrict__ positions, float* POOLV, bf16_t* Q, bf16_t* Kb, bf16_t* Vb, bf16_t* QM) {
    const size_t gid = (size_t)blockIdx.x * blockDim.x + threadIdx.x;
    if (gid >= (size_t)MTOK * IN_W) return;
    const int t = (int)(gid / IN_W), col = (int)(gid % IN_W);
    const float* hr = H + (size_t)t * IN_W;
    const float v = hr[col];
    if (col < POOL_W) { POOLV[(size_t)t * POOL_W + col] = v; return; }
    if (col < POOL_W + SWA_W + KV_W) {
        const bool isq = col < POOL_W + SWA_W;
        const int c = isq ? col - POOL_W : col - POOL_W - SWA_W;
        const int d = c & 63;
        float o = v;
        if (d < 16) {
            const int j = d & 7; float cs, sn; rope_cs(positions[t], j, cs, sn);
            if (d < 8) o = v * cs - hr[col + 8] * sn; else o = v * cs + hr[col - 8] * sn;
        }
        if (isq) Q[(size_t)t * SWA_W + c] = f2bf(o); else Kb[(size_t)t * KV_W + c] = f2bf(o);
        return;
    }
    if (col < POOL_W + SWA_W + 2 * KV_W) { Vb[(size_t)t * KV_W + (col - POOL_W - SWA_W - KV_W)] = f2bf(v); return; }
    QM[(size_t)t * MEM_W + (col - POOL_W - SWA_W - 2 * KV_W)] = f2bf(v);
}
__global__ void nv_cvt_bf16(const float* __restrict__ in, bf16_t* out, size_t n) {
    const size_t gid = (size_t)blockIdx.x * blockDim.x + threadIdx.x;
    if (gid < n) out[gid] = f2bf(in[gid]);
}
__global__ void nv_pool1(const float* __restrict__ POOLV, float* PS) {
    const size_t gid = (size_t)blockIdx.x * blockDim.x + threadIdx.x;
    if (gid >= (size_t)MTOK * POOL_W) return;
    const int t = (int)(gid / POOL_W), ch = (int)(gid % POOL_W);
    const int g = ch >> 7, w = 2 << g, s = t & (SEQ - 1);
    const int cnt = (s + 1) < w ? (s + 1) : w;
    float sum = 0.f;
    for (int i = 0; i < cnt; ++i) sum += POOLV[(size_t)(t - i) * POOL_W + ch];
    PS[gid] = sum / (float)cnt - POOLV[gid];
}
__global__ void nv_pool2(const float* __restrict__ PS, const float* __restrict__ w_pool, const float* __restrict__ pool_scale, bf16_t* CONCAT) {
    const size_t gid = (size_t)blockIdx.x * blockDim.x + threadIdx.x;
    if (gid >= (size_t)MTOK * POOL_W) return;
    const int t = (int)(gid / POOL_W), ch = (int)(gid % POOL_W);
    const int g = ch >> 7, d = ch & 127;
    const float* p = PS + (size_t)t * POOL_W + g * 128;
    const float* w = w_pool + (size_t)g * 128 * 128 + d;
    float y = 0.f;
    for (int c = 0; c < 128; ++c) y += p[c] * w[(size_t)c * 128];
    CONCAT[(size_t)t * D_MODEL + ch] = f2bf(y * pool_scale[ch]);
}
__global__ void __launch_bounds__(256) nv_swa(const bf16_t* __restrict__ Q, const bf16_t* __restrict__ Kb, const bf16_t* __restrict__ Vb, const float* __restrict__ sinks, bf16_t* CONCAT) {
    const int wv = (int)((blockIdx.x * 256 + threadIdx.x) >> 6), lane = threadIdx.x & 63;
    if (wv >= MTOK * NHEAD) return;
    const int t = wv / NHEAD, h = wv % NHEAD, kvh = h >> 2, s = t & (SEQ - 1), tb = t - s;
    const float q = bf2f(Q[(size_t)t * SWA_W + h * HD + lane]);
    float m = sinks[h], l = 1.0f, o = 0.f;
    const int k0 = s - (WINDOW - 1) < 0 ? 0 : s - (WINDOW - 1);
    for (int kk = k0; kk <= s; ++kk) {
        const size_t kt = (size_t)(tb + kk);
        const float sc = wave_sum(q * bf2f(Kb[kt * KV_W + kvh * HD + lane])) * 0.125f;
        const float mn = fmaxf(m, sc), r = expf(m - mn), p = expf(sc - mn);
        l = l * r + p; o = o * r + p * bf2f(Vb[kt * KV_W + kvh * HD + lane]); m = mn;
    }
    CONCAT[(size_t)t * D_MODEL + POOL_W + h * HD + lane] = f2bf(o / l);
}
__global__ void __launch_bounds__(256) nv_mem(const bf16_t* __restrict__ QM, const bf16_t* __restrict__ KVM, bf16_t* CONCAT) {
    const int wv = (int)((blockIdx.x * 256 + threadIdx.x) >> 6), lane = threadIdx.x & 63;
    if (wv >= MTOK * MHEADS) return;
    const int t = wv / MHEADS, hm = wv % MHEADS, b = t / SEQ;
    const float q0 = bf2f(QM[(size_t)t * MEM_W + hm * MHD + lane]), q1 = bf2f(QM[(size_t)t * MEM_W + hm * MHD + 64 + lane]);
    float m = -1e30f, l = 0.f, o0 = 0.f, o1 = 0.f;
    const float scale = 0.08838834764831845f;
    for (int j = 0; j < MEM_LEN; ++j) {
        const bf16_t* kr = KVM + (size_t)(b * MEM_LEN + j) * (2 * MEM_W) + hm * MHD;
        const bf16_t* vr = kr + MEM_W;
        const float sc = wave_sum(q0 * bf2f(kr[lane]) + q1 * bf2f(kr[64 + lane])) * scale;
        const float mn = fmaxf(m, sc), r = expf(m - mn), p = expf(sc - mn);
        l = l * r + p; o0 = o0 * r + p * bf2f(vr[lane]); o1 = o1 * r + p * bf2f(vr[64 + lane]); m = mn;
    }
    bf16_t* orow = CONCAT + (size_t)t * D_MODEL + POOL_W + SWA_W + hm * MHD;
    orow[lane] = f2bf(o0 / l); orow[64 + lane] = f2bf(o1 / l);
}
__global__ void __launch_bounds__(256) nv_ln(const float* __restrict__ in, const float* __restrict__ g, const float* __restrict__ bta, float* outf, bf16_t* outb) {
    const int row = (int)((blockIdx.x * 256 + threadIdx.x) >> 6), lane = threadIdx.x & 63;
    if (row >= MTOK) return;
    const float* r = in + (size_t)row * D_MODEL;
    float v[32]; float s = 0.f;
#pragma unroll
    for (int i = 0; i < 32; ++i) { v[i] = r[lane + 64 * i]; s += v[i]; }
    const float mean = wave_sum(s) * (1.f / D_MODEL); float q = 0.f;
#pragma unroll
    for (int i = 0; i < 32; ++i) { v[i] -= mean; q += v[i] * v[i]; }
    const float rstd = 1.0f / sqrtf(wave_sum(q) * (1.f / D_MODEL) + LN_EPS);
#pragma unroll
    for (int i = 0; i < 32; ++i) {
        const int c = lane + 64 * i; const float y = v[i] * rstd * g[c] + bta[c];
        if (outf) outf[(size_t)row * D_MODEL + c] = y;
        if (outb) outb[(size_t)row * D_MODEL + c] = f2bf(y);
    }
}
__global__ void __launch_bounds__(32) nv_topk(const bf16_t* __restrict__ QP, const float* __restrict__ K1, const float* __restrict__ K2, int* EIDX, float* GATE) {
    __shared__ float sc[256][32];
    __shared__ float lv[32][32];
    __shared__ int li[32][32];
    const int tid = threadIdx.x, gid = blockIdx.x * 32 + tid;
    const int t = gid / PHEADS, h = gid % PHEADS;
    const bf16_t* q = QP + (size_t)t * D_MODEL + h * 256;
    for (int half = 0; half < 2; ++half) {
        const float* Kk = half ? K2 : K1;
        for (int k = 0; k < NKEYS; ++k) {
            float a = 0.f;
            for (int c = 0; c < 128; ++c) a += bf2f(q[half * 128 + c]) * Kk[k * 128 + c];
            sc[half * 128 + k][tid] = a;
        }
        for (int r = 0; r < TOPK; ++r) {
            float best = -INFINITY; int bi = 0;
            for (int k = 0; k < NKEYS; ++k) { const float v = sc[half * 128 + k][tid]; if (v > best) { best = v; bi = k; } }
            lv[half * 16 + r][tid] = best; li[half * 16 + r][tid] = bi; sc[half * 128 + bi][tid] = -INFINITY;
        }
    }
    for (int a = 0; a < 16; ++a) for (int b = 0; b < 16; ++b) sc[a * 16 + b][tid] = lv[a][tid] + lv[16 + b][tid];
    float mx = 0.f, den = 0.f;
    float tv[16]; int ti[16];
#pragma unroll
    for (int r = 0; r < TOPK; ++r) {
        float best = -INFINITY; int bi = 0;
        for (int k = 0; k < 256; ++k) { const float v = sc[k][tid]; if (v > best) { best = v; bi = k; } }
        sc[bi][tid] = -INFINITY;
        if (r == 0) mx = best;
        tv[r] = expf(best - mx); den += tv[r]; ti[r] = li[bi >> 4][tid] * NKEYS + li[16 + (bi & 15)][tid];
    }
#pragma unroll
    for (int r = 0; r < TOPK; ++r) { EIDX[(size_t)t * EPT + h * TOPK + r] = ti[r]; GATE[(size_t)t * EPT + h * TOPK + r] = tv[r] / den; }
}
__global__ void __launch_bounds__(256) nv_gather(const float* __restrict__ X1, const int* __restrict__ EIDX, const float* __restrict__ GATE, const float* __restrict__ EU, const float* __restrict__ EV,
                                                  const float* __restrict__ g, const float* __restrict__ bta, float* out) {
    const int t = (int)((blockIdx.x * 256 + threadIdx.x) >> 6), lane = threadIdx.x & 63;
    if (t >= MTOK) return;
    float x[32], acc[32];
#pragma unroll
    for (int i = 0; i < 32; ++i) { x[i] = X1[(size_t)t * D_MODEL + lane + 64 * i]; acc[i] = 0.f; }
    for (int e = 0; e < EPT; ++e) {
        const int id = EIDX[(size_t)t * EPT + e]; const float gt = GATE[(size_t)t * EPT + e];
        const float* u = EU + (size_t)id * D_MODEL; const float* vv = EV + (size_t)id * D_MODEL;
        float p = 0.f;
#pragma unroll
        for (int i = 0; i < 32; ++i) p += x[i] * u[lane + 64 * i];
        const float a = gt * gelu_erf(wave_sum(p));
#pragma unroll
        for (int i = 0; i < 32; ++i) acc[i] += a * vv[lane + 64 * i];
    }
    float s = 0.f;
#pragma unroll
    for (int i = 0; i < 32; ++i) { acc[i] = ALPHA * x[i] + acc[i]; s += acc[i]; }
    const float mean = wave_sum(s) * (1.f / D_MODEL); float q = 0.f;
#pragma unroll
    for (int i = 0; i < 32; ++i) { acc[i] -= mean; q += acc[i] * acc[i]; }
    const float rstd = 1.0f / sqrtf(wave_sum(q) * (1.f / D_MODEL) + LN_EPS);
#pragma unroll
    for (int i = 0; i < 32; ++i) { const int c = lane + 64 * i; out[(size_t)t * D_MODEL + c] = acc[i] * rstd * g[c] + bta[c]; }
}

#endif
extern "C" void kernel_launch(void* const* d_in, const int* in_sizes, int n_in, void* d_out, int out_size, void* d_ws, size_t ws_size, hipStream_t stream) {
    static int grid = 0;
    if (grid == 0) {
        if (n_in != 18 || in_sizes[0] != MTOK * D_MODEL || out_size != MTOK * D_MODEL || ws_size < WS_END) {
            fprintf(stderr, "kernel_launch: unexpected shapes (n_in %d, in0 %d, out %d, ws %zu)\n", n_in, n_in > 0 ? in_sizes[0] : -1, out_size, ws_size); grid = -1; return; }
        int dev = 0, cus = 0, per_cu = 0;
        if (hipGetDevice(&dev) != hipSuccess || hipDeviceGetAttribute(&cus, hipDeviceAttributeMultiprocessorCount, dev) != hipSuccess) { fprintf(stderr, "kernel_launch: device query failed\n"); grid = -1; return; }
        if (hipFuncSetAttribute((const void*)mega_fwd, hipFuncAttributeMaxDynamicSharedMemorySize, LDS_BYTES) != hipSuccess) { fprintf(stderr, "kernel_launch: hipFuncSetAttribute failed\n"); grid = -1; return; }
        if (hipOccupancyMaxActiveBlocksPerMultiprocessor(&per_cu, (const void*)mega_fwd, NTHREADS, LDS_BYTES) != hipSuccess || per_cu < 1) {
            fprintf(stderr, "kernel_launch: occupancy query reports %d workgroups per CU\n", per_cu); (void)hipGetLastError(); grid = -1; return; }
        grid = cus;
    }
    if (grid < 0) return;
    unsigned char* ws = (unsigned char*)d_ws;
    (void)hipMemsetAsync(ws + WS_CTL, 0, 1 * MiB, stream);
    Args a{};
    for (int i = 0; i < 18; ++i) a.in[i] = d_in[i];
    a.out = (float*)d_out; a.ws = ws;
#if NAIVE_MASK != 0
    const float* x = (const float*)d_in[0]; const float* mem = (const float*)d_in[1]; const int* positions = (const int*)d_in[2];
    const float* w_in = (const float*)d_in[3]; const float* w_mem_kv = (const float*)d_in[4]; const float* w_pool = (const float*)d_in[5];
    const float* pool_scale = (const float*)d_in[6]; const float* sinks = (const float*)d_in[7]; const float* w_out = (const float*)d_in[8];
    const float* ln1_g = (const float*)d_in[9]; const float* ln1_b = (const float*)d_in[10]; const float* w_peer_q = (const float*)d_in[11];
    const float* sk1 = (const float*)d_in[12]; const float* sk2 = (const float*)d_in[13]; const float* eu = (const float*)d_in[14]; const float* ev = (const float*)d_in[15];
    const float* ln2_g = (const float*)d_in[16]; const float* ln2_b = (const float*)d_in[17];
    float* out = (float*)d_out;
    float* POOLV = (float*)(ws + WS_POOLV); bf16_t* Q = (bf16_t*)(ws + WS_Q); bf16_t* Kb = (bf16_t*)(ws + WS_K); bf16_t* Vb = (bf16_t*)(ws + WS_V); bf16_t* QM = (bf16_t*)(ws + WS_QM);
    bf16_t* KVM = (bf16_t*)(ws + WS_KVM); bf16_t* CONCAT = (bf16_t*)(ws + WS_CONCAT); float* Y1 = (float*)(ws + WS_Y1); float* X1 = (float*)(ws + WS_X1); bf16_t* X1B = (bf16_t*)(ws + WS_X1B);
    bf16_t* QP = (bf16_t*)(ws + WS_QP); int* EIDX = (int*)(ws + WS_EIDX); float* GATE = (float*)(ws + WS_GATE);
    float* NVH = (float*)(ws + WS_NV_H); float* NVPS = (float*)(ws + WS_NV_PS); float* NVKVM = (float*)(ws + WS_NV_KVM);
#endif
    int li = 0;
    for (int p = 0; p < N_PHASES;) {
#if NAIVE_MASK != 0
        if ((NAIVE_MASK >> p) & 1) {
            switch (p) {
            case 1:
                nv_gemm<float, NvEpiF32><<<dim3(IN_W / 64, MTOK / 64), 256, 0, stream>>>(x, w_in, MTOK, IN_W, D_MODEL, NvEpiF32{NVH, IN_W, 0});
                nv_gemm<float, NvEpiF32><<<dim3(2 * MEM_W / 64, MMEM / 64), 256, 0, stream>>>(mem, w_mem_kv, MMEM, 2 * MEM_W, D_MODEL, NvEpiF32{NVKVM, 2 * MEM_W, 0});
                nv_post1<<<(unsigned)(((size_t)MTOK * IN_W + 255) / 256), 256, 0, stream>>>(NVH, positions, POOLV, Q, Kb, Vb, QM);
                nv_cvt_bf16<<<(MMEM * 2 * MEM_W + 255) / 256, 256, 0, stream>>>(NVKVM, KVM, (size_t)MMEM * 2 * MEM_W);
                break;
            case 2:
                nv_pool1<<<MTOK * POOL_W / 256, 256, 0, stream>>>(POOLV, NVPS);
                nv_pool2<<<MTOK * POOL_W / 256, 256, 0, stream>>>(NVPS, w_pool, pool_scale, CONCAT);
                nv_swa<<<MTOK * NHEAD / 4, 256, 0, stream>>>(Q, Kb, Vb, sinks, CONCAT);
                nv_mem<<<MTOK * MHEADS / 4, 256, 0, stream>>>(QM, KVM, CONCAT);
                break;
            case 3: nv_gemm<bf16_t, NvEpiY1><<<dim3(D_MODEL / 64, MTOK / 64), 256, 0, stream>>>(CONCAT, w_out, MTOK, D_MODEL, D_MODEL, NvEpiY1{x, Y1}); break;
            case 4: nv_ln<<<MTOK / 4, 256, 0, stream>>>(Y1, ln1_g, ln1_b, X1, X1B); break;
            case 5: nv_gemm<float, NvEpiBf><<<dim3(D_MODEL / 64, MTOK / 64), 256, 0, stream>>>(X1, w_peer_q, MTOK, D_MODEL, D_MODEL, NvEpiBf{QP, D_MODEL, 0}); break;
            case 6: nv_topk<<<MTOK * PHEADS / 32, 32, 0, stream>>>(QP, sk1, sk2, EIDX, GATE); break;
            case 7: nv_gather<<<MTOK / 4, 256, 0, stream>>>(X1, EIDX, GATE, eu, ev, ln2_g, ln2_b, out); p = N_PHASES - 1; break;
            default: break;
            }
            ++p; continue;
        }
#endif
        int q = p;
        while (q < N_PHASES && !((NAIVE_MASK >> q) & 1)) ++q;
        a.ph_lo = p; a.ph_hi = q; a.li = li++;
        hipLaunchKernelGGL(mega_fwd, dim3(grid), dim3(NTHREADS), LDS_BYTES, stream, a);
        const hipError_t le = hipPeekAtLastError();
        if (le != hipSuccess) { fprintf(stderr, "kernel_launch: launch failed: %s\n", hipGetErrorName(le)); break; }
        p = q;
    }
#ifdef PROBE_EXTRA_LO
    a.ph_lo = PROBE_EXTRA_LO; a.ph_hi = PROBE_EXTRA_HI; a.li = li++;
    hipLaunchKernelGGL(mega_fwd, dim3(grid), dim3(NTHREADS), LDS_BYTES, stream, a);
#endif
}
```
